# Optimizing an MI355X kernel written in HIP

```python
import math
import jax, jax.numpy as jnp
from jax import lax
import numpy as np

D_MODEL = 1024
BATCH = 4
SEQ = 8192
DEPTH = 2

BLOCK = 128
MLA_HEADS = 8
MLA_NOPE = 64
MLA_ROPE = 32
MLA_V = 64
MLA_Q_RANK = 256
MLA_KV_RANK = 128
ROPE_BASE = 10000.0
CONV_CH = 256
CONV_GROUPS = 4
CONV_WIDTH = 31
SWA_HEADS = 4
SWA_KV_HEADS = 2
SWA_HEAD_DIM = 64
WINDOW = 128
MLA_OUT = MLA_HEADS * MLA_V
SWA_OUT = SWA_HEADS * SWA_HEAD_DIM
D_MIX = MLA_OUT + CONV_CH + SWA_OUT
IN_SPLITS = (MLA_Q_RANK, MLA_KV_RANK, MLA_ROPE, 2 * CONV_CH,
             SWA_HEADS * SWA_HEAD_DIM, SWA_KV_HEADS * SWA_HEAD_DIM, SWA_KV_HEADS * SWA_HEAD_DIM)
D_IN = 256 + 128 + 32 + 512 + 256 + 128 + 128
N_SUBKEYS = 128
N_EXPERTS = N_SUBKEYS * N_SUBKEYS
PEER_HEADS = 8
PEER_QDIM = 256
PEER_TOPK = 16
DN_ALPHA = (2 * DEPTH) ** 0.25
DN_BETA = (8 * DEPTH) ** -0.25
EPS = 1e-6
ADA_SCALE = 0.1

kernel_name = "hybrid_mla_conformer_swa_peer_deepnorm"


def layer_norm(x, g, b):
    xf = x.astype(jnp.float32)
    mu = jnp.mean(xf, axis=-1, keepdims=True)
    var = jnp.mean(jnp.square(xf - mu), axis=-1, keepdims=True)
    return ((xf - mu) * lax.rsqrt(var + EPS)).astype(x.dtype) * g + b


def rms_norm(x, g):
    xf = x.astype(jnp.float32)
    return (xf * lax.rsqrt(jnp.mean(xf * xf, axis=-1, keepdims=True) + EPS)).astype(x.dtype) * g


def rope_tables(seq, dim, dtype):
    inv = 1.0 / (ROPE_BASE ** (jnp.arange(0, dim, 2, dtype=jnp.float32) / dim))
    ang = jnp.arange(seq, dtype=jnp.float32)[:, None] * inv[None, :]
    return jnp.cos(ang).astype(dtype), jnp.sin(ang).astype(dtype)


def apply_rope(t, cos, sin):
    half = t.shape[-1] // 2
    t1, t2 = t[..., :half], t[..., half:]
    return jnp.concatenate([t1 * cos - t2 * sin, t1 * sin + t2 * cos], axis=-1)


def mla_attention(c_q, c_kv, k_rope, g_q, w_uq, g_kv, w_ukv, cos, sin):
    B, S, _ = c_q.shape
    q = (rms_norm(c_q, g_q) @ w_uq).reshape(B, S, MLA_HEADS, MLA_NOPE + MLA_ROPE)
    q_nope = q[..., :MLA_NOPE]
    q_rope = apply_rope(q[..., MLA_NOPE:], cos[:, None, :], sin[:, None, :])
    k_rope = apply_rope(k_rope, cos, sin)
    kv = (rms_norm(c_kv, g_kv) @ w_ukv).reshape(B, S, MLA_HEADS, MLA_NOPE + MLA_V)
    k_nope, v = kv[..., :MLA_NOPE], kv[..., MLA_NOPE:]
    scale = (MLA_NOPE + MLA_ROPE) ** -0.5
    nb = S // BLOCK
    qn_b = q_nope.reshape(B, nb, BLOCK, MLA_HEADS, MLA_NOPE).transpose(1, 0, 2, 3, 4)
    qr_b = q_rope.reshape(B, nb, BLOCK, MLA_HEADS, MLA_ROPE).transpose(1, 0, 2, 3, 4)
    kpos = jnp.arange(S)

    def one_block(args):
        qn, qr, n = args
        s = (jnp.einsum('bqhd,bkhd->bhqk', qn, k_nope)
             + jnp.einsum('bqhr,bkr->bhqk', qr, k_rope)).astype(jnp.float32) * scale
        qpos = n * BLOCK + jnp.arange(BLOCK)
        s = jnp.where(kpos[None, :] <= qpos[:, None], s, -jnp.inf)
        p = jax.nn.softmax(s, axis=-1).astype(v.dtype)
        return jnp.einsum('bhqk,bkhd->bqhd', p, v)

    out = lax.map(one_block, (qn_b, qr_b, jnp.arange(nb)))
    return out.transpose(1, 0, 2, 3, 4).reshape(B, S, MLA_OUT)


def conformer_conv(u, w_dw, b_dw, g_ln, b_ln, w_pw, b_pw):
    a, gate = jnp.split(u, 2, axis=-1)
    h = a * jax.nn.sigmoid(gate)
    h = lax.conv_general_dilated(h, w_dw[:, None, :], window_strides=(1,),
                                 padding=[(CONV_WIDTH - 1, 0)],
                                 dimension_numbers=('NWC', 'WIO', 'NWC'),
                                 feature_group_count=CONV_CH) + b_dw
    h = jax.nn.silu(layer_norm(h, g_ln, b_ln))
    return h @ w_pw + b_pw


def swa_attention(q, k, v, sinks):
    B, S, _ = q.shape
    nb = S // BLOCK
    G = SWA_HEADS // SWA_KV_HEADS
    q = q.reshape(B, nb, BLOCK, SWA_KV_HEADS, G, SWA_HEAD_DIM)
    k = k.reshape(B, nb, BLOCK, SWA_KV_HEADS, SWA_HEAD_DIM)
    v = v.reshape(B, nb, BLOCK, SWA_KV_HEADS, SWA_HEAD_DIM)

    def with_prev(t):
        prev = jnp.pad(t, ((0, 0), (1, 0), (0, 0), (0, 0), (0, 0)))[:, :-1]
        return jnp.concatenate([prev, t], axis=2)

    kb, vb = with_prev(k), with_prev(v)
    s = jnp.einsum('bnqhgd,bnkhd->bnhgqk', q, kb).astype(jnp.float32) * (SWA_HEAD_DIM ** -0.5)
    i = jnp.arange(BLOCK)[:, None]
    j = jnp.arange(2 * BLOCK)[None, :]
    rel = i + BLOCK - j
    band = (rel >= 0) & (rel < WINDOW)
    valid = (jnp.arange(nb)[:, None, None] > 0) | (j >= BLOCK)[None]
    mask = band[None] & valid
    s = jnp.where(mask[None, :, None, None], s, -jnp.inf)
    sink = sinks.astype(jnp.float32).reshape(SWA_KV_HEADS, G)[None, None, :, :, None, None]
    m = jnp.maximum(jnp.max(s, axis=-1, keepdims=True), sink)
    p = jnp.exp(s - m)
    p = (p / (jnp.sum(p, axis=-1, keepdims=True) + jnp.exp(sink - m))).astype(vb.dtype)
    o = jnp.einsum('bnhgqk,bnkhd->bnqhgd', p, vb)
    return o.reshape(B, S, SWA_OUT)


def peer(h, w_pq, sub_keys, u_tab, v_tab):
    B, S, D = h.shape
    q = (h @ w_pq).reshape(B, S, PEER_HEADS, 2, PEER_QDIM // 2)
    sc = jnp.einsum('bshpd,hpnd->bshpn', q, sub_keys).astype(jnp.float32)
    s1, i1 = lax.top_k(sc[..., 0, :], PEER_TOPK)
    s2, i2 = lax.top_k(sc[..., 1, :], PEER_TOPK)
    cand = (s1[..., :, None] + s2[..., None, :]).reshape(B, S, PEER_HEADS, PEER_TOPK * PEER_TOPK)
    cidx = (i1[..., :, None] * N_SUBKEYS + i2[..., None, :]).reshape(B, S, PEER_HEADS, PEER_TOPK * PEER_TOPK)
    top_s, pos = lax.top_k(cand, PEER_TOPK)
    eidx = jnp.take_along_axis(cidx, pos, axis=-1)
    gate = jax.nn.softmax(top_s, axis=-1).astype(h.dtype)
    nb = S // BLOCK
    HK = PEER_HEADS * PEER_TOPK
    hb = h.reshape(B, nb, BLOCK, D).transpose(1, 0, 2, 3)
    eb = eidx.reshape(B, nb, BLOCK, HK).transpose(1, 0, 2, 3)
    gb = gate.reshape(B, nb, BLOCK, HK).transpose(1, 0, 2, 3)

    def one_block(args):
        xb, e, g = args
        a = jax.nn.gelu(jnp.einsum('bqd,bqkd->bqk', xb, u_tab[e]), approximate=False)
        return jnp.einsum('bqk,bqkd->bqd', g * a, v_tab[e])

    out = lax.map(one_block, (hb, eb, gb))
    return out.transpose(1, 0, 2, 3).reshape(B, S, D)


def setup_inputs(seed: int = 0) -> dict:
    key = jax.random.key(seed)
    ks = jax.random.split(key, 32)
    f32 = jnp.float32
    L, D = DEPTH, D_MODEL

    def nrm(k, shape, scale):
        return jax.random.normal(k, shape, f32) * scale

    def gain(k, shape):
        return 1.0 + 0.02 * jax.random.normal(k, shape, f32)

    return {
        "x": nrm(ks[0], (BATCH, SEQ, D), 1.0),
        "c": nrm(ks[1], (BATCH, D), 1.0),
        "w_ada": nrm(ks[2], (L, D, 6 * D), ADA_SCALE * D ** -0.5),
        "b_ada": nrm(ks[3], (L, 6 * D), 0.02),
        "w_in": nrm(ks[4], (L, D, D_IN), D ** -0.5),
        "g_q": gain(ks[5], (L, MLA_Q_RANK)),
        "w_uq": nrm(ks[6], (L, MLA_Q_RANK, MLA_HEADS * (MLA_NOPE + MLA_ROPE)), MLA_Q_RANK ** -0.5),
        "g_kv": gain(ks[7], (L, MLA_KV_RANK)),
        "w_ukv": nrm(ks[8], (L, MLA_KV_RANK, MLA_HEADS * (MLA_NOPE + MLA_V)), MLA_KV_RANK ** -0.5),
        "w_dw": nrm(ks[9], (L, CONV_WIDTH, CONV_CH), CONV_WIDTH ** -0.5),
        "b_dw": nrm(ks[10], (L, CONV_CH), 0.02),
        "g_conv": gain(ks[11], (L, CONV_CH)),
        "b_conv": nrm(ks[12], (L, CONV_CH), 0.02),
        "w_pw": nrm(ks[13], (L, CONV_CH, CONV_CH), CONV_CH ** -0.5),
        "b_pw": nrm(ks[14], (L, CONV_CH), 0.02),
        "sinks": nrm(ks[15], (L, SWA_HEADS), 1.0),
        "w_o": nrm(ks[16], (L, D_MIX, D), DN_BETA * D_MIX ** -0.5),
        "g_ln1": gain(ks[17], (L, D)),
        "b_ln1": nrm(ks[18], (L, D), 0.02),
        "w_pq": nrm(ks[19], (L, D, PEER_HEADS * PEER_QDIM), D ** -0.5),
        "sub_keys": nrm(ks[20], (L, PEER_HEADS, 2, N_SUBKEYS, PEER_QDIM // 2), (PEER_QDIM // 2) ** -0.5),
        "u_tab": nrm(ks[21], (L, N_EXPERTS, D), D ** -0.5),
        "v_tab": nrm(ks[22], (L, N_EXPERTS, D), DN_BETA),
        "g_ln2": gain(ks[23], (L, D)),
        "b_ln2": nrm(ks[24], (L, D), 0.02),
    }


def reference(x, c, w_ada, b_ada, w_in, g_q, w_uq, g_kv, w_ukv, w_dw, b_dw, g_conv, b_conv,
              w_pw, b_pw, sinks, w_o, g_ln1, b_ln1, w_pq, sub_keys, u_tab, v_tab, g_ln2, b_ln2):
    B, S, _ = x.shape
    cos, sin = rope_tables(S, MLA_ROPE, x.dtype)
    cs = jax.nn.silu(c)
    offsets = [int(o) for o in np.cumsum(IN_SPLITS)[:-1]]
    for l in range(DEPTH):
        mod = cs @ w_ada[l] + b_ada[l]
        sh1, sc1, gt1, sh2, sc2, gt2 = [m[:, None, :] for m in jnp.split(mod, 6, axis=-1)]

        h = x * (1.0 + sc1) + sh1
        proj = h @ w_in[l]
        c_q, c_kv, k_r, conv_u, q_s, k_s, v_s = jnp.split(proj, offsets, axis=-1)
        o_mla = mla_attention(c_q, c_kv, k_r, g_q[l], w_uq[l], g_kv[l], w_ukv[l], cos, sin)
        o_conv = conformer_conv(conv_u, w_dw[l], b_dw[l], g_conv[l], b_conv[l], w_pw[l], b_pw[l])
        o_swa = swa_attention(q_s, k_s, v_s, sinks[l])
        mix = jnp.concatenate([o_mla, o_conv, o_swa], axis=-1) @ w_o[l]
        x = layer_norm(DN_ALPHA * x + (1.0 + gt1) * mix, g_ln1[l], b_ln1[l])

        h = x * (1.0 + sc2) + sh2
        y = peer(h, w_pq[l], sub_keys[l], u_tab[l], v_tab[l])
        x = layer_norm(DN_ALPHA * x + (1.0 + gt2) * y, g_ln2[l], b_ln2[l])
    return x
```

```cpp
#include <hip/hip_runtime.h>
#include <hip/hip_cooperative_groups.h>
#include <cstdio>
#include <cstdint>
namespace cg = cooperative_groups;

constexpr int D = 1024, BATCH = 4, SEQ = 8192, DEPTH = 2, NTOK = BATCH * SEQ;
constexpr int D_IN = 1440;
constexpr int OFF_CQ = 0, OFF_CKV = 256, OFF_KR = 384, OFF_CONV = 416, OFF_QS = 928, OFF_KS = 1184, OFF_VS = 1312;
constexpr float EPS = 1e-6f;
constexpr float DN_ALPHA = 1.41421356237309515f;

__global__ void __launch_bounds__(256) k_rope_tables(float* cosT, float* sinT) {
    int idx = blockIdx.x * 256 + threadIdx.x;
    if (idx >= SEQ * 16) return;
    int pos = idx >> 4, i = idx & 15;
    float inv = 1.0f / powf(10000.0f, (float)(2 * i) / 32.0f);
    float ang = (float)pos * inv;
    double fr = (double)ang * 0.15915494309189535;
    fr -= rint(fr);
    float f = (float)fr;
    cosT[idx] = __builtin_amdgcn_cosf(f);
    sinT[idx] = __builtin_amdgcn_sinf(f);
}

__global__ void __launch_bounds__(256) k_ada(const float* c, const float* w_ada, const float* b_ada, float* mod) {
    int j = blockIdx.x * 256 + threadIdx.x, b = blockIdx.y, l = blockIdx.z;
    const float* w = w_ada + (size_t)l * D * 6 * D;
    float acc = 0.f;
    for (int k = 0; k < D; ++k) { float cv = c[b * D + k]; float s = cv / (1.f + expf(-cv)); acc += s * w[(size_t)k * 6 * D + j]; }
    mod[((size_t)l * BATCH + b) * 6 * D + j] = acc + b_ada[l * 6 * D + j];
}

__global__ void __launch_bounds__(256) k_modh(const float* x, const float* sh, const float* sc, float* h, int rows) {
    size_t idx = (size_t)blockIdx.x * 256 + threadIdx.x;
    if (idx >= (size_t)rows * D) return;
    int col = idx & (D - 1);
    h[idx] = x[idx] * (1.f + sc[col]) + sh[col];
}

__global__ void __launch_bounds__(256) k_gemm(const float* A, int lda, size_t sA, const float* B, int ldb, size_t sB, float* C, int ldc, size_t sC,
                                              int M, int N, int K, const float* bias, int transB) {
    __shared__ float As[16][65];
    __shared__ float Bs[16][65];
    A += sA * blockIdx.z; B += sB * blockIdx.z; C += sC * blockIdx.z;
    const int tx = threadIdx.x & 15, ty = threadIdx.x >> 4;
    const int m0 = blockIdx.y * 64, n0 = blockIdx.x * 64;
    float acc[4][4];
#pragma unroll
    for (int i = 0; i < 4; ++i)
#pragma unroll
        for (int j = 0; j < 4; ++j) acc[i][j] = 0.f;
    for (int k0 = 0; k0 < K; k0 += 16) {
#pragma unroll
        for (int i = 0; i < 4; ++i) {
            int idx = threadIdx.x + i * 256;
            int r = idx >> 4, kk = idx & 15;
            As[kk][r] = A[(size_t)(m0 + r) * lda + k0 + kk];
        }
        if (!transB) {
#pragma unroll
            for (int i = 0; i < 4; ++i) {
                int idx = threadIdx.x + i * 256;
                int kk = idx >> 6, cc = idx & 63;
                Bs[kk][cc] = (n0 + cc < N) ? B[(size_t)(k0 + kk) * ldb + n0 + cc] : 0.f;
            }
        } else {
#pragma unroll
            for (int i = 0; i < 4; ++i) {
                int idx = threadIdx.x + i * 256;
                int cc = idx >> 4, kk = idx & 15;
                Bs[kk][cc] = (n0 + cc < N) ? B[(size_t)(n0 + cc) * ldb + k0 + kk] : 0.f;
            }
        }
        __syncthreads();
#pragma unroll
        for (int kk = 0; kk < 16; ++kk) {
            float a[4], b[4];
#pragma unroll
            for (int i = 0; i < 4; ++i) a[i] = As[kk][ty * 4 + i];
#pragma unroll
            for (int j = 0; j < 4; ++j) b[j] = Bs[kk][tx * 4 + j];
#pragma unroll
            for (int i = 0; i < 4; ++i)
#pragma unroll
                for (int j = 0; j < 4; ++j) acc[i][j] += a[i] * b[j];
        }
        __syncthreads();
    }
#pragma unroll
    for (int i = 0; i < 4; ++i)
#pragma unroll
        for (int j = 0; j < 4; ++j) {
            int n = n0 + tx * 4 + j;
            if (n < N) C[(size_t)(m0 + ty * 4 + i) * ldc + n] = acc[i][j] + (bias ? bias[n] : 0.f);
        }
}

__global__ void __launch_bounds__(256) k_rmsnorm(const float* src, int ld, int off, int W, const float* g, float* out, int rows) {
    int row = blockIdx.x * 4 + (threadIdx.x >> 6), lane = threadIdx.x & 63;
    if (row >= rows) return;
    const float* p = src + (size_t)row * ld + off;
    float s = 0.f;
    for (int c = lane; c < W; c += 64) s += p[c] * p[c];
#pragma unroll
    for (int o = 1; o < 64; o <<= 1) s += __shfl_xor(s, o);
    float r = rsqrtf(s / (float)W + EPS);
    for (int c = lane; c < W; c += 64) out[(size_t)row * W + c] = p[c] * r * g[c];
}

__global__ void __launch_bounds__(256) k_rope(float* q, const float* proj, float* kr, const float* cosT, const float* sinT, int rows) {
    int idx = blockIdx.x * 256 + threadIdx.x;
    if (idx >= rows * 9 * 16) return;
    int i = idx & 15, hh = (idx >> 4) % 9, r = idx / (9 * 16);
    float cs = cosT[r * 16 + i], sn = sinT[r * 16 + i];
    if (hh < 8) {
        float* p = q + (size_t)r * 768 + hh * 96 + 64;
        float t1 = p[i], t2 = p[i + 16];
        p[i] = t1 * cs - t2 * sn; p[i + 16] = t1 * sn + t2 * cs;
    } else {
        const float* p = proj + (size_t)r * D_IN + OFF_KR;
        float t1 = p[i], t2 = p[i + 16];
        kr[r * 32 + i] = t1 * cs - t2 * sn; kr[r * 32 + i + 16] = t1 * sn + t2 * cs;
    }
}

__global__ void __launch_bounds__(256) k_mla(const float* q, const float* kv, const float* kr, float* out  ) {
    const int h = blockIdx.y, s = blockIdx.x * 256 + threadIdx.x;
    const float scale = 0.10206207261596577f;
    float qv[96], o[64];
#pragma unroll
    for (int d = 0; d < 96; ++d) qv[d] = q[(size_t)s * 768 + h * 96 + d] * scale;
#pragma unroll
    for (int d = 0; d < 64; ++d) o[d] = 0.f;
    float m = -INFINITY, l = 0.f;
    const int jend = (blockIdx.x * 256 + (threadIdx.x | 63));
    for (int j = 0; j <= jend; ++j) {
        const float* kp = kv + (size_t)j * 1024 + h * 128;
        const float* krp = kr + (size_t)j * 32;
        float sc = 0.f;
#pragma unroll
        for (int d = 0; d < 64; ++d) sc += qv[d] * kp[d];
#pragma unroll
        for (int d = 0; d < 32; ++d) sc += qv[64 + d] * krp[d];
        if (j <= s) {
            float mn = fmaxf(m, sc), al = __expf(m - mn), p = __expf(sc - mn);
            l = l * al + p; m = mn;
#pragma unroll
            for (int d = 0; d < 64; ++d) o[d] = o[d] * al + p * kp[64 + d];
        }
    }
    float inv = 1.f / l;
#pragma unroll
    for (int d = 0; d < 64; ++d) out[(size_t)s * 1024 + h * 64 + d] = o[d] * inv;
}

__global__ void __launch_bounds__(256) k_swa(const float* proj, const float* sinks, float* out  ) {
    const int hq = blockIdx.y, s = blockIdx.x * 256 + threadIdx.x, kvh = hq >> 1;
    float qv[64], o[64];
#pragma unroll
    for (int d = 0; d < 64; ++d) { qv[d] = proj[(size_t)s * D_IN + OFF_QS + hq * 64 + d] * 0.125f; o[d] = 0.f; }
    float m = sinks[hq], l = 1.f;
    const int sw = blockIdx.x * 256 + (threadIdx.x & ~63);
    int j0 = sw - 127; if (j0 < 0) j0 = 0;
    for (int j = j0; j <= sw + 63; ++j) {
        const float* kp = proj + (size_t)j * D_IN + OFF_KS + kvh * 64;
        const float* vp = proj + (size_t)j * D_IN + OFF_VS + kvh * 64;
        float sc = 0.f;
#pragma unroll
        for (int d = 0; d < 64; ++d) sc += qv[d] * kp[d];
        if (j <= s && j > s - 128) {
            float mn = fmaxf(m, sc), al = __expf(m - mn), p = __expf(sc - mn);
            l = l * al + p; m = mn;
#pragma unroll
            for (int d = 0; d < 64; ++d) o[d] = o[d] * al + p * vp[d];
        }
    }
    float inv = 1.f / l;
#pragma unroll
    for (int d = 0; d < 64; ++d) out[(size_t)s * 1024 + 768 + hq * 64 + d] = o[d] * inv;
}

__global__ void __launch_bounds__(256) k_glu(const float* proj, float* glu, int rows) {
    int idx = blockIdx.x * 256 + threadIdx.x;
    if (idx >= rows * 256) return;
    int r = idx >> 8, c = idx & 255;
    float a = proj[(size_t)r * D_IN + OFF_CONV + c], g = proj[(size_t)r * D_IN + OFF_CONV + 256 + c];
    glu[idx] = a / (1.f + expf(-g));
}

__device__ __forceinline__ float block_sum_256(float v, float* red) {
#pragma unroll
    for (int o = 1; o < 64; o <<= 1) v += __shfl_xor(v, o);
    __syncthreads();
    if ((threadIdx.x & 63) == 0) red[threadIdx.x >> 6] = v;
    __syncthreads();
    return red[0] + red[1] + red[2] + red[3];
}

__global__ void __launch_bounds__(256) k_dwconv_ln(const float* glu, const float* w_dw, const float* b_dw, const float* g, const float* b, float* out) {
    __shared__ float red[4];
    const int t = blockIdx.x, c = threadIdx.x;
    float acc = b_dw[c];
    for (int k = 0; k < 31; ++k) { int tt = t - 30 + k; if (tt >= 0) acc += glu[(size_t)tt * 256 + c] * w_dw[k * 256 + c]; }
    float mean = block_sum_256(acc, red) * (1.f / 256.f);
    float dv = acc - mean;
    float var = block_sum_256(dv * dv, red) * (1.f / 256.f);
    float y = dv * rsqrtf(var + EPS) * g[c] + b[c];
    out[(size_t)t * 256 + c] = y / (1.f + expf(-y));
}

__global__ void __launch_bounds__(256) k_ln_res(const float* x, const float* y, const float* gt, const float* g, const float* b, float* xo) {
    __shared__ float red[4];
    const size_t base = (size_t)blockIdx.x * D;
    float v[4]; float s = 0.f;
#pragma unroll
    for (int i = 0; i < 4; ++i) { int c = threadIdx.x + i * 256; v[i] = DN_ALPHA * x[base + c] + (1.f + gt[c]) * y[base + c]; s += v[i]; }
    float mean = block_sum_256(s, red) * (1.f / D);
    float q = 0.f;
#pragma unroll
    for (int i = 0; i < 4; ++i) { v[i] -= mean; q += v[i] * v[i]; }
    float var = block_sum_256(q, red) * (1.f / D);
    float r = rsqrtf(var + EPS);
#pragma unroll
    for (int i = 0; i < 4; ++i) { int c = threadIdx.x + i * 256; xo[base + c] = v[i] * r * g[c] + b[c]; }
}

#define INS16(LV, LI, VV, II) do { float v_ = (VV); int i_ = (II); \
    _Pragma("unroll") for (int k_ = 0; k_ < 16; ++k_) { if (v_ > LV[k_]) { float tv_ = LV[k_]; LV[k_] = v_; v_ = tv_; int ti_ = LI[k_]; LI[k_] = i_; i_ = ti_; } } } while (0)

__global__ void __launch_bounds__(256) k_topk(const float* sc  , int* eidx, float* gate, int rows) {
    int idx = blockIdx.x * 256 + threadIdx.x;
    if (idx >= rows * 8) return;
    int t = idx >> 3, h = idx & 7;
    const float* p1 = sc + (size_t)t * 2048 + h * 256;
    float s1[16], s2[16]; int i1[16], i2[16];
#pragma unroll
    for (int k = 0; k < 16; ++k) { s1[k] = -INFINITY; s2[k] = -INFINITY; i1[k] = 0; i2[k] = 0; }
    for (int n = 0; n < 128; ++n) { INS16(s1, i1, p1[n], n); }
    for (int n = 0; n < 128; ++n) { INS16(s2, i2, p1[128 + n], n); }
    float tv[16]; int ti[16];
#pragma unroll
    for (int k = 0; k < 16; ++k) { tv[k] = -INFINITY; ti[k] = 0; }
#pragma unroll
    for (int a = 0; a < 16; ++a)
#pragma unroll
        for (int b = 0; b < 16; ++b)
            if ((a + 1) * (b + 1) <= 16) { INS16(tv, ti, s1[a] + s2[b], i1[a] * 128 + i2[b]); }
    float mx = tv[0], sum = 0.f; float e[16];
#pragma unroll
    for (int k = 0; k < 16; ++k) { e[k] = expf(tv[k] - mx); sum += e[k]; }
    float inv = 1.f / sum;
#pragma unroll
    for (int k = 0; k < 16; ++k) { eidx[(size_t)t * 128 + h * 16 + k] = ti[k]; gate[(size_t)t * 128 + h * 16 + k] = e[k] * inv; }
}

__global__ void __launch_bounds__(256) k_peer(const float* h2, const int* eidx, const float* gate, const float* u, const float* v,
                                              const float* x1, const float* gt, const float* g, const float* b, float* xo, int rows) {
    int t = blockIdx.x * 4 + (threadIdx.x >> 6), lane = threadIdx.x & 63;
    if (t >= rows) return;
    float4 hv[4], y[4];
#pragma unroll
    for (int j = 0; j < 4; ++j) { hv[j] = *(const float4*)(h2 + (size_t)t * D + j * 256 + lane * 4); y[j] = make_float4(0.f, 0.f, 0.f, 0.f); }
    for (int k = 0; k < 128; ++k) {
        int e = eidx[(size_t)t * 128 + k]; float gk = gate[(size_t)t * 128 + k];
        const float* ur = u + (size_t)e * D; const float* vr = v + (size_t)e * D;
        float a = 0.f;
#pragma unroll
        for (int j = 0; j < 4; ++j) { float4 uu = *(const float4*)(ur + j * 256 + lane * 4); a += hv[j].x * uu.x + hv[j].y * uu.y + hv[j].z * uu.z + hv[j].w * uu.w; }
#pragma unroll
        for (int o = 1; o < 64; o <<= 1) a += __shfl_xor(a, o);
        float w = gk * 0.5f * a * (1.f + erff(a * 0.70710678118654752f));
#pragma unroll
        for (int j = 0; j < 4; ++j) { float4 vv = *(const float4*)(vr + j * 256 + lane * 4); y[j].x += w * vv.x; y[j].y += w * vv.y; y[j].z += w * vv.z; y[j].w += w * vv.w; }
    }
    float vals[16]; float s = 0.f;
#pragma unroll
    for (int j = 0; j < 4; ++j) {
        float4 xx = *(const float4*)(x1 + (size_t)t * D + j * 256 + lane * 4); float4 gg = *(const float4*)(gt + j * 256 + lane * 4);
        vals[j * 4 + 0] = DN_ALPHA * xx.x + (1.f + gg.x) * y[j].x; vals[j * 4 + 1] = DN_ALPHA * xx.y + (1.f + gg.y) * y[j].y;
        vals[j * 4 + 2] = DN_ALPHA * xx.z + (1.f + gg.z) * y[j].z; vals[j * 4 + 3] = DN_ALPHA * xx.w + (1.f + gg.w) * y[j].w;
    }
#pragma unroll
    for (int i = 0; i < 16; ++i) s += vals[i];
#pragma unroll
    for (int o = 1; o < 64; o <<= 1) s += __shfl_xor(s, o);
    float mean = s * (1.f / D), q = 0.f;
#pragma unroll
    for (int i = 0; i < 16; ++i) { vals[i] -= mean; q += vals[i] * vals[i]; }
#pragma unroll
    for (int o = 1; o < 64; o <<= 1) q += __shfl_xor(q, o);
    float r = rsqrtf(q * (1.f / D) + EPS);
#pragma unroll
    for (int j = 0; j < 4; ++j) {
        float4 gg = *(const float4*)(g + j * 256 + lane * 4), bb = *(const float4*)(b + j * 256 + lane * 4), oo;
        oo.x = vals[j * 4 + 0] * r * gg.x + bb.x; oo.y = vals[j * 4 + 1] * r * gg.y + bb.y; oo.z = vals[j * 4 + 2] * r * gg.z + bb.z; oo.w = vals[j * 4 + 3] * r * gg.w + bb.w;
        *(float4*)(xo + (size_t)t * D + j * 256 + lane * 4) = oo;
    }
}

__global__ void __launch_bounds__(256) k_coop_final(float* out, float* tmp, size_t n4) {
    cg::grid_group grid = cg::this_grid();
    const size_t nth = (size_t)gridDim.x * 256, tid = (size_t)blockIdx.x * 256 + threadIdx.x;
    for (size_t i = tid; i < n4; i += nth) ((float4*)tmp)[i] = ((const float4*)out)[i];
    grid.sync();
    const size_t rtid = (size_t)(gridDim.x - 1 - blockIdx.x) * 256 + threadIdx.x;
    for (size_t i = rtid; i < n4; i += nth) { float4 v = ((const float4*)tmp)[i]; ((float4*)out)[i] = v; }
    grid.sync();
}

static inline void gemm(hipStream_t st, const float* A, int lda, size_t sA, const float* B, int ldb, size_t sB, float* C, int ldc, size_t sC,
                        int M, int N, int K, const float* bias, int transB, int batch) {
    dim3 g((N + 63) / 64, M / 64, batch);
    hipLaunchKernelGGL(k_gemm, g, dim3(256), 0, st, A, lda, sA, B, ldb, sB, C, ldc, sC, M, N, K, bias, transB);
}

extern "C" void kernel_launch(void* const* d_in, const int* in_sizes, int n_in, void* d_out, int out_size, void* d_ws, size_t ws_size, hipStream_t stream) {
    const float* x_in = (const float*)d_in[0]; const float* c = (const float*)d_in[1];
    const float* w_ada = (const float*)d_in[2]; const float* b_ada = (const float*)d_in[3];
    const float* w_in = (const float*)d_in[4]; const float* g_q = (const float*)d_in[5]; const float* w_uq = (const float*)d_in[6];
    const float* g_kv = (const float*)d_in[7]; const float* w_ukv = (const float*)d_in[8]; const float* w_dw = (const float*)d_in[9];
    const float* b_dw = (const float*)d_in[10]; const float* g_conv = (const float*)d_in[11]; const float* b_conv = (const float*)d_in[12];
    const float* w_pw = (const float*)d_in[13]; const float* b_pw = (const float*)d_in[14]; const float* sinks = (const float*)d_in[15];
    const float* w_o = (const float*)d_in[16]; const float* g_ln1 = (const float*)d_in[17]; const float* b_ln1 = (const float*)d_in[18];
    const float* w_pq = (const float*)d_in[19]; const float* sub_keys = (const float*)d_in[20]; const float* u_tab = (const float*)d_in[21];
    const float* v_tab = (const float*)d_in[22]; const float* g_ln2 = (const float*)d_in[23]; const float* b_ln2 = (const float*)d_in[24];
    float* out = (float*)d_out;
    char* ws = (char*)d_ws;
    const size_t MiB = 1u << 20;
    float* XA = (float*)(ws);
    float* XB = (float*)(ws + 128 * MiB);
    float* MOD = (float*)(ws + 256 * MiB);
    float* COS = (float*)(ws + 257 * MiB);
    float* SIN = (float*)(ws + 258 * MiB);
    char* ar = ws + 260 * MiB;
    float* Hc = (float*)(ar);
    float* PROJ = (float*)(ar + 32 * MiB);
    float* CQN = (float*)(ar + 78 * MiB);
    float* CKVN = (float*)(ar + 86 * MiB);
    float* KR = (float*)(ar + 90 * MiB);
    float* Qc = (float*)(ar + 92 * MiB);
    float* KVc = (float*)(ar + 116 * MiB);
    float* GLU = (float*)(ar + 148 * MiB);
    float* CONVH = (float*)(ar + 156 * MiB);
    float* MIXIN = (float*)(ar + 164 * MiB);
    float* MIX = (float*)(ar + 196 * MiB);
    float* H2 = (float*)(ar);
    float* PQ = (float*)(ar + 32 * MiB);
    float* SC = (float*)(ar + 96 * MiB);
    int* EIDX = (int*)(ar + 160 * MiB);
    float* GATE = (float*)(ar + 164 * MiB);

    hipLaunchKernelGGL(k_rope_tables, dim3(SEQ * 16 / 256), dim3(256), 0, stream, COS, SIN);
    hipLaunchKernelGGL(k_ada, dim3(6 * D / 256, BATCH, DEPTH), dim3(256), 0, stream, c, w_ada, b_ada, MOD);

    for (int l = 0; l < DEPTH; ++l) {
        const float* xin = (l == 0) ? x_in : XB;
        float* xout = (l == 0) ? XB : out;
        for (int b = 0; b < BATCH; ++b) {
            const float* mod = MOD + ((size_t)l * BATCH + b) * 6 * D;
            const float *sh1 = mod, *sc1 = mod + D, *gt1 = mod + 2 * D, *sh2 = mod + 3 * D, *sc2 = mod + 4 * D, *gt2 = mod + 5 * D;
            const float* xb = xin + (size_t)b * SEQ * D;
            float* x1b = XA + (size_t)b * SEQ * D;
            float* xob = xout + (size_t)b * SEQ * D;
            hipLaunchKernelGGL(k_modh, dim3(SEQ * D / 256), dim3(256), 0, stream, xb, sh1, sc1, Hc, SEQ);
            gemm(stream, Hc, D, 0, w_in + (size_t)l * D * D_IN, D_IN, 0, PROJ, D_IN, 0, SEQ, D_IN, D, nullptr, 0, 1);
            hipLaunchKernelGGL(k_rmsnorm, dim3(SEQ / 4), dim3(256), 0, stream, PROJ, D_IN, OFF_CQ, 256, g_q + l * 256, CQN, SEQ);
            hipLaunchKernelGGL(k_rmsnorm, dim3(SEQ / 4), dim3(256), 0, stream, PROJ, D_IN, OFF_CKV, 128, g_kv + l * 128, CKVN, SEQ);
            gemm(stream, CQN, 256, 0, w_uq + (size_t)l * 256 * 768, 768, 0, Qc, 768, 0, SEQ, 768, 256, nullptr, 0, 1);
            gemm(stream, CKVN, 128, 0, w_ukv + (size_t)l * 128 * 1024, 1024, 0, KVc, 1024, 0, SEQ, 1024, 128, nullptr, 0, 1);
            hipLaunchKernelGGL(k_rope, dim3(SEQ * 9 * 16 / 256), dim3(256), 0, stream, Qc, PROJ, KR, COS, SIN, SEQ);
            hipLaunchKernelGGL(k_mla, dim3(SEQ / 256, 8), dim3(256), 0, stream, Qc, KVc, KR, MIXIN);
            hipLaunchKernelGGL(k_glu, dim3(SEQ), dim3(256), 0, stream, PROJ, GLU, SEQ);
            hipLaunchKernelGGL(k_dwconv_ln, dim3(SEQ), dim3(256), 0, stream, GLU, w_dw + (size_t)l * 31 * 256, b_dw + l * 256, g_conv + l * 256, b_conv + l * 256, CONVH);
            gemm(stream, CONVH, 256, 0, w_pw + (size_t)l * 256 * 256, 256, 0, MIXIN + 512, 1024, 0, SEQ, 256, 256, b_pw + l * 256, 0, 1);
            hipLaunchKernelGGL(k_swa, dim3(SEQ / 256, 4), dim3(256), 0, stream, PROJ, sinks + l * 4, MIXIN);
            gemm(stream, MIXIN, 1024, 0, w_o + (size_t)l * D * D, D, 0, MIX, D, 0, SEQ, D, D, nullptr, 0, 1);
            hipLaunchKernelGGL(k_ln_res, dim3(SEQ), dim3(256), 0, stream, xb, MIX, gt1, g_ln1 + l * D, b_ln1 + l * D, x1b);
            hipLaunchKernelGGL(k_modh, dim3(SEQ * D / 256), dim3(256), 0, stream, x1b, sh2, sc2, H2, SEQ);
            gemm(stream, H2, D, 0, w_pq + (size_t)l * D * 2048, 2048, 0, PQ, 2048, 0, SEQ, 2048, D, nullptr, 0, 1);
            gemm(stream, PQ, 2048, 128, sub_keys + (size_t)l * 16 * 128 * 128, 128, (size_t)128 * 128, SC, 2048, 128, SEQ, 128, 128, nullptr, 1, 16);
            hipLaunchKernelGGL(k_topk, dim3(SEQ * 8 / 256), dim3(256), 0, stream, SC, EIDX, GATE, SEQ);
            hipLaunchKernelGGL(k_peer, dim3(SEQ / 4), dim3(256), 0, stream, H2, EIDX, GATE, u_tab + (size_t)l * 16384 * D, v_tab + (size_t)l * 16384 * D,
                               x1b, gt2, g_ln2 + l * D, b_ln2 + l * D, xob, SEQ);
        }
    }
    static int grid_blocks = 0;
    if (!grid_blocks) {
        int dev = 0, cus = 0, per_cu = 0;
        (void)hipGetDevice(&dev);
        (void)hipDeviceGetAttribute(&cus, hipDeviceAttributeMultiprocessorCount, dev);
        (void)hipOccupancyMaxActiveBlocksPerMultiprocessor(&per_cu, k_coop_final, 256, 0);
        if (per_cu > 2) per_cu = 2;
        grid_blocks = cus * per_cu;
    }
    float* tmp = XA; size_t n4 = (size_t)NTOK * D / 4;
    void* args[] = {(void*)&out, (void*)&tmp, (void*)&n4};
    hipError_t e = hipLaunchCooperativeKernel((void*)k_coop_final, dim3(grid_blocks), dim3(256), args, 0, stream);
    if (e != hipSuccess) fprintf(stderr, "cooperative launch failed: %s (grid %d)\n", hipGetErrorString(e), grid_blocks);
}
```

```cpp
#include <hip/hip_runtime.h>
#include <hip/hip_cooperative_groups.h>
#include <cstdio>
#include <cstdint>
namespace cg = cooperative_groups;

constexpr int D = 1024, BATCH = 4, SEQ = 8192, DEPTH = 2, NTOK = BATCH * SEQ;
constexpr int D_IN = 1440;
constexpr int OFF_CQ = 0, OFF_CKV = 256, OFF_KR = 384, OFF_CONV = 416, OFF_QS = 928, OFF_KS = 1184, OFF_VS = 1312;
constexpr float EPS = 1e-6f;
constexpr float DN_ALPHA = 1.41421356237309515f;

typedef __attribute__((ext_vector_type(8))) short bf16x8;
typedef __attribute__((ext_vector_type(16))) float f32x16;
typedef __attribute__((ext_vector_type(4))) unsigned u32x4;
typedef __attribute__((ext_vector_type(2))) unsigned u32x2;
typedef float f32x2_t __attribute__((ext_vector_type(2)));
typedef __bf16 bf16x2_t __attribute__((ext_vector_type(2)));
typedef unsigned short bf16;
#define DI __device__ __forceinline__
#define MFMA32(a, b, c) __builtin_amdgcn_mfma_f32_32x32x16_bf16((a), (b), (c), 0, 0, 0)

DI unsigned pk2(float lo, float hi) { f32x2_t v = {lo, hi}; bf16x2_t b = __builtin_convertvector(v, bf16x2_t); return __builtin_bit_cast(unsigned, b); }
DI bf16 f2bf(float f) { return (bf16)(pk2(f, 0.f) & 0xffffu); }
DI float bf2f(bf16 b) { return __uint_as_float((unsigned)b << 16); }
DI float bflo(unsigned u) { return __uint_as_float(u << 16); }
DI float bfhi(unsigned u) { return __uint_as_float(u & 0xffff0000u); }
DI int crow(int reg, int hh) { return (reg & 3) + 8 * (reg >> 2) + 4 * hh; }
DI int cperm_lin(int rho) { return 16 * ((rho >> 2) & 1) + (rho & 3) + 4 * (rho >> 3); }
DI int cperm_rope(int rho) { int hh = (rho >> 2) & 1, reg = (rho & 3) + 4 * (rho >> 3); return (reg < 8) ? 8 * hh + reg : 16 + 8 * hh + (reg - 8); }
DI int perm16(int p) { int g = (p >> 2) & 3; g = (g == 1) ? 2 : (g == 2) ? 1 : g; return (p & ~15) | (g << 2) | (p & 3); }

constexpr float LOG2E = 1.4426950408889634f;
constexpr int PROJ_LD = 1280;
constexpr int WIN_N = 1536;
constexpr int TS = 144;
constexpr int TILE_B = 128 * TS;
constexpr int STAGE_B = 2 * TILE_B;
constexpr int LDS_BYTES = 2 * STAGE_B;

struct Params {
    const float* in[25];
    float* out;
    bf16 *WinT, *WuqT, *WukvT, *WoT, *WpqT, *SKp, *Ut, *Vt;
    float* biasO;
    float* MOD;
    float* COS; float* SIN;
    bf16 *H, *PROJ, *Q, *KN, *KR, *VT, *VsT, *MIXIN;
    float* XB;
    unsigned* TOPK;
    unsigned* ctr;
    int rows;
    int tok0;
};

enum { TK_WIN = 0, TK_WUQ = 1, TK_WUKV = 2, TK_WO = 3, TK_WPQ = 4 };
DI void transpose_item(int kind, const float* W, int ldin, int K, int Nout, bf16* WT, const float* rowscale, float* scr, int item, int lane) {
    const int nblk = Nout / 32, kb = item / nblk, nb = item % nblk, k0 = 64 * kb, n0 = 32 * nb;
    int src0 = n0; float cs = 1.f;
    if (kind == TK_WIN) {
        if (n0 < 384) src0 = n0;
        else if (n0 < 896) src0 = 416 + (n0 - 384);
        else if (n0 < 1152) { src0 = 928 + (n0 - 896); cs = 0.125f * LOG2E; }
        else if (n0 < 1280) src0 = 1184 + (n0 - 1152);
        else if (n0 < 1408) src0 = 1312 + (n0 - 1280);
        else if (n0 < 1440) src0 = 384 + (n0 - 1408);
        else src0 = -1;
    } else if (kind == TK_WUQ) cs = 0.10206207261596577f * LOG2E;
#pragma unroll 8
    for (int i = 0; i < 32; ++i) {
        const int kk = 2 * i + (lane >> 5);
        float v = (src0 >= 0) ? W[(size_t)(k0 + kk) * ldin + src0 + (lane & 31)] : 0.f;
        if (rowscale) v *= rowscale[k0 + kk];
        scr[kk * 33 + (lane & 31)] = v * cs;
    }
    __builtin_amdgcn_s_waitcnt(0xc07f); asm volatile("" ::: "memory");
    const int c = lane & 7;
#pragma unroll
    for (int j = 0; j < 4; ++j) {
        const int n = (lane >> 3) + 8 * j; const float* s = scr + (8 * c) * 33 + n;
        u32x4 o; o.x = pk2(s[0], s[33]); o.y = pk2(s[66], s[99]); o.z = pk2(s[132], s[165]); o.w = pk2(s[198], s[231]);
        if (!(kind == TK_WO && k0 + 8 * c >= 512 && k0 + 8 * c < 768))
            *(u32x4*)(WT + (size_t)(n0 + n) * K + k0 + 8 * c) = o;
    }
    __builtin_amdgcn_s_waitcnt(0xc07f); asm volatile("" ::: "memory");
}

DI void cvt8(const float* src, bf16* dst, size_t i8) {
    const float4 a = ((const float4*)src)[2 * i8], b = ((const float4*)src)[2 * i8 + 1];
    u32x4 o; o.x = pk2(a.x, a.y); o.y = pk2(a.z, a.w); o.z = pk2(b.x, b.y); o.w = pk2(b.z, b.w);
    ((u32x4*)dst)[i8] = o;
}

struct TileRegs { u32x4 v[4]; };
DI void gload_tile(TileRegs& t, const bf16* base, int ld, int k0, int tid) {
#pragma unroll
    for (int i = 0; i < 4; ++i) { const int q = tid + 256 * i, row = q >> 3, kc = q & 7; t.v[i] = *(const u32x4*)(base + (size_t)row * ld + k0 + kc * 8); }
}
DI void sstore_tile(const TileRegs& t, char* lds, int tid) {
#pragma unroll
    for (int i = 0; i < 4; ++i) { const int q = tid + 256 * i, row = q >> 3, kc = q & 7; *(u32x4*)(lds + row * TS + kc * 16) = t.v[i]; }
}
template <int NF, int NG>
DI void gemm_core(const bf16* A, int lda, const bf16* W, int ldw, int K, char* lds, f32x16 (&acc)[NF][NG], int fo, const int (&frow)[NF], int go, const int (&grow)[NG]) {
    int tid_ = threadIdx.x; asm volatile("" : "+v"(tid_)); const int tid = tid_, hh = (tid & 63) >> 5;
    TileRegs ta, tw;
    gload_tile(ta, A, lda, 0, tid); gload_tile(tw, W, ldw, 0, tid);
    __syncthreads();
    sstore_tile(ta, lds, tid); sstore_tile(tw, lds + TILE_B, tid);
    __syncthreads();
    const int nk = K / 64;
    for (int ks = 0; ks < nk; ++ks) {
        char* cur = lds + (ks & 1) * STAGE_B;
        if (ks + 1 < nk) { gload_tile(ta, A, lda, (ks + 1) * 64, tid); gload_tile(tw, W, ldw, (ks + 1) * 64, tid); }
#pragma unroll
        for (int kk = 0; kk < 4; ++kk) {
            bf16x8 f[NF], g[NG];
#pragma unroll
            for (int x = 0; x < NF; ++x) f[x] = *(const bf16x8*)(cur + fo + frow[x] * TS + kk * 32 + hh * 16);
#pragma unroll
            for (int y = 0; y < NG; ++y) g[y] = *(const bf16x8*)(cur + go + grow[y] * TS + kk * 32 + hh * 16);
#pragma unroll
            for (int x = 0; x < NF; ++x)
#pragma unroll
                for (int y = 0; y < NG; ++y) acc[x][y] = MFMA32(f[x], g[y], acc[x][y]);
        }
        if (ks + 1 < nk) { char* nxt = lds + ((ks + 1) & 1) * STAGE_B; sstore_tile(ta, nxt, tid); sstore_tile(tw, nxt + TILE_B, tid); }
        __syncthreads();
    }
}

template <int NF, int NG> DI void zero_acc(f32x16 (&acc)[NF][NG]) {
#pragma unroll
    for (int x = 0; x < NF; ++x)
#pragma unroll
        for (int y = 0; y < NG; ++y)
#pragma unroll
            for (int r = 0; r < 16; ++r) acc[x][y][r] = 0.f;
}

DI void store16(bf16* dst, const float* v) {
    u32x4 a, b;
    a.x = pk2(v[0], v[1]); a.y = pk2(v[2], v[3]); a.z = pk2(v[4], v[5]); a.w = pk2(v[6], v[7]);
    b.x = pk2(v[8], v[9]); b.y = pk2(v[10], v[11]); b.z = pk2(v[12], v[13]); b.w = pk2(v[14], v[15]);
    *(u32x4*)dst = a; *(u32x4*)(dst + 8) = b;
}
DI void store8(bf16* dst, const float* v) {
    u32x4 a; a.x = pk2(v[0], v[1]); a.y = pk2(v[2], v[3]); a.z = pk2(v[4], v[5]); a.w = pk2(v[6], v[7]);
    *(u32x4*)dst = a;
}
DI void store_vt(bf16* dst, const f32x16& a, int hh) {
    float v0[8], v1[8];
#pragma unroll
    for (int i = 0; i < 8; ++i) { v0[i] = a[i]; v1[i] = a[8 + i]; }
    store8(dst + 8 * hh, v0); store8(dst + 16 + 8 * hh, v1);
}

DI void p1_tile(const Params& p, int l, int tile, char* lds) {
    int tid_ = threadIdx.x; asm volatile("" : "+v"(tid_)); const int tid = tid_, lane = tid & 63, r = lane & 31, hh = lane >> 5;
    const int wv = __builtin_amdgcn_readfirstlane(tid >> 6), wm = wv >> 1, wn = wv & 1;
    const int mt = tile / 12, nt = tile % 12, m0 = mt * 128, n0 = nt * 128;
    const bf16* A = p.H + (size_t)m0 * D;
    const bf16* W = p.WinT + ((size_t)l * WIN_N + n0) * D;
    f32x16 acc[2][2]; zero_acc(acc);
    int frow[2], grow[2];
    const bool kr = (nt == 11);
    int fo, go;
    if (nt == 10) { fo = 0; go = TILE_B; frow[0] = 64 * wm + r; frow[1] = frow[0] + 32; grow[0] = 64 * wn + r; grow[1] = grow[0] + 32; }
    else { fo = TILE_B; go = 0; frow[0] = 64 * wn + (kr ? cperm_rope(r) : cperm_lin(r)); frow[1] = 64 * wn + 32 + cperm_lin(r); grow[0] = 64 * wm + r; grow[1] = grow[0] + 32; }
    gemm_core<2, 2>(A, D, W, D, D, lds, acc, fo, frow, go, grow);
    if (nt == 10) {
#pragma unroll
        for (int x = 0; x < 2; ++x)
#pragma unroll
            for (int y = 0; y < 2; ++y) {
                const int tok = m0 + 64 * wm + 32 * x, b = tok / SEQ, s0 = tok % SEQ, d = 32 * y + r;
                store_vt(p.VsT + ((size_t)(b * 2 + wn) * 64 + d) * SEQ + s0, acc[x][y], hh);
            }
    } else {
        if (!kr) {
#pragma unroll
            for (int x = 0; x < 2; ++x)
#pragma unroll
                for (int y = 0; y < 2; ++y) {
                    const int tok = m0 + 64 * wm + 32 * y + r, col = n0 + 64 * wn + 32 * x + 16 * hh;
                    float v[16];
#pragma unroll
                    for (int i = 0; i < 16; ++i) v[i] = acc[x][y][i];
                    store16(p.PROJ + (size_t)tok * PROJ_LD + col, v);
                }
        } else if (wn == 0) {
#pragma unroll
            for (int y = 0; y < 2; ++y) {
                const int tok = m0 + 64 * wm + 32 * y + r, pos = tok % SEQ;
                const float4 c0 = *(const float4*)(p.COS + pos * 16 + 8 * hh), c1 = *(const float4*)(p.COS + pos * 16 + 8 * hh + 4);
                const float4 s0 = *(const float4*)(p.SIN + pos * 16 + 8 * hh), s1 = *(const float4*)(p.SIN + pos * 16 + 8 * hh + 4);
                const float cs[8] = {c0.x, c0.y, c0.z, c0.w, c1.x, c1.y, c1.z, c1.w}, sn[8] = {s0.x, s0.y, s0.z, s0.w, s1.x, s1.y, s1.z, s1.w};
                float o1[8], o2[8];
#pragma unroll
                for (int i = 0; i < 8; ++i) { const float t1 = acc[0][y][i], t2 = acc[0][y][8 + i]; o1[i] = t1 * cs[i] - t2 * sn[i]; o2[i] = t1 * sn[i] + t2 * cs[i]; }
                store8(p.KR + (size_t)tok * 32 + 8 * hh, o1); store8(p.KR + (size_t)tok * 32 + 16 + 8 * hh, o2);
            }
        }
    }
}
constexpr int LDS_RS_OFF = LDS_BYTES;
constexpr int LDS_TOTAL = LDS_BYTES + 1024;

template <int W> DI void row_rms(const bf16* A, int lda, float* rs, int tid) {
    const int row = tid >> 1, half = tid & 1;
    const u32x4* p = (const u32x4*)(A + (size_t)row * lda + half * (W / 2));
    float ss = 0.f;
#pragma unroll
    for (int i = 0; i < W / 16; ++i) { const u32x4 v = p[i];
        ss += bflo(v.x) * bflo(v.x) + bfhi(v.x) * bfhi(v.x) + bflo(v.y) * bflo(v.y) + bfhi(v.y) * bfhi(v.y)
            + bflo(v.z) * bflo(v.z) + bfhi(v.z) * bfhi(v.z) + bflo(v.w) * bflo(v.w) + bfhi(v.w) * bfhi(v.w); }
    ss += __shfl_xor(ss, 1);
    if (half == 0) rs[row] = rsqrtf(ss * (1.f / W) + EPS);
}

DI void p2q_tile(const Params& p, int l, int tile, char* lds) {
    int tid_ = threadIdx.x; asm volatile("" : "+v"(tid_)); const int tid = tid_, lane = tid & 63, r = lane & 31, hh = lane >> 5;
    const int wv = __builtin_amdgcn_readfirstlane(tid >> 6), wm = wv >> 1, wn = wv & 1;
    const int mt = tile / 6, nt = tile % 6, m0 = mt * 128, n0 = nt * 128;
    const bf16* A = p.PROJ + (size_t)m0 * PROJ_LD;
    const bf16* W = p.WuqT + ((size_t)l * 768 + n0) * 256;
    float* rs = (float*)(lds + LDS_RS_OFF);
    __syncthreads();
    row_rms<256>(A, PROJ_LD, rs, tid);
    f32x16 acc[2][2]; zero_acc(acc);
    int frow[2], grow[2]; bool rope[2];
#pragma unroll
    for (int x = 0; x < 2; ++x) { rope[x] = (((n0 + 64 * wn + 32 * x) >> 5) % 3) == 2; frow[x] = 64 * wn + 32 * x + (rope[x] ? cperm_rope(r) : cperm_lin(r)); }
    grow[0] = 64 * wm + r; grow[1] = grow[0] + 32;
    gemm_core<2, 2>(A, PROJ_LD, W, 256, 256, lds, acc, TILE_B, frow, 0, grow);
#pragma unroll
    for (int y = 0; y < 2; ++y) {
        const int tl = 64 * wm + 32 * y + r, tok = m0 + tl, pos = tok % SEQ;
        const float sc = rs[tl];
#pragma unroll
        for (int x = 0; x < 2; ++x) {
            bf16* dst = p.Q + (size_t)tok * 768 + n0 + 64 * wn + 32 * x;
            if (rope[x]) {
                const float4 c0 = *(const float4*)(p.COS + pos * 16 + 8 * hh), c1 = *(const float4*)(p.COS + pos * 16 + 8 * hh + 4);
                const float4 s0 = *(const float4*)(p.SIN + pos * 16 + 8 * hh), s1 = *(const float4*)(p.SIN + pos * 16 + 8 * hh + 4);
                const float cs[8] = {c0.x, c0.y, c0.z, c0.w, c1.x, c1.y, c1.z, c1.w}, sn[8] = {s0.x, s0.y, s0.z, s0.w, s1.x, s1.y, s1.z, s1.w};
                float o1[8], o2[8];
#pragma unroll
                for (int i = 0; i < 8; ++i) { const float t1 = acc[x][y][i] * sc, t2 = acc[x][y][8 + i] * sc; o1[i] = t1 * cs[i] - t2 * sn[i]; o2[i] = t1 * sn[i] + t2 * cs[i]; }
                store8(dst + 8 * hh, o1); store8(dst + 16 + 8 * hh, o2);
            } else {
                float v[16];
#pragma unroll
                for (int i = 0; i < 16; ++i) v[i] = acc[x][y][i] * sc;
                store16(dst + 16 * hh, v);
            }
        }
    }
}

DI void p2kv_tile(const Params& p, int l, int tile, char* lds) {
    int tid_ = threadIdx.x; asm volatile("" : "+v"(tid_)); const int tid = tid_, lane = tid & 63, r = lane & 31, hh = lane >> 5;
    const int wv = __builtin_amdgcn_readfirstlane(tid >> 6), wm = wv >> 1, wn = wv & 1;
    const int mt = tile >> 3, h = tile & 7, m0 = mt * 128, n0 = h * 128;
    const bf16* A = p.PROJ + (size_t)m0 * PROJ_LD + 256;
    const bf16* W = p.WukvT + ((size_t)l * 1024 + n0) * 128;
    float* rs = (float*)(lds + LDS_RS_OFF);
    __syncthreads();
    row_rms<128>(A, PROJ_LD, rs, tid);
    f32x16 acc[2][2]; zero_acc(acc);
    int frow[2], grow[2];
    int fo, go;
    if (wn == 0) { fo = TILE_B; go = 0; frow[0] = cperm_lin(r); frow[1] = 32 + cperm_lin(r); grow[0] = 64 * wm + r; grow[1] = grow[0] + 32; }
    else         { fo = 0; go = TILE_B; frow[0] = 64 * wm + r; frow[1] = frow[0] + 32; grow[0] = 64 + r; grow[1] = 96 + r; }
    gemm_core<2, 2>(A, PROJ_LD, W, 128, 128, lds, acc, fo, frow, go, grow);
    if (wn == 0) {
#pragma unroll
        for (int y = 0; y < 2; ++y) {
            const int tl = 64 * wm + 32 * y + r, tok = m0 + tl; const float sc = rs[tl];
#pragma unroll
            for (int x = 0; x < 2; ++x) {
                float v[16];
#pragma unroll
                for (int i = 0; i < 16; ++i) v[i] = acc[x][y][i] * sc;
                store16(p.KN + (size_t)tok * 512 + h * 64 + 32 * x + 16 * hh, v);
            }
        }
    } else {
#pragma unroll
        for (int x = 0; x < 2; ++x) {
            const int tl0 = 64 * wm + 32 * x, tok0 = m0 + tl0, b = tok0 / SEQ, s0 = tok0 % SEQ;
#pragma unroll
            for (int y = 0; y < 2; ++y) {
                f32x16 a = acc[x][y];
#pragma unroll
                for (int i = 0; i < 16; ++i) a[i] *= rs[tl0 + crow(i, hh)];
                store_vt(p.VT + ((size_t)(b * 8 + h) * 64 + 32 * y + r) * SEQ + s0, a, hh);
            }
        }
    }
}
constexpr int VSTR = 144;
template <int KD> struct AttnCfg { static constexpr int KSTR = KD * 2 + 16; static constexpr int BUF = 64 * KSTR + 64 * VSTR; };

template <int KD, int MODE>
DI void attn_unit(const bf16* Qp, int qld, const bf16* K1, int k1ld, const bf16* K2, const bf16* VTp, bf16* Op, int b, int qb, float sink_l2, char* lds) {
    constexpr int KSTR = AttnCfg<KD>::KSTR, BUF = AttnCfg<KD>::BUF, NKS = KD / 16;
    int tid_ = threadIdx.x; asm volatile("" : "+v"(tid_)); const int tid = tid_, lane = tid & 63, r = lane & 31, hh = lane >> 5;
    const int wv = __builtin_amdgcn_readfirstlane(tid >> 6);
    const int q0 = qb * 128, qpos = q0 + 32 * wv + r;
    const size_t rowb = (size_t)b * SEQ;
    bf16x8 qf[NKS];
#pragma unroll
    for (int ks = 0; ks < NKS; ++ks) qf[ks] = *(const bf16x8*)(Qp + (rowb + qpos) * qld + ks * 16 + hh * 8);
    const int kstart = (MODE == 0) ? 0 : (q0 >= 128 ? q0 - 128 : 0);
    const int nt = (q0 + 128 - kstart) / 64;
    f32x16 ot[2];
#pragma unroll
    for (int i = 0; i < 16; ++i) { ot[0][i] = 0.f; ot[1][i] = 0.f; }
    float m = (MODE == 0) ? -INFINITY : sink_l2, l = (MODE == 1 && hh == 0) ? 1.f : 0.f;
    u32x4 sk[3], sv[2];
    auto gload = [&](int t) {
        const int key0 = kstart + 64 * t;
#pragma unroll
        for (int i = 0; i < 2; ++i) { const int q = tid + 256 * i, row = q >> 3, c = q & 7;
            sk[i] = *(const u32x4*)(K1 + (rowb + key0 + row) * k1ld + c * 8);
            sv[i] = *(const u32x4*)(VTp + (size_t)row * SEQ + key0 + c * 8); }
        if (KD == 96) { const int row = tid >> 2, c = tid & 3; sk[2] = *(const u32x4*)(K2 + (rowb + key0 + row) * 32 + c * 8); }
    };
    auto sstore = [&](char* buf) {
#pragma unroll
        for (int i = 0; i < 2; ++i) { const int q = tid + 256 * i, row = q >> 3, c = q & 7;
            *(u32x4*)(buf + row * KSTR + c * 16) = sk[i];
            *(u32x4*)(buf + 64 * KSTR + row * VSTR + c * 16) = sv[i]; }
        if (KD == 96) { const int row = tid >> 2, c = tid & 3; *(u32x4*)(buf + row * KSTR + 128 + c * 16) = sk[2]; }
    };
    gload(0);
    __syncthreads();
    sstore(lds);
    __syncthreads();
    for (int t = 0; t < nt; ++t) {
        const char* cur = lds + (t & 1) * BUF;
        if (t + 1 < nt) gload(t + 1);
        const int key0 = kstart + 64 * t;
        f32x16 st[2];
#pragma unroll
        for (int mt = 0; mt < 2; ++mt) {
#pragma unroll
            for (int i = 0; i < 16; ++i) st[mt][i] = 0.f;
#pragma unroll
            for (int ks = 0; ks < NKS; ++ks) {
                const bf16x8 a = *(const bf16x8*)(cur + (mt * 32 + r) * KSTR + ks * 32 + hh * 16);
                st[mt] = MFMA32(a, qf[ks], st[mt]);
            }
        }
        const bool need_mask = (MODE == 1) || (key0 + 63 > q0 + 32 * wv);
        if (need_mask) {
#pragma unroll
            for (int mt = 0; mt < 2; ++mt)
#pragma unroll
                for (int i = 0; i < 16; ++i) {
                    const int key = key0 + mt * 32 + crow(i, hh);
                    const bool ok = (MODE == 0) ? (key <= qpos) : (key <= qpos && key > qpos - 128);
                    if (!ok) st[mt][i] = -INFINITY;
                }
        }
        float mx = st[0][0];
#pragma unroll
        for (int i = 1; i < 16; ++i) mx = fmaxf(mx, st[0][i]);
#pragma unroll
        for (int i = 0; i < 16; ++i) mx = fmaxf(mx, st[1][i]);
        { auto rr = __builtin_amdgcn_permlane32_swap(__float_as_uint(mx), __float_as_uint(mx), false, false); mx = fmaxf(__uint_as_float(rr[0]), __uint_as_float(rr[1])); }
        const float mn = fmaxf(m, mx);
        const float alpha = __builtin_amdgcn_exp2f(m - mn);
        m = mn;
        float ps = 0.f;
#pragma unroll
        for (int mt = 0; mt < 2; ++mt)
#pragma unroll
            for (int i = 0; i < 16; ++i) { const float pv = __builtin_amdgcn_exp2f(st[mt][i] - mn); st[mt][i] = pv; ps += pv; }
        l = l * alpha + ps;
#pragma unroll
        for (int i = 0; i < 16; ++i) { ot[0][i] *= alpha; ot[1][i] *= alpha; }
        bf16x8 pb[4];
#pragma unroll
        for (int s = 0; s < 4; ++s) {
            const int mt = s >> 1, o = 8 * (s & 1);
            u32x4 w; w.x = pk2(st[mt][o], st[mt][o + 1]); w.y = pk2(st[mt][o + 2], st[mt][o + 3]); w.z = pk2(st[mt][o + 4], st[mt][o + 5]); w.w = pk2(st[mt][o + 6], st[mt][o + 7]);
            pb[s] = __builtin_bit_cast(bf16x8, w);
        }
        const char* vt = cur + 64 * KSTR;
#pragma unroll
        for (int mt = 0; mt < 2; ++mt)
#pragma unroll
            for (int s = 0; s < 4; ++s) {
                const bf16x8 a = *(const bf16x8*)(vt + (mt * 32 + r) * VSTR + s * 32 + hh * 16);
                ot[mt] = MFMA32(a, pb[s], ot[mt]);
            }
        if (t + 1 < nt) sstore(lds + ((t + 1) & 1) * BUF);
        __syncthreads();
    }
    { auto rr = __builtin_amdgcn_permlane32_swap(__float_as_uint(l), __float_as_uint(l), false, false); l = __uint_as_float(rr[0]) + __uint_as_float(rr[1]); }
    const float inv = 1.f / l;
    bf16* orow = Op + (rowb + qpos) * 1024;
#pragma unroll
    for (int mt = 0; mt < 2; ++mt)
#pragma unroll
        for (int g = 0; g < 4; ++g) {
            u32x2 w; w.x = pk2(ot[mt][4 * g] * inv, ot[mt][4 * g + 1] * inv); w.y = pk2(ot[mt][4 * g + 2] * inv, ot[mt][4 * g + 3] * inv);
            *(u32x2*)(orow + mt * 32 + 8 * g + 4 * hh) = w;
        }
}

DI void mla_unit(const Params& p, int u, char* lds) {
    const int nbh = (p.rows / SEQ) * 8, qb = 63 - u / nbh, bh = u % nbh, b = bh >> 3, h = bh & 7;
    attn_unit<96, 0>(p.Q + h * 96, 768, p.KN + h * 64, 512, p.KR, p.VT + (size_t)bh * 64 * SEQ, p.MIXIN + h * 64, b, qb, 0.f, lds);
}
DI void swa_unit(const Params& p, int l, int u, char* lds) {
    const int qb = u & 63, bh = u >> 6, b = bh >> 2, hq = bh & 3, kvh = hq >> 1;
    attn_unit<64, 1>(p.PROJ + 896 + hq * 64, PROJ_LD, p.PROJ + 1152 + kvh * 64, PROJ_LD, nullptr, p.VsT + (size_t)(b * 2 + kvh) * 64 * SEQ, p.MIXIN + 768 + hq * 64, b, qb,
                     p.in[15][l * 4 + hq] * LOG2E, lds);
}

DI void conv_unit(const Params& p, int l, int u, char* lds) {
    int tid_ = threadIdx.x; asm volatile("" : "+v"(tid_)); const int tid = tid_, lane = tid & 63, wv = tid >> 6;
    const int tok0 = u * 32, pos0 = tok0 % SEQ;
    bf16* glu = (bf16*)lds;
    float* hc = (float*)(lds + 62 * 512);
    __syncthreads();
    for (int it = tid; it < 62 * 32; it += 256) {
        const int row = it >> 5, c8 = (it & 31) * 8, pos = pos0 - 30 + row;
        u32x4 o = {0u, 0u, 0u, 0u};
        if (pos >= 0) {
            const bf16* src = p.PROJ + (size_t)(tok0 - 30 + row) * PROJ_LD + 384 + c8;
            const u32x4 a = *(const u32x4*)src, g = *(const u32x4*)(src + 256);
            const unsigned av[4] = {a.x, a.y, a.z, a.w}, gv[4] = {g.x, g.y, g.z, g.w}; unsigned ov[4];
#pragma unroll
            for (int i = 0; i < 4; ++i) {
                const float g0 = bflo(gv[i]), g1 = bfhi(gv[i]);
                ov[i] = pk2(bflo(av[i]) / (1.f + __expf(-g0)), bfhi(av[i]) / (1.f + __expf(-g1)));
            }
            o.x = ov[0]; o.y = ov[1]; o.z = ov[2]; o.w = ov[3];
        }
        *(u32x4*)(glu + row * 256 + c8) = o;
    }
    __syncthreads();
    {
        const int c = tid;
        float w[31];
        const float* wd = p.in[9] + (size_t)l * 31 * 256 + c;
#pragma unroll
        for (int k = 0; k < 31; ++k) w[k] = wd[k * 256];
        const float bd = p.in[10][l * 256 + c];
#pragma unroll 1
        for (int ch = 0; ch < 4; ++ch) {
            float g[38], acc[8];
#pragma unroll
            for (int i = 0; i < 38; ++i) g[i] = bf2f(glu[(ch * 8 + i) * 256 + c]);
#pragma unroll
            for (int tt = 0; tt < 8; ++tt) { acc[tt] = bd;
#pragma unroll
                for (int k = 0; k < 31; ++k) acc[tt] += w[k] * g[tt + k]; }
#pragma unroll
            for (int tt = 0; tt < 8; ++tt) hc[(ch * 8 + tt) * 256 + c] = acc[tt];
        }
    }
    __syncthreads();
    {
        const float4 gg = *(const float4*)(p.in[11] + l * 256 + lane * 4), bb = *(const float4*)(p.in[12] + l * 256 + lane * 4);
#pragma unroll 1
        for (int i = 0; i < 8; ++i) {
            const int t = wv * 8 + i;
            const float4 v = *(const float4*)(hc + t * 256 + lane * 4);
            float s = v.x + v.y + v.z + v.w;
#pragma unroll
            for (int o = 1; o < 64; o <<= 1) s += __shfl_xor(s, o);
            const float mean = s * (1.f / 256.f);
            const float d0 = v.x - mean, d1 = v.y - mean, d2 = v.z - mean, d3 = v.w - mean;
            float q = d0 * d0 + d1 * d1 + d2 * d2 + d3 * d3;
#pragma unroll
            for (int o = 1; o < 64; o <<= 1) q += __shfl_xor(q, o);
            const float rstd = rsqrtf(q * (1.f / 256.f) + EPS);
            float y0 = d0 * rstd * gg.x + bb.x, y1 = d1 * rstd * gg.y + bb.y, y2 = d2 * rstd * gg.z + bb.z, y3 = d3 * rstd * gg.w + bb.w;
            y0 = y0 / (1.f + __expf(-y0)); y1 = y1 / (1.f + __expf(-y1)); y2 = y2 / (1.f + __expf(-y2)); y3 = y3 / (1.f + __expf(-y3));
            u32x2 w; w.x = pk2(y0, y1); w.y = pk2(y2, y3);
            *(u32x2*)(p.MIXIN + (size_t)(tok0 + t) * 1024 + 512 + lane * 4) = w;
        }
    }
}
DI void fold_pw_item(const Params& p, int l, int item) {
    const int tid = threadIdx.x;
    const float* wo = p.in[16] + (size_t)l * D * D + (size_t)512 * D;
    if (item < 1024) {
        const int kp = item >> 2, n = (item & 3) * 256 + tid;
        const float* wp = p.in[13] + (size_t)l * 256 * 256 + (size_t)kp * 256;
        float acc = 0.f;
        for (int j = 0; j < 256; ++j) acc += wp[j] * wo[(size_t)j * D + n];
        p.WoT[((size_t)l * D + n) * D + 512 + kp] = f2bf(acc);
    } else {
        const int n = (item - 1024) * 256 + tid;
        const float* bp = p.in[14] + l * 256;
        float acc = 0.f;
        for (int j = 0; j < 256; ++j) acc += bp[j] * wo[(size_t)j * D + n];
        p.biasO[l * D + n] = acc;
    }
}

DI void p4_tile(const Params& p, int l, int tile, const float* xin, float* X1, char* lds) {
    int tid_ = threadIdx.x; asm volatile("" : "+v"(tid_)); const int tid = tid_, lane = tid & 63, r = lane & 31, hh = lane >> 5;
    const int wv = __builtin_amdgcn_readfirstlane(tid >> 6), wm = wv >> 1, wn = wv & 1;
    const int mt = tile >> 3, nt = tile & 7, m0 = mt * 128, n0 = nt * 128;
    const bf16* A = p.MIXIN + (size_t)m0 * D;
    const bf16* W = p.WoT + ((size_t)l * D + n0) * D;
    f32x16 acc[2][2]; zero_acc(acc);
    int frow[2], grow[2];
    frow[0] = 64 * wn + cperm_lin(r); frow[1] = frow[0] + 32; grow[0] = 64 * wm + r; grow[1] = grow[0] + 32;
    gemm_core<2, 2>(A, D, W, D, D, lds, acc, TILE_B, frow, 0, grow);
#pragma unroll
    for (int y = 0; y < 2; ++y) {
        const int tok = m0 + 64 * wm + 32 * y + r, b = (p.tok0 + tok) / SEQ;
        const float* gt = p.MOD + ((size_t)l * BATCH + b) * 6 * D + 2 * D;
#pragma unroll
        for (int x = 0; x < 2; ++x) {
            const int col = n0 + 64 * wn + 32 * x + 16 * hh;
#pragma unroll
            for (int q = 0; q < 4; ++q) {
                const float4 xv = *(const float4*)(xin + (size_t)tok * D + col + 4 * q), g4 = *(const float4*)(gt + col + 4 * q), b4 = *(const float4*)(p.biasO + l * D + col + 4 * q);
                float4 o;
                o.x = DN_ALPHA * xv.x + (1.f + g4.x) * (acc[x][y][4 * q + 0] + b4.x); o.y = DN_ALPHA * xv.y + (1.f + g4.y) * (acc[x][y][4 * q + 1] + b4.y);
                o.z = DN_ALPHA * xv.z + (1.f + g4.z) * (acc[x][y][4 * q + 2] + b4.z); o.w = DN_ALPHA * xv.w + (1.f + g4.w) * (acc[x][y][4 * q + 3] + b4.w);
                *(float4*)(X1 + (size_t)tok * D + col + 4 * q) = o;
            }
        }
    }
}

DI void ln16(float (&v)[16], const float* g, const float* bta, int lane) {
    float s = 0.f;
#pragma unroll
    for (int i = 0; i < 16; ++i) s += v[i];
#pragma unroll
    for (int o = 1; o < 64; o <<= 1) s += __shfl_xor(s, o);
    const float mean = s * (1.f / D); float q = 0.f;
#pragma unroll
    for (int i = 0; i < 16; ++i) { v[i] -= mean; q += v[i] * v[i]; }
#pragma unroll
    for (int o = 1; o < 64; o <<= 1) q += __shfl_xor(q, o);
    const float rstd = rsqrtf(q * (1.f / D) + EPS);
#pragma unroll
    for (int hf = 0; hf < 2; ++hf)
#pragma unroll
        for (int q4 = 0; q4 < 2; ++q4) {
            const int c = hf * 512 + lane * 8 + q4 * 4;
            const float4 gg = *(const float4*)(g + c), bb = *(const float4*)(bta + c);
            const int i = hf * 8 + q4 * 4;
            v[i] = v[i] * rstd * gg.x + bb.x; v[i + 1] = v[i + 1] * rstd * gg.y + bb.y; v[i + 2] = v[i + 2] * rstd * gg.z + bb.z; v[i + 3] = v[i + 3] * rstd * gg.w + bb.w;
        }
}
DI void load16(float (&v)[16], const float* row, int lane) {
#pragma unroll
    for (int hf = 0; hf < 2; ++hf)
#pragma unroll
        for (int q4 = 0; q4 < 2; ++q4) { const float4 t = *(const float4*)(row + hf * 512 + lane * 8 + q4 * 4); const int i = hf * 8 + q4 * 4; v[i] = t.x; v[i + 1] = t.y; v[i + 2] = t.z; v[i + 3] = t.w; }
}
DI void store16f(float* row, const float (&v)[16], int lane) {
#pragma unroll
    for (int hf = 0; hf < 2; ++hf)
#pragma unroll
        for (int q4 = 0; q4 < 2; ++q4) { const int i = hf * 8 + q4 * 4; *(float4*)(row + hf * 512 + lane * 8 + q4 * 4) = make_float4(v[i], v[i + 1], v[i + 2], v[i + 3]); }
}
DI void store_mod16(bf16* hrow, const float (&v)[16], const float* sh, const float* sc, int lane) {
#pragma unroll
    for (int hf = 0; hf < 2; ++hf) {
        float o[8];
#pragma unroll
        for (int q4 = 0; q4 < 2; ++q4) {
            const int c = hf * 512 + lane * 8 + q4 * 4, i = hf * 8 + q4 * 4;
            const float4 s4 = *(const float4*)(sc + c), h4 = *(const float4*)(sh + c);
            o[q4 * 4] = v[i] * (1.f + s4.x) + h4.x; o[q4 * 4 + 1] = v[i + 1] * (1.f + s4.y) + h4.y; o[q4 * 4 + 2] = v[i + 2] * (1.f + s4.z) + h4.z; o[q4 * 4 + 3] = v[i + 3] * (1.f + s4.w) + h4.w;
        }
        store8(hrow + hf * 512 + lane * 8, o);
    }
}
DI void p4b_row(const Params& p, int l, int row, float* X1, int lane) {
    float v[16];
    load16(v, X1 + (size_t)row * D, lane);
    ln16(v, p.in[17] + l * D, p.in[18] + l * D, lane);
    store16f(X1 + (size_t)row * D, v, lane);
    const int b = (p.tok0 + row) / SEQ;
    const float* mod = p.MOD + ((size_t)l * BATCH + b) * 6 * D;
    store_mod16(p.H + (size_t)row * D, v, mod + 3 * D, mod + 4 * D, lane);
}

DI unsigned ford(float f) { const unsigned u = __float_as_uint(f); return u ^ ((u >> 31) ? 0xffffffffu : 0x80000000u); }
DI float funord(unsigned o) { const unsigned u = o ^ ((o >> 31) ? 0x80000000u : 0xffffffffu); return __uint_as_float(u); }
constexpr int SKSTR = 272;

DI void p5_tile(const Params& p, int l, int tile, char* lds) {
    int tid_ = threadIdx.x; asm volatile("" : "+v"(tid_)); const int tid = tid_, lane = tid & 63, r = lane & 31, hh = lane >> 5;
    const int wv = __builtin_amdgcn_readfirstlane(tid >> 6);
    const int mt = tile >> 4, hp = tile & 15, m0 = mt * 128;
    const bf16* A = p.H + (size_t)m0 * D;
    const bf16* W = p.WpqT + ((size_t)l * 2048 + hp * 128) * D;
    f32x16 acc[4][1]; zero_acc(acc);
    int frow[4], grow[1];
#pragma unroll
    for (int x = 0; x < 4; ++x) frow[x] = 32 * x + r;
    grow[0] = 32 * wv + r;
    gemm_core<4, 1>(A, D, W, D, D, lds, acc, TILE_B, frow, 0, grow);
    bf16x8 xb[8];
#pragma unroll
    for (int s = 0; s < 8; ++s) {
        const int x = s >> 1, o = 8 * (s & 1);
        u32x4 w; w.x = pk2(acc[x][0][o], acc[x][0][o + 1]); w.y = pk2(acc[x][0][o + 2], acc[x][0][o + 3]); w.z = pk2(acc[x][0][o + 4], acc[x][0][o + 5]); w.w = pk2(acc[x][0][o + 6], acc[x][0][o + 7]);
        xb[s] = __builtin_bit_cast(bf16x8, w);
    }
    const bf16* sk = p.SKp + ((size_t)l * 16 + hp) * 128 * 128;
#pragma unroll
    for (int i = 0; i < 8; ++i) { const int q = tid + 256 * i, row = q >> 4, c = q & 15; *(u32x4*)(lds + row * SKSTR + c * 16) = *(const u32x4*)(sk + row * 128 + c * 8); }
    __syncthreads();
    unsigned L[16];
#pragma unroll
    for (int k = 0; k < 16; ++k) L[k] = 0u;
#pragma unroll
    for (int m2 = 0; m2 < 4; ++m2) {
        f32x16 st;
#pragma unroll
        for (int i = 0; i < 16; ++i) st[i] = 0.f;
#pragma unroll
        for (int s = 0; s < 8; ++s) {
            const bf16x8 a = *(const bf16x8*)(lds + (32 * m2 + r) * SKSTR + s * 32 + hh * 16);
            st = MFMA32(a, xb[s], st);
        }
#pragma unroll
        for (int i = 0; i < 16; ++i) {
            unsigned v = (ford(st[i]) & ~0x7fu) | (unsigned)(32 * m2 + crow(i, hh));
#pragma unroll
            for (int k = 0; k < 16; ++k) { const unsigned t = max(L[k], v); v = min(L[k], v); L[k] = t; }
        }
    }
    unsigned C[16];
#pragma unroll
    for (int k = 0; k < 16; ++k) C[k] = max(L[k], (unsigned)__shfl_xor((int)L[15 - k], 32));
#pragma unroll
    for (int d = 8; d >= 1; d >>= 1)
#pragma unroll
        for (int i = 0; i < 16; ++i) if ((i & d) == 0) { const unsigned a = max(C[i], C[i + d]), b = min(C[i], C[i + d]); C[i] = a; C[i + d] = b; }
    unsigned* dst = p.TOPK + ((size_t)(m0 + 32 * wv + r) * 16 + hp) * 16 + 8 * hh;
    u32x4 o0, o1;
    if (hh == 0) { o0 = (u32x4){C[0], C[1], C[2], C[3]}; o1 = (u32x4){C[4], C[5], C[6], C[7]}; }
    else { o0 = (u32x4){C[8], C[9], C[10], C[11]}; o1 = (u32x4){C[12], C[13], C[14], C[15]}; }
    *(u32x4*)dst = o0; *(u32x4*)(dst + 4) = o1;
}
typedef __bf16 bf16x2v __attribute__((ext_vector_type(2)));
DI float dot2(unsigned a, unsigned b, float c) { return __builtin_amdgcn_fdot2_f32_bf16(__builtin_bit_cast(bf16x2v, a), __builtin_bit_cast(bf16x2v, b), c, false); }
DI float gelu_erf(float a) { return 0.5f * a * (1.f + erff(a * 0.70710678118654752f)); }

DI void p6_unit(const Params& p, int l, int u, const float* X1, float* xout, char* lds) {
    int tid_ = threadIdx.x; asm volatile("" : "+v"(tid_)); const int tid = tid_, lane = tid & 63;
    const int wv = __builtin_amdgcn_readfirstlane(tid >> 6);
    unsigned* LA = (unsigned*)(lds + wv * 16384); unsigned* LB = LA + 1024; unsigned* Ee = LA + 2048; float* Eg = (float*)(LA + 3072);
    const int tokb = u * 32 + wv * 8;
    __syncthreads();
    {
        const int ti = lane >> 3, head = lane & 7;
        const unsigned* src = p.TOPK + ((size_t)(tokb + ti) * 16 + head * 2) * 16;
        unsigned A[16], B[16];
#pragma unroll
        for (int q = 0; q < 4; ++q) { const u32x4 a = *(const u32x4*)(src + 4 * q), b = *(const u32x4*)(src + 16 + 4 * q);
            A[4 * q] = a.x; A[4 * q + 1] = a.y; A[4 * q + 2] = a.z; A[4 * q + 3] = a.w; B[4 * q] = b.x; B[4 * q + 1] = b.y; B[4 * q + 2] = b.z; B[4 * q + 3] = b.w;
            *(u32x4*)(LA + lane * 16 + 4 * q) = a; *(u32x4*)(LB + lane * 16 + 4 * q) = b; }
        float sA[16], sB[16];
#pragma unroll
        for (int k = 0; k < 16; ++k) { sA[k] = funord(A[k] & ~0x7fu); sB[k] = funord(B[k] & ~0x7fu); }
        unsigned T[16];
#pragma unroll
        for (int k = 0; k < 16; ++k) T[k] = 0u;
#pragma unroll
        for (int a = 0; a < 16; ++a)
#pragma unroll
            for (int b = 0; b < 16; ++b)
                if ((a + 1) * (b + 1) <= 16) {
                    unsigned v = (ford(sA[a] + sB[b]) & ~0xffu) | (unsigned)(a * 16 + b);
#pragma unroll
                    for (int k = 0; k < 16; ++k) { const unsigned t = max(T[k], v); v = min(T[k], v); T[k] = t; }
                }
        float ex[16]; float sum = 0.f; const float mx = funord(T[0] & ~0xffu);
#pragma unroll
        for (int k = 0; k < 16; ++k) { ex[k] = __expf(funord(T[k] & ~0xffu) - mx); sum += ex[k]; }
        const float inv = 1.f / sum;
#pragma unroll
        for (int k = 0; k < 16; ++k) {
            const unsigned cid = T[k] & 0xffu, ia = LA[lane * 16 + (cid >> 4)] & 0x7fu, ib = LB[lane * 16 + (cid & 15u)] & 0x7fu;
            Ee[ti * 128 + head * 16 + k] = ia * 128u + ib; Eg[ti * 128 + head * 16 + k] = ex[k] * inv;
        }
    }
    const bf16* Ut = p.Ut; const bf16* Vt = p.Vt;
    const int jl = 4 * (lane >> 5) + 2 * ((lane >> 4) & 1) + ((lane >> 3) & 1);
    const bool b5 = lane & 32, b4 = lane & 16, b3 = lane & 8;
#pragma unroll 1
    for (int ti = 0; ti < 8; ++ti) {
        const int tok = tokb + ti;
        const u32x4 h0 = *(const u32x4*)(p.H + (size_t)tok * D + lane * 8), h1 = *(const u32x4*)(p.H + (size_t)tok * D + 512 + lane * 8);
        float y[16];
#pragma unroll
        for (int i = 0; i < 16; ++i) y[i] = 0.f;
#pragma unroll 1
        for (int bt = 0; bt < 16; ++bt) {
            u32x4 uu[8][2], vv[8][2];
#pragma unroll
            for (int j = 0; j < 8; ++j) {
                const unsigned e = __builtin_amdgcn_readfirstlane(Ee[ti * 128 + bt * 8 + j]);
                const bf16* ur = Ut + (size_t)e * D + lane * 8; const bf16* vr = Vt + (size_t)e * D + lane * 8;
                uu[j][0] = *(const u32x4*)ur; uu[j][1] = *(const u32x4*)(ur + 512);
                vv[j][0] = *(const u32x4*)vr; vv[j][1] = *(const u32x4*)(vr + 512);
            }
            float a[8];
#pragma unroll
            for (int j = 0; j < 8; ++j) {
                float s = dot2(h0.x, uu[j][0].x, 0.f); s = dot2(h0.y, uu[j][0].y, s); s = dot2(h0.z, uu[j][0].z, s); s = dot2(h0.w, uu[j][0].w, s);
                s = dot2(h1.x, uu[j][1].x, s); s = dot2(h1.y, uu[j][1].y, s); s = dot2(h1.z, uu[j][1].z, s); s = dot2(h1.w, uu[j][1].w, s);
                a[j] = s;
            }
            float k1[4], k2[2], k3;
#pragma unroll
            for (int i = 0; i < 4; ++i) { const float snd = b5 ? a[i] : a[4 + i]; const float rcv = __shfl_xor(snd, 32); k1[i] = (b5 ? a[4 + i] : a[i]) + rcv; }
#pragma unroll
            for (int i = 0; i < 2; ++i) { const float snd = b4 ? k1[i] : k1[2 + i]; const float rcv = __shfl_xor(snd, 16); k2[i] = (b4 ? k1[2 + i] : k1[i]) + rcv; }
            { const float snd = b3 ? k2[0] : k2[1]; const float rcv = __shfl_xor(snd, 8); k3 = (b3 ? k2[1] : k2[0]) + rcv; }
            k3 += __shfl_xor(k3, 4); k3 += __shfl_xor(k3, 2); k3 += __shfl_xor(k3, 1);
            const float w = Eg[ti * 128 + bt * 8 + jl] * gelu_erf(k3);
#pragma unroll
            for (int j = 0; j < 8; ++j) {
                const int src = 32 * (j >> 2) + 16 * ((j >> 1) & 1) + 8 * (j & 1);
                const float wj = __uint_as_float(__builtin_amdgcn_readlane(__float_as_uint(w), src));
                const unsigned w0[4] = {vv[j][0].x, vv[j][0].y, vv[j][0].z, vv[j][0].w}, w1[4] = {vv[j][1].x, vv[j][1].y, vv[j][1].z, vv[j][1].w};
#pragma unroll
                for (int i = 0; i < 4; ++i) { y[2 * i] += wj * bflo(w0[i]); y[2 * i + 1] += wj * bfhi(w0[i]); y[8 + 2 * i] += wj * bflo(w1[i]); y[8 + 2 * i + 1] += wj * bfhi(w1[i]); }
            }
        }
        const int b = (p.tok0 + tok) / SEQ;
        const float* mod = p.MOD + ((size_t)l * BATCH + b) * 6 * D;
        float v[16], gt[16];
        load16(v, X1 + (size_t)tok * D, lane); load16(gt, mod + 5 * D, lane);
#pragma unroll
        for (int i = 0; i < 16; ++i) v[i] = DN_ALPHA * v[i] + (1.f + gt[i]) * y[i];
        ln16(v, p.in[23] + l * D, p.in[24] + l * D, lane);
        store16f(xout + (size_t)tok * D, v, lane);
        if (l + 1 < DEPTH) { const float* modn = p.MOD + ((size_t)(l + 1) * BATCH + b) * 6 * D; store_mod16(p.H + (size_t)tok * D, v, modn, modn + D, lane); }
    }
}
DI void ada_item(const Params& p, int item, char* lds) {
    int tid_ = threadIdx.x; asm volatile("" : "+v"(tid_)); const int tid = tid_, lane = tid & 63, wv = tid >> 6;
    float* cs = (float*)lds;
    float* part = cs + 4 * D;
    __syncthreads();
    for (int i = tid; i < BATCH * D; i += 256) { const float cv = p.in[1][i]; cs[i] = cv / (1.f + __expf(-cv)); }
    __syncthreads();
    const int col = item * 64 + lane, l = col / (6 * D), j = col % (6 * D);
    const float* w = p.in[2] + (size_t)l * D * 6 * D + j;
    float a0 = 0.f, a1 = 0.f, a2 = 0.f, a3 = 0.f;
#pragma unroll 4
    for (int k = wv * 256; k < wv * 256 + 256; ++k) { const float wk = w[(size_t)k * 6 * D]; a0 += cs[k] * wk; a1 += cs[D + k] * wk; a2 += cs[2 * D + k] * wk; a3 += cs[3 * D + k] * wk; }
    part[(wv * 4 + 0) * 64 + lane] = a0; part[(wv * 4 + 1) * 64 + lane] = a1; part[(wv * 4 + 2) * 64 + lane] = a2; part[(wv * 4 + 3) * 64 + lane] = a3;
    __syncthreads();
    {
        const float s = part[(0 * 4 + wv) * 64 + lane] + part[(1 * 4 + wv) * 64 + lane] + part[(2 * 4 + wv) * 64 + lane] + part[(3 * 4 + wv) * 64 + lane];
        p.MOD[((size_t)l * BATCH + wv) * 6 * D + j] = s + p.in[3][l * 6 * D + j];
    }
}

DI void rope_table_item(const Params& p, int idx) {
    const int pos = idx >> 4, i = idx & 15;
    const float inv = 1.0f / powf(10000.0f, (float)(2 * i) / 32.0f);
    const float ang = (float)pos * inv;
    double fr = (double)ang * 0.15915494309189535;
    fr -= rint(fr);
    const float f = (float)fr;
    p.COS[idx] = __builtin_amdgcn_cosf(f); p.SIN[idx] = __builtin_amdgcn_sinf(f);
}

DI void convert_tables(const Params& p, int l, int bid, int nb) {
    const float* us = p.in[21] + (size_t)l * 16384 * D; const float* vs = p.in[22] + (size_t)l * 16384 * D;
    const size_t n8 = (size_t)16384 * D / 8;
    for (size_t i = (size_t)bid * 256 + threadIdx.x; i < n8; i += (size_t)nb * 256) { cvt8(us, p.Ut, i); cvt8(vs, p.Vt, i); }
}

DI void prologue(const Params& p, char* lds) {
    int tid_ = threadIdx.x; asm volatile("" : "+v"(tid_)); const int tid = tid_, lane = tid & 63, wv = tid >> 6, bid = blockIdx.x, nb = gridDim.x;
    for (int it = bid; it < DEPTH * 6 * D / 64; it += nb) ada_item(p, it, lds);
    __syncthreads();
    float* scr = (float*)(lds + wv * 16384);
    const int n_win = (D / 64) * (WIN_N / 32), n_uq = 4 * 24, n_ukv = 2 * 32, n_wo = 16 * 32, n_pq = 16 * 64, per_l = n_win + n_uq + n_ukv + n_wo + n_pq;
    for (int it = bid * 4 + wv; it < DEPTH * per_l; it += nb * 4) {
        const int l = it / per_l; int r = it % per_l;
        if (r < n_win) { transpose_item(TK_WIN, p.in[4] + (size_t)l * D * D_IN, D_IN, D, WIN_N, p.WinT + (size_t)l * WIN_N * D, nullptr, scr, r, lane); continue; } r -= n_win;
        if (r < n_uq) { transpose_item(TK_WUQ, p.in[6] + (size_t)l * 256 * 768, 768, 256, 768, p.WuqT + (size_t)l * 768 * 256, p.in[5] + l * 256, scr, r, lane); continue; } r -= n_uq;
        if (r < n_ukv) { transpose_item(TK_WUKV, p.in[8] + (size_t)l * 128 * 1024, 1024, 128, 1024, p.WukvT + (size_t)l * 1024 * 128, p.in[7] + l * 128, scr, r, lane); continue; } r -= n_ukv;
        if (r < n_wo) { transpose_item(TK_WO, p.in[16] + (size_t)l * D * D, D, D, D, p.WoT + (size_t)l * D * D, nullptr, scr, r, lane); continue; } r -= n_wo;
        transpose_item(TK_WPQ, p.in[19] + (size_t)l * D * 2048, 2048, D, 2048, p.WpqT + (size_t)l * 2048 * D, nullptr, scr, r, lane);
    }
    for (int it = bid; it < DEPTH * 1028; it += nb) fold_pw_item(p, it / 1028, it % 1028);
    for (size_t i = (size_t)bid * 256 + tid; i < (size_t)DEPTH * 16 * 128 * 128; i += (size_t)nb * 256)
        p.SKp[i] = f2bf(p.in[20][(i & ~(size_t)127) + perm16((int)(i & 127))]);
    for (int i = bid * 256 + tid; i < SEQ * 16; i += nb * 256) rope_table_item(p, i);
    convert_tables(p, 0, bid, nb);
}

DI void modh_items(const Params& p, int bid, int nb) {
    const size_t n8 = (size_t)p.rows * D / 8;
    for (size_t i = (size_t)bid * 256 + threadIdx.x; i < n8; i += (size_t)nb * 256) {
        const size_t e = i * 8; const int row = (int)(e >> 10), col = (int)(e & 1023), b = row / SEQ;
        const float* mod = p.MOD + (size_t)b * 6 * D;
        const float4 x0 = *(const float4*)(p.in[0] + e), x1 = *(const float4*)(p.in[0] + e + 4);
        const float4 h0 = *(const float4*)(mod + col), h1 = *(const float4*)(mod + col + 4), s0 = *(const float4*)(mod + D + col), s1 = *(const float4*)(mod + D + col + 4);
        u32x4 o;
        o.x = pk2(x0.x * (1.f + s0.x) + h0.x, x0.y * (1.f + s0.y) + h0.y); o.y = pk2(x0.z * (1.f + s0.z) + h0.z, x0.w * (1.f + s0.w) + h0.w);
        o.z = pk2(x1.x * (1.f + s1.x) + h1.x, x1.y * (1.f + s1.y) + h1.y); o.w = pk2(x1.z * (1.f + s1.z) + h1.z, x1.w * (1.f + s1.w) + h1.w);
        *(u32x4*)(p.H + e) = o;
    }
}

__global__ void __launch_bounds__(256, 2) mega(Params p) {
    extern __shared__ __attribute__((aligned(16))) char lds[];
    cg::grid_group grid = cg::this_grid();
    const int bid = blockIdx.x, nb = gridDim.x;
    const int rows = p.rows, mtiles = rows / 128;
    prologue(p, lds);
    grid.sync();
    modh_items(p, bid, nb);
    grid.sync();
    for (int l = 0; l < DEPTH; ++l) {
        const float* xin = (l == 0) ? p.in[0] : p.XB;
        float* X1 = p.out;
        float* xout = (l + 1 < DEPTH) ? p.XB : p.out;
        for (int t = bid; t < mtiles * 12; t += nb) p1_tile(p, l, t, lds);
        if (l > 0) convert_tables(p, l, bid, nb);
        grid.sync();
        for (int t = bid; t < mtiles * 14; t += nb) { if (t < mtiles * 6) p2q_tile(p, l, t, lds); else p2kv_tile(p, l, t - mtiles * 6, lds); }
        grid.sync();
        {
            const int nbt = rows / SEQ, nmla = nbt * 8 * 64, nswa = nbt * 4 * 64, nconv = rows / 32, ntot = nmla + nswa + nconv;
            unsigned* ctr = p.ctr + l * 64;
            int* su = (int*)(lds + LDS_TOTAL - 16);
            for (;;) {
                __syncthreads();
                if (threadIdx.x == 0) *su = (int)atomicAdd(ctr, 1u);
                __syncthreads();
                const int u = *su;
                if (u >= ntot) break;
                if (u < nmla) mla_unit(p, u, lds);
                else if (u < nmla + nswa) swa_unit(p, l, u - nmla, lds);
                else conv_unit(p, l, u - nmla - nswa, lds);
            }
        }
        grid.sync();
        for (int t = bid; t < mtiles * 8; t += nb) p4_tile(p, l, t, xin, X1, lds);
        grid.sync();
        { int t_ = threadIdx.x; asm volatile("" : "+v"(t_)); const int wv = t_ >> 6, lane = t_ & 63; for (int r = bid * 4 + wv; r < rows; r += nb * 4) p4b_row(p, l, r, X1, lane); }
        grid.sync();
        for (int t = bid; t < mtiles * 16; t += nb) p5_tile(p, l, t, lds);
        grid.sync();
        for (int u = bid; u < rows / 32; u += nb) p6_unit(p, l, u, X1, xout, lds);
        if (l + 1 < DEPTH) grid.sync();
    }
}

extern "C" void kernel_launch(void* const* d_in, const int* in_sizes, int n_in, void* d_out, int out_size, void* d_ws, size_t ws_size, hipStream_t stream) {
    const size_t MiB = 1u << 20;
    char* ws = (char*)d_ws;
    Params P{};
    for (int i = 0; i < 25; ++i) P.in[i] = (const float*)d_in[i];
    P.out = (float*)d_out; P.rows = NTOK; P.tok0 = 0;
    size_t o = 0;
    auto take = [&](size_t mib) { char* r = ws + o; o += mib * MiB; return r; };
    char* ctl = take(1);
    P.ctr = (unsigned*)ctl; P.biasO = (float*)(ctl + 64 * 1024); P.MOD = (float*)(ctl + 128 * 1024);
    P.COS = (float*)take(1); P.SIN = P.COS + SEQ * 16;
    P.WinT = (bf16*)take(6); P.WuqT = (bf16*)take(1); P.WukvT = (bf16*)take(1); P.WoT = (bf16*)take(4); P.WpqT = (bf16*)take(8); P.SKp = (bf16*)take(1);
    P.Ut = (bf16*)take(32); P.Vt = (bf16*)take(32);
    P.H = (bf16*)take(64); P.MIXIN = P.H;
    P.PROJ = (bf16*)take(80); P.Q = (bf16*)take(48); P.TOPK = (unsigned*)P.Q;
    P.KN = (bf16*)take(32); P.KR = (bf16*)take(2); P.VT = (bf16*)take(32); P.VsT = (bf16*)take(8);
    P.XB = (float*)take(128);
    if (o > ws_size) { fprintf(stderr, "kernel_launch: workspace too small: need %zu, have %zu\n", o, ws_size); return; }
    static int grid_blocks = 0;
    if (!grid_blocks) {
        int dev = 0, cus = 0, per_cu = 0;
        (void)hipGetDevice(&dev);
        (void)hipDeviceGetAttribute(&cus, hipDeviceAttributeMultiprocessorCount, dev);
        (void)hipFuncSetAttribute((const void*)mega, hipFuncAttributeMaxDynamicSharedMemorySize, LDS_TOTAL);
        (void)hipOccupancyMaxActiveBlocksPerMultiprocessor(&per_cu, mega, 256, LDS_TOTAL);
        if (per_cu > 2) per_cu = 2;
        if (per_cu < 1) per_cu = 1;
        grid_blocks = cus * per_cu;
    }
    (void)hipMemsetAsync(ctl, 0, 4096, stream);
    void* args[] = {(void*)&P};
    hipError_t e = hipLaunchCooperativeKernel((void*)mega, dim3(grid_blocks), dim3(256), args, LDS_TOTAL, stream);
    if (e != hipSuccess) fprintf(stderr, "cooperative launch failed: %s (grid %d)\n", hipGetErrorString(e), grid_blocks);
}
```

```cpp
#include <hip/hip_runtime.h>
#include <hip/hip_cooperative_groups.h>
#include <cstdio>
#include <cstdint>
namespace cg = cooperative_groups;

constexpr int D = 1024, BATCH = 4, SEQ = 8192, DEPTH = 2, NTOK = BATCH * SEQ;
constexpr int D_IN = 1440;
constexpr int OFF_CQ = 0, OFF_CKV = 256, OFF_KR = 384, OFF_CONV = 416, OFF_QS = 928, OFF_KS = 1184, OFF_VS = 1312;
constexpr float EPS = 1e-6f;
constexpr float DN_ALPHA = 1.41421356237309515f;

typedef __attribute__((ext_vector_type(8))) short bf16x8;
typedef __attribute__((ext_vector_type(16))) float f32x16;
typedef __attribute__((ext_vector_type(4))) unsigned u32x4;
typedef __attribute__((ext_vector_type(2))) unsigned u32x2;
typedef float f32x2_t __attribute__((ext_vector_type(2)));
typedef __bf16 bf16x2_t __attribute__((ext_vector_type(2)));
typedef unsigned short bf16;
#define DI __device__ __forceinline__
#define MFMA32(a, b, c) __builtin_amdgcn_mfma_f32_32x32x16_bf16((a), (b), (c), 0, 0, 0)

DI unsigned pk2(float lo, float hi) { f32x2_t v = {lo, hi}; bf16x2_t b = __builtin_convertvector(v, bf16x2_t); return __builtin_bit_cast(unsigned, b); }
DI bf16 f2bf(float f) { return (bf16)(pk2(f, 0.f) & 0xffffu); }
DI float bf2f(bf16 b) { return __uint_as_float((unsigned)b << 16); }
DI float bflo(unsigned u) { return __uint_as_float(u << 16); }
DI float bfhi(unsigned u) { return __uint_as_float(u & 0xffff0000u); }
DI int crow(int reg, int hh) { return (reg & 3) + 8 * (reg >> 2) + 4 * hh; }
DI int cperm_lin(int rho) { return 16 * ((rho >> 2) & 1) + (rho & 3) + 4 * (rho >> 3); }
DI int cperm_rope(int rho) { int hh = (rho >> 2) & 1, reg = (rho & 3) + 4 * (rho >> 3); return (reg < 8) ? 8 * hh + reg : 16 + 8 * hh + (reg - 8); }
DI int perm16(int p) { int g = (p >> 2) & 3; g = (g == 1) ? 2 : (g == 2) ? 1 : g; return (p & ~15) | (g << 2) | (p & 3); }

constexpr float LOG2E = 1.4426950408889634f;
constexpr int PROJ_LD = 1280;
constexpr int WIN_N = 1536;
constexpr int TS = 144;
constexpr int TILE_B = 128 * TS;
constexpr int STAGE_B = 2 * TILE_B;
constexpr int LDS_BYTES = 2 * STAGE_B;

struct Params {
    const float* in[25];
    float* out;
    bf16 *WinT, *WuqT, *WukvT, *WoT, *WpqT, *SKp, *Ut, *Vt;
    float* biasO;
    float* MOD;
    float* COS; float* SIN;
    bf16 *H, *PROJ, *Q, *KN, *KR, *VT, *VsT, *MIXIN;
    float* XB;
    unsigned* TOPK;
    unsigned char *U8, *V8; float *US, *VS;
    unsigned* ctr;
    int rows;
    int tok0;
};

enum { TK_WIN = 0, TK_WUQ = 1, TK_WUKV = 2, TK_WO = 3, TK_WPQ = 4 };
DI void transpose_item(int kind, const float* W, int ldin, int K, int Nout, bf16* WT, const float* rowscale, float* scr, int item, int lane) {
    const int nblk = Nout / 32, kb = item / nblk, nb = item % nblk, k0 = 64 * kb, n0 = 32 * nb;
    int src0 = n0; float cs = 1.f;
    if (kind == TK_WIN) {
        if (n0 < 384) src0 = n0;
        else if (n0 < 896) src0 = 416 + (n0 - 384);
        else if (n0 < 1152) { src0 = 928 + (n0 - 896); cs = 0.125f * LOG2E; }
        else if (n0 < 1280) src0 = 1184 + (n0 - 1152);
        else if (n0 < 1408) src0 = 1312 + (n0 - 1280);
        else if (n0 < 1440) src0 = 384 + (n0 - 1408);
        else src0 = -1;
    } else if (kind == TK_WUQ) cs = 0.10206207261596577f * LOG2E;
#pragma unroll 8
    for (int i = 0; i < 32; ++i) {
        const int kk = 2 * i + (lane >> 5);
        float v = (src0 >= 0) ? W[(size_t)(k0 + kk) * ldin + src0 + (lane & 31)] : 0.f;
        if (rowscale) v *= rowscale[k0 + kk];
        scr[kk * 33 + (lane & 31)] = v * cs;
    }
    __builtin_amdgcn_s_waitcnt(0xc07f); asm volatile("" ::: "memory");
    const int c = lane & 7;
#pragma unroll
    for (int j = 0; j < 4; ++j) {
        const int n = (lane >> 3) + 8 * j; const float* s = scr + (8 * c) * 33 + n;
        u32x4 o; o.x = pk2(s[0], s[33]); o.y = pk2(s[66], s[99]); o.z = pk2(s[132], s[165]); o.w = pk2(s[198], s[231]);
        if (!(kind == TK_WO && k0 + 8 * c >= 512 && k0 + 8 * c < 768))
            *(u32x4*)(WT + (size_t)(n0 + n) * K + k0 + 8 * c) = o;
    }
    __builtin_amdgcn_s_waitcnt(0xc07f); asm volatile("" ::: "memory");
}

DI void cvt8(const float* src, bf16* dst, size_t i8) {
    const float4 a = ((const float4*)src)[2 * i8], b = ((const float4*)src)[2 * i8 + 1];
    u32x4 o; o.x = pk2(a.x, a.y); o.y = pk2(a.z, a.w); o.z = pk2(b.x, b.y); o.w = pk2(b.z, b.w);
    ((u32x4*)dst)[i8] = o;
}

struct TileRegs { u32x4 v[4]; };
DI void gload_tile(TileRegs& t, const bf16* base, int ld, int k0, int tid) {
#pragma unroll
    for (int i = 0; i < 4; ++i) { const int q = tid + 256 * i, row = q >> 3, kc = q & 7; t.v[i] = *(const u32x4*)(base + (size_t)row * ld + k0 + kc * 8); }
}
DI void sstore_tile(const TileRegs& t, char* lds, int tid) {
#pragma unroll
    for (int i = 0; i < 4; ++i) { const int q = tid + 256 * i, row = q >> 3, kc = q & 7; *(u32x4*)(lds + row * TS + kc * 16) = t.v[i]; }
}
template <int NF, int NG>
DI void gemm_core(const bf16* A, int lda, const bf16* W, int ldw, int K, char* lds, f32x16 (&acc)[NF][NG], int fo, const int (&frow)[NF], int go, const int (&grow)[NG]) {
    int tid_ = threadIdx.x; asm volatile("" : "+v"(tid_)); const int tid = tid_, hh = (tid & 63) >> 5;
    TileRegs ta, tw;
    gload_tile(ta, A, lda, 0, tid); gload_tile(tw, W, ldw, 0, tid);
    __syncthreads();
    sstore_tile(ta, lds, tid); sstore_tile(tw, lds + TILE_B, tid);
    __syncthreads();
    const int nk = K / 64;
    for (int ks = 0; ks < nk; ++ks) {
        char* cur = lds + (ks & 1) * STAGE_B;
        if (ks + 1 < nk) { gload_tile(ta, A, lda, (ks + 1) * 64, tid); gload_tile(tw, W, ldw, (ks + 1) * 64, tid); }
#pragma unroll
        for (int kk = 0; kk < 4; ++kk) {
            bf16x8 f[NF], g[NG];
#pragma unroll
            for (int x = 0; x < NF; ++x) f[x] = *(const bf16x8*)(cur + fo + frow[x] * TS + kk * 32 + hh * 16);
#pragma unroll
            for (int y = 0; y < NG; ++y) g[y] = *(const bf16x8*)(cur + go + grow[y] * TS + kk * 32 + hh * 16);
#pragma unroll
            for (int x = 0; x < NF; ++x)
#pragma unroll
                for (int y = 0; y < NG; ++y) acc[x][y] = MFMA32(f[x], g[y], acc[x][y]);
        }
        if (ks + 1 < nk) { char* nxt = lds + ((ks + 1) & 1) * STAGE_B; sstore_tile(ta, nxt, tid); sstore_tile(tw, nxt + TILE_B, tid); }
        __syncthreads();
    }
}

template <int NF, int NG> DI void zero_acc(f32x16 (&acc)[NF][NG]) {
#pragma unroll
    for (int x = 0; x < NF; ++x)
#pragma unroll
        for (int y = 0; y < NG; ++y)
#pragma unroll
            for (int r = 0; r < 16; ++r) acc[x][y][r] = 0.f;
}

DI void store16(bf16* dst, const float* v) {
    u32x4 a, b;
    a.x = pk2(v[0], v[1]); a.y = pk2(v[2], v[3]); a.z = pk2(v[4], v[5]); a.w = pk2(v[6], v[7]);
    b.x = pk2(v[8], v[9]); b.y = pk2(v[10], v[11]); b.z = pk2(v[12], v[13]); b.w = pk2(v[14], v[15]);
    *(u32x4*)dst = a; *(u32x4*)(dst + 8) = b;
}
DI void store8(bf16* dst, const float* v) {
    u32x4 a; a.x = pk2(v[0], v[1]); a.y = pk2(v[2], v[3]); a.z = pk2(v[4], v[5]); a.w = pk2(v[6], v[7]);
    *(u32x4*)dst = a;
}
DI void store_vt(bf16* dst, const f32x16& a, int hh) {
    float v0[8], v1[8];
#pragma unroll
    for (int i = 0; i < 8; ++i) { v0[i] = a[i]; v1[i] = a[8 + i]; }
    store8(dst + 8 * hh, v0); store8(dst + 16 + 8 * hh, v1);
}

DI void p1_tile(const Params& p, int l, int tile, char* lds) {
    int tid_ = threadIdx.x; asm volatile("" : "+v"(tid_)); const int tid = tid_, lane = tid & 63, r = lane & 31, hh = lane >> 5;
    const int wv = __builtin_amdgcn_readfirstlane(tid >> 6), wm = wv >> 1, wn = wv & 1;
    const int mt = tile / 12, nt = tile % 12, m0 = mt * 128, n0 = nt * 128;
    const bf16* A = p.H + (size_t)m0 * D;
    const bf16* W = p.WinT + ((size_t)l * WIN_N + n0) * D;
    f32x16 acc[2][2]; zero_acc(acc);
    int frow[2], grow[2];
    const bool kr = (nt == 11);
    int fo, go;
    if (nt == 10) { fo = 0; go = TILE_B; frow[0] = 64 * wm + r; frow[1] = frow[0] + 32; grow[0] = 64 * wn + r; grow[1] = grow[0] + 32; }
    else { fo = TILE_B; go = 0; frow[0] = 64 * wn + (kr ? cperm_rope(r) : cperm_lin(r)); frow[1] = 64 * wn + 32 + cperm_lin(r); grow[0] = 64 * wm + r; grow[1] = grow[0] + 32; }
    gemm_core<2, 2>(A, D, W, D, D, lds, acc, fo, frow, go, grow);
    if (nt == 10) {
#pragma unroll
        for (int x = 0; x < 2; ++x)
#pragma unroll
            for (int y = 0; y < 2; ++y) {
                const int tok = m0 + 64 * wm + 32 * x, b = tok / SEQ, s0 = tok % SEQ, d = 32 * y + r;
                store_vt(p.VsT + ((size_t)(b * 2 + wn) * 64 + d) * SEQ + s0, acc[x][y], hh);
            }
    } else {
        if (!kr) {
#pragma unroll
            for (int x = 0; x < 2; ++x)
#pragma unroll
                for (int y = 0; y < 2; ++y) {
                    const int tok = m0 + 64 * wm + 32 * y + r, col = n0 + 64 * wn + 32 * x + 16 * hh;
                    float v[16];
#pragma unroll
                    for (int i = 0; i < 16; ++i) v[i] = acc[x][y][i];
                    store16(p.PROJ + (size_t)tok * PROJ_LD + col, v);
                }
        } else if (wn == 0) {
#pragma unroll
            for (int y = 0; y < 2; ++y) {
                const int tok = m0 + 64 * wm + 32 * y + r, pos = tok % SEQ;
                const float4 c0 = *(const float4*)(p.COS + pos * 16 + 8 * hh), c1 = *(const float4*)(p.COS + pos * 16 + 8 * hh + 4);
                const float4 s0 = *(const float4*)(p.SIN + pos * 16 + 8 * hh), s1 = *(const float4*)(p.SIN + pos * 16 + 8 * hh + 4);
                const float cs[8] = {c0.x, c0.y, c0.z, c0.w, c1.x, c1.y, c1.z, c1.w}, sn[8] = {s0.x, s0.y, s0.z, s0.w, s1.x, s1.y, s1.z, s1.w};
                float o1[8], o2[8];
#pragma unroll
                for (int i = 0; i < 8; ++i) { const float t1 = acc[0][y][i], t2 = acc[0][y][8 + i]; o1[i] = t1 * cs[i] - t2 * sn[i]; o2[i] = t1 * sn[i] + t2 * cs[i]; }
                store8(p.KR + (size_t)tok * 32 + 8 * hh, o1); store8(p.KR + (size_t)tok * 32 + 16 + 8 * hh, o2);
            }
        }
    }
}
constexpr int LDS_RS_OFF = LDS_BYTES;
constexpr int LDS_TOTAL = LDS_BYTES + 1024;

template <int W> DI void row_rms(const bf16* A, int lda, float* rs, int tid) {
    const int row = tid >> 1, half = tid & 1;
    const u32x4* p = (const u32x4*)(A + (size_t)row * lda + half * (W / 2));
    float ss = 0.f;
#pragma unroll
    for (int i = 0; i < W / 16; ++i) { const u32x4 v = p[i];
        ss += bflo(v.x) * bflo(v.x) + bfhi(v.x) * bfhi(v.x) + bflo(v.y) * bflo(v.y) + bfhi(v.y) * bfhi(v.y)
            + bflo(v.z) * bflo(v.z) + bfhi(v.z) * bfhi(v.z) + bflo(v.w) * bflo(v.w) + bfhi(v.w) * bfhi(v.w); }
    ss += __shfl_xor(ss, 1);
    if (half == 0) rs[row] = rsqrtf(ss * (1.f / W) + EPS);
}

DI void p2q_tile(const Params& p, int l, int tile, char* lds) {
    int tid_ = threadIdx.x; asm volatile("" : "+v"(tid_)); const int tid = tid_, lane = tid & 63, r = lane & 31, hh = lane >> 5;
    const int wv = __builtin_amdgcn_readfirstlane(tid >> 6), wm = wv >> 1, wn = wv & 1;
    const int mt = tile / 6, nt = tile % 6, m0 = mt * 128, n0 = nt * 128;
    const bf16* A = p.PROJ + (size_t)m0 * PROJ_LD;
    const bf16* W = p.WuqT + ((size_t)l * 768 + n0) * 256;
    float* rs = (float*)(lds + LDS_RS_OFF);
    __syncthreads();
    row_rms<256>(A, PROJ_LD, rs, tid);
    f32x16 acc[2][2]; zero_acc(acc);
    int frow[2], grow[2]; bool rope[2];
#pragma unroll
    for (int x = 0; x < 2; ++x) { rope[x] = (((n0 + 64 * wn + 32 * x) >> 5) % 3) == 2; frow[x] = 64 * wn + 32 * x + (rope[x] ? cperm_rope(r) : cperm_lin(r)); }
    grow[0] = 64 * wm + r; grow[1] = grow[0] + 32;
    gemm_core<2, 2>(A, PROJ_LD, W, 256, 256, lds, acc, TILE_B, frow, 0, grow);
#pragma unroll
    for (int y = 0; y < 2; ++y) {
        const int tl = 64 * wm + 32 * y + r, tok = m0 + tl, pos = tok % SEQ;
        const float sc = rs[tl];
#pragma unroll
        for (int x = 0; x < 2; ++x) {
            bf16* dst = p.Q + (size_t)tok * 768 + n0 + 64 * wn + 32 * x;
            if (rope[x]) {
                const float4 c0 = *(const float4*)(p.COS + pos * 16 + 8 * hh), c1 = *(const float4*)(p.COS + pos * 16 + 8 * hh + 4);
                const float4 s0 = *(const float4*)(p.SIN + pos * 16 + 8 * hh), s1 = *(const float4*)(p.SIN + pos * 16 + 8 * hh + 4);
                const float cs[8] = {c0.x, c0.y, c0.z, c0.w, c1.x, c1.y, c1.z, c1.w}, sn[8] = {s0.x, s0.y, s0.z, s0.w, s1.x, s1.y, s1.z, s1.w};
                float o1[8], o2[8];
#pragma unroll
                for (int i = 0; i < 8; ++i) { const float t1 = acc[x][y][i] * sc, t2 = acc[x][y][8 + i] * sc; o1[i] = t1 * cs[i] - t2 * sn[i]; o2[i] = t1 * sn[i] + t2 * cs[i]; }
                store8(dst + 8 * hh, o1); store8(dst + 16 + 8 * hh, o2);
            } else {
                float v[16];
#pragma unroll
                for (int i = 0; i < 16; ++i) v[i] = acc[x][y][i] * sc;
                store16(dst + 16 * hh, v);
            }
        }
    }
}

DI void p2kv_tile(const Params& p, int l, int tile, char* lds) {
    int tid_ = threadIdx.x; asm volatile("" : "+v"(tid_)); const int tid = tid_, lane = tid & 63, r = lane & 31, hh = lane >> 5;
    const int wv = __builtin_amdgcn_readfirstlane(tid >> 6), wm = wv >> 1, wn = wv & 1;
    const int mt = tile >> 3, h = tile & 7, m0 = mt * 128, n0 = h * 128;
    const bf16* A = p.PROJ + (size_t)m0 * PROJ_LD + 256;
    const bf16* W = p.WukvT + ((size_t)l * 1024 + n0) * 128;
    float* rs = (float*)(lds + LDS_RS_OFF);
    __syncthreads();
    row_rms<128>(A, PROJ_LD, rs, tid);
    f32x16 acc[2][2]; zero_acc(acc);
    int frow[2], grow[2];
    int fo, go;
    if (wn == 0) { fo = TILE_B; go = 0; frow[0] = cperm_lin(r); frow[1] = 32 + cperm_lin(r); grow[0] = 64 * wm + r; grow[1] = grow[0] + 32; }
    else         { fo = 0; go = TILE_B; frow[0] = 64 * wm + r; frow[1] = frow[0] + 32; grow[0] = 64 + r; grow[1] = 96 + r; }
    gemm_core<2, 2>(A, PROJ_LD, W, 128, 128, lds, acc, fo, frow, go, grow);
    if (wn == 0) {
#pragma unroll
        for (int y = 0; y < 2; ++y) {
            const int tl = 64 * wm + 32 * y + r, tok = m0 + tl; const float sc = rs[tl];
#pragma unroll
            for (int x = 0; x < 2; ++x) {
                float v[16];
#pragma unroll
                for (int i = 0; i < 16; ++i) v[i] = acc[x][y][i] * sc;
                store16(p.KN + (size_t)tok * 512 + h * 64 + 32 * x + 16 * hh, v);
            }
        }
    } else {
#pragma unroll
        for (int x = 0; x < 2; ++x) {
            const int tl0 = 64 * wm + 32 * x, tok0 = m0 + tl0, b = tok0 / SEQ, s0 = tok0 % SEQ;
#pragma unroll
            for (int y = 0; y < 2; ++y) {
                f32x16 a = acc[x][y];
#pragma unroll
                for (int i = 0; i < 16; ++i) a[i] *= rs[tl0 + crow(i, hh)];
                store_vt(p.VT + ((size_t)(b * 8 + h) * 64 + 32 * y + r) * SEQ + s0, a, hh);
            }
        }
    }
}
constexpr int VSTR = 144;
template <int KD> struct AttnCfg { static constexpr int KSTR = KD * 2 + 16; static constexpr int BUF = 64 * KSTR + 64 * VSTR; };

template <int KD, int MODE>
DI void attn_unit(const bf16* Qp, int qld, const bf16* K1, int k1ld, const bf16* K2, const bf16* VTp, bf16* Op, int b, int qb, float sink_l2, char* lds) {
    constexpr int KSTR = AttnCfg<KD>::KSTR, BUF = AttnCfg<KD>::BUF, NKS = KD / 16;
    int tid_ = threadIdx.x; asm volatile("" : "+v"(tid_)); const int tid = tid_, lane = tid & 63, r = lane & 31, hh = lane >> 5;
    const int wv = __builtin_amdgcn_readfirstlane(tid >> 6);
    const int q0 = qb * 128, qpos = q0 + 32 * wv + r;
    const size_t rowb = (size_t)b * SEQ;
    bf16x8 qf[NKS];
#pragma unroll
    for (int ks = 0; ks < NKS; ++ks) qf[ks] = *(const bf16x8*)(Qp + (rowb + qpos) * qld + ks * 16 + hh * 8);
    const int kstart = (MODE == 0) ? 0 : (q0 >= 128 ? q0 - 128 : 0);
    const int nt = (q0 + 128 - kstart) / 64;
    f32x16 ot[2];
#pragma unroll
    for (int i = 0; i < 16; ++i) { ot[0][i] = 0.f; ot[1][i] = 0.f; }
    float m = (MODE == 0) ? -INFINITY : sink_l2, l = (MODE == 1 && hh == 0) ? 1.f : 0.f;
    u32x4 sk[3], sv[2];
    auto gload = [&](int t) {
        const int key0 = kstart + 64 * t;
#pragma unroll
        for (int i = 0; i < 2; ++i) { const int q = tid + 256 * i, row = q >> 3, c = q & 7;
            sk[i] = *(const u32x4*)(K1 + (rowb + key0 + row) * k1ld + c * 8);
            sv[i] = *(const u32x4*)(VTp + (size_t)row * SEQ + key0 + c * 8); }
        if (KD == 96) { const int row = tid >> 2, c = tid & 3; sk[2] = *(const u32x4*)(K2 + (rowb + key0 + row) * 32 + c * 8); }
    };
    auto sstore = [&](char* buf) {
#pragma unroll
        for (int i = 0; i < 2; ++i) { const int q = tid + 256 * i, row = q >> 3, c = q & 7;
            *(u32x4*)(buf + row * KSTR + c * 16) = sk[i];
            *(u32x4*)(buf + 64 * KSTR + row * VSTR + c * 16) = sv[i]; }
        if (KD == 96) { const int row = tid >> 2, c = tid & 3; *(u32x4*)(buf + row * KSTR + 128 + c * 16) = sk[2]; }
    };
    gload(0);
    __syncthreads();
    sstore(lds);
    __syncthreads();
    for (int t = 0; t < nt; ++t) {
        const char* cur = lds + (t & 1) * BUF;
        if (t + 1 < nt) gload(t + 1);
        const int key0 = kstart + 64 * t;
        f32x16 st[2];
#pragma unroll
        for (int mt = 0; mt < 2; ++mt) {
#pragma unroll
            for (int i = 0; i < 16; ++i) st[mt][i] = 0.f;
#pragma unroll
            for (int ks = 0; ks < NKS; ++ks) {
                const bf16x8 a = *(const bf16x8*)(cur + (mt * 32 + r) * KSTR + ks * 32 + hh * 16);
                st[mt] = MFMA32(a, qf[ks], st[mt]);
            }
        }
        const bool need_mask = (MODE == 1) || (key0 + 63 > q0 + 32 * wv);
        if (need_mask) {
#pragma unroll
            for (int mt = 0; mt < 2; ++mt)
#pragma unroll
                for (int i = 0; i < 16; ++i) {
                    const int key = key0 + mt * 32 + crow(i, hh);
                    const bool ok = (MODE == 0) ? (key <= qpos) : (key <= qpos && key > qpos - 128);
                    if (!ok) st[mt][i] = -INFINITY;
                }
        }
        float mx = st[0][0];
#pragma unroll
        for (int i = 1; i < 16; ++i) mx = fmaxf(mx, st[0][i]);
#pragma unroll
        for (int i = 0; i < 16; ++i) mx = fmaxf(mx, st[1][i]);
        { auto rr = __builtin_amdgcn_permlane32_swap(__float_as_uint(mx), __float_as_uint(mx), false, false); mx = fmaxf(__uint_as_float(rr[0]), __uint_as_float(rr[1])); }
        const float mn = fmaxf(m, mx);
        const float alpha = __builtin_amdgcn_exp2f(m - mn);
        m = mn;
        float ps = 0.f;
#pragma unroll
        for (int mt = 0; mt < 2; ++mt)
#pragma unroll
            for (int i = 0; i < 16; ++i) { const float pv = __builtin_amdgcn_exp2f(st[mt][i] - mn); st[mt][i] = pv; ps += pv; }
        l = l * alpha + ps;
#pragma unroll
        for (int i = 0; i < 16; ++i) { ot[0][i] *= alpha; ot[1][i] *= alpha; }
        bf16x8 pb[4];
#pragma unroll
        for (int s = 0; s < 4; ++s) {
            const int mt = s >> 1, o = 8 * (s & 1);
            u32x4 w; w.x = pk2(st[mt][o], st[mt][o + 1]); w.y = pk2(st[mt][o + 2], st[mt][o + 3]); w.z = pk2(st[mt][o + 4], st[mt][o + 5]); w.w = pk2(st[mt][o + 6], st[mt][o + 7]);
            pb[s] = __builtin_bit_cast(bf16x8, w);
        }
        const char* vt = cur + 64 * KSTR;
#pragma unroll
        for (int mt = 0; mt < 2; ++mt)
#pragma unroll
            for (int s = 0; s < 4; ++s) {
                const bf16x8 a = *(const bf16x8*)(vt + (mt * 32 + r) * VSTR + s * 32 + hh * 16);
                ot[mt] = MFMA32(a, pb[s], ot[mt]);
            }
        if (t + 1 < nt) sstore(lds + ((t + 1) & 1) * BUF);
        __syncthreads();
    }
    { auto rr = __builtin_amdgcn_permlane32_swap(__float_as_uint(l), __float_as_uint(l), false, false); l = __uint_as_float(rr[0]) + __uint_as_float(rr[1]); }
    const float inv = 1.f / l;
    bf16* orow = Op + (rowb + qpos) * 1024;
#pragma unroll
    for (int mt = 0; mt < 2; ++mt)
#pragma unroll
        for (int g = 0; g < 4; ++g) {
            u32x2 w; w.x = pk2(ot[mt][4 * g] * inv, ot[mt][4 * g + 1] * inv); w.y = pk2(ot[mt][4 * g + 2] * inv, ot[mt][4 * g + 3] * inv);
            *(u32x2*)(orow + mt * 32 + 8 * g + 4 * hh) = w;
        }
}

DI void mla_unit(const Params& p, int u, char* lds) {
    const int nbh = (p.rows / SEQ) * 8, qb = 63 - u / nbh, bh = u % nbh, b = bh >> 3, h = bh & 7;
    attn_unit<96, 0>(p.Q + h * 96, 768, p.KN + h * 64, 512, p.KR, p.VT + (size_t)bh * 64 * SEQ, p.MIXIN + h * 64, b, qb, 0.f, lds);
}
DI void swa_unit(const Params& p, int l, int u, char* lds) {
    const int qb = u & 63, bh = u >> 6, b = bh >> 2, hq = bh & 3, kvh = hq >> 1;
    attn_unit<64, 1>(p.PROJ + 896 + hq * 64, PROJ_LD, p.PROJ + 1152 + kvh * 64, PROJ_LD, nullptr, p.VsT + (size_t)(b * 2 + kvh) * 64 * SEQ, p.MIXIN + 768 + hq * 64, b, qb,
                     p.in[15][l * 4 + hq] * LOG2E, lds);
}

DI void conv_unit(const Params& p, int l, int u, char* lds) {
    int tid_ = threadIdx.x; asm volatile("" : "+v"(tid_)); const int tid = tid_, lane = tid & 63, wv = tid >> 6;
    const int tok0 = u * 32, pos0 = tok0 % SEQ;
    bf16* glu = (bf16*)lds;
    float* hc = (float*)(lds + 62 * 512);
    __syncthreads();
    for (int it = tid; it < 62 * 32; it += 256) {
        const int row = it >> 5, c8 = (it & 31) * 8, pos = pos0 - 30 + row;
        u32x4 o = {0u, 0u, 0u, 0u};
        if (pos >= 0) {
            const bf16* src = p.PROJ + (size_t)(tok0 - 30 + row) * PROJ_LD + 384 + c8;
            const u32x4 a = *(const u32x4*)src, g = *(const u32x4*)(src + 256);
            const unsigned av[4] = {a.x, a.y, a.z, a.w}, gv[4] = {g.x, g.y, g.z, g.w}; unsigned ov[4];
#pragma unroll
            for (int i = 0; i < 4; ++i) {
                const float g0 = bflo(gv[i]), g1 = bfhi(gv[i]);
                ov[i] = pk2(bflo(av[i]) / (1.f + __expf(-g0)), bfhi(av[i]) / (1.f + __expf(-g1)));
            }
            o.x = ov[0]; o.y = ov[1]; o.z = ov[2]; o.w = ov[3];
        }
        *(u32x4*)(glu + row * 256 + c8) = o;
    }
    __syncthreads();
    {
        const int c = tid;
        float w[31];
        const float* wd = p.in[9] + (size_t)l * 31 * 256 + c;
#pragma unroll
        for (int k = 0; k < 31; ++k) w[k] = wd[k * 256];
        const float bd = p.in[10][l * 256 + c];
#pragma unroll 1
        for (int ch = 0; ch < 4; ++ch) {
            float g[38], acc[8];
#pragma unroll
            for (int i = 0; i < 38; ++i) g[i] = bf2f(glu[(ch * 8 + i) * 256 + c]);
#pragma unroll
            for (int tt = 0; tt < 8; ++tt) { acc[tt] = bd;
#pragma unroll
                for (int k = 0; k < 31; ++k) acc[tt] += w[k] * g[tt + k]; }
#pragma unroll
            for (int tt = 0; tt < 8; ++tt) hc[(ch * 8 + tt) * 256 + c] = acc[tt];
        }
    }
    __syncthreads();
    {
        const float4 gg = *(const float4*)(p.in[11] + l * 256 + lane * 4), bb = *(const float4*)(p.in[12] + l * 256 + lane * 4);
#pragma unroll 1
        for (int i = 0; i < 8; ++i) {
            const int t = wv * 8 + i;
            const float4 v = *(const float4*)(hc + t * 256 + lane * 4);
            float s = v.x + v.y + v.z + v.w;
#pragma unroll
            for (int o = 1; o < 64; o <<= 1) s += __shfl_xor(s, o);
            const float mean = s * (1.f / 256.f);
            const float d0 = v.x - mean, d1 = v.y - mean, d2 = v.z - mean, d3 = v.w - mean;
            float q = d0 * d0 + d1 * d1 + d2 * d2 + d3 * d3;
#pragma unroll
            for (int o = 1; o < 64; o <<= 1) q += __shfl_xor(q, o);
            const float rstd = rsqrtf(q * (1.f / 256.f) + EPS);
            float y0 = d0 * rstd * gg.x + bb.x, y1 = d1 * rstd * gg.y + bb.y, y2 = d2 * rstd * gg.z + bb.z, y3 = d3 * rstd * gg.w + bb.w;
            y0 = y0 / (1.f + __expf(-y0)); y1 = y1 / (1.f + __expf(-y1)); y2 = y2 / (1.f + __expf(-y2)); y3 = y3 / (1.f + __expf(-y3));
            u32x2 w; w.x = pk2(y0, y1); w.y = pk2(y2, y3);
            *(u32x2*)(p.MIXIN + (size_t)(tok0 + t) * 1024 + 512 + lane * 4) = w;
        }
    }
}
DI void fold_pw_item(const Params& p, int l, int item) {
    const int tid = threadIdx.x;
    const float* wo = p.in[16] + (size_t)l * D * D + (size_t)512 * D;
    if (item < 1024) {
        const int kp = item >> 2, n = (item & 3) * 256 + tid;
        const float* wp = p.in[13] + (size_t)l * 256 * 256 + (size_t)kp * 256;
        float acc = 0.f;
        for (int j = 0; j < 256; ++j) acc += wp[j] * wo[(size_t)j * D + n];
        p.WoT[((size_t)l * D + n) * D + 512 + kp] = f2bf(acc);
    } else {
        const int n = (item - 1024) * 256 + tid;
        const float* bp = p.in[14] + l * 256;
        float acc = 0.f;
        for (int j = 0; j < 256; ++j) acc += bp[j] * wo[(size_t)j * D + n];
        p.biasO[l * D + n] = acc;
    }
}

DI void p4_tile(const Params& p, int l, int tile, const float* xin, float* X1, char* lds) {
    int tid_ = threadIdx.x; asm volatile("" : "+v"(tid_)); const int tid = tid_, lane = tid & 63, r = lane & 31, hh = lane >> 5;
    const int wv = __builtin_amdgcn_readfirstlane(tid >> 6), wm = wv >> 1, wn = wv & 1;
    const int mt = tile >> 3, nt = tile & 7, m0 = mt * 128, n0 = nt * 128;
    const bf16* A = p.MIXIN + (size_t)m0 * D;
    const bf16* W = p.WoT + ((size_t)l * D + n0) * D;
    f32x16 acc[2][2]; zero_acc(acc);
    int frow[2], grow[2];
    frow[0] = 64 * wn + cperm_lin(r); frow[1] = frow[0] + 32; grow[0] = 64 * wm + r; grow[1] = grow[0] + 32;
    gemm_core<2, 2>(A, D, W, D, D, lds, acc, TILE_B, frow, 0, grow);
#pragma unroll
    for (int y = 0; y < 2; ++y) {
        const int tok = m0 + 64 * wm + 32 * y + r, b = (p.tok0 + tok) / SEQ;
        const float* gt = p.MOD + ((size_t)l * BATCH + b) * 6 * D + 2 * D;
#pragma unroll
        for (int x = 0; x < 2; ++x) {
            const int col = n0 + 64 * wn + 32 * x + 16 * hh;
#pragma unroll
            for (int q = 0; q < 4; ++q) {
                const float4 xv = *(const float4*)(xin + (size_t)tok * D + col + 4 * q), g4 = *(const float4*)(gt + col + 4 * q), b4 = *(const float4*)(p.biasO + l * D + col + 4 * q);
                float4 o;
                o.x = DN_ALPHA * xv.x + (1.f + g4.x) * (acc[x][y][4 * q + 0] + b4.x); o.y = DN_ALPHA * xv.y + (1.f + g4.y) * (acc[x][y][4 * q + 1] + b4.y);
                o.z = DN_ALPHA * xv.z + (1.f + g4.z) * (acc[x][y][4 * q + 2] + b4.z); o.w = DN_ALPHA * xv.w + (1.f + g4.w) * (acc[x][y][4 * q + 3] + b4.w);
                *(float4*)(X1 + (size_t)tok * D + col + 4 * q) = o;
            }
        }
    }
}

DI void ln16(float (&v)[16], const float* g, const float* bta, int lane) {
    float s = 0.f;
#pragma unroll
    for (int i = 0; i < 16; ++i) s += v[i];
#pragma unroll
    for (int o = 1; o < 64; o <<= 1) s += __shfl_xor(s, o);
    const float mean = s * (1.f / D); float q = 0.f;
#pragma unroll
    for (int i = 0; i < 16; ++i) { v[i] -= mean; q += v[i] * v[i]; }
#pragma unroll
    for (int o = 1; o < 64; o <<= 1) q += __shfl_xor(q, o);
    const float rstd = rsqrtf(q * (1.f / D) + EPS);
#pragma unroll
    for (int hf = 0; hf < 2; ++hf)
#pragma unroll
        for (int q4 = 0; q4 < 2; ++q4) {
            const int c = hf * 512 + lane * 8 + q4 * 4;
            const float4 gg = *(const float4*)(g + c), bb = *(const float4*)(bta + c);
            const int i = hf * 8 + q4 * 4;
            v[i] = v[i] * rstd * gg.x + bb.x; v[i + 1] = v[i + 1] * rstd * gg.y + bb.y; v[i + 2] = v[i + 2] * rstd * gg.z + bb.z; v[i + 3] = v[i + 3] * rstd * gg.w + bb.w;
        }
}
DI void load16(float (&v)[16], const float* row, int lane) {
#pragma unroll
    for (int hf = 0; hf < 2; ++hf)
#pragma unroll
        for (int q4 = 0; q4 < 2; ++q4) { const float4 t = *(const float4*)(row + hf * 512 + lane * 8 + q4 * 4); const int i = hf * 8 + q4 * 4; v[i] = t.x; v[i + 1] = t.y; v[i + 2] = t.z; v[i + 3] = t.w; }
}
DI void store16f(float* row, const float (&v)[16], int lane) {
#pragma unroll
    for (int hf = 0; hf < 2; ++hf)
#pragma unroll
        for (int q4 = 0; q4 < 2; ++q4) { const int i = hf * 8 + q4 * 4; *(float4*)(row + hf * 512 + lane * 8 + q4 * 4) = make_float4(v[i], v[i + 1], v[i + 2], v[i + 3]); }
}
DI void store_mod16(bf16* hrow, const float (&v)[16], const float* sh, const float* sc, int lane) {
#pragma unroll
    for (int hf = 0; hf < 2; ++hf) {
        float o[8];
#pragma unroll
        for (int q4 = 0; q4 < 2; ++q4) {
            const int c = hf * 512 + lane * 8 + q4 * 4, i = hf * 8 + q4 * 4;
            const float4 s4 = *(const float4*)(sc + c), h4 = *(const float4*)(sh + c);
            o[q4 * 4] = v[i] * (1.f + s4.x) + h4.x; o[q4 * 4 + 1] = v[i + 1] * (1.f + s4.y) + h4.y; o[q4 * 4 + 2] = v[i + 2] * (1.f + s4.z) + h4.z; o[q4 * 4 + 3] = v[i + 3] * (1.f + s4.w) + h4.w;
        }
        store8(hrow + hf * 512 + lane * 8, o);
    }
}
DI void p4b_row(const Params& p, int l, int row, float* X1, int lane) {
    float v[16];
    load16(v, X1 + (size_t)row * D, lane);
    ln16(v, p.in[17] + l * D, p.in[18] + l * D, lane);
    store16f(X1 + (size_t)row * D, v, lane);
    const int b = (p.tok0 + row) / SEQ;
    const float* mod = p.MOD + ((size_t)l * BATCH + b) * 6 * D;
    store_mod16(p.H + (size_t)row * D, v, mod + 3 * D, mod + 4 * D, lane);
}

DI unsigned ford(float f) { const unsigned u = __float_as_uint(f); return u ^ ((u >> 31) ? 0xffffffffu : 0x80000000u); }
DI float funord(unsigned o) { const unsigned u = o ^ ((o >> 31) ? 0x80000000u : 0xffffffffu); return __uint_as_float(u); }
constexpr int SKSTR = 272;

DI void p5_tile(const Params& p, int l, int tile, char* lds) {
    int tid_ = threadIdx.x; asm volatile("" : "+v"(tid_)); const int tid = tid_, lane = tid & 63, r = lane & 31, hh = lane >> 5;
    const int wv = __builtin_amdgcn_readfirstlane(tid >> 6);
    const int mt = tile >> 4, hp = tile & 15, m0 = mt * 128;
    const bf16* A = p.H + (size_t)m0 * D;
    const bf16* W = p.WpqT + ((size_t)l * 2048 + hp * 128) * D;
    f32x16 acc[4][1]; zero_acc(acc);
    int frow[4], grow[1];
#pragma unroll
    for (int x = 0; x < 4; ++x) frow[x] = 32 * x + r;
    grow[0] = 32 * wv + r;
    gemm_core<4, 1>(A, D, W, D, D, lds, acc, TILE_B, frow, 0, grow);
    bf16x8 xb[8];
#pragma unroll
    for (int s = 0; s < 8; ++s) {
        const int x = s >> 1, o = 8 * (s & 1);
        u32x4 w; w.x = pk2(acc[x][0][o], acc[x][0][o + 1]); w.y = pk2(acc[x][0][o + 2], acc[x][0][o + 3]); w.z = pk2(acc[x][0][o + 4], acc[x][0][o + 5]); w.w = pk2(acc[x][0][o + 6], acc[x][0][o + 7]);
        xb[s] = __builtin_bit_cast(bf16x8, w);
    }
    const bf16* sk = p.SKp + ((size_t)l * 16 + hp) * 128 * 128;
#pragma unroll
    for (int i = 0; i < 8; ++i) { const int q = tid + 256 * i, row = q >> 4, c = q & 15; *(u32x4*)(lds + row * SKSTR + c * 16) = *(const u32x4*)(sk + row * 128 + c * 8); }
    __syncthreads();
    unsigned L[16];
#pragma unroll
    for (int k = 0; k < 16; ++k) L[k] = 0u;
#pragma unroll
    for (int m2 = 0; m2 < 4; ++m2) {
        f32x16 st;
#pragma unroll
        for (int i = 0; i < 16; ++i) st[i] = 0.f;
#pragma unroll
        for (int s = 0; s < 8; ++s) {
            const bf16x8 a = *(const bf16x8*)(lds + (32 * m2 + r) * SKSTR + s * 32 + hh * 16);
            st = MFMA32(a, xb[s], st);
        }
#pragma unroll
        for (int i = 0; i < 16; ++i) {
            unsigned v = (ford(st[i]) & ~0x7fu) | (unsigned)(32 * m2 + crow(i, hh));
#pragma unroll
            for (int k = 0; k < 16; ++k) { const unsigned t = max(L[k], v); v = min(L[k], v); L[k] = t; }
        }
    }
    unsigned C[16];
#pragma unroll
    for (int k = 0; k < 16; ++k) C[k] = max(L[k], (unsigned)__shfl_xor((int)L[15 - k], 32));
#pragma unroll
    for (int d = 8; d >= 1; d >>= 1)
#pragma unroll
        for (int i = 0; i < 16; ++i) if ((i & d) == 0) { const unsigned a = max(C[i], C[i + d]), b = min(C[i], C[i + d]); C[i] = a; C[i + d] = b; }
    unsigned* dst = p.TOPK + ((size_t)(m0 + 32 * wv + r) * 16 + hp) * 16 + 8 * hh;
    u32x4 o0, o1;
    if (hh == 0) { o0 = (u32x4){C[0], C[1], C[2], C[3]}; o1 = (u32x4){C[4], C[5], C[6], C[7]}; }
    else { o0 = (u32x4){C[8], C[9], C[10], C[11]}; o1 = (u32x4){C[12], C[13], C[14], C[15]}; }
    *(u32x4*)dst = o0; *(u32x4*)(dst + 4) = o1;
}
typedef __bf16 bf16x2v __attribute__((ext_vector_type(2)));
DI float dot2(unsigned a, unsigned b, float c) { return __builtin_amdgcn_fdot2_f32_bf16(__builtin_bit_cast(bf16x2v, a), __builtin_bit_cast(bf16x2v, b), c, false); }
DI float gelu_erf(float a) { return 0.5f * a * (1.f + erff(a * 0.70710678118654752f)); }

DI void p6_unit(const Params& p, int l, int u, const float* X1, float* xout, char* lds) {
    int tid_ = threadIdx.x; asm volatile("" : "+v"(tid_)); const int tid = tid_, lane = tid & 63;
    const int wv = __builtin_amdgcn_readfirstlane(tid >> 6);
    unsigned* LA = (unsigned*)(lds + wv * 16384); unsigned* LB = LA + 1024; unsigned* Ee = LA + 2048; float* Eg = (float*)(LA + 3072);
    const int tokb = u * 32 + wv * 8;
    __syncthreads();
    {
        const int ti = lane >> 3, head = lane & 7;
        const unsigned* src = p.TOPK + ((size_t)(tokb + ti) * 16 + head * 2) * 16;
        unsigned A[16], B[16];
#pragma unroll
        for (int q = 0; q < 4; ++q) { const u32x4 a = *(const u32x4*)(src + 4 * q), b = *(const u32x4*)(src + 16 + 4 * q);
            A[4 * q] = a.x; A[4 * q + 1] = a.y; A[4 * q + 2] = a.z; A[4 * q + 3] = a.w; B[4 * q] = b.x; B[4 * q + 1] = b.y; B[4 * q + 2] = b.z; B[4 * q + 3] = b.w;
            *(u32x4*)(LA + lane * 16 + 4 * q) = a; *(u32x4*)(LB + lane * 16 + 4 * q) = b; }
        float sA[16], sB[16];
#pragma unroll
        for (int k = 0; k < 16; ++k) { sA[k] = funord(A[k] & ~0x7fu); sB[k] = funord(B[k] & ~0x7fu); }
        unsigned T[16];
#pragma unroll
        for (int k = 0; k < 16; ++k) T[k] = 0u;
#pragma unroll
        for (int a = 0; a < 16; ++a)
#pragma unroll
            for (int b = 0; b < 16; ++b)
                if ((a + 1) * (b + 1) <= 16) {
                    unsigned v = (ford(sA[a] + sB[b]) & ~0xffu) | (unsigned)(a * 16 + b);
#pragma unroll
                    for (int k = 0; k < 16; ++k) { const unsigned t = max(T[k], v); v = min(T[k], v); T[k] = t; }
                }
        float ex[16]; float sum = 0.f; const float mx = funord(T[0] & ~0xffu);
#pragma unroll
        for (int k = 0; k < 16; ++k) { ex[k] = __expf(funord(T[k] & ~0xffu) - mx); sum += ex[k]; }
        const float inv = 1.f / sum;
#pragma unroll
        for (int k = 0; k < 16; ++k) {
            const unsigned cid = T[k] & 0xffu, ia = LA[lane * 16 + (cid >> 4)] & 0x7fu, ib = LB[lane * 16 + (cid & 15u)] & 0x7fu;
            Ee[ti * 128 + head * 16 + k] = ia * 128u + ib; Eg[ti * 128 + head * 16 + k] = ex[k] * inv;
        }
    }
    const bf16* Ut = p.Ut; const bf16* Vt = p.Vt;
    const int jl = 4 * (lane >> 5) + 2 * ((lane >> 4) & 1) + ((lane >> 3) & 1);
    const bool b5 = lane & 32, b4 = lane & 16, b3 = lane & 8;
#pragma unroll 1
    for (int ti = 0; ti < 8; ++ti) {
        const int tok = tokb + ti;
        const u32x4 h0 = *(const u32x4*)(p.H + (size_t)tok * D + lane * 8), h1 = *(const u32x4*)(p.H + (size_t)tok * D + 512 + lane * 8);
        float y[16];
#pragma unroll
        for (int i = 0; i < 16; ++i) y[i] = 0.f;
#pragma unroll 1
        for (int bt = 0; bt < 16; ++bt) {
            u32x4 uu[8][2], vv[8][2];
#pragma unroll
            for (int j = 0; j < 8; ++j) {
                const unsigned e = __builtin_amdgcn_readfirstlane(Ee[ti * 128 + bt * 8 + j]);
                const bf16* ur = Ut + (size_t)e * D + lane * 8; const bf16* vr = Vt + (size_t)e * D + lane * 8;
                uu[j][0] = *(const u32x4*)ur; uu[j][1] = *(const u32x4*)(ur + 512);
                vv[j][0] = *(const u32x4*)vr; vv[j][1] = *(const u32x4*)(vr + 512);
            }
            float a[8];
#pragma unroll
            for (int j = 0; j < 8; ++j) {
                float s = dot2(h0.x, uu[j][0].x, 0.f); s = dot2(h0.y, uu[j][0].y, s); s = dot2(h0.z, uu[j][0].z, s); s = dot2(h0.w, uu[j][0].w, s);
                s = dot2(h1.x, uu[j][1].x, s); s = dot2(h1.y, uu[j][1].y, s); s = dot2(h1.z, uu[j][1].z, s); s = dot2(h1.w, uu[j][1].w, s);
                a[j] = s;
            }
            float k1[4], k2[2], k3;
#pragma unroll
            for (int i = 0; i < 4; ++i) { const float snd = b5 ? a[i] : a[4 + i]; const float rcv = __shfl_xor(snd, 32); k1[i] = (b5 ? a[4 + i] : a[i]) + rcv; }
#pragma unroll
            for (int i = 0; i < 2; ++i) { const float snd = b4 ? k1[i] : k1[2 + i]; const float rcv = __shfl_xor(snd, 16); k2[i] = (b4 ? k1[2 + i] : k1[i]) + rcv; }
            { const float snd = b3 ? k2[0] : k2[1]; const float rcv = __shfl_xor(snd, 8); k3 = (b3 ? k2[1] : k2[0]) + rcv; }
            k3 += __shfl_xor(k3, 4); k3 += __shfl_xor(k3, 2); k3 += __shfl_xor(k3, 1);
            const float w = Eg[ti * 128 + bt * 8 + jl] * gelu_erf(k3);
#pragma unroll
            for (int j = 0; j < 8; ++j) {
                const int src = 32 * (j >> 2) + 16 * ((j >> 1) & 1) + 8 * (j & 1);
                const float wj = __uint_as_float(__builtin_amdgcn_readlane(__float_as_uint(w), src));
                const unsigned w0[4] = {vv[j][0].x, vv[j][0].y, vv[j][0].z, vv[j][0].w}, w1[4] = {vv[j][1].x, vv[j][1].y, vv[j][1].z, vv[j][1].w};
#pragma unroll
                for (int i = 0; i < 4; ++i) { y[2 * i] += wj * bflo(w0[i]); y[2 * i + 1] += wj * bfhi(w0[i]); y[8 + 2 * i] += wj * bflo(w1[i]); y[8 + 2 * i + 1] += wj * bfhi(w1[i]); }
            }
        }
        const int b = (p.tok0 + tok) / SEQ;
        const float* mod = p.MOD + ((size_t)l * BATCH + b) * 6 * D;
        float v[16], gt[16];
        load16(v, X1 + (size_t)tok * D, lane); load16(gt, mod + 5 * D, lane);
#pragma unroll
        for (int i = 0; i < 16; ++i) v[i] = DN_ALPHA * v[i] + (1.f + gt[i]) * y[i];
        ln16(v, p.in[23] + l * D, p.in[24] + l * D, lane);
        store16f(xout + (size_t)tok * D, v, lane);
        if (l + 1 < DEPTH) { const float* modn = p.MOD + ((size_t)(l + 1) * BATCH + b) * 6 * D; store_mod16(p.H + (size_t)tok * D, v, modn, modn + D, lane); }
    }
}
typedef float f32x2v __attribute__((ext_vector_type(2)));
DI void table_row_fp8(const float* src, unsigned char* dst, float* inv_scale, int lane) {
    float v[16];
#pragma unroll
    for (int q = 0; q < 4; ++q) { const float4 t = *(const float4*)(src + lane * 16 + q * 4); v[4 * q] = t.x; v[4 * q + 1] = t.y; v[4 * q + 2] = t.z; v[4 * q + 3] = t.w; }
    float mx = 0.f;
#pragma unroll
    for (int i = 0; i < 16; ++i) mx = fmaxf(mx, fabsf(v[i]));
#pragma unroll
    for (int o = 1; o < 64; o <<= 1) mx = fmaxf(mx, __shfl_xor(mx, o));
    const float sc = (mx > 0.f) ? 448.f / mx : 1.f;
    u32x4 o;
    unsigned w[4];
#pragma unroll
    for (int q = 0; q < 4; ++q) { unsigned t = 0u; t = __builtin_amdgcn_cvt_pk_fp8_f32(v[4 * q] * sc, v[4 * q + 1] * sc, t, false); t = __builtin_amdgcn_cvt_pk_fp8_f32(v[4 * q + 2] * sc, v[4 * q + 3] * sc, t, true); w[q] = t; }
    o.x = w[0]; o.y = w[1]; o.z = w[2]; o.w = w[3];
    *(u32x4*)(dst + lane * 16) = o;
    if (lane == 0) *inv_scale = (mx > 0.f) ? mx * (1.f / 448.f) : 1.f;
}
DI void convert_tables_fp8(const Params& p, int l, int bid, int nb) {
    int t_ = threadIdx.x; asm volatile("" : "+v"(t_)); const int wv = t_ >> 6, lane = t_ & 63;
    const float* us = p.in[21] + (size_t)l * 16384 * D; const float* vs = p.in[22] + (size_t)l * 16384 * D;
    for (int row = bid * 4 + wv; row < 2 * 16384; row += nb * 4) {
        if (row < 16384) table_row_fp8(us + (size_t)row * D, p.U8 + (size_t)row * D, p.US + l * 16384 + row, lane);
        else { const int r2 = row - 16384; table_row_fp8(vs + (size_t)r2 * D, p.V8 + (size_t)r2 * D, p.VS + l * 16384 + r2, lane); }
    }
}
DI void load16c(float (&v)[16], const float* row, int lane) {
#pragma unroll
    for (int q = 0; q < 4; ++q) { const float4 t = *(const float4*)(row + lane * 16 + q * 4); v[4 * q] = t.x; v[4 * q + 1] = t.y; v[4 * q + 2] = t.z; v[4 * q + 3] = t.w; }
}
DI void ln16c(float (&v)[16], const float* g, const float* bta, int lane) {
    float s = 0.f;
#pragma unroll
    for (int i = 0; i < 16; ++i) s += v[i];
#pragma unroll
    for (int o = 1; o < 64; o <<= 1) s += __shfl_xor(s, o);
    const float mean = s * (1.f / D); float q = 0.f;
#pragma unroll
    for (int i = 0; i < 16; ++i) { v[i] -= mean; q += v[i] * v[i]; }
#pragma unroll
    for (int o = 1; o < 64; o <<= 1) q += __shfl_xor(q, o);
    const float rstd = rsqrtf(q * (1.f / D) + EPS);
    float gg[16], bb[16]; load16c(gg, g, lane); load16c(bb, bta, lane);
#pragma unroll
    for (int i = 0; i < 16; ++i) v[i] = v[i] * rstd * gg[i] + bb[i];
}
DI void store16c(float* row, const float (&v)[16], int lane) {
#pragma unroll
    for (int q = 0; q < 4; ++q) *(float4*)(row + lane * 16 + q * 4) = make_float4(v[4 * q], v[4 * q + 1], v[4 * q + 2], v[4 * q + 3]);
}
DI void store_mod16c(bf16* hrow, const float (&v)[16], const float* sh, const float* sc, int lane) {
    float s[16], h[16], o[16]; load16c(s, sc, lane); load16c(h, sh, lane);
#pragma unroll
    for (int i = 0; i < 16; ++i) o[i] = v[i] * (1.f + s[i]) + h[i];
    store16(hrow + lane * 16, o);
}

DI void p6f_unit(const Params& p, int l, int u, const float* X1, float* xout, char* lds) {
    int tid_ = threadIdx.x; asm volatile("" : "+v"(tid_)); const int tid = tid_, lane = tid & 63;
    const int wv = __builtin_amdgcn_readfirstlane(tid >> 6);
    unsigned* LA = (unsigned*)(lds + wv * 16384); unsigned* LB = LA + 1024; unsigned* Ee = LA + 2048; float* Eg = (float*)(LA + 3072); float* Es = (float*)LA;
    const int tokb = u * 32 + wv * 8;
    __syncthreads();
    {
        const int ti = lane >> 3, head = lane & 7;
        const unsigned* src = p.TOPK + ((size_t)(tokb + ti) * 16 + head * 2) * 16;
        unsigned A[16], B[16];
#pragma unroll
        for (int q = 0; q < 4; ++q) { const u32x4 a = *(const u32x4*)(src + 4 * q), b = *(const u32x4*)(src + 16 + 4 * q);
            A[4 * q] = a.x; A[4 * q + 1] = a.y; A[4 * q + 2] = a.z; A[4 * q + 3] = a.w; B[4 * q] = b.x; B[4 * q + 1] = b.y; B[4 * q + 2] = b.z; B[4 * q + 3] = b.w;
            *(u32x4*)(LA + lane * 16 + 4 * q) = a; *(u32x4*)(LB + lane * 16 + 4 * q) = b; }
        float sA[16], sB[16];
#pragma unroll
        for (int k = 0; k < 16; ++k) { sA[k] = funord(A[k] & ~0x7fu); sB[k] = funord(B[k] & ~0x7fu); }
        unsigned T[16];
#pragma unroll
        for (int k = 0; k < 16; ++k) T[k] = 0u;
#pragma unroll
        for (int a = 0; a < 16; ++a)
#pragma unroll
            for (int b = 0; b < 16; ++b)
                if ((a + 1) * (b + 1) <= 16) {
                    unsigned v = (ford(sA[a] + sB[b]) & ~0xffu) | (unsigned)(a * 16 + b);
#pragma unroll
                    for (int k = 0; k < 16; ++k) { const unsigned t = max(T[k], v); v = min(T[k], v); T[k] = t; }
                }
        float ex[16]; float sum = 0.f; const float mx = funord(T[0] & ~0xffu);
        unsigned ev[16];
#pragma unroll
        for (int k = 0; k < 16; ++k) { ex[k] = __expf(funord(T[k] & ~0xffu) - mx); sum += ex[k];
            const unsigned cid = T[k] & 0xffu; ev[k] = (LA[lane * 16 + (cid >> 4)] & 0x7fu) * 128u + (LB[lane * 16 + (cid & 15u)] & 0x7fu); }
        const float inv = 1.f / sum;
        const float* US = p.US + l * 16384; const float* VS = p.VS + l * 16384;
#pragma unroll
        for (int k = 0; k < 16; ++k) {
            const float su = US[ev[k]], sv = VS[ev[k]];
            Ee[ti * 128 + head * 16 + k] = ev[k]; Eg[ti * 128 + head * 16 + k] = ex[k] * inv * sv; Es[ti * 128 + head * 16 + k] = su;
        }
    }
    const unsigned char* U8 = p.U8; const unsigned char* V8 = p.V8;
    const int jl = 8 * (lane >> 5) + 4 * ((lane >> 4) & 1) + 2 * ((lane >> 3) & 1) + ((lane >> 2) & 1);
    const bool b5 = lane & 32, b4 = lane & 16, b3 = lane & 8, b2 = lane & 4;
#pragma unroll 1
    for (int ti = 0; ti < 8; ++ti) {
        const int tok = tokb + ti;
        const u32x4 h0 = *(const u32x4*)(p.H + (size_t)tok * D + lane * 16), h1 = *(const u32x4*)(p.H + (size_t)tok * D + lane * 16 + 8);
        const unsigned hw[8] = {h0.x, h0.y, h0.z, h0.w, h1.x, h1.y, h1.z, h1.w};
        f32x2v hf[8], y2[8];
#pragma unroll
        for (int i = 0; i < 8; ++i) { hf[i] = (f32x2v){bflo(hw[i]), bfhi(hw[i])}; y2[i] = (f32x2v){0.f, 0.f}; }
#pragma unroll 1
        for (int bt = 0; bt < 8; ++bt) {
            u32x4 uu[16], vv[16];
#pragma unroll
            for (int j = 0; j < 16; ++j) {
                const unsigned e = __builtin_amdgcn_readfirstlane(Ee[ti * 128 + bt * 16 + j]);
                uu[j] = *(const u32x4*)(U8 + (size_t)e * D + lane * 16);
                vv[j] = *(const u32x4*)(V8 + (size_t)e * D + lane * 16);
            }
            float a[16];
#pragma unroll
            for (int j = 0; j < 16; ++j) {
                const unsigned w[4] = {uu[j].x, uu[j].y, uu[j].z, uu[j].w};
                f32x2v acc = {0.f, 0.f};
#pragma unroll
                for (int q = 0; q < 4; ++q) { acc = __builtin_amdgcn_cvt_pk_f32_fp8(w[q], false) * hf[2 * q] + acc; acc = __builtin_amdgcn_cvt_pk_f32_fp8(w[q], true) * hf[2 * q + 1] + acc; }
                a[j] = acc.x + acc.y;
            }
            float k1[8], k2[4], k3[2], k4;
#pragma unroll
            for (int i = 0; i < 8; ++i) { const float snd = b5 ? a[i] : a[8 + i]; const float rcv = __shfl_xor(snd, 32); k1[i] = (b5 ? a[8 + i] : a[i]) + rcv; }
#pragma unroll
            for (int i = 0; i < 4; ++i) { const float snd = b4 ? k1[i] : k1[4 + i]; const float rcv = __shfl_xor(snd, 16); k2[i] = (b4 ? k1[4 + i] : k1[i]) + rcv; }
#pragma unroll
            for (int i = 0; i < 2; ++i) { const float snd = b3 ? k2[i] : k2[2 + i]; const float rcv = __shfl_xor(snd, 8); k3[i] = (b3 ? k2[2 + i] : k2[i]) + rcv; }
            { const float snd = b2 ? k3[0] : k3[1]; const float rcv = __shfl_xor(snd, 4); k4 = (b2 ? k3[1] : k3[0]) + rcv; }
            k4 += __shfl_xor(k4, 2); k4 += __shfl_xor(k4, 1);
            const int ei = ti * 128 + bt * 16 + jl;
            const float w = Eg[ei] * gelu_erf(k4 * Es[ei]);
#pragma unroll
            for (int j = 0; j < 16; ++j) {
                const int src = 32 * (j >> 3) + 16 * ((j >> 2) & 1) + 8 * ((j >> 1) & 1) + 4 * (j & 1);
                const float wj = __uint_as_float(__builtin_amdgcn_readlane(__float_as_uint(w), src));
                const f32x2v wj2 = {wj, wj};
                const unsigned wd[4] = {vv[j].x, vv[j].y, vv[j].z, vv[j].w};
#pragma unroll
                for (int q = 0; q < 4; ++q) { y2[2 * q] = __builtin_amdgcn_cvt_pk_f32_fp8(wd[q], false) * wj2 + y2[2 * q]; y2[2 * q + 1] = __builtin_amdgcn_cvt_pk_f32_fp8(wd[q], true) * wj2 + y2[2 * q + 1]; }
            }
        }
        const int b = (p.tok0 + tok) / SEQ;
        const float* mod = p.MOD + ((size_t)l * BATCH + b) * 6 * D;
        float v[16], gt[16];
        load16c(v, X1 + (size_t)tok * D, lane); load16c(gt, mod + 5 * D, lane);
#pragma unroll
        for (int i = 0; i < 8; ++i) { v[2 * i] = DN_ALPHA * v[2 * i] + (1.f + gt[2 * i]) * y2[i].x; v[2 * i + 1] = DN_ALPHA * v[2 * i + 1] + (1.f + gt[2 * i + 1]) * y2[i].y; }
        ln16c(v, p.in[23] + l * D, p.in[24] + l * D, lane);
        store16c(xout + (size_t)tok * D, v, lane);
        if (l + 1 < DEPTH) { const float* modn = p.MOD + ((size_t)(l + 1) * BATCH + b) * 6 * D; store_mod16c(p.H + (size_t)tok * D, v, modn, modn + D, lane); }
    }
}
DI void ada_item(const Params& p, int item, char* lds) {
    int tid_ = threadIdx.x; asm volatile("" : "+v"(tid_)); const int tid = tid_, lane = tid & 63, wv = tid >> 6;
    float* cs = (float*)lds;
    float* part = cs + 4 * D;
    __syncthreads();
    for (int i = tid; i < BATCH * D; i += 256) { const float cv = p.in[1][i]; cs[i] = cv / (1.f + __expf(-cv)); }
    __syncthreads();
    const int col = item * 64 + lane, l = col / (6 * D), j = col % (6 * D);
    const float* w = p.in[2] + (size_t)l * D * 6 * D + j;
    float a0 = 0.f, a1 = 0.f, a2 = 0.f, a3 = 0.f;
#pragma unroll 4
    for (int k = wv * 256; k < wv * 256 + 256; ++k) { const float wk = w[(size_t)k * 6 * D]; a0 += cs[k] * wk; a1 += cs[D + k] * wk; a2 += cs[2 * D + k] * wk; a3 += cs[3 * D + k] * wk; }
    part[(wv * 4 + 0) * 64 + lane] = a0; part[(wv * 4 + 1) * 64 + lane] = a1; part[(wv * 4 + 2) * 64 + lane] = a2; part[(wv * 4 + 3) * 64 + lane] = a3;
    __syncthreads();
    {
        const float s = part[(0 * 4 + wv) * 64 + lane] + part[(1 * 4 + wv) * 64 + lane] + part[(2 * 4 + wv) * 64 + lane] + part[(3 * 4 + wv) * 64 + lane];
        p.MOD[((size_t)l * BATCH + wv) * 6 * D + j] = s + p.in[3][l * 6 * D + j];
    }
}

DI void rope_table_item(const Params& p, int idx) {
    const int pos = idx >> 4, i = idx & 15;
    const float inv = 1.0f / powf(10000.0f, (float)(2 * i) / 32.0f);
    const float ang = (float)pos * inv;
    double fr = (double)ang * 0.15915494309189535;
    fr -= rint(fr);
    const float f = (float)fr;
    p.COS[idx] = __builtin_amdgcn_cosf(f); p.SIN[idx] = __builtin_amdgcn_sinf(f);
}

DI void convert_tables(const Params& p, int l, int bid, int nb) {
    const float* us = p.in[21] + (size_t)l * 16384 * D; const float* vs = p.in[22] + (size_t)l * 16384 * D;
    const size_t n8 = (size_t)16384 * D / 8;
    for (size_t i = (size_t)bid * 256 + threadIdx.x; i < n8; i += (size_t)nb * 256) { cvt8(us, p.Ut, i); cvt8(vs, p.Vt, i); }
}

DI void prologue(const Params& p, char* lds) {
    int tid_ = threadIdx.x; asm volatile("" : "+v"(tid_)); const int tid = tid_, lane = tid & 63, wv = tid >> 6, bid = blockIdx.x, nb = gridDim.x;
    for (int it = bid; it < DEPTH * 6 * D / 64; it += nb) ada_item(p, it, lds);
    __syncthreads();
    float* scr = (float*)(lds + wv * 16384);
    const int n_win = (D / 64) * (WIN_N / 32), n_uq = 4 * 24, n_ukv = 2 * 32, n_wo = 16 * 32, n_pq = 16 * 64, per_l = n_win + n_uq + n_ukv + n_wo + n_pq;
    for (int it = bid * 4 + wv; it < DEPTH * per_l; it += nb * 4) {
        const int l = it / per_l; int r = it % per_l;
        if (r < n_win) { transpose_item(TK_WIN, p.in[4] + (size_t)l * D * D_IN, D_IN, D, WIN_N, p.WinT + (size_t)l * WIN_N * D, nullptr, scr, r, lane); continue; } r -= n_win;
        if (r < n_uq) { transpose_item(TK_WUQ, p.in[6] + (size_t)l * 256 * 768, 768, 256, 768, p.WuqT + (size_t)l * 768 * 256, p.in[5] + l * 256, scr, r, lane); continue; } r -= n_uq;
        if (r < n_ukv) { transpose_item(TK_WUKV, p.in[8] + (size_t)l * 128 * 1024, 1024, 128, 1024, p.WukvT + (size_t)l * 1024 * 128, p.in[7] + l * 128, scr, r, lane); continue; } r -= n_ukv;
        if (r < n_wo) { transpose_item(TK_WO, p.in[16] + (size_t)l * D * D, D, D, D, p.WoT + (size_t)l * D * D, nullptr, scr, r, lane); continue; } r -= n_wo;
        transpose_item(TK_WPQ, p.in[19] + (size_t)l * D * 2048, 2048, D, 2048, p.WpqT + (size_t)l * 2048 * D, nullptr, scr, r, lane);
    }
    for (int it = bid; it < DEPTH * 1028; it += nb) fold_pw_item(p, it / 1028, it % 1028);
    for (size_t i = (size_t)bid * 256 + tid; i < (size_t)DEPTH * 16 * 128 * 128; i += (size_t)nb * 256)
        p.SKp[i] = f2bf(p.in[20][(i & ~(size_t)127) + perm16((int)(i & 127))]);
    for (int i = bid * 256 + tid; i < SEQ * 16; i += nb * 256) rope_table_item(p, i);
    convert_tables_fp8(p, 0, bid, nb);
}

DI void modh_items(const Params& p, int bid, int nb) {
    const size_t n8 = (size_t)p.rows * D / 8;
    for (size_t i = (size_t)bid * 256 + threadIdx.x; i < n8; i += (size_t)nb * 256) {
        const size_t e = i * 8; const int row = (int)(e >> 10), col = (int)(e & 1023), b = row / SEQ;
        const float* mod = p.MOD + (size_t)b * 6 * D;
        const float4 x0 = *(const float4*)(p.in[0] + e), x1 = *(const float4*)(p.in[0] + e + 4);
        const float4 h0 = *(const float4*)(mod + col), h1 = *(const float4*)(mod + col + 4), s0 = *(const float4*)(mod + D + col), s1 = *(const float4*)(mod + D + col + 4);
        u32x4 o;
        o.x = pk2(x0.x * (1.f + s0.x) + h0.x, x0.y * (1.f + s0.y) + h0.y); o.y = pk2(x0.z * (1.f + s0.z) + h0.z, x0.w * (1.f + s0.w) + h0.w);
        o.z = pk2(x1.x * (1.f + s1.x) + h1.x, x1.y * (1.f + s1.y) + h1.y); o.w = pk2(x1.z * (1.f + s1.z) + h1.z, x1.w * (1.f + s1.w) + h1.w);
        *(u32x4*)(p.H + e) = o;
    }
}

#ifndef REP_P1
#define REP_P1 1
#endif
#ifndef REP_P2
#define REP_P2 1
#endif
#ifndef REP_P3
#define REP_P3 1
#endif
#ifndef REP_P4
#define REP_P4 1
#endif
#ifndef REP_P5
#define REP_P5 1
#endif
#ifndef REP_SYNC
#define REP_SYNC 1
#endif
#define GSYNC() do { for (int rs_ = 0; rs_ < REP_SYNC; ++rs_) grid.sync(); } while (0)
__global__ void __launch_bounds__(256, 2) mega(Params p) {
    extern __shared__ __attribute__((aligned(16))) char lds[];
    cg::grid_group grid = cg::this_grid();
    const int bid = blockIdx.x, nb = gridDim.x;
    const int rows = p.rows, mtiles = rows / 128;
    prologue(p, lds);
    GSYNC();
    modh_items(p, bid, nb);
    GSYNC();
    for (int l = 0; l < DEPTH; ++l) {
        const float* xin = (l == 0) ? p.in[0] : p.XB;
        float* X1 = p.out;
        float* xout = (l + 1 < DEPTH) ? p.XB : p.out;
        for (int rep = 0; rep < REP_P1; ++rep) for (int t = bid; t < mtiles * 12; t += nb) p1_tile(p, l, t, lds);
        if (l > 0) convert_tables_fp8(p, l, bid, nb);
        GSYNC();
        for (int rep = 0; rep < REP_P2; ++rep) for (int t = bid; t < mtiles * 14; t += nb) { if (t < mtiles * 6) p2q_tile(p, l, t, lds); else p2kv_tile(p, l, t - mtiles * 6, lds); }
        GSYNC();
        {
            const int nbt = rows / SEQ, nmla = nbt * 8 * 64, nswa = nbt * 4 * 64, nconv = rows / 32, ntot = nmla + nswa + nconv;
            int* su = (int*)(lds + LDS_TOTAL - 16);
            for (int rep = 0; rep < REP_P3; ++rep) { unsigned* ctr = p.ctr + l * 64 + rep * 16;
            for (;;) {
                __syncthreads();
                if (threadIdx.x == 0) *su = (int)atomicAdd(ctr, 1u);
                __syncthreads();
                const int u = *su;
                if (u >= ntot) break;
                if (u < nmla) mla_unit(p, u, lds);
                else if (u < nmla + nswa) swa_unit(p, l, u - nmla, lds);
                else conv_unit(p, l, u - nmla - nswa, lds);
            } }
        }
        GSYNC();
        for (int rep = 0; rep < REP_P4; ++rep) for (int t = bid; t < mtiles * 8; t += nb) p4_tile(p, l, t, xin, X1, lds);
        GSYNC();
        { int t_ = threadIdx.x; asm volatile("" : "+v"(t_)); const int wv = t_ >> 6, lane = t_ & 63; for (int r = bid * 4 + wv; r < rows; r += nb * 4) p4b_row(p, l, r, X1, lane); }
        GSYNC();
        for (int rep = 0; rep < REP_P5; ++rep) for (int t = bid; t < mtiles * 16; t += nb) p5_tile(p, l, t, lds);
        GSYNC();
        for (int u = bid; u < rows / 32; u += nb) p6f_unit(p, l, u, X1, xout, lds);
        if (l + 1 < DEPTH) GSYNC();
    }
}

extern "C" void kernel_launch(void* const* d_in, const int* in_sizes, int n_in, void* d_out, int out_size, void* d_ws, size_t ws_size, hipStream_t stream) {
    const size_t MiB = 1u << 20;
    char* ws = (char*)d_ws;
    Params P{};
    for (int i = 0; i < 25; ++i) P.in[i] = (const float*)d_in[i];
    P.out = (float*)d_out; P.rows = NTOK; P.tok0 = 0;
    size_t o = 0;
    auto take = [&](size_t mib) { char* r = ws + o; o += mib * MiB; return r; };
    char* ctl = take(1);
    P.ctr = (unsigned*)ctl; P.biasO = (float*)(ctl + 64 * 1024); P.MOD = (float*)(ctl + 128 * 1024);
    P.COS = (float*)take(1); P.SIN = P.COS + SEQ * 16;
    P.WinT = (bf16*)take(6); P.WuqT = (bf16*)take(1); P.WukvT = (bf16*)take(1); P.WoT = (bf16*)take(4); P.WpqT = (bf16*)take(8); P.SKp = (bf16*)take(1);
    P.U8 = (unsigned char*)take(16); P.V8 = (unsigned char*)take(16); P.US = (float*)take(1); P.VS = P.US + DEPTH * 16384;
    P.H = (bf16*)take(64); P.MIXIN = P.H;
    P.PROJ = (bf16*)take(80); P.Q = (bf16*)take(48); P.TOPK = (unsigned*)P.Q;
    P.KN = (bf16*)take(32); P.KR = (bf16*)take(2); P.VT = (bf16*)take(32); P.VsT = (bf16*)take(8);
    P.XB = (float*)take(128);
    if (o > ws_size) { fprintf(stderr, "kernel_launch: workspace too small: need %zu, have %zu\n", o, ws_size); return; }
    static int grid_blocks = 0;
    if (!grid_blocks) {
        int dev = 0, cus = 0, per_cu = 0;
        (void)hipGetDevice(&dev);
        (void)hipDeviceGetAttribute(&cus, hipDeviceAttributeMultiprocessorCount, dev);
        (void)hipFuncSetAttribute((const void*)mega, hipFuncAttributeMaxDynamicSharedMemorySize, LDS_TOTAL);
        (void)hipOccupancyMaxActiveBlocksPerMultiprocessor(&per_cu, mega, 256, LDS_TOTAL);
        if (per_cu > 2) per_cu = 2;
        if (per_cu < 1) per_cu = 1;
        grid_blocks = cus * per_cu;
    }
    (void)hipMemsetAsync(ctl, 0, 4096, stream);
    void* args[] = {(void*)&P};
    hipError_t e = hipLaunchCooperativeKernel((void*)mega, dim3(grid_blocks), dim3(256), args, LDS_TOTAL, stream);
    if (e != hipSuccess) fprintf(stderr, "cooperative launch failed: %s (grid %d)\n", hipGetErrorString(e), grid_blocks);
}
```

```cpp
#include <hip/hip_runtime.h>
#include <hip/hip_cooperative_groups.h>
#include <cstdio>
#include <cstdint>
namespace cg = cooperative_groups;

constexpr int D = 1024, BATCH = 4, SEQ = 8192, DEPTH = 2, NTOK = BATCH * SEQ;
constexpr int D_IN = 1440;
constexpr int OFF_CQ = 0, OFF_CKV = 256, OFF_KR = 384, OFF_CONV = 416, OFF_QS = 928, OFF_KS = 1184, OFF_VS = 1312;
constexpr float EPS = 1e-6f;
constexpr float DN_ALPHA = 1.41421356237309515f;

typedef __attribute__((ext_vector_type(8))) short bf16x8;
typedef __attribute__((ext_vector_type(16))) float f32x16;
typedef __attribute__((ext_vector_type(4))) unsigned u32x4;
typedef __attribute__((ext_vector_type(2))) unsigned u32x2;
typedef float f32x2_t __attribute__((ext_vector_type(2)));
typedef __bf16 bf16x2_t __attribute__((ext_vector_type(2)));
typedef unsigned short bf16;
#define DI __device__ __forceinline__
#define MFMA32(a, b, c) __builtin_amdgcn_mfma_f32_32x32x16_bf16((a), (b), (c), 0, 0, 0)

DI unsigned pk2(float lo, float hi) { f32x2_t v = {lo, hi}; bf16x2_t b = __builtin_convertvector(v, bf16x2_t); return __builtin_bit_cast(unsigned, b); }
DI bf16 f2bf(float f) { return (bf16)(pk2(f, 0.f) & 0xffffu); }
DI float bf2f(bf16 b) { return __uint_as_float((unsigned)b << 16); }
DI float bflo(unsigned u) { return __uint_as_float(u << 16); }
DI float bfhi(unsigned u) { return __uint_as_float(u & 0xffff0000u); }
DI int crow(int reg, int hh) { return (reg & 3) + 8 * (reg >> 2) + 4 * hh; }
DI int cperm_lin(int rho) { return 16 * ((rho >> 2) & 1) + (rho & 3) + 4 * (rho >> 3); }
DI int cperm_rope(int rho) { int hh = (rho >> 2) & 1, reg = (rho & 3) + 4 * (rho >> 3); return (reg < 8) ? 8 * hh + reg : 16 + 8 * hh + (reg - 8); }
DI int perm16(int p) { int g = (p >> 2) & 3; g = (g == 1) ? 2 : (g == 2) ? 1 : g; return (p & ~15) | (g << 2) | (p & 3); }

constexpr float LOG2E = 1.4426950408889634f;
constexpr int PROJ_LD = 1280;
constexpr int WIN_N = 1536;
constexpr int TS = 144;
constexpr int TILE_B = 128 * TS;
constexpr int STAGE_B = 2 * TILE_B;
constexpr int LDS_BYTES = 2 * STAGE_B;

struct Params {
    const float* in[25];
    float* out;
    bf16 *WinT, *WuqT, *WukvT, *WoT, *WpqT, *SKp, *Ut, *Vt;
    float* biasO;
    float* MOD;
    float* COS; float* SIN;
    bf16 *H, *PROJ, *Q, *KN, *KR, *VT, *VsT, *MIXIN;
    float* XB;
    unsigned* TOPK;
    unsigned char *U8, *V8; float *US, *VS;
    unsigned* ctr;
    int rows;
    int tok0;
};

enum { TK_WIN = 0, TK_WUQ = 1, TK_WUKV = 2, TK_WO = 3, TK_WPQ = 4 };
DI void transpose_item(int kind, const float* W, int ldin, int K, int Nout, bf16* WT, const float* rowscale, float* scr, int item, int lane) {
    const int nblk = Nout / 32, kb = item / nblk, nb = item % nblk, k0 = 64 * kb, n0 = 32 * nb;
    int src0 = n0; float cs = 1.f;
    if (kind == TK_WIN) {
        if (n0 < 384) src0 = n0;
        else if (n0 < 896) src0 = 416 + (n0 - 384);
        else if (n0 < 1152) { src0 = 928 + (n0 - 896); cs = 0.125f * LOG2E; }
        else if (n0 < 1280) src0 = 1184 + (n0 - 1152);
        else if (n0 < 1408) src0 = 1312 + (n0 - 1280);
        else if (n0 < 1440) src0 = 384 + (n0 - 1408);
        else src0 = -1;
    } else if (kind == TK_WUQ) cs = 0.10206207261596577f * LOG2E;
#pragma unroll 8
    for (int i = 0; i < 32; ++i) {
        const int kk = 2 * i + (lane >> 5);
        float v = (src0 >= 0) ? W[(size_t)(k0 + kk) * ldin + src0 + (lane & 31)] : 0.f;
        if (rowscale) v *= rowscale[k0 + kk];
        scr[kk * 33 + (lane & 31)] = v * cs;
    }
    __builtin_amdgcn_s_waitcnt(0xc07f); asm volatile("" ::: "memory");
    const int c = lane & 7;
#pragma unroll
    for (int j = 0; j < 4; ++j) {
        const int n = (lane >> 3) + 8 * j; const float* s = scr + (8 * c) * 33 + n;
        u32x4 o; o.x = pk2(s[0], s[33]); o.y = pk2(s[66], s[99]); o.z = pk2(s[132], s[165]); o.w = pk2(s[198], s[231]);
        if (!(kind == TK_WO && k0 + 8 * c >= 512 && k0 + 8 * c < 768))
            *(u32x4*)(WT + (size_t)(n0 + n) * K + k0 + 8 * c) = o;
    }
    __builtin_amdgcn_s_waitcnt(0xc07f); asm volatile("" ::: "memory");
}

DI void cvt8(const float* src, bf16* dst, size_t i8) {
    const float4 a = ((const float4*)src)[2 * i8], b = ((const float4*)src)[2 * i8 + 1];
    u32x4 o; o.x = pk2(a.x, a.y); o.y = pk2(a.z, a.w); o.z = pk2(b.x, b.y); o.w = pk2(b.z, b.w);
    ((u32x4*)dst)[i8] = o;
}

struct TileRegs { u32x4 v[4]; };
DI void gload_tile(TileRegs& t, const bf16* base, int ld, int k0, int tid) {
#pragma unroll
    for (int i = 0; i < 4; ++i) { const int q = tid + 256 * i, row = q >> 3, kc = q & 7; t.v[i] = *(const u32x4*)(base + (size_t)row * ld + k0 + kc * 8); }
}
DI void sstore_tile(const TileRegs& t, char* lds, int tid) {
#pragma unroll
    for (int i = 0; i < 4; ++i) { const int q = tid + 256 * i, row = q >> 3, kc = q & 7; *(u32x4*)(lds + row * TS + kc * 16) = t.v[i]; }
}
template <int NF, int NG>
DI void gemm_core(const bf16* A, int lda, const bf16* W, int ldw, int K, char* lds, f32x16 (&acc)[NF][NG], int fo, const int (&frow)[NF], int go, const int (&grow)[NG]) {
    int tid_ = threadIdx.x; asm volatile("" : "+v"(tid_)); const int tid = tid_, hh = (tid & 63) >> 5;
    TileRegs ta, tw;
    gload_tile(ta, A, lda, 0, tid); gload_tile(tw, W, ldw, 0, tid);
    __syncthreads();
    sstore_tile(ta, lds, tid); sstore_tile(tw, lds + TILE_B, tid);
    __syncthreads();
    const int nk = K / 64;
    for (int ks = 0; ks < nk; ++ks) {
        char* cur = lds + (ks & 1) * STAGE_B;
        if (ks + 1 < nk) { gload_tile(ta, A, lda, (ks + 1) * 64, tid); gload_tile(tw, W, ldw, (ks + 1) * 64, tid); }
#pragma unroll
        for (int kk = 0; kk < 4; ++kk) {
            bf16x8 f[NF], g[NG];
#pragma unroll
            for (int x = 0; x < NF; ++x) f[x] = *(const bf16x8*)(cur + fo + frow[x] * TS + kk * 32 + hh * 16);
#pragma unroll
            for (int y = 0; y < NG; ++y) g[y] = *(const bf16x8*)(cur + go + grow[y] * TS + kk * 32 + hh * 16);
#pragma unroll
            for (int x = 0; x < NF; ++x)
#pragma unroll
                for (int y = 0; y < NG; ++y) acc[x][y] = MFMA32(f[x], g[y], acc[x][y]);
        }
        if (ks + 1 < nk) { char* nxt = lds + ((ks + 1) & 1) * STAGE_B; sstore_tile(ta, nxt, tid); sstore_tile(tw, nxt + TILE_B, tid); }
        __syncthreads();
    }
}

template <int NF, int NG> DI void zero_acc(f32x16 (&acc)[NF][NG]) {
#pragma unroll
    for (int x = 0; x < NF; ++x)
#pragma unroll
        for (int y = 0; y < NG; ++y)
#pragma unroll
            for (int r = 0; r < 16; ++r) acc[x][y][r] = 0.f;
}

DI void store16(bf16* dst, const float* v) {
    u32x4 a, b;
    a.x = pk2(v[0], v[1]); a.y = pk2(v[2], v[3]); a.z = pk2(v[4], v[5]); a.w = pk2(v[6], v[7]);
    b.x = pk2(v[8], v[9]); b.y = pk2(v[10], v[11]); b.z = pk2(v[12], v[13]); b.w = pk2(v[14], v[15]);
    *(u32x4*)dst = a; *(u32x4*)(dst + 8) = b;
}
DI void store8(bf16* dst, const float* v) {
    u32x4 a; a.x = pk2(v[0], v[1]); a.y = pk2(v[2], v[3]); a.z = pk2(v[4], v[5]); a.w = pk2(v[6], v[7]);
    *(u32x4*)dst = a;
}
DI void store_vt(bf16* dst, const f32x16& a, int hh) {
    float v0[8], v1[8];
#pragma unroll
    for (int i = 0; i < 8; ++i) { v0[i] = a[i]; v1[i] = a[8 + i]; }
    store8(dst + 8 * hh, v0); store8(dst + 16 + 8 * hh, v1);
}

DI void p1_tile(const Params& p, int l, int tile, char* lds) {
    int tid_ = threadIdx.x; asm volatile("" : "+v"(tid_)); const int tid = tid_, lane = tid & 63, r = lane & 31, hh = lane >> 5;
    const int wv = __builtin_amdgcn_readfirstlane(tid >> 6), wm = wv >> 1, wn = wv & 1;
    const int mt = tile / 12, nt = tile % 12, m0 = mt * 128, n0 = nt * 128;
    const bf16* A = p.H + (size_t)m0 * D;
    const bf16* W = p.WinT + ((size_t)l * WIN_N + n0) * D;
    f32x16 acc[2][2]; zero_acc(acc);
    int frow[2], grow[2];
    const bool kr = (nt == 11);
    int fo, go;
    if (nt == 10) { fo = 0; go = TILE_B; frow[0] = 64 * wm + r; frow[1] = frow[0] + 32; grow[0] = 64 * wn + r; grow[1] = grow[0] + 32; }
    else { fo = TILE_B; go = 0; frow[0] = 64 * wn + (kr ? cperm_rope(r) : cperm_lin(r)); frow[1] = 64 * wn + 32 + cperm_lin(r); grow[0] = 64 * wm + r; grow[1] = grow[0] + 32; }
    gemm_core<2, 2>(A, D, W, D, D, lds, acc, fo, frow, go, grow);
    if (nt == 10) {
#pragma unroll
        for (int x = 0; x < 2; ++x)
#pragma unroll
            for (int y = 0; y < 2; ++y) {
                const int tok = m0 + 64 * wm + 32 * x, b = tok / SEQ, s0 = tok % SEQ, d = 32 * y + r;
                store_vt(p.VsT + ((size_t)(b * 2 + wn) * 64 + d) * SEQ + s0, acc[x][y], hh);
            }
    } else {
        if (!kr) {
#pragma unroll
            for (int x = 0; x < 2; ++x)
#pragma unroll
                for (int y = 0; y < 2; ++y) {
                    const int tok = m0 + 64 * wm + 32 * y + r, col = n0 + 64 * wn + 32 * x + 16 * hh;
                    float v[16];
#pragma unroll
                    for (int i = 0; i < 16; ++i) v[i] = acc[x][y][i];
                    store16(p.PROJ + (size_t)tok * PROJ_LD + col, v);
                }
        } else if (wn == 0) {
#pragma unroll
            for (int y = 0; y < 2; ++y) {
                const int tok = m0 + 64 * wm + 32 * y + r, pos = tok % SEQ;
                const float4 c0 = *(const float4*)(p.COS + pos * 16 + 8 * hh), c1 = *(const float4*)(p.COS + pos * 16 + 8 * hh + 4);
                const float4 s0 = *(const float4*)(p.SIN + pos * 16 + 8 * hh), s1 = *(const float4*)(p.SIN + pos * 16 + 8 * hh + 4);
                const float cs[8] = {c0.x, c0.y, c0.z, c0.w, c1.x, c1.y, c1.z, c1.w}, sn[8] = {s0.x, s0.y, s0.z, s0.w, s1.x, s1.y, s1.z, s1.w};
                float o1[8], o2[8];
#pragma unroll
                for (int i = 0; i < 8; ++i) { const float t1 = acc[0][y][i], t2 = acc[0][y][8 + i]; o1[i] = t1 * cs[i] - t2 * sn[i]; o2[i] = t1 * sn[i] + t2 * cs[i]; }
                store8(p.KR + (size_t)tok * 32 + 8 * hh, o1); store8(p.KR + (size_t)tok * 32 + 16 + 8 * hh, o2);
            }
        }
    }
}
constexpr int LDS_RS_OFF = LDS_BYTES;
constexpr int LDS_TOTAL = LDS_BYTES + 1024;

template <int W> DI void row_rms(const bf16* A, int lda, float* rs, int tid) {
    const int row = tid >> 1, half = tid & 1;
    const u32x4* p = (const u32x4*)(A + (size_t)row * lda + half * (W / 2));
    float ss = 0.f;
#pragma unroll
    for (int i = 0; i < W / 16; ++i) { const u32x4 v = p[i];
        ss += bflo(v.x) * bflo(v.x) + bfhi(v.x) * bfhi(v.x) + bflo(v.y) * bflo(v.y) + bfhi(v.y) * bfhi(v.y)
            + bflo(v.z) * bflo(v.z) + bfhi(v.z) * bfhi(v.z) + bflo(v.w) * bflo(v.w) + bfhi(v.w) * bfhi(v.w); }
    ss += __shfl_xor(ss, 1);
    if (half == 0) rs[row] = rsqrtf(ss * (1.f / W) + EPS);
}

DI void p2q_tile(const Params& p, int l, int tile, char* lds) {
    int tid_ = threadIdx.x; asm volatile("" : "+v"(tid_)); const int tid = tid_, lane = tid & 63, r = lane & 31, hh = lane >> 5;
    const int wv = __builtin_amdgcn_readfirstlane(tid >> 6), wm = wv >> 1, wn = wv & 1;
    const int mt = tile / 6, nt = tile % 6, m0 = mt * 128, n0 = nt * 128;
    const bf16* A = p.PROJ + (size_t)m0 * PROJ_LD;
    const bf16* W = p.WuqT + ((size_t)l * 768 + n0) * 256;
    float* rs = (float*)(lds + LDS_RS_OFF);
    __syncthreads();
    row_rms<256>(A, PROJ_LD, rs, tid);
    f32x16 acc[2][2]; zero_acc(acc);
    int frow[2], grow[2]; bool rope[2];
#pragma unroll
    for (int x = 0; x < 2; ++x) { rope[x] = (((n0 + 64 * wn + 32 * x) >> 5) % 3) == 2; frow[x] = 64 * wn + 32 * x + (rope[x] ? cperm_rope(r) : cperm_lin(r)); }
    grow[0] = 64 * wm + r; grow[1] = grow[0] + 32;
    gemm_core<2, 2>(A, PROJ_LD, W, 256, 256, lds, acc, TILE_B, frow, 0, grow);
#pragma unroll
    for (int y = 0; y < 2; ++y) {
        const int tl = 64 * wm + 32 * y + r, tok = m0 + tl, pos = tok % SEQ;
        const float sc = rs[tl];
#pragma unroll
        for (int x = 0; x < 2; ++x) {
            bf16* dst = p.Q + (size_t)tok * 768 + n0 + 64 * wn + 32 * x;
            if (rope[x]) {
                const float4 c0 = *(const float4*)(p.COS + pos * 16 + 8 * hh), c1 = *(const float4*)(p.COS + pos * 16 + 8 * hh + 4);
                const float4 s0 = *(const float4*)(p.SIN + pos * 16 + 8 * hh), s1 = *(const float4*)(p.SIN + pos * 16 + 8 * hh + 4);
                const float cs[8] = {c0.x, c0.y, c0.z, c0.w, c1.x, c1.y, c1.z, c1.w}, sn[8] = {s0.x, s0.y, s0.z, s0.w, s1.x, s1.y, s1.z, s1.w};
                float o1[8], o2[8];
#pragma unroll
                for (int i = 0; i < 8; ++i) { const float t1 = acc[x][y][i] * sc, t2 = acc[x][y][8 + i] * sc; o1[i] = t1 * cs[i] - t2 * sn[i]; o2[i] = t1 * sn[i] + t2 * cs[i]; }
                store8(dst + 8 * hh, o1); store8(dst + 16 + 8 * hh, o2);
            } else {
                float v[16];
#pragma unroll
                for (int i = 0; i < 16; ++i) v[i] = acc[x][y][i] * sc;
                store16(dst + 16 * hh, v);
            }
        }
    }
}

DI void p2kv_tile(const Params& p, int l, int tile, char* lds) {
    int tid_ = threadIdx.x; asm volatile("" : "+v"(tid_)); const int tid = tid_, lane = tid & 63, r = lane & 31, hh = lane >> 5;
    const int wv = __builtin_amdgcn_readfirstlane(tid >> 6), wm = wv >> 1, wn = wv & 1;
    const int mt = tile >> 3, h = tile & 7, m0 = mt * 128, n0 = h * 128;
    const bf16* A = p.PROJ + (size_t)m0 * PROJ_LD + 256;
    const bf16* W = p.WukvT + ((size_t)l * 1024 + n0) * 128;
    float* rs = (float*)(lds + LDS_RS_OFF);
    __syncthreads();
    row_rms<128>(A, PROJ_LD, rs, tid);
    f32x16 acc[2][2]; zero_acc(acc);
    int frow[2], grow[2];
    int fo, go;
    if (wn == 0) { fo = TILE_B; go = 0; frow[0] = cperm_lin(r); frow[1] = 32 + cperm_lin(r); grow[0] = 64 * wm + r; grow[1] = grow[0] + 32; }
    else         { fo = 0; go = TILE_B; frow[0] = 64 * wm + r; frow[1] = frow[0] + 32; grow[0] = 64 + r; grow[1] = 96 + r; }
    gemm_core<2, 2>(A, PROJ_LD, W, 128, 128, lds, acc, fo, frow, go, grow);
    if (wn == 0) {
#pragma unroll
        for (int y = 0; y < 2; ++y) {
            const int tl = 64 * wm + 32 * y + r, tok = m0 + tl; const float sc = rs[tl];
#pragma unroll
            for (int x = 0; x < 2; ++x) {
                float v[16];
#pragma unroll
                for (int i = 0; i < 16; ++i) v[i] = acc[x][y][i] * sc;
                store16(p.KN + (size_t)tok * 512 + h * 64 + 32 * x + 16 * hh, v);
            }
        }
    } else {
#pragma unroll
        for (int x = 0; x < 2; ++x) {
            const int tl0 = 64 * wm + 32 * x, tok0 = m0 + tl0, b = tok0 / SEQ, s0 = tok0 % SEQ;
#pragma unroll
            for (int y = 0; y < 2; ++y) {
                f32x16 a = acc[x][y];
#pragma unroll
                for (int i = 0; i < 16; ++i) a[i] *= rs[tl0 + crow(i, hh)];
                store_vt(p.VT + ((size_t)(b * 8 + h) * 64 + 32 * y + r) * SEQ + s0, a, hh);
            }
        }
    }
}
constexpr int VSTR = 144;
template <int KD> struct AttnCfg { static constexpr int KSTR = KD * 2 + 16; static constexpr int BUF = 64 * KSTR + 64 * VSTR; };

template <int KD, int MODE>
DI void attn_unit(const bf16* Qp, int qld, const bf16* K1, int k1ld, const bf16* K2, const bf16* VTp, bf16* Op, int b, int qb, float sink_l2, char* lds) {
    constexpr int KSTR = AttnCfg<KD>::KSTR, BUF = AttnCfg<KD>::BUF, NKS = KD / 16;
    int tid_ = threadIdx.x; asm volatile("" : "+v"(tid_)); const int tid = tid_, lane = tid & 63, r = lane & 31, hh = lane >> 5;
    const int wv = __builtin_amdgcn_readfirstlane(tid >> 6);
    const int q0 = qb * 128, qpos = q0 + 32 * wv + r;
    const size_t rowb = (size_t)b * SEQ;
    bf16x8 qf[NKS];
#pragma unroll
    for (int ks = 0; ks < NKS; ++ks) qf[ks] = *(const bf16x8*)(Qp + (rowb + qpos) * qld + ks * 16 + hh * 8);
    const int kstart = (MODE == 0) ? 0 : (q0 >= 128 ? q0 - 128 : 0);
    const int nt = (q0 + 128 - kstart) / 64;
    f32x16 ot[2];
#pragma unroll
    for (int i = 0; i < 16; ++i) { ot[0][i] = 0.f; ot[1][i] = 0.f; }
    float m = (MODE == 0) ? -INFINITY : sink_l2, l = (MODE == 1 && hh == 0) ? 1.f : 0.f;
    u32x4 sk[3], sv[2];
    auto gload = [&](int t) {
        const int key0 = kstart + 64 * t;
#pragma unroll
        for (int i = 0; i < 2; ++i) { const int q = tid + 256 * i, row = q >> 3, c = q & 7;
            sk[i] = *(const u32x4*)(K1 + (rowb + key0 + row) * k1ld + c * 8);
            sv[i] = *(const u32x4*)(VTp + (size_t)row * SEQ + key0 + c * 8); }
        if (KD == 96) { const int row = tid >> 2, c = tid & 3; sk[2] = *(const u32x4*)(K2 + (rowb + key0 + row) * 32 + c * 8); }
    };
    auto sstore = [&](char* buf) {
#pragma unroll
        for (int i = 0; i < 2; ++i) { const int q = tid + 256 * i, row = q >> 3, c = q & 7;
            *(u32x4*)(buf + row * KSTR + c * 16) = sk[i];
            *(u32x4*)(buf + 64 * KSTR + row * VSTR + c * 16) = sv[i]; }
        if (KD == 96) { const int row = tid >> 2, c = tid & 3; *(u32x4*)(buf + row * KSTR + 128 + c * 16) = sk[2]; }
    };
    gload(0);
    __syncthreads();
    sstore(lds);
    __syncthreads();
    for (int t = 0; t < nt; ++t) {
        const char* cur = lds + (t & 1) * BUF;
        if (t + 1 < nt) gload(t + 1);
        const int key0 = kstart + 64 * t;
        f32x16 st[2];
#pragma unroll
        for (int mt = 0; mt < 2; ++mt) {
#pragma unroll
            for (int i = 0; i < 16; ++i) st[mt][i] = 0.f;
#pragma unroll
            for (int ks = 0; ks < NKS; ++ks) {
                const bf16x8 a = *(const bf16x8*)(cur + (mt * 32 + r) * KSTR + ks * 32 + hh * 16);
                st[mt] = MFMA32(a, qf[ks], st[mt]);
            }
        }
        const bool need_mask = (MODE == 1) || (key0 + 63 > q0 + 32 * wv);
        if (need_mask) {
#pragma unroll
            for (int mt = 0; mt < 2; ++mt)
#pragma unroll
                for (int i = 0; i < 16; ++i) {
                    const int key = key0 + mt * 32 + crow(i, hh);
                    const bool ok = (MODE == 0) ? (key <= qpos) : (key <= qpos && key > qpos - 128);
                    if (!ok) st[mt][i] = -INFINITY;
                }
        }
        float mx = st[0][0];
#pragma unroll
        for (int i = 1; i < 16; ++i) mx = fmaxf(mx, st[0][i]);
#pragma unroll
        for (int i = 0; i < 16; ++i) mx = fmaxf(mx, st[1][i]);
        { auto rr = __builtin_amdgcn_permlane32_swap(__float_as_uint(mx), __float_as_uint(mx), false, false); mx = fmaxf(__uint_as_float(rr[0]), __uint_as_float(rr[1])); }
        const float mn = fmaxf(m, mx);
        const float alpha = __builtin_amdgcn_exp2f(m - mn);
        m = mn;
        float ps = 0.f;
#pragma unroll
        for (int mt = 0; mt < 2; ++mt)
#pragma unroll
            for (int i = 0; i < 16; ++i) { const float pv = __builtin_amdgcn_exp2f(st[mt][i] - mn); st[mt][i] = pv; ps += pv; }
        l = l * alpha + ps;
#pragma unroll
        for (int i = 0; i < 16; ++i) { ot[0][i] *= alpha; ot[1][i] *= alpha; }
        bf16x8 pb[4];
#pragma unroll
        for (int s = 0; s < 4; ++s) {
            const int mt = s >> 1, o = 8 * (s & 1);
            u32x4 w; w.x = pk2(st[mt][o], st[mt][o + 1]); w.y = pk2(st[mt][o + 2], st[mt][o + 3]); w.z = pk2(st[mt][o + 4], st[mt][o + 5]); w.w = pk2(st[mt][o + 6], st[mt][o + 7]);
            pb[s] = __builtin_bit_cast(bf16x8, w);
        }
        const char* vt = cur + 64 * KSTR;
#pragma unroll
        for (int mt = 0; mt < 2; ++mt)
#pragma unroll
            for (int s = 0; s < 4; ++s) {
                const bf16x8 a = *(const bf16x8*)(vt + (mt * 32 + r) * VSTR + s * 32 + hh * 16);
                ot[mt] = MFMA32(a, pb[s], ot[mt]);
            }
        if (t + 1 < nt) sstore(lds + ((t + 1) & 1) * BUF);
        __syncthreads();
    }
    { auto rr = __builtin_amdgcn_permlane32_swap(__float_as_uint(l), __float_as_uint(l), false, false); l = __uint_as_float(rr[0]) + __uint_as_float(rr[1]); }
    const float inv = 1.f / l;
    bf16* orow = Op + (rowb + qpos) * 1024;
#pragma unroll
    for (int mt = 0; mt < 2; ++mt)
#pragma unroll
        for (int g = 0; g < 4; ++g) {
            u32x2 w; w.x = pk2(ot[mt][4 * g] * inv, ot[mt][4 * g + 1] * inv); w.y = pk2(ot[mt][4 * g + 2] * inv, ot[mt][4 * g + 3] * inv);
            *(u32x2*)(orow + mt * 32 + 8 * g + 4 * hh) = w;
        }
}

DI void mla_unit(const Params& p, int u, char* lds) {
    const int nbh = (p.rows / SEQ) * 8, qb = 63 - u / nbh, bh = u % nbh, b = bh >> 3, h = bh & 7;
    attn_unit<96, 0>(p.Q + h * 96, 768, p.KN + h * 64, 512, p.KR, p.VT + (size_t)bh * 64 * SEQ, p.MIXIN + h * 64, b, qb, 0.f, lds);
}
DI void swa_unit(const Params& p, int l, int u, char* lds) {
    const int qb = u & 63, bh = u >> 6, b = bh >> 2, hq = bh & 3, kvh = hq >> 1;
    attn_unit<64, 1>(p.PROJ + 896 + hq * 64, PROJ_LD, p.PROJ + 1152 + kvh * 64, PROJ_LD, nullptr, p.VsT + (size_t)(b * 2 + kvh) * 64 * SEQ, p.MIXIN + 768 + hq * 64, b, qb,
                     p.in[15][l * 4 + hq] * LOG2E, lds);
}

DI void conv_unit(const Params& p, int l, int u, char* lds) {
    int tid_ = threadIdx.x; asm volatile("" : "+v"(tid_)); const int tid = tid_, lane = tid & 63, wv = tid >> 6;
    const int tok0 = u * 32, pos0 = tok0 % SEQ;
    bf16* glu = (bf16*)lds;
    float* hc = (float*)(lds + 62 * 512);
    __syncthreads();
    for (int it = tid; it < 62 * 32; it += 256) {
        const int row = it >> 5, c8 = (it & 31) * 8, pos = pos0 - 30 + row;
        u32x4 o = {0u, 0u, 0u, 0u};
        if (pos >= 0) {
            const bf16* src = p.PROJ + (size_t)(tok0 - 30 + row) * PROJ_LD + 384 + c8;
            const u32x4 a = *(const u32x4*)src, g = *(const u32x4*)(src + 256);
            const unsigned av[4] = {a.x, a.y, a.z, a.w}, gv[4] = {g.x, g.y, g.z, g.w}; unsigned ov[4];
#pragma unroll
            for (int i = 0; i < 4; ++i) {
                const float g0 = bflo(gv[i]), g1 = bfhi(gv[i]);
                ov[i] = pk2(bflo(av[i]) / (1.f + __expf(-g0)), bfhi(av[i]) / (1.f + __expf(-g1)));
            }
            o.x = ov[0]; o.y = ov[1]; o.z = ov[2]; o.w = ov[3];
        }
        *(u32x4*)(glu + row * 256 + c8) = o;
    }
    __syncthreads();
    {
        const int c = tid;
        float w[31];
        const float* wd = p.in[9] + (size_t)l * 31 * 256 + c;
#pragma unroll
        for (int k = 0; k < 31; ++k) w[k] = wd[k * 256];
        const float bd = p.in[10][l * 256 + c];
#pragma unroll 1
        for (int ch = 0; ch < 4; ++ch) {
            float g[38], acc[8];
#pragma unroll
            for (int i = 0; i < 38; ++i) g[i] = bf2f(glu[(ch * 8 + i) * 256 + c]);
#pragma unroll
            for (int tt = 0; tt < 8; ++tt) { acc[tt] = bd;
#pragma unroll
                for (int k = 0; k < 31; ++k) acc[tt] += w[k] * g[tt + k]; }
#pragma unroll
            for (int tt = 0; tt < 8; ++tt) hc[(ch * 8 + tt) * 256 + c] = acc[tt];
        }
    }
    __syncthreads();
    {
        const float4 gg = *(const float4*)(p.in[11] + l * 256 + lane * 4), bb = *(const float4*)(p.in[12] + l * 256 + lane * 4);
#pragma unroll 1
        for (int i = 0; i < 8; ++i) {
            const int t = wv * 8 + i;
            const float4 v = *(const float4*)(hc + t * 256 + lane * 4);
            float s = v.x + v.y + v.z + v.w;
#pragma unroll
            for (int o = 1; o < 64; o <<= 1) s += __shfl_xor(s, o);
            const float mean = s * (1.f / 256.f);
            const float d0 = v.x - mean, d1 = v.y - mean, d2 = v.z - mean, d3 = v.w - mean;
            float q = d0 * d0 + d1 * d1 + d2 * d2 + d3 * d3;
#pragma unroll
            for (int o = 1; o < 64; o <<= 1) q += __shfl_xor(q, o);
            const float rstd = rsqrtf(q * (1.f / 256.f) + EPS);
            float y0 = d0 * rstd * gg.x + bb.x, y1 = d1 * rstd * gg.y + bb.y, y2 = d2 * rstd * gg.z + bb.z, y3 = d3 * rstd * gg.w + bb.w;
            y0 = y0 / (1.f + __expf(-y0)); y1 = y1 / (1.f + __expf(-y1)); y2 = y2 / (1.f + __expf(-y2)); y3 = y3 / (1.f + __expf(-y3));
            u32x2 w; w.x = pk2(y0, y1); w.y = pk2(y2, y3);
            *(u32x2*)(p.MIXIN + (size_t)(tok0 + t) * 1024 + 512 + lane * 4) = w;
        }
    }
}
DI void fold_pw_item(const Params& p, int l, int item) {
    const int tid = threadIdx.x;
    const float* wo = p.in[16] + (size_t)l * D * D + (size_t)512 * D;
    if (item < 1024) {
        const int kp = item >> 2, n = (item & 3) * 256 + tid;
        const float* wp = p.in[13] + (size_t)l * 256 * 256 + (size_t)kp * 256;
        float acc = 0.f;
        for (int j = 0; j < 256; ++j) acc += wp[j] * wo[(size_t)j * D + n];
        p.WoT[((size_t)l * D + n) * D + 512 + kp] = f2bf(acc);
    } else {
        const int n = (item - 1024) * 256 + tid;
        const float* bp = p.in[14] + l * 256;
        float acc = 0.f;
        for (int j = 0; j < 256; ++j) acc += bp[j] * wo[(size_t)j * D + n];
        p.biasO[l * D + n] = acc;
    }
}

DI void p4_tile(const Params& p, int l, int tile, const float* xin, float* X1, char* lds) {
    int tid_ = threadIdx.x; asm volatile("" : "+v"(tid_)); const int tid = tid_, lane = tid & 63, r = lane & 31, hh = lane >> 5;
    const int wv = __builtin_amdgcn_readfirstlane(tid >> 6), wm = wv >> 1, wn = wv & 1;
    const int mt = tile >> 3, nt = tile & 7, m0 = mt * 128, n0 = nt * 128;
    const bf16* A = p.MIXIN + (size_t)m0 * D;
    const bf16* W = p.WoT + ((size_t)l * D + n0) * D;
    f32x16 acc[2][2]; zero_acc(acc);
    int frow[2], grow[2];
    frow[0] = 64 * wn + cperm_lin(r); frow[1] = frow[0] + 32; grow[0] = 64 * wm + r; grow[1] = grow[0] + 32;
    gemm_core<2, 2>(A, D, W, D, D, lds, acc, TILE_B, frow, 0, grow);
#pragma unroll
    for (int y = 0; y < 2; ++y) {
        const int tok = m0 + 64 * wm + 32 * y + r, b = (p.tok0 + tok) / SEQ;
        const float* gt = p.MOD + ((size_t)l * BATCH + b) * 6 * D + 2 * D;
#pragma unroll
        for (int x = 0; x < 2; ++x) {
            const int col = n0 + 64 * wn + 32 * x + 16 * hh;
#pragma unroll
            for (int q = 0; q < 4; ++q) {
                const float4 xv = *(const float4*)(xin + (size_t)tok * D + col + 4 * q), g4 = *(const float4*)(gt + col + 4 * q), b4 = *(const float4*)(p.biasO + l * D + col + 4 * q);
                float4 o;
                o.x = DN_ALPHA * xv.x + (1.f + g4.x) * (acc[x][y][4 * q + 0] + b4.x); o.y = DN_ALPHA * xv.y + (1.f + g4.y) * (acc[x][y][4 * q + 1] + b4.y);
                o.z = DN_ALPHA * xv.z + (1.f + g4.z) * (acc[x][y][4 * q + 2] + b4.z); o.w = DN_ALPHA * xv.w + (1.f + g4.w) * (acc[x][y][4 * q + 3] + b4.w);
                *(float4*)(X1 + (size_t)tok * D + col + 4 * q) = o;
            }
        }
    }
}

DI void ln16(float (&v)[16], const float* g, const float* bta, int lane) {
    float s = 0.f;
#pragma unroll
    for (int i = 0; i < 16; ++i) s += v[i];
#pragma unroll
    for (int o = 1; o < 64; o <<= 1) s += __shfl_xor(s, o);
    const float mean = s * (1.f / D); float q = 0.f;
#pragma unroll
    for (int i = 0; i < 16; ++i) { v[i] -= mean; q += v[i] * v[i]; }
#pragma unroll
    for (int o = 1; o < 64; o <<= 1) q += __shfl_xor(q, o);
    const float rstd = rsqrtf(q * (1.f / D) + EPS);
#pragma unroll
    for (int hf = 0; hf < 2; ++hf)
#pragma unroll
        for (int q4 = 0; q4 < 2; ++q4) {
            const int c = hf * 512 + lane * 8 + q4 * 4;
            const float4 gg = *(const float4*)(g + c), bb = *(const float4*)(bta + c);
            const int i = hf * 8 + q4 * 4;
            v[i] = v[i] * rstd * gg.x + bb.x; v[i + 1] = v[i + 1] * rstd * gg.y + bb.y; v[i + 2] = v[i + 2] * rstd * gg.z + bb.z; v[i + 3] = v[i + 3] * rstd * gg.w + bb.w;
        }
}
DI void load16(float (&v)[16], const float* row, int lane) {
#pragma unroll
    for (int hf = 0; hf < 2; ++hf)
#pragma unroll
        for (int q4 = 0; q4 < 2; ++q4) { const float4 t = *(const float4*)(row + hf * 512 + lane * 8 + q4 * 4); const int i = hf * 8 + q4 * 4; v[i] = t.x; v[i + 1] = t.y; v[i + 2] = t.z; v[i + 3] = t.w; }
}
DI void store16f(float* row, const float (&v)[16], int lane) {
#pragma unroll
    for (int hf = 0; hf < 2; ++hf)
#pragma unroll
        for (int q4 = 0; q4 < 2; ++q4) { const int i = hf * 8 + q4 * 4; *(float4*)(row + hf * 512 + lane * 8 + q4 * 4) = make_float4(v[i], v[i + 1], v[i + 2], v[i + 3]); }
}
DI void store_mod16(bf16* hrow, const float (&v)[16], const float* sh, const float* sc, int lane) {
#pragma unroll
    for (int hf = 0; hf < 2; ++hf) {
        float o[8];
#pragma unroll
        for (int q4 = 0; q4 < 2; ++q4) {
            const int c = hf * 512 + lane * 8 + q4 * 4, i = hf * 8 + q4 * 4;
            const float4 s4 = *(const float4*)(sc + c), h4 = *(const float4*)(sh + c);
            o[q4 * 4] = v[i] * (1.f + s4.x) + h4.x; o[q4 * 4 + 1] = v[i + 1] * (1.f + s4.y) + h4.y; o[q4 * 4 + 2] = v[i + 2] * (1.f + s4.z) + h4.z; o[q4 * 4 + 3] = v[i + 3] * (1.f + s4.w) + h4.w;
        }
        store8(hrow + hf * 512 + lane * 8, o);
    }
}
DI void p4b_row(const Params& p, int l, int row, float* X1, int lane) {
    float v[16];
    load16(v, X1 + (size_t)row * D, lane);
    ln16(v, p.in[17] + l * D, p.in[18] + l * D, lane);
    store16f(X1 + (size_t)row * D, v, lane);
    const int b = (p.tok0 + row) / SEQ;
    const float* mod = p.MOD + ((size_t)l * BATCH + b) * 6 * D;
    store_mod16(p.H + (size_t)row * D, v, mod + 3 * D, mod + 4 * D, lane);
}

DI unsigned ford(float f) { const unsigned u = __float_as_uint(f); return u ^ ((u >> 31) ? 0xffffffffu : 0x80000000u); }
DI float funord(unsigned o) { const unsigned u = o ^ ((o >> 31) ? 0x80000000u : 0xffffffffu); return __uint_as_float(u); }
constexpr int SKSTR = 272;

DI void p5_tile(const Params& p, int l, int tile, char* lds) {
    int tid_ = threadIdx.x; asm volatile("" : "+v"(tid_)); const int tid = tid_, lane = tid & 63, r = lane & 31, hh = lane >> 5;
    const int wv = __builtin_amdgcn_readfirstlane(tid >> 6);
    const int mt = tile >> 4, hp = tile & 15, m0 = mt * 128;
    const bf16* A = p.H + (size_t)m0 * D;
    const bf16* W = p.WpqT + ((size_t)l * 2048 + hp * 128) * D;
    f32x16 acc[4][1]; zero_acc(acc);
    int frow[4], grow[1];
#pragma unroll
    for (int x = 0; x < 4; ++x) frow[x] = 32 * x + r;
    grow[0] = 32 * wv + r;
    gemm_core<4, 1>(A, D, W, D, D, lds, acc, TILE_B, frow, 0, grow);
    bf16x8 xb[8];
#pragma unroll
    for (int s = 0; s < 8; ++s) {
        const int x = s >> 1, o = 8 * (s & 1);
        u32x4 w; w.x = pk2(acc[x][0][o], acc[x][0][o + 1]); w.y = pk2(acc[x][0][o + 2], acc[x][0][o + 3]); w.z = pk2(acc[x][0][o + 4], acc[x][0][o + 5]); w.w = pk2(acc[x][0][o + 6], acc[x][0][o + 7]);
        xb[s] = __builtin_bit_cast(bf16x8, w);
    }
    const bf16* sk = p.SKp + ((size_t)l * 16 + hp) * 128 * 128;
#pragma unroll
    for (int i = 0; i < 8; ++i) { const int q = tid + 256 * i, row = q >> 4, c = q & 15; *(u32x4*)(lds + row * SKSTR + c * 16) = *(const u32x4*)(sk + row * 128 + c * 8); }
    __syncthreads();
    unsigned L[16];
#pragma unroll
    for (int k = 0; k < 16; ++k) L[k] = 0u;
#pragma unroll
    for (int m2 = 0; m2 < 4; ++m2) {
        f32x16 st;
#pragma unroll
        for (int i = 0; i < 16; ++i) st[i] = 0.f;
#pragma unroll
        for (int s = 0; s < 8; ++s) {
            const bf16x8 a = *(const bf16x8*)(lds + (32 * m2 + r) * SKSTR + s * 32 + hh * 16);
            st = MFMA32(a, xb[s], st);
        }
#pragma unroll
        for (int i = 0; i < 16; ++i) {
            unsigned v = (ford(st[i]) & ~0x7fu) | (unsigned)(32 * m2 + crow(i, hh));
#pragma unroll
            for (int k = 0; k < 16; ++k) { const unsigned t = max(L[k], v); v = min(L[k], v); L[k] = t; }
        }
    }
    unsigned C[16];
#pragma unroll
    for (int k = 0; k < 16; ++k) C[k] = max(L[k], (unsigned)__shfl_xor((int)L[15 - k], 32));
#pragma unroll
    for (int d = 8; d >= 1; d >>= 1)
#pragma unroll
        for (int i = 0; i < 16; ++i) if ((i & d) == 0) { const unsigned a = max(C[i], C[i + d]), b = min(C[i], C[i + d]); C[i] = a; C[i + d] = b; }
    unsigned* dst = p.TOPK + ((size_t)(m0 + 32 * wv + r) * 16 + hp) * 16 + 8 * hh;
    u32x4 o0, o1;
    if (hh == 0) { o0 = (u32x4){C[0], C[1], C[2], C[3]}; o1 = (u32x4){C[4], C[5], C[6], C[7]}; }
    else { o0 = (u32x4){C[8], C[9], C[10], C[11]}; o1 = (u32x4){C[12], C[13], C[14], C[15]}; }
    *(u32x4*)dst = o0; *(u32x4*)(dst + 4) = o1;
}
typedef __bf16 bf16x2v __attribute__((ext_vector_type(2)));
DI float dot2(unsigned a, unsigned b, float c) { return __builtin_amdgcn_fdot2_f32_bf16(__builtin_bit_cast(bf16x2v, a), __builtin_bit_cast(bf16x2v, b), c, false); }
DI float gelu_erf(float a) { return 0.5f * a * (1.f + erff(a * 0.70710678118654752f)); }

DI void p6_unit(const Params& p, int l, int u, const float* X1, float* xout, char* lds) {
    int tid_ = threadIdx.x; asm volatile("" : "+v"(tid_)); const int tid = tid_, lane = tid & 63;
    const int wv = __builtin_amdgcn_readfirstlane(tid >> 6);
    unsigned* LA = (unsigned*)(lds + wv * 16384); unsigned* LB = LA + 1024; unsigned* Ee = LA + 2048; float* Eg = (float*)(LA + 3072);
    const int tokb = u * 32 + wv * 8;
    __syncthreads();
    {
        const int ti = lane >> 3, head = lane & 7;
        const unsigned* src = p.TOPK + ((size_t)(tokb + ti) * 16 + head * 2) * 16;
        unsigned A[16], B[16];
#pragma unroll
        for (int q = 0; q < 4; ++q) { const u32x4 a = *(const u32x4*)(src + 4 * q), b = *(const u32x4*)(src + 16 + 4 * q);
            A[4 * q] = a.x; A[4 * q + 1] = a.y; A[4 * q + 2] = a.z; A[4 * q + 3] = a.w; B[4 * q] = b.x; B[4 * q + 1] = b.y; B[4 * q + 2] = b.z; B[4 * q + 3] = b.w;
            *(u32x4*)(LA + lane * 16 + 4 * q) = a; *(u32x4*)(LB + lane * 16 + 4 * q) = b; }
        float sA[16], sB[16];
#pragma unroll
        for (int k = 0; k < 16; ++k) { sA[k] = funord(A[k] & ~0x7fu); sB[k] = funord(B[k] & ~0x7fu); }
        unsigned T[16];
#pragma unroll
        for (int k = 0; k < 16; ++k) T[k] = 0u;
#pragma unroll
        for (int a = 0; a < 16; ++a)
#pragma unroll
            for (int b = 0; b < 16; ++b)
                if ((a + 1) * (b + 1) <= 16) {
                    unsigned v = (ford(sA[a] + sB[b]) & ~0xffu) | (unsigned)(a * 16 + b);
#pragma unroll
                    for (int k = 0; k < 16; ++k) { const unsigned t = max(T[k], v); v = min(T[k], v); T[k] = t; }
                }
        float ex[16]; float sum = 0.f; const float mx = funord(T[0] & ~0xffu);
#pragma unroll
        for (int k = 0; k < 16; ++k) { ex[k] = __expf(funord(T[k] & ~0xffu) - mx); sum += ex[k]; }
        const float inv = 1.f / sum;
#pragma unroll
        for (int k = 0; k < 16; ++k) {
            const unsigned cid = T[k] & 0xffu, ia = LA[lane * 16 + (cid >> 4)] & 0x7fu, ib = LB[lane * 16 + (cid & 15u)] & 0x7fu;
            Ee[ti * 128 + head * 16 + k] = ia * 128u + ib; Eg[ti * 128 + head * 16 + k] = ex[k] * inv;
        }
    }
    const bf16* Ut = p.Ut; const bf16* Vt = p.Vt;
    const int jl = 4 * (lane >> 5) + 2 * ((lane >> 4) & 1) + ((lane >> 3) & 1);
    const bool b5 = lane & 32, b4 = lane & 16, b3 = lane & 8;
#pragma unroll 1
    for (int ti = 0; ti < 8; ++ti) {
        const int tok = tokb + ti;
        const u32x4 h0 = *(const u32x4*)(p.H + (size_t)tok * D + lane * 8), h1 = *(const u32x4*)(p.H + (size_t)tok * D + 512 + lane * 8);
        float y[16];
#pragma unroll
        for (int i = 0; i < 16; ++i) y[i] = 0.f;
#pragma unroll 1
        for (int bt = 0; bt < 16; ++bt) {
            u32x4 uu[8][2], vv[8][2];
#pragma unroll
            for (int j = 0; j < 8; ++j) {
                const unsigned e = __builtin_amdgcn_readfirstlane(Ee[ti * 128 + bt * 8 + j]);
                const bf16* ur = Ut + (size_t)e * D + lane * 8; const bf16* vr = Vt + (size_t)e * D + lane * 8;
                uu[j][0] = *(const u32x4*)ur; uu[j][1] = *(const u32x4*)(ur + 512);
                vv[j][0] = *(const u32x4*)vr; vv[j][1] = *(const u32x4*)(vr + 512);
            }
            float a[8];
#pragma unroll
            for (int j = 0; j < 8; ++j) {
                float s = dot2(h0.x, uu[j][0].x, 0.f); s = dot2(h0.y, uu[j][0].y, s); s = dot2(h0.z, uu[j][0].z, s); s = dot2(h0.w, uu[j][0].w, s);
                s = dot2(h1.x, uu[j][1].x, s); s = dot2(h1.y, uu[j][1].y, s); s = dot2(h1.z, uu[j][1].z, s); s = dot2(h1.w, uu[j][1].w, s);
                a[j] = s;
            }
            float k1[4], k2[2], k3;
#pragma unroll
            for (int i = 0; i < 4; ++i) { const float snd = b5 ? a[i] : a[4 + i]; const float rcv = __shfl_xor(snd, 32); k1[i] = (b5 ? a[4 + i] : a[i]) + rcv; }
#pragma unroll
            for (int i = 0; i < 2; ++i) { const float snd = b4 ? k1[i] : k1[2 + i]; const float rcv = __shfl_xor(snd, 16); k2[i] = (b4 ? k1[2 + i] : k1[i]) + rcv; }
            { const float snd = b3 ? k2[0] : k2[1]; const float rcv = __shfl_xor(snd, 8); k3 = (b3 ? k2[1] : k2[0]) + rcv; }
            k3 += __shfl_xor(k3, 4); k3 += __shfl_xor(k3, 2); k3 += __shfl_xor(k3, 1);
            const float w = Eg[ti * 128 + bt * 8 + jl] * gelu_erf(k3);
#pragma unroll
            for (int j = 0; j < 8; ++j) {
                const int src = 32 * (j >> 2) + 16 * ((j >> 1) & 1) + 8 * (j & 1);
                const float wj = __uint_as_float(__builtin_amdgcn_readlane(__float_as_uint(w), src));
                const unsigned w0[4] = {vv[j][0].x, vv[j][0].y, vv[j][0].z, vv[j][0].w}, w1[4] = {vv[j][1].x, vv[j][1].y, vv[j][1].z, vv[j][1].w};
#pragma unroll
                for (int i = 0; i < 4; ++i) { y[2 * i] += wj * bflo(w0[i]); y[2 * i + 1] += wj * bfhi(w0[i]); y[8 + 2 * i] += wj * bflo(w1[i]); y[8 + 2 * i + 1] += wj * bfhi(w1[i]); }
            }
        }
        const int b = (p.tok0 + tok) / SEQ;
        const float* mod = p.MOD + ((size_t)l * BATCH + b) * 6 * D;
        float v[16], gt[16];
        load16(v, X1 + (size_t)tok * D, lane); load16(gt, mod + 5 * D, lane);
#pragma unroll
        for (int i = 0; i < 16; ++i) v[i] = DN_ALPHA * v[i] + (1.f + gt[i]) * y[i];
        ln16(v, p.in[23] + l * D, p.in[24] + l * D, lane);
        store16f(xout + (size_t)tok * D, v, lane);
        if (l + 1 < DEPTH) { const float* modn = p.MOD + ((size_t)(l + 1) * BATCH + b) * 6 * D; store_mod16(p.H + (size_t)tok * D, v, modn, modn + D, lane); }
    }
}
typedef float f32x2v __attribute__((ext_vector_type(2)));
DI void table_row_fp8(const float* src, unsigned char* dst, float* inv_scale, int lane) {
    float v[16];
#pragma unroll
    for (int q = 0; q < 4; ++q) { const float4 t = *(const float4*)(src + lane * 16 + q * 4); v[4 * q] = t.x; v[4 * q + 1] = t.y; v[4 * q + 2] = t.z; v[4 * q + 3] = t.w; }
    float mx = 0.f;
#pragma unroll
    for (int i = 0; i < 16; ++i) mx = fmaxf(mx, fabsf(v[i]));
#pragma unroll
    for (int o = 1; o < 64; o <<= 1) mx = fmaxf(mx, __shfl_xor(mx, o));
    const float sc = (mx > 0.f) ? 448.f / mx : 1.f;
    u32x4 o;
    unsigned w[4];
#pragma unroll
    for (int q = 0; q < 4; ++q) { unsigned t = 0u; t = __builtin_amdgcn_cvt_pk_fp8_f32(v[4 * q] * sc, v[4 * q + 1] * sc, t, false); t = __builtin_amdgcn_cvt_pk_fp8_f32(v[4 * q + 2] * sc, v[4 * q + 3] * sc, t, true); w[q] = t; }
    o.x = w[0]; o.y = w[1]; o.z = w[2]; o.w = w[3];
    *(u32x4*)(dst + lane * 16) = o;
    if (lane == 0) *inv_scale = (mx > 0.f) ? mx * (1.f / 448.f) : 1.f;
}
DI void convert_tables_fp8(const Params& p, int l, int bid, int nb) {
    int t_ = threadIdx.x; asm volatile("" : "+v"(t_)); const int wv = t_ >> 6, lane = t_ & 63;
    const float* us = p.in[21] + (size_t)l * 16384 * D; const float* vs = p.in[22] + (size_t)l * 16384 * D;
    for (int row = bid * 4 + wv; row < 2 * 16384; row += nb * 4) {
        if (row < 16384) table_row_fp8(us + (size_t)row * D, p.U8 + (size_t)row * D, p.US + l * 16384 + row, lane);
        else { const int r2 = row - 16384; table_row_fp8(vs + (size_t)r2 * D, p.V8 + (size_t)r2 * D, p.VS + l * 16384 + r2, lane); }
    }
}
DI void load16c(float (&v)[16], const float* row, int lane) {
#pragma unroll
    for (int q = 0; q < 4; ++q) { const float4 t = *(const float4*)(row + lane * 16 + q * 4); v[4 * q] = t.x; v[4 * q + 1] = t.y; v[4 * q + 2] = t.z; v[4 * q + 3] = t.w; }
}
DI void ln16c(float (&v)[16], const float* g, const float* bta, int lane) {
    float s = 0.f;
#pragma unroll
    for (int i = 0; i < 16; ++i) s += v[i];
#pragma unroll
    for (int o = 1; o < 64; o <<= 1) s += __shfl_xor(s, o);
    const float mean = s * (1.f / D); float q = 0.f;
#pragma unroll
    for (int i = 0; i < 16; ++i) { v[i] -= mean; q += v[i] * v[i]; }
#pragma unroll
    for (int o = 1; o < 64; o <<= 1) q += __shfl_xor(q, o);
    const float rstd = rsqrtf(q * (1.f / D) + EPS);
    float gg[16], bb[16]; load16c(gg, g, lane); load16c(bb, bta, lane);
#pragma unroll
    for (int i = 0; i < 16; ++i) v[i] = v[i] * rstd * gg[i] + bb[i];
}
DI void store16c(float* row, const float (&v)[16], int lane) {
#pragma unroll
    for (int q = 0; q < 4; ++q) *(float4*)(row + lane * 16 + q * 4) = make_float4(v[4 * q], v[4 * q + 1], v[4 * q + 2], v[4 * q + 3]);
}
DI void store_mod16c(bf16* hrow, const float (&v)[16], const float* sh, const float* sc, int lane) {
    float s[16], h[16], o[16]; load16c(s, sc, lane); load16c(h, sh, lane);
#pragma unroll
    for (int i = 0; i < 16; ++i) o[i] = v[i] * (1.f + s[i]) + h[i];
    store16(hrow + lane * 16, o);
}

DI void p6f_unit(const Params& p, int l, int u, const float* X1, float* xout, char* lds) {
    int tid_ = threadIdx.x; asm volatile("" : "+v"(tid_)); const int tid = tid_, lane = tid & 63;
    const int wv = __builtin_amdgcn_readfirstlane(tid >> 6);
    unsigned* LA = (unsigned*)(lds + wv * 16384); unsigned* LB = LA + 1024; unsigned* Ee = LA + 2048; float* Eg = (float*)(LA + 3072); float* Es = (float*)LA;
    const int tokb = u * 32 + wv * 8;
    __syncthreads();
    {
        const int ti = lane >> 3, head = lane & 7;
        const unsigned* src = p.TOPK + ((size_t)(tokb + ti) * 16 + head * 2) * 16;
        unsigned A[16], B[16];
#pragma unroll
        for (int q = 0; q < 4; ++q) { const u32x4 a = *(const u32x4*)(src + 4 * q), b = *(const u32x4*)(src + 16 + 4 * q);
            A[4 * q] = a.x; A[4 * q + 1] = a.y; A[4 * q + 2] = a.z; A[4 * q + 3] = a.w; B[4 * q] = b.x; B[4 * q + 1] = b.y; B[4 * q + 2] = b.z; B[4 * q + 3] = b.w;
            *(u32x4*)(LA + lane * 16 + 4 * q) = a; *(u32x4*)(LB + lane * 16 + 4 * q) = b; }
        float sA[16], sB[16];
#pragma unroll
        for (int k = 0; k < 16; ++k) { sA[k] = funord(A[k] & ~0x7fu); sB[k] = funord(B[k] & ~0x7fu); }
        unsigned T[16];
#pragma unroll
        for (int k = 0; k < 16; ++k) T[k] = 0u;
#pragma unroll
        for (int a = 0; a < 16; ++a)
#pragma unroll
            for (int b = 0; b < 16; ++b)
                if ((a + 1) * (b + 1) <= 16) {
                    unsigned v = (ford(sA[a] + sB[b]) & ~0xffu) | (unsigned)(a * 16 + b);
#pragma unroll
                    for (int k = 0; k < 16; ++k) { const unsigned t = max(T[k], v); v = min(T[k], v); T[k] = t; }
                }
        float ex[16]; float sum = 0.f; const float mx = funord(T[0] & ~0xffu);
        unsigned ev[16];
#pragma unroll
        for (int k = 0; k < 16; ++k) { ex[k] = __expf(funord(T[k] & ~0xffu) - mx); sum += ex[k];
            const unsigned cid = T[k] & 0xffu; ev[k] = (LA[lane * 16 + (cid >> 4)] & 0x7fu) * 128u + (LB[lane * 16 + (cid & 15u)] & 0x7fu); }
        const float inv = 1.f / sum;
        const float* US = p.US + l * 16384; const float* VS = p.VS + l * 16384;
#pragma unroll
        for (int k = 0; k < 16; ++k) {
            const float su = US[ev[k]], sv = VS[ev[k]];
            Ee[ti * 128 + head * 16 + k] = ev[k]; Eg[ti * 128 + head * 16 + k] = ex[k] * inv * sv; Es[ti * 128 + head * 16 + k] = su;
        }
    }
    const unsigned char* U8 = p.U8; const unsigned char* V8 = p.V8;
    const int jl = 8 * (lane >> 5) + 4 * ((lane >> 4) & 1) + 2 * ((lane >> 3) & 1) + ((lane >> 2) & 1);
    const bool b5 = lane & 32, b4 = lane & 16, b3 = lane & 8, b2 = lane & 4;
#pragma unroll 1
    for (int ti = 0; ti < 8; ++ti) {
        const int tok = tokb + ti;
        const u32x4 h0 = *(const u32x4*)(p.H + (size_t)tok * D + lane * 16), h1 = *(const u32x4*)(p.H + (size_t)tok * D + lane * 16 + 8);
        const unsigned hw[8] = {h0.x, h0.y, h0.z, h0.w, h1.x, h1.y, h1.z, h1.w};
        f32x2v hf[8], y2[8];
#pragma unroll
        for (int i = 0; i < 8; ++i) { hf[i] = (f32x2v){bflo(hw[i]), bfhi(hw[i])}; y2[i] = (f32x2v){0.f, 0.f}; }
#pragma unroll 1
        for (int bt = 0; bt < 8; ++bt) {
            u32x4 uu[16], vv[16];
#pragma unroll
            for (int j = 0; j < 16; ++j) {
                const unsigned e = __builtin_amdgcn_readfirstlane(Ee[ti * 128 + bt * 16 + j]);
                uu[j] = *(const u32x4*)(U8 + (size_t)e * D + lane * 16);
                vv[j] = *(const u32x4*)(V8 + (size_t)e * D + lane * 16);
            }
            float a[16];
#pragma unroll
            for (int j = 0; j < 16; ++j) {
                const unsigned w[4] = {uu[j].x, uu[j].y, uu[j].z, uu[j].w};
                f32x2v acc = {0.f, 0.f};
#pragma unroll
                for (int q = 0; q < 4; ++q) { acc = __builtin_amdgcn_cvt_pk_f32_fp8(w[q], false) * hf[2 * q] + acc; acc = __builtin_amdgcn_cvt_pk_f32_fp8(w[q], true) * hf[2 * q + 1] + acc; }
                a[j] = acc.x + acc.y;
            }
            float k1[8], k2[4], k3[2], k4;
#pragma unroll
            for (int i = 0; i < 8; ++i) { const float snd = b5 ? a[i] : a[8 + i]; const float rcv = __shfl_xor(snd, 32); k1[i] = (b5 ? a[8 + i] : a[i]) + rcv; }
#pragma unroll
            for (int i = 0; i < 4; ++i) { const float snd = b4 ? k1[i] : k1[4 + i]; const float rcv = __shfl_xor(snd, 16); k2[i] = (b4 ? k1[4 + i] : k1[i]) + rcv; }
#pragma unroll
            for (int i = 0; i < 2; ++i) { const float snd = b3 ? k2[i] : k2[2 + i]; const float rcv = __shfl_xor(snd, 8); k3[i] = (b3 ? k2[2 + i] : k2[i]) + rcv; }
            { const float snd = b2 ? k3[0] : k3[1]; const float rcv = __shfl_xor(snd, 4); k4 = (b2 ? k3[1] : k3[0]) + rcv; }
            k4 += __shfl_xor(k4, 2); k4 += __shfl_xor(k4, 1);
            const int ei = ti * 128 + bt * 16 + jl;
            const float w = Eg[ei] * gelu_erf(k4 * Es[ei]);
#pragma unroll
            for (int j = 0; j < 16; ++j) {
                const int src = 32 * (j >> 3) + 16 * ((j >> 2) & 1) + 8 * ((j >> 1) & 1) + 4 * (j & 1);
                const float wj = __uint_as_float(__builtin_amdgcn_readlane(__float_as_uint(w), src));
                const f32x2v wj2 = {wj, wj};
                const unsigned wd[4] = {vv[j].x, vv[j].y, vv[j].z, vv[j].w};
#pragma unroll
                for (int q = 0; q < 4; ++q) { y2[2 * q] = __builtin_amdgcn_cvt_pk_f32_fp8(wd[q], false) * wj2 + y2[2 * q]; y2[2 * q + 1] = __builtin_amdgcn_cvt_pk_f32_fp8(wd[q], true) * wj2 + y2[2 * q + 1]; }
            }
        }
        const int b = (p.tok0 + tok) / SEQ;
        const float* mod = p.MOD + ((size_t)l * BATCH + b) * 6 * D;
        float v[16], gt[16];
        load16c(v, X1 + (size_t)tok * D, lane); load16c(gt, mod + 5 * D, lane);
#pragma unroll
        for (int i = 0; i < 8; ++i) { v[2 * i] = DN_ALPHA * v[2 * i] + (1.f + gt[2 * i]) * y2[i].x; v[2 * i + 1] = DN_ALPHA * v[2 * i + 1] + (1.f + gt[2 * i + 1]) * y2[i].y; }
        ln16c(v, p.in[23] + l * D, p.in[24] + l * D, lane);
        store16c(xout + (size_t)tok * D, v, lane);
        if (l + 1 < DEPTH) { const float* modn = p.MOD + ((size_t)(l + 1) * BATCH + b) * 6 * D; store_mod16c(p.H + (size_t)tok * D, v, modn, modn + D, lane); }
    }
}
#define XB_TMO      128
#define XB_XCNT(j)  (256  + 64 * (j))
#define XB_XSUB(j)  (1280 + 64 * (j))
#define XB_XGEN(j)  (2304 + 64 * (j))
#define XB_TOP      3328
#define XB_TOPGEN   3392
#define XCD_BAR_WORDS 3456
#define XB_SPIN_CAP (1u << 22)
#define LAS __attribute__((address_space(3)))
DI unsigned xb_ld(unsigned* p)              { return __hip_atomic_load(p, __ATOMIC_RELAXED, __HIP_MEMORY_SCOPE_AGENT); }
DI unsigned xb_add(unsigned* p, unsigned v) { return __hip_atomic_fetch_add(p, v, __ATOMIC_RELAXED, __HIP_MEMORY_SCOPE_AGENT); }
DI unsigned xb_xcc_id() { return (unsigned)__builtin_amdgcn_s_getreg((3 << 11) | 20) & 0xFu; }
#define XB_SPIN(cond, bar) do { unsigned _sp = 0; while (cond) { __builtin_amdgcn_s_sleep(1); \
    if ((++_sp & 255u) == 0u) { if (xb_ld(&(bar)[XB_TMO])) break; if (_sp > XB_SPIN_CAP) { atomicAdd(&(bar)[XB_TMO], 1u); break; } } } } while (0)
struct XcdBarrier { unsigned* bar; unsigned x; volatile LAS unsigned* st; };
DI XcdBarrier xcd_barrier_post(unsigned* bar, volatile LAS unsigned* st) {
    XcdBarrier b; b.bar = bar; b.x = xb_xcc_id(); b.st = st;
    if (threadIdx.x == 0) (void)xb_add(&bar[XB_XCNT(b.x)], 1u);
    return b;
}
DI void xcd_barrier_complete(unsigned* bar, unsigned x, unsigned& nloc, unsigned& nx) {
    const unsigned G = gridDim.x * gridDim.y * gridDim.z;
    unsigned sum, cnt, mine, sp = 0u;
    for (;;) {
        sum = 0u; cnt = 0u; mine = 0u;
#pragma unroll
        for (unsigned j = 0; j < 16; ++j) { const unsigned c = xb_ld(&bar[XB_XCNT(j)]); sum += c; cnt += (c > 0u) ? 1u : 0u; mine = (j == x) ? c : mine; }
        if (sum == G) break;
        __builtin_amdgcn_s_sleep(1);
        if ((++sp & 255u) == 0u) { if (xb_ld(&bar[XB_TMO])) break; if (sp > XB_SPIN_CAP) { atomicAdd(&bar[XB_TMO], 1u); break; } }
    }
    nloc = mine > 0u ? mine : 1u; nx = cnt > 0u ? cnt : 1u;
}
DI void xcd_barrier(const XcdBarrier& b) {
    asm volatile("s_waitcnt vmcnt(0)" ::: "memory");
    __syncthreads();
    if (threadIdx.x == 0) {
        unsigned* bar = b.bar;
        __builtin_amdgcn_s_waitcnt(0);
        unsigned nloc = b.st[0], nx = b.st[1];
        if (nloc == 0u) { xcd_barrier_complete(bar, b.x, nloc, nx); b.st[0] = nloc; b.st[1] = nx; }
        const unsigned old = xb_add(&bar[XB_XSUB(b.x)], 1u);
        const unsigned gen = old / nloc;
        if (old + 1u == (gen + 1u) * nloc) {
            __builtin_amdgcn_fence(__ATOMIC_RELEASE, "agent");
            asm volatile("s_waitcnt vmcnt(0)" ::: "memory");
            const unsigned og = xb_add(&bar[XB_TOP], 1u);
            const unsigned tg = og / nx;
            if (og + 1u == (tg + 1u) * nx) xb_add(&bar[XB_TOPGEN], 1u);
            else XB_SPIN(xb_ld(&bar[XB_TOPGEN]) == tg, bar);
            __builtin_amdgcn_fence(__ATOMIC_ACQUIRE, "agent");
            xb_add(&bar[XB_XGEN(b.x)], 1u);
            asm volatile("s_waitcnt vmcnt(0)" ::: "memory");
        } else {
            XB_SPIN(xb_ld(&bar[XB_XGEN(b.x)]) == gen, bar);
            __builtin_amdgcn_fence(__ATOMIC_ACQUIRE, "agent");
            asm volatile("s_waitcnt vmcnt(0)" ::: "memory");
        }
    }
    __syncthreads();
}
DI void ada_item(const Params& p, int item, char* lds) {
    int tid_ = threadIdx.x; asm volatile("" : "+v"(tid_)); const int tid = tid_, lane = tid & 63, wv = tid >> 6;
    float* cs = (float*)lds;
    float* part = cs + 4 * D;
    __syncthreads();
    for (int i = tid; i < BATCH * D; i += 256) { const float cv = p.in[1][i]; cs[i] = cv / (1.f + __expf(-cv)); }
    __syncthreads();
    const int col = item * 64 + lane, l = col / (6 * D), j = col % (6 * D);
    const float* w = p.in[2] + (size_t)l * D * 6 * D + j;
    float a0 = 0.f, a1 = 0.f, a2 = 0.f, a3 = 0.f;
#pragma unroll 4
    for (int k = wv * 256; k < wv * 256 + 256; ++k) { const float wk = w[(size_t)k * 6 * D]; a0 += cs[k] * wk; a1 += cs[D + k] * wk; a2 += cs[2 * D + k] * wk; a3 += cs[3 * D + k] * wk; }
    part[(wv * 4 + 0) * 64 + lane] = a0; part[(wv * 4 + 1) * 64 + lane] = a1; part[(wv * 4 + 2) * 64 + lane] = a2; part[(wv * 4 + 3) * 64 + lane] = a3;
    __syncthreads();
    {
        const float s = part[(0 * 4 + wv) * 64 + lane] + part[(1 * 4 + wv) * 64 + lane] + part[(2 * 4 + wv) * 64 + lane] + part[(3 * 4 + wv) * 64 + lane];
        p.MOD[((size_t)l * BATCH + wv) * 6 * D + j] = s + p.in[3][l * 6 * D + j];
    }
}

DI void rope_table_item(const Params& p, int idx) {
    const int pos = idx >> 4, i = idx & 15;
    const float inv = 1.0f / powf(10000.0f, (float)(2 * i) / 32.0f);
    const float ang = (float)pos * inv;
    double fr = (double)ang * 0.15915494309189535;
    fr -= rint(fr);
    const float f = (float)fr;
    p.COS[idx] = __builtin_amdgcn_cosf(f); p.SIN[idx] = __builtin_amdgcn_sinf(f);
}

DI void convert_tables(const Params& p, int l, int bid, int nb) {
    const float* us = p.in[21] + (size_t)l * 16384 * D; const float* vs = p.in[22] + (size_t)l * 16384 * D;
    const size_t n8 = (size_t)16384 * D / 8;
    for (size_t i = (size_t)bid * 256 + threadIdx.x; i < n8; i += (size_t)nb * 256) { cvt8(us, p.Ut, i); cvt8(vs, p.Vt, i); }
}

DI void prologue(const Params& p, char* lds) {
    int tid_ = threadIdx.x; asm volatile("" : "+v"(tid_)); const int tid = tid_, lane = tid & 63, wv = tid >> 6, bid = blockIdx.x, nb = gridDim.x;
    for (int it = bid; it < DEPTH * 6 * D / 64; it += nb) ada_item(p, it, lds);
    __syncthreads();
    float* scr = (float*)(lds + wv * 16384);
    const int n_win = (D / 64) * (WIN_N / 32), n_uq = 4 * 24, n_ukv = 2 * 32, n_wo = 16 * 32, n_pq = 16 * 64, per_l = n_win + n_uq + n_ukv + n_wo + n_pq;
    for (int it = bid * 4 + wv; it < DEPTH * per_l; it += nb * 4) {
        const int l = it / per_l; int r = it % per_l;
        if (r < n_win) { transpose_item(TK_WIN, p.in[4] + (size_t)l * D * D_IN, D_IN, D, WIN_N, p.WinT + (size_t)l * WIN_N * D, nullptr, scr, r, lane); continue; } r -= n_win;
        if (r < n_uq) { transpose_item(TK_WUQ, p.in[6] + (size_t)l * 256 * 768, 768, 256, 768, p.WuqT + (size_t)l * 768 * 256, p.in[5] + l * 256, scr, r, lane); continue; } r -= n_uq;
        if (r < n_ukv) { transpose_item(TK_WUKV, p.in[8] + (size_t)l * 128 * 1024, 1024, 128, 1024, p.WukvT + (size_t)l * 1024 * 128, p.in[7] + l * 128, scr, r, lane); continue; } r -= n_ukv;
        if (r < n_wo) { transpose_item(TK_WO, p.in[16] + (size_t)l * D * D, D, D, D, p.WoT + (size_t)l * D * D, nullptr, scr, r, lane); continue; } r -= n_wo;
        transpose_item(TK_WPQ, p.in[19] + (size_t)l * D * 2048, 2048, D, 2048, p.WpqT + (size_t)l * 2048 * D, nullptr, scr, r, lane);
    }
    for (int it = bid; it < DEPTH * 1028; it += nb) fold_pw_item(p, it / 1028, it % 1028);
    for (size_t i = (size_t)bid * 256 + tid; i < (size_t)DEPTH * 16 * 128 * 128; i += (size_t)nb * 256)
        p.SKp[i] = f2bf(p.in[20][(i & ~(size_t)127) + perm16((int)(i & 127))]);
    for (int i = bid * 256 + tid; i < SEQ * 16; i += nb * 256) rope_table_item(p, i);
    convert_tables_fp8(p, 0, bid, nb);
}

DI void modh_items(const Params& p, int bid, int nb) {
    const size_t n8 = (size_t)p.rows * D / 8;
    for (size_t i = (size_t)bid * 256 + threadIdx.x; i < n8; i += (size_t)nb * 256) {
        const size_t e = i * 8; const int row = (int)(e >> 10), col = (int)(e & 1023), b = row / SEQ;
        const float* mod = p.MOD + (size_t)b * 6 * D;
        const float4 x0 = *(const float4*)(p.in[0] + e), x1 = *(const float4*)(p.in[0] + e + 4);
        const float4 h0 = *(const float4*)(mod + col), h1 = *(const float4*)(mod + col + 4), s0 = *(const float4*)(mod + D + col), s1 = *(const float4*)(mod + D + col + 4);
        u32x4 o;
        o.x = pk2(x0.x * (1.f + s0.x) + h0.x, x0.y * (1.f + s0.y) + h0.y); o.y = pk2(x0.z * (1.f + s0.z) + h0.z, x0.w * (1.f + s0.w) + h0.w);
        o.z = pk2(x1.x * (1.f + s1.x) + h1.x, x1.y * (1.f + s1.y) + h1.y); o.w = pk2(x1.z * (1.f + s1.z) + h1.z, x1.w * (1.f + s1.w) + h1.w);
        *(u32x4*)(p.H + e) = o;
    }
}

#ifndef REP_P1
#define REP_P1 1
#endif
#ifndef REP_P2
#define REP_P2 1
#endif
#ifndef REP_P3
#define REP_P3 1
#endif
#ifndef REP_P4
#define REP_P4 1
#endif
#ifndef REP_P5
#define REP_P5 1
#endif
#ifndef REP_SYNC
#define REP_SYNC 1
#endif
#define GSYNC() do { for (int rs_ = 0; rs_ < REP_SYNC; ++rs_) xcd_barrier(xb); } while (0)
__global__ void __launch_bounds__(256, 2) mega(Params p) {
    extern __shared__ __attribute__((aligned(16))) char lds[];
    cg::grid_group grid = cg::this_grid();
    const int bid = blockIdx.x, nb = gridDim.x;
    const int rows = p.rows, mtiles = rows / 128;
    {
        if (threadIdx.x < 4) ((volatile LAS unsigned*)(lds + LDS_TOTAL - 32))[threadIdx.x] = 0u;
        __syncthreads();
    }
    const XcdBarrier xb = xcd_barrier_post(p.ctr + 4096, (volatile LAS unsigned*)(lds + LDS_TOTAL - 32));
    prologue(p, lds);
    grid.sync();
    modh_items(p, bid, nb);
    GSYNC();
    for (int l = 0; l < DEPTH; ++l) {
        const float* xin = (l == 0) ? p.in[0] : p.XB;
        float* X1 = p.out;
        float* xout = (l + 1 < DEPTH) ? p.XB : p.out;
        for (int rep = 0; rep < REP_P1; ++rep) for (int t = bid; t < mtiles * 12; t += nb) p1_tile(p, l, t, lds);
        if (l > 0) convert_tables_fp8(p, l, bid, nb);
        GSYNC();
        for (int rep = 0; rep < REP_P2; ++rep) for (int t = bid; t < mtiles * 14; t += nb) { if (t < mtiles * 6) p2q_tile(p, l, t, lds); else p2kv_tile(p, l, t - mtiles * 6, lds); }
        GSYNC();
        {
            const int nbt = rows / SEQ, nmla = nbt * 8 * 64, nswa = nbt * 4 * 64, nconv = rows / 32, ntot = nmla + nswa + nconv;
            int* su = (int*)(lds + LDS_TOTAL - 16);
            for (int rep = 0; rep < REP_P3; ++rep) { unsigned* ctr = p.ctr + l * 64 + rep * 16;
            for (;;) {
                __syncthreads();
                if (threadIdx.x == 0) *su = (int)atomicAdd(ctr, 1u);
                __syncthreads();
                const int u = *su;
                if (u >= ntot) break;
                if (u < nmla) mla_unit(p, u, lds);
                else if (u < nmla + nswa) swa_unit(p, l, u - nmla, lds);
                else conv_unit(p, l, u - nmla - nswa, lds);
            } }
        }
        GSYNC();
        for (int rep = 0; rep < REP_P4; ++rep) for (int t = bid; t < mtiles * 8; t += nb) p4_tile(p, l, t, xin, X1, lds);
        GSYNC();
        { int t_ = threadIdx.x; asm volatile("" : "+v"(t_)); const int wv = t_ >> 6, lane = t_ & 63; for (int r = bid * 4 + wv; r < rows; r += nb * 4) p4b_row(p, l, r, X1, lane); }
        GSYNC();
        for (int rep = 0; rep < REP_P5; ++rep) for (int t = bid; t < mtiles * 16; t += nb) p5_tile(p, l, t, lds);
        GSYNC();
        for (int u = bid; u < rows / 32; u += nb) p6f_unit(p, l, u, X1, xout, lds);
        if (l + 1 < DEPTH) GSYNC();
    }
}

extern "C" void kernel_launch(void* const* d_in, const int* in_sizes, int n_in, void* d_out, int out_size, void* d_ws, size_t ws_size, hipStream_t stream) {
    const size_t MiB = 1u << 20;
    char* ws = (char*)d_ws;
    Params P{};
    for (int i = 0; i < 25; ++i) P.in[i] = (const float*)d_in[i];
    P.out = (float*)d_out; P.rows = NTOK; P.tok0 = 0;
    size_t o = 0;
    auto take = [&](size_t mib) { char* r = ws + o; o += mib * MiB; return r; };
    char* ctl = take(1);
    P.ctr = (unsigned*)ctl; P.biasO = (float*)(ctl + 64 * 1024); P.MOD = (float*)(ctl + 128 * 1024);
    P.COS = (float*)take(1); P.SIN = P.COS + SEQ * 16;
    P.WinT = (bf16*)take(6); P.WuqT = (bf16*)take(1); P.WukvT = (bf16*)take(1); P.WoT = (bf16*)take(4); P.WpqT = (bf16*)take(8); P.SKp = (bf16*)take(1);
    P.U8 = (unsigned char*)take(16); P.V8 = (unsigned char*)take(16); P.US = (float*)take(1); P.VS = P.US + DEPTH * 16384;
    P.H = (bf16*)take(64); P.MIXIN = P.H;
    P.PROJ = (bf16*)take(80); P.Q = (bf16*)take(48); P.TOPK = (unsigned*)P.Q;
    P.KN = (bf16*)take(32); P.KR = (bf16*)take(2); P.VT = (bf16*)take(32); P.VsT = (bf16*)take(8);
    P.XB = (float*)take(128);
    if (o > ws_size) { fprintf(stderr, "kernel_launch: workspace too small: need %zu, have %zu\n", o, ws_size); return; }
    static int grid_blocks = 0;
    if (!grid_blocks) {
        int dev = 0, cus = 0, per_cu = 0;
        (void)hipGetDevice(&dev);
        (void)hipDeviceGetAttribute(&cus, hipDeviceAttributeMultiprocessorCount, dev);
        (void)hipFuncSetAttribute((const void*)mega, hipFuncAttributeMaxDynamicSharedMemorySize, LDS_TOTAL);
        (void)hipOccupancyMaxActiveBlocksPerMultiprocessor(&per_cu, mega, 256, LDS_TOTAL);
        if (per_cu > 2) per_cu = 2;
        if (per_cu < 1) per_cu = 1;
        grid_blocks = cus * per_cu;
    }
    (void)hipMemsetAsync(ctl, 0, 32768, stream);
    void* args[] = {(void*)&P};
    hipError_t e = hipLaunchCooperativeKernel((void*)mega, dim3(grid_blocks), dim3(256), args, LDS_TOTAL, stream);
    if (e != hipSuccess) fprintf(stderr, "cooperative launch failed: %s (grid %d)\n", hipGetErrorString(e), grid_blocks);
}
```

```cpp
#include <hip/hip_runtime.h>
#include <hip/hip_cooperative_groups.h>
#include <cstdio>
#include <cstdint>
namespace cg = cooperative_groups;

constexpr int D = 1024, BATCH = 4, SEQ = 8192, DEPTH = 2, NTOK = BATCH * SEQ;
constexpr int D_IN = 1440;
constexpr int OFF_CQ = 0, OFF_CKV = 256, OFF_KR = 384, OFF_CONV = 416, OFF_QS = 928, OFF_KS = 1184, OFF_VS = 1312;
constexpr float EPS = 1e-6f;
constexpr float DN_ALPHA = 1.41421356237309515f;

typedef __attribute__((ext_vector_type(8))) short bf16x8;
typedef __attribute__((ext_vector_type(16))) float f32x16;
typedef __attribute__((ext_vector_type(4))) unsigned u32x4;
typedef __attribute__((ext_vector_type(2))) unsigned u32x2;
typedef float f32x2_t __attribute__((ext_vector_type(2)));
typedef __bf16 bf16x2_t __attribute__((ext_vector_type(2)));
typedef unsigned short bf16;
#define DI __device__ __forceinline__
#define MFMA32(a, b, c) __builtin_amdgcn_mfma_f32_32x32x16_bf16((a), (b), (c), 0, 0, 0)

DI unsigned pk2(float lo, float hi) { f32x2_t v = {lo, hi}; bf16x2_t b = __builtin_convertvector(v, bf16x2_t); return __builtin_bit_cast(unsigned, b); }
DI bf16 f2bf(float f) { return (bf16)(pk2(f, 0.f) & 0xffffu); }
DI float bf2f(bf16 b) { return __uint_as_float((unsigned)b << 16); }
DI float bflo(unsigned u) { return __uint_as_float(u << 16); }
DI float bfhi(unsigned u) { return __uint_as_float(u & 0xffff0000u); }
DI int crow(int reg, int hh) { return (reg & 3) + 8 * (reg >> 2) + 4 * hh; }
DI int cperm_lin(int rho) { return 16 * ((rho >> 2) & 1) + (rho & 3) + 4 * (rho >> 3); }
DI int cperm_rope(int rho) { int hh = (rho >> 2) & 1, reg = (rho & 3) + 4 * (rho >> 3); return (reg < 8) ? 8 * hh + reg : 16 + 8 * hh + (reg - 8); }
DI int perm16(int p) { int g = (p >> 2) & 3; g = (g == 1) ? 2 : (g == 2) ? 1 : g; return (p & ~15) | (g << 2) | (p & 3); }

constexpr float LOG2E = 1.4426950408889634f;
constexpr int PROJ_LD = 1280;
constexpr int WIN_N = 1536;
constexpr int TS = 144;
constexpr int TILE_B = 128 * TS;
constexpr int STAGE_B = 2 * TILE_B;
constexpr int LDS_BYTES = 2 * STAGE_B;

struct Params {
    const float* in[25];
    float* out;
    bf16 *WinT, *WuqT, *WukvT, *WoT, *WpqT, *SKp, *Ut, *Vt;
    float* biasO;
    float* MOD;
    float* COS; float* SIN;
    bf16 *H, *PROJ, *Q, *KN, *KR, *VT, *VsT, *MIXIN;
    float* XB;
    unsigned* TOPK;
    unsigned char *U8, *V8; float *US, *VS;
    unsigned* ctr;
    int rows;
    int tok0;
};

enum { TK_WIN = 0, TK_WUQ = 1, TK_WUKV = 2, TK_WO = 3, TK_WPQ = 4 };
DI void transpose_item(int kind, const float* W, int ldin, int K, int Nout, bf16* WT, const float* rowscale, float* scr, int item, int lane) {
    const int nblk = Nout / 32, kb = item / nblk, nb = item % nblk, k0 = 64 * kb, n0 = 32 * nb;
    int src0 = n0; float cs = 1.f;
    if (kind == TK_WIN) {
        if (n0 < 384) src0 = n0;
        else if (n0 < 896) src0 = 416 + (n0 - 384);
        else if (n0 < 1152) { src0 = 928 + (n0 - 896); cs = 0.125f * LOG2E; }
        else if (n0 < 1280) src0 = 1184 + (n0 - 1152);
        else if (n0 < 1408) src0 = 1312 + (n0 - 1280);
        else if (n0 < 1440) src0 = 384 + (n0 - 1408);
        else src0 = -1;
    } else if (kind == TK_WUQ) cs = 0.10206207261596577f * LOG2E;
#pragma unroll 8
    for (int i = 0; i < 32; ++i) {
        const int kk = 2 * i + (lane >> 5);
        float v = (src0 >= 0) ? W[(size_t)(k0 + kk) * ldin + src0 + (lane & 31)] : 0.f;
        if (rowscale) v *= rowscale[k0 + kk];
        scr[kk * 33 + (lane & 31)] = v * cs;
    }
    __builtin_amdgcn_s_waitcnt(0xc07f); asm volatile("" ::: "memory");
    const int c = lane & 7;
#pragma unroll
    for (int j = 0; j < 4; ++j) {
        const int n = (lane >> 3) + 8 * j; const float* s = scr + (8 * c) * 33 + n;
        u32x4 o; o.x = pk2(s[0], s[33]); o.y = pk2(s[66], s[99]); o.z = pk2(s[132], s[165]); o.w = pk2(s[198], s[231]);
        if (!(kind == TK_WO && k0 + 8 * c >= 512 && k0 + 8 * c < 768))
            *(u32x4*)(WT + (size_t)(n0 + n) * K + k0 + 8 * c) = o;
    }
    __builtin_amdgcn_s_waitcnt(0xc07f); asm volatile("" ::: "memory");
}

DI void cvt8(const float* src, bf16* dst, size_t i8) {
    const float4 a = ((const float4*)src)[2 * i8], b = ((const float4*)src)[2 * i8 + 1];
    u32x4 o; o.x = pk2(a.x, a.y); o.y = pk2(a.z, a.w); o.z = pk2(b.x, b.y); o.w = pk2(b.z, b.w);
    ((u32x4*)dst)[i8] = o;
}

struct TileRegs { u32x4 v[4]; };
DI void gload_tile(TileRegs& t, const bf16* base, int ld, int k0, int tid) {
#pragma unroll
    for (int i = 0; i < 4; ++i) { const int q = tid + 256 * i, row = q >> 3, kc = q & 7; t.v[i] = *(const u32x4*)(base + (size_t)row * ld + k0 + kc * 8); }
}
DI void sstore_tile(const TileRegs& t, char* lds, int tid) {
#pragma unroll
    for (int i = 0; i < 4; ++i) { const int q = tid + 256 * i, row = q >> 3, kc = q & 7; *(u32x4*)(lds + row * TS + kc * 16) = t.v[i]; }
}
template <int NF, int NG>
DI void gemm_core(const bf16* A, int lda, const bf16* W, int ldw, int K, char* lds, f32x16 (&acc)[NF][NG], int fo, const int (&frow)[NF], int go, const int (&grow)[NG]) {
    int tid_ = threadIdx.x; asm volatile("" : "+v"(tid_)); const int tid = tid_, hh = (tid & 63) >> 5;
    TileRegs ta, tw;
    gload_tile(ta, A, lda, 0, tid); gload_tile(tw, W, ldw, 0, tid);
    __syncthreads();
    sstore_tile(ta, lds, tid); sstore_tile(tw, lds + TILE_B, tid);
    __syncthreads();
    const int nk = K / 64;
    for (int ks = 0; ks < nk; ++ks) {
        char* cur = lds + (ks & 1) * STAGE_B;
        if (ks + 1 < nk) { gload_tile(ta, A, lda, (ks + 1) * 64, tid); gload_tile(tw, W, ldw, (ks + 1) * 64, tid); }
#pragma unroll
        for (int kk = 0; kk < 4; ++kk) {
            bf16x8 f[NF], g[NG];
#pragma unroll
            for (int x = 0; x < NF; ++x) f[x] = *(const bf16x8*)(cur + fo + frow[x] * TS + kk * 32 + hh * 16);
#pragma unroll
            for (int y = 0; y < NG; ++y) g[y] = *(const bf16x8*)(cur + go + grow[y] * TS + kk * 32 + hh * 16);
#pragma unroll
            for (int x = 0; x < NF; ++x)
#pragma unroll
                for (int y = 0; y < NG; ++y) acc[x][y] = MFMA32(f[x], g[y], acc[x][y]);
        }
        if (ks + 1 < nk) { char* nxt = lds + ((ks + 1) & 1) * STAGE_B; sstore_tile(ta, nxt, tid); sstore_tile(tw, nxt + TILE_B, tid); }
        __syncthreads();
    }
}

template <int NF, int NG> DI void zero_acc(f32x16 (&acc)[NF][NG]) {
#pragma unroll
    for (int x = 0; x < NF; ++x)
#pragma unroll
        for (int y = 0; y < NG; ++y)
#pragma unroll
            for (int r = 0; r < 16; ++r) acc[x][y][r] = 0.f;
}

DI void store16(bf16* dst, const float* v) {
    u32x4 a, b;
    a.x = pk2(v[0], v[1]); a.y = pk2(v[2], v[3]); a.z = pk2(v[4], v[5]); a.w = pk2(v[6], v[7]);
    b.x = pk2(v[8], v[9]); b.y = pk2(v[10], v[11]); b.z = pk2(v[12], v[13]); b.w = pk2(v[14], v[15]);
    *(u32x4*)dst = a; *(u32x4*)(dst + 8) = b;
}
DI void store8(bf16* dst, const float* v) {
    u32x4 a; a.x = pk2(v[0], v[1]); a.y = pk2(v[2], v[3]); a.z = pk2(v[4], v[5]); a.w = pk2(v[6], v[7]);
    *(u32x4*)dst = a;
}
DI void store_vt(bf16* dst, const f32x16& a, int hh) {
    float v0[8], v1[8];
#pragma unroll
    for (int i = 0; i < 8; ++i) { v0[i] = a[i]; v1[i] = a[8 + i]; }
    store8(dst + 8 * hh, v0); store8(dst + 16 + 8 * hh, v1);
}

DI void p1_tile(const Params& p, int l, int tile, char* lds) {
    int tid_ = threadIdx.x; asm volatile("" : "+v"(tid_)); const int tid = tid_, lane = tid & 63, r = lane & 31, hh = lane >> 5;
    const int wv = __builtin_amdgcn_readfirstlane(tid >> 6), wm = wv >> 1, wn = wv & 1;
    const int mt = tile / 12, nt = tile % 12, m0 = mt * 128, n0 = nt * 128;
    const bf16* A = p.H + (size_t)m0 * D;
    const bf16* W = p.WinT + ((size_t)l * WIN_N + n0) * D;
    f32x16 acc[2][2]; zero_acc(acc);
    int frow[2], grow[2];
    const bool kr = (nt == 11);
    int fo, go;
    if (nt == 10) { fo = 0; go = TILE_B; frow[0] = 64 * wm + r; frow[1] = frow[0] + 32; grow[0] = 64 * wn + r; grow[1] = grow[0] + 32; }
    else { fo = TILE_B; go = 0; frow[0] = 64 * wn + (kr ? cperm_rope(r) : cperm_lin(r)); frow[1] = 64 * wn + 32 + cperm_lin(r); grow[0] = 64 * wm + r; grow[1] = grow[0] + 32; }
    gemm_core<2, 2>(A, D, W, D, D, lds, acc, fo, frow, go, grow);
    if (nt == 10) {
#pragma unroll
        for (int x = 0; x < 2; ++x)
#pragma unroll
            for (int y = 0; y < 2; ++y) {
                const int tok = m0 + 64 * wm + 32 * x, b = tok / SEQ, s0 = tok % SEQ, d = 32 * y + r;
                store_vt(p.VsT + ((size_t)(b * 2 + wn) * 64 + d) * SEQ + s0, acc[x][y], hh);
            }
    } else {
        if (!kr) {
#pragma unroll
            for (int x = 0; x < 2; ++x)
#pragma unroll
                for (int y = 0; y < 2; ++y) {
                    const int tok = m0 + 64 * wm + 32 * y + r, col = n0 + 64 * wn + 32 * x + 16 * hh;
                    float v[16];
#pragma unroll
                    for (int i = 0; i < 16; ++i) v[i] = acc[x][y][i];
                    store16(p.PROJ + (size_t)tok * PROJ_LD + col, v);
                }
        } else if (wn == 0) {
#pragma unroll
            for (int y = 0; y < 2; ++y) {
                const int tok = m0 + 64 * wm + 32 * y + r, pos = tok % SEQ;
                const float4 c0 = *(const float4*)(p.COS + pos * 16 + 8 * hh), c1 = *(const float4*)(p.COS + pos * 16 + 8 * hh + 4);
                const float4 s0 = *(const float4*)(p.SIN + pos * 16 + 8 * hh), s1 = *(const float4*)(p.SIN + pos * 16 + 8 * hh + 4);
                const float cs[8] = {c0.x, c0.y, c0.z, c0.w, c1.x, c1.y, c1.z, c1.w}, sn[8] = {s0.x, s0.y, s0.z, s0.w, s1.x, s1.y, s1.z, s1.w};
                float o1[8], o2[8];
#pragma unroll
                for (int i = 0; i < 8; ++i) { const float t1 = acc[0][y][i], t2 = acc[0][y][8 + i]; o1[i] = t1 * cs[i] - t2 * sn[i]; o2[i] = t1 * sn[i] + t2 * cs[i]; }
                store8(p.KR + (size_t)tok * 32 + 8 * hh, o1); store8(p.KR + (size_t)tok * 32 + 16 + 8 * hh, o2);
            }
        }
    }
}
constexpr int LDS_RS_OFF = LDS_BYTES;
constexpr int LDS_TOTAL = LDS_BYTES + 1024;

template <int W> DI void row_rms(const bf16* A, int lda, float* rs, int tid) {
    const int row = tid >> 1, half = tid & 1;
    const u32x4* p = (const u32x4*)(A + (size_t)row * lda + half * (W / 2));
    float ss = 0.f;
#pragma unroll
    for (int i = 0; i < W / 16; ++i) { const u32x4 v = p[i];
        ss += bflo(v.x) * bflo(v.x) + bfhi(v.x) * bfhi(v.x) + bflo(v.y) * bflo(v.y) + bfhi(v.y) * bfhi(v.y)
            + bflo(v.z) * bflo(v.z) + bfhi(v.z) * bfhi(v.z) + bflo(v.w) * bflo(v.w) + bfhi(v.w) * bfhi(v.w); }
    ss += __shfl_xor(ss, 1);
    if (half == 0) rs[row] = rsqrtf(ss * (1.f / W) + EPS);
}

DI void p2q_tile(const Params& p, int l, int tile, char* lds) {
    int tid_ = threadIdx.x; asm volatile("" : "+v"(tid_)); const int tid = tid_, lane = tid & 63, r = lane & 31, hh = lane >> 5;
    const int wv = __builtin_amdgcn_readfirstlane(tid >> 6), wm = wv >> 1, wn = wv & 1;
    const int mt = tile / 6, nt = tile % 6, m0 = mt * 128, n0 = nt * 128;
    const bf16* A = p.PROJ + (size_t)m0 * PROJ_LD;
    const bf16* W = p.WuqT + ((size_t)l * 768 + n0) * 256;
    float* rs = (float*)(lds + LDS_RS_OFF);
    __syncthreads();
    row_rms<256>(A, PROJ_LD, rs, tid);
    f32x16 acc[2][2]; zero_acc(acc);
    int frow[2], grow[2]; bool rope[2];
#pragma unroll
    for (int x = 0; x < 2; ++x) { rope[x] = (((n0 + 64 * wn + 32 * x) >> 5) % 3) == 2; frow[x] = 64 * wn + 32 * x + (rope[x] ? cperm_rope(r) : cperm_lin(r)); }
    grow[0] = 64 * wm + r; grow[1] = grow[0] + 32;
    gemm_core<2, 2>(A, PROJ_LD, W, 256, 256, lds, acc, TILE_B, frow, 0, grow);
#pragma unroll
    for (int y = 0; y < 2; ++y) {
        const int tl = 64 * wm + 32 * y + r, tok = m0 + tl, pos = tok % SEQ;
        const float sc = rs[tl];
#pragma unroll
        for (int x = 0; x < 2; ++x) {
            bf16* dst = p.Q + (size_t)tok * 768 + n0 + 64 * wn + 32 * x;
            if (rope[x]) {
                const float4 c0 = *(const float4*)(p.COS + pos * 16 + 8 * hh), c1 = *(const float4*)(p.COS + pos * 16 + 8 * hh + 4);
                const float4 s0 = *(const float4*)(p.SIN + pos * 16 + 8 * hh), s1 = *(const float4*)(p.SIN + pos * 16 + 8 * hh + 4);
                const float cs[8] = {c0.x, c0.y, c0.z, c0.w, c1.x, c1.y, c1.z, c1.w}, sn[8] = {s0.x, s0.y, s0.z, s0.w, s1.x, s1.y, s1.z, s1.w};
                float o1[8], o2[8];
#pragma unroll
                for (int i = 0; i < 8; ++i) { const float t1 = acc[x][y][i] * sc, t2 = acc[x][y][8 + i] * sc; o1[i] = t1 * cs[i] - t2 * sn[i]; o2[i] = t1 * sn[i] + t2 * cs[i]; }
                store8(dst + 8 * hh, o1); store8(dst + 16 + 8 * hh, o2);
            } else {
                float v[16];
#pragma unroll
                for (int i = 0; i < 16; ++i) v[i] = acc[x][y][i] * sc;
                store16(dst + 16 * hh, v);
            }
        }
    }
}

DI void p2kv_tile(const Params& p, int l, int tile, char* lds) {
    int tid_ = threadIdx.x; asm volatile("" : "+v"(tid_)); const int tid = tid_, lane = tid & 63, r = lane & 31, hh = lane >> 5;
    const int wv = __builtin_amdgcn_readfirstlane(tid >> 6), wm = wv >> 1, wn = wv & 1;
    const int mt = tile >> 3, h = tile & 7, m0 = mt * 128, n0 = h * 128;
    const bf16* A = p.PROJ + (size_t)m0 * PROJ_LD + 256;
    const bf16* W = p.WukvT + ((size_t)l * 1024 + n0) * 128;
    float* rs = (float*)(lds + LDS_RS_OFF);
    __syncthreads();
    row_rms<128>(A, PROJ_LD, rs, tid);
    f32x16 acc[2][2]; zero_acc(acc);
    int frow[2], grow[2];
    int fo, go;
    if (wn == 0) { fo = TILE_B; go = 0; frow[0] = cperm_lin(r); frow[1] = 32 + cperm_lin(r); grow[0] = 64 * wm + r; grow[1] = grow[0] + 32; }
    else         { fo = 0; go = TILE_B; frow[0] = 64 * wm + r; frow[1] = frow[0] + 32; grow[0] = 64 + r; grow[1] = 96 + r; }
    gemm_core<2, 2>(A, PROJ_LD, W, 128, 128, lds, acc, fo, frow, go, grow);
    if (wn == 0) {
#pragma unroll
        for (int y = 0; y < 2; ++y) {
            const int tl = 64 * wm + 32 * y + r, tok = m0 + tl; const float sc = rs[tl];
#pragma unroll
            for (int x = 0; x < 2; ++x) {
                float v[16];
#pragma unroll
                for (int i = 0; i < 16; ++i) v[i] = acc[x][y][i] * sc;
                store16(p.KN + (size_t)tok * 512 + h * 64 + 32 * x + 16 * hh, v);
            }
        }
    } else {
#pragma unroll
        for (int x = 0; x < 2; ++x) {
            const int tl0 = 64 * wm + 32 * x, tok0 = m0 + tl0, b = tok0 / SEQ, s0 = tok0 % SEQ;
#pragma unroll
            for (int y = 0; y < 2; ++y) {
                f32x16 a = acc[x][y];
#pragma unroll
                for (int i = 0; i < 16; ++i) a[i] *= rs[tl0 + crow(i, hh)];
                store_vt(p.VT + ((size_t)(b * 8 + h) * 64 + 32 * y + r) * SEQ + s0, a, hh);
            }
        }
    }
}
constexpr int VSTR = 144;
template <int KD> struct AttnCfg { static constexpr int KSTR = KD * 2 + 16; static constexpr int BUF = 64 * KSTR + 64 * VSTR; };

template <int KD, int MODE>
DI void attn_unit(const bf16* Qp, int qld, const bf16* K1, int k1ld, const bf16* K2, const bf16* VTp, bf16* Op, int b, int qb, float sink_l2, char* lds) {
    constexpr int KSTR = AttnCfg<KD>::KSTR, BUF = AttnCfg<KD>::BUF, NKS = KD / 16;
    int tid_ = threadIdx.x; asm volatile("" : "+v"(tid_)); const int tid = tid_, lane = tid & 63, r = lane & 31, hh = lane >> 5;
    const int wv = __builtin_amdgcn_readfirstlane(tid >> 6);
    const int q0 = qb * 128, qpos = q0 + 32 * wv + r;
    const size_t rowb = (size_t)b * SEQ;
    bf16x8 qf[NKS];
#pragma unroll
    for (int ks = 0; ks < NKS; ++ks) qf[ks] = *(const bf16x8*)(Qp + (rowb + qpos) * qld + ks * 16 + hh * 8);
    const int kstart = (MODE == 0) ? 0 : (q0 >= 128 ? q0 - 128 : 0);
    const int nt = (q0 + 128 - kstart) / 64;
    f32x16 ot[2];
#pragma unroll
    for (int i = 0; i < 16; ++i) { ot[0][i] = 0.f; ot[1][i] = 0.f; }
    float m = (MODE == 0) ? -INFINITY : sink_l2, l = (MODE == 1 && hh == 0) ? 1.f : 0.f;
    u32x4 sk[3], sv[2];
    auto gload = [&](int t) {
        const int key0 = kstart + 64 * t;
#pragma unroll
        for (int i = 0; i < 2; ++i) { const int q = tid + 256 * i, row = q >> 3, c = q & 7;
            sk[i] = *(const u32x4*)(K1 + (rowb + key0 + row) * k1ld + c * 8);
            sv[i] = *(const u32x4*)(VTp + (size_t)row * SEQ + key0 + c * 8); }
        if (KD == 96) { const int row = tid >> 2, c = tid & 3; sk[2] = *(const u32x4*)(K2 + (rowb + key0 + row) * 32 + c * 8); }
    };
    auto sstore = [&](char* buf) {
#pragma unroll
        for (int i = 0; i < 2; ++i) { const int q = tid + 256 * i, row = q >> 3, c = q & 7;
            *(u32x4*)(buf + row * KSTR + c * 16) = sk[i];
            *(u32x4*)(buf + 64 * KSTR + row * VSTR + c * 16) = sv[i]; }
        if (KD == 96) { const int row = tid >> 2, c = tid & 3; *(u32x4*)(buf + row * KSTR + 128 + c * 16) = sk[2]; }
    };
    gload(0);
    __syncthreads();
    sstore(lds);
    __syncthreads();
    for (int t = 0; t < nt; ++t) {
        const char* cur = lds + (t & 1) * BUF;
        if (t + 1 < nt) gload(t + 1);
        const int key0 = kstart + 64 * t;
        f32x16 st[2];
#pragma unroll
        for (int mt = 0; mt < 2; ++mt) {
#pragma unroll
            for (int i = 0; i < 16; ++i) st[mt][i] = 0.f;
#pragma unroll
            for (int ks = 0; ks < NKS; ++ks) {
                const bf16x8 a = *(const bf16x8*)(cur + (mt * 32 + r) * KSTR + ks * 32 + hh * 16);
                st[mt] = MFMA32(a, qf[ks], st[mt]);
            }
        }
        const bool need_mask = (MODE == 1) || (key0 + 63 > q0 + 32 * wv);
        if (need_mask) {
#pragma unroll
            for (int mt = 0; mt < 2; ++mt)
#pragma unroll
                for (int i = 0; i < 16; ++i) {
                    const int key = key0 + mt * 32 + crow(i, hh);
                    const bool ok = (MODE == 0) ? (key <= qpos) : (key <= qpos && key > qpos - 128);
                    if (!ok) st[mt][i] = -INFINITY;
                }
        }
        float mx = st[0][0];
#pragma unroll
        for (int i = 1; i < 16; ++i) mx = fmaxf(mx, st[0][i]);
#pragma unroll
        for (int i = 0; i < 16; ++i) mx = fmaxf(mx, st[1][i]);
        { auto rr = __builtin_amdgcn_permlane32_swap(__float_as_uint(mx), __float_as_uint(mx), false, false); mx = fmaxf(__uint_as_float(rr[0]), __uint_as_float(rr[1])); }
        const float mn = fmaxf(m, mx);
        const float alpha = __builtin_amdgcn_exp2f(m - mn);
        m = mn;
        float ps = 0.f;
#pragma unroll
        for (int mt = 0; mt < 2; ++mt)
#pragma unroll
            for (int i = 0; i < 16; ++i) { const float pv = __builtin_amdgcn_exp2f(st[mt][i] - mn); st[mt][i] = pv; ps += pv; }
        l = l * alpha + ps;
#pragma unroll
        for (int i = 0; i < 16; ++i) { ot[0][i] *= alpha; ot[1][i] *= alpha; }
        bf16x8 pb[4];
#pragma unroll
        for (int s = 0; s < 4; ++s) {
            const int mt = s >> 1, o = 8 * (s & 1);
            u32x4 w; w.x = pk2(st[mt][o], st[mt][o + 1]); w.y = pk2(st[mt][o + 2], st[mt][o + 3]); w.z = pk2(st[mt][o + 4], st[mt][o + 5]); w.w = pk2(st[mt][o + 6], st[mt][o + 7]);
            pb[s] = __builtin_bit_cast(bf16x8, w);
        }
        const char* vt = cur + 64 * KSTR;
#pragma unroll
        for (int mt = 0; mt < 2; ++mt)
#pragma unroll
            for (int s = 0; s < 4; ++s) {
                const bf16x8 a = *(const bf16x8*)(vt + (mt * 32 + r) * VSTR + s * 32 + hh * 16);
                ot[mt] = MFMA32(a, pb[s], ot[mt]);
            }
        if (t + 1 < nt) sstore(lds + ((t + 1) & 1) * BUF);
        __syncthreads();
    }
    { auto rr = __builtin_amdgcn_permlane32_swap(__float_as_uint(l), __float_as_uint(l), false, false); l = __uint_as_float(rr[0]) + __uint_as_float(rr[1]); }
    const float inv = 1.f / l;
    bf16* orow = Op + (rowb + qpos) * 1024;
#pragma unroll
    for (int mt = 0; mt < 2; ++mt)
#pragma unroll
        for (int g = 0; g < 4; ++g) {
            u32x2 w; w.x = pk2(ot[mt][4 * g] * inv, ot[mt][4 * g + 1] * inv); w.y = pk2(ot[mt][4 * g + 2] * inv, ot[mt][4 * g + 3] * inv);
            *(u32x2*)(orow + mt * 32 + 8 * g + 4 * hh) = w;
        }
}

DI void mla_unit(const Params& p, int u, char* lds) {
    const int nbh = (p.rows / SEQ) * 8, qb = 63 - u / nbh, bh = u % nbh, b = bh >> 3, h = bh & 7;
    attn_unit<96, 0>(p.Q + h * 96, 768, p.KN + h * 64, 512, p.KR, p.VT + (size_t)bh * 64 * SEQ, p.MIXIN + h * 64, b, qb, 0.f, lds);
}
DI void swa_unit(const Params& p, int l, int u, char* lds) {
    const int qb = u & 63, bh = u >> 6, b = bh >> 2, hq = bh & 3, kvh = hq >> 1;
    attn_unit<64, 1>(p.PROJ + 896 + hq * 64, PROJ_LD, p.PROJ + 1152 + kvh * 64, PROJ_LD, nullptr, p.VsT + (size_t)(b * 2 + kvh) * 64 * SEQ, p.MIXIN + 768 + hq * 64, b, qb,
                     p.in[15][l * 4 + hq] * LOG2E, lds);
}

DI void conv_unit(const Params& p, int l, int u, char* lds) {
    int tid_ = threadIdx.x; asm volatile("" : "+v"(tid_)); const int tid = tid_, lane = tid & 63, wv = tid >> 6;
    const int tok0 = u * 32, pos0 = tok0 % SEQ;
    bf16* glu = (bf16*)lds;
    float* hc = (float*)(lds + 62 * 512);
    __syncthreads();
    for (int it = tid; it < 62 * 32; it += 256) {
        const int row = it >> 5, c8 = (it & 31) * 8, pos = pos0 - 30 + row;
        u32x4 o = {0u, 0u, 0u, 0u};
        if (pos >= 0) {
            const bf16* src = p.PROJ + (size_t)(tok0 - 30 + row) * PROJ_LD + 384 + c8;
            const u32x4 a = *(const u32x4*)src, g = *(const u32x4*)(src + 256);
            const unsigned av[4] = {a.x, a.y, a.z, a.w}, gv[4] = {g.x, g.y, g.z, g.w}; unsigned ov[4];
#pragma unroll
            for (int i = 0; i < 4; ++i) {
                const float g0 = bflo(gv[i]), g1 = bfhi(gv[i]);
                ov[i] = pk2(bflo(av[i]) / (1.f + __expf(-g0)), bfhi(av[i]) / (1.f + __expf(-g1)));
            }
            o.x = ov[0]; o.y = ov[1]; o.z = ov[2]; o.w = ov[3];
        }
        *(u32x4*)(glu + row * 256 + c8) = o;
    }
    __syncthreads();
    {
        const int c = tid;
        float w[31];
        const float* wd = p.in[9] + (size_t)l * 31 * 256 + c;
#pragma unroll
        for (int k = 0; k < 31; ++k) w[k] = wd[k * 256];
        const float bd = p.in[10][l * 256 + c];
#pragma unroll 1
        for (int ch = 0; ch < 4; ++ch) {
            float g[38], acc[8];
#pragma unroll
            for (int i = 0; i < 38; ++i) g[i] = bf2f(glu[(ch * 8 + i) * 256 + c]);
#pragma unroll
            for (int tt = 0; tt < 8; ++tt) { acc[tt] = bd;
#pragma unroll
                for (int k = 0; k < 31; ++k) acc[tt] += w[k] * g[tt + k]; }
#pragma unroll
            for (int tt = 0; tt < 8; ++tt) hc[(ch * 8 + tt) * 256 + c] = acc[tt];
        }
    }
    __syncthreads();
    {
        const float4 gg = *(const float4*)(p.in[11] + l * 256 + lane * 4), bb = *(const float4*)(p.in[12] + l * 256 + lane * 4);
#pragma unroll 1
        for (int i = 0; i < 8; ++i) {
            const int t = wv * 8 + i;
            const float4 v = *(const float4*)(hc + t * 256 + lane * 4);
            float s = v.x + v.y + v.z + v.w;
#pragma unroll
            for (int o = 1; o < 64; o <<= 1) s += __shfl_xor(s, o);
            const float mean = s * (1.f / 256.f);
            const float d0 = v.x - mean, d1 = v.y - mean, d2 = v.z - mean, d3 = v.w - mean;
            float q = d0 * d0 + d1 * d1 + d2 * d2 + d3 * d3;
#pragma unroll
            for (int o = 1; o < 64; o <<= 1) q += __shfl_xor(q, o);
            const float rstd = rsqrtf(q * (1.f / 256.f) + EPS);
            float y0 = d0 * rstd * gg.x + bb.x, y1 = d1 * rstd * gg.y + bb.y, y2 = d2 * rstd * gg.z + bb.z, y3 = d3 * rstd * gg.w + bb.w;
            y0 = y0 / (1.f + __expf(-y0)); y1 = y1 / (1.f + __expf(-y1)); y2 = y2 / (1.f + __expf(-y2)); y3 = y3 / (1.f + __expf(-y3));
            u32x2 w; w.x = pk2(y0, y1); w.y = pk2(y2, y3);
            *(u32x2*)(p.MIXIN + (size_t)(tok0 + t) * 1024 + 512 + lane * 4) = w;
        }
    }
}
DI void fold_pw_item(const Params& p, int l, int item) {
    const int tid = threadIdx.x;
    const float* wo = p.in[16] + (size_t)l * D * D + (size_t)512 * D;
    if (item < 1024) {
        const int kp = item >> 2, n = (item & 3) * 256 + tid;
        const float* wp = p.in[13] + (size_t)l * 256 * 256 + (size_t)kp * 256;
        float acc = 0.f;
        for (int j = 0; j < 256; ++j) acc += wp[j] * wo[(size_t)j * D + n];
        p.WoT[((size_t)l * D + n) * D + 512 + kp] = f2bf(acc);
    } else {
        const int n = (item - 1024) * 256 + tid;
        const float* bp = p.in[14] + l * 256;
        float acc = 0.f;
        for (int j = 0; j < 256; ++j) acc += bp[j] * wo[(size_t)j * D + n];
        p.biasO[l * D + n] = acc;
    }
}

DI void p4_tile(const Params& p, int l, int tile, const float* xin, float* X1, char* lds) {
    int tid_ = threadIdx.x; asm volatile("" : "+v"(tid_)); const int tid = tid_, lane = tid & 63, r = lane & 31, hh = lane >> 5;
    const int wv = __builtin_amdgcn_readfirstlane(tid >> 6), wm = wv >> 1, wn = wv & 1;
    const int mt = tile >> 3, nt = tile & 7, m0 = mt * 128, n0 = nt * 128;
    const bf16* A = p.MIXIN + (size_t)m0 * D;
    const bf16* W = p.WoT + ((size_t)l * D + n0) * D;
    f32x16 acc[2][2]; zero_acc(acc);
    int frow[2], grow[2];
    frow[0] = 64 * wn + cperm_lin(r); frow[1] = frow[0] + 32; grow[0] = 64 * wm + r; grow[1] = grow[0] + 32;
    gemm_core<2, 2>(A, D, W, D, D, lds, acc, TILE_B, frow, 0, grow);
#pragma unroll
    for (int y = 0; y < 2; ++y) {
        const int tok = m0 + 64 * wm + 32 * y + r, b = (p.tok0 + tok) / SEQ;
        const float* gt = p.MOD + ((size_t)l * BATCH + b) * 6 * D + 2 * D;
#pragma unroll
        for (int x = 0; x < 2; ++x) {
            const int col = n0 + 64 * wn + 32 * x + 16 * hh;
#pragma unroll
            for (int q = 0; q < 4; ++q) {
                const float4 xv = *(const float4*)(xin + (size_t)tok * D + col + 4 * q), g4 = *(const float4*)(gt + col + 4 * q), b4 = *(const float4*)(p.biasO + l * D + col + 4 * q);
                float4 o;
                o.x = DN_ALPHA * xv.x + (1.f + g4.x) * (acc[x][y][4 * q + 0] + b4.x); o.y = DN_ALPHA * xv.y + (1.f + g4.y) * (acc[x][y][4 * q + 1] + b4.y);
                o.z = DN_ALPHA * xv.z + (1.f + g4.z) * (acc[x][y][4 * q + 2] + b4.z); o.w = DN_ALPHA * xv.w + (1.f + g4.w) * (acc[x][y][4 * q + 3] + b4.w);
                *(float4*)(X1 + (size_t)tok * D + col + 4 * q) = o;
            }
        }
    }
}

DI void ln16(float (&v)[16], const float* g, const float* bta, int lane) {
    float s = 0.f;
#pragma unroll
    for (int i = 0; i < 16; ++i) s += v[i];
#pragma unroll
    for (int o = 1; o < 64; o <<= 1) s += __shfl_xor(s, o);
    const float mean = s * (1.f / D); float q = 0.f;
#pragma unroll
    for (int i = 0; i < 16; ++i) { v[i] -= mean; q += v[i] * v[i]; }
#pragma unroll
    for (int o = 1; o < 64; o <<= 1) q += __shfl_xor(q, o);
    const float rstd = rsqrtf(q * (1.f / D) + EPS);
#pragma unroll
    for (int hf = 0; hf < 2; ++hf)
#pragma unroll
        for (int q4 = 0; q4 < 2; ++q4) {
            const int c = hf * 512 + lane * 8 + q4 * 4;
            const float4 gg = *(const float4*)(g + c), bb = *(const float4*)(bta + c);
            const int i = hf * 8 + q4 * 4;
            v[i] = v[i] * rstd * gg.x + bb.x; v[i + 1] = v[i + 1] * rstd * gg.y + bb.y; v[i + 2] = v[i + 2] * rstd * gg.z + bb.z; v[i + 3] = v[i + 3] * rstd * gg.w + bb.w;
        }
}
DI void load16(float (&v)[16], const float* row, int lane) {
#pragma unroll
    for (int hf = 0; hf < 2; ++hf)
#pragma unroll
        for (int q4 = 0; q4 < 2; ++q4) { const float4 t = *(const float4*)(row + hf * 512 + lane * 8 + q4 * 4); const int i = hf * 8 + q4 * 4; v[i] = t.x; v[i + 1] = t.y; v[i + 2] = t.z; v[i + 3] = t.w; }
}
DI void store16f(float* row, const float (&v)[16], int lane) {
#pragma unroll
    for (int hf = 0; hf < 2; ++hf)
#pragma unroll
        for (int q4 = 0; q4 < 2; ++q4) { const int i = hf * 8 + q4 * 4; *(float4*)(row + hf * 512 + lane * 8 + q4 * 4) = make_float4(v[i], v[i + 1], v[i + 2], v[i + 3]); }
}
DI void store_mod16(bf16* hrow, const float (&v)[16], const float* sh, const float* sc, int lane) {
#pragma unroll
    for (int hf = 0; hf < 2; ++hf) {
        float o[8];
#pragma unroll
        for (int q4 = 0; q4 < 2; ++q4) {
            const int c = hf * 512 + lane * 8 + q4 * 4, i = hf * 8 + q4 * 4;
            const float4 s4 = *(const float4*)(sc + c), h4 = *(const float4*)(sh + c);
            o[q4 * 4] = v[i] * (1.f + s4.x) + h4.x; o[q4 * 4 + 1] = v[i + 1] * (1.f + s4.y) + h4.y; o[q4 * 4 + 2] = v[i + 2] * (1.f + s4.z) + h4.z; o[q4 * 4 + 3] = v[i + 3] * (1.f + s4.w) + h4.w;
        }
        store8(hrow + hf * 512 + lane * 8, o);
    }
}
DI void p4b_row(const Params& p, int l, int row, float* X1, int lane) {
    float v[16];
    load16(v, X1 + (size_t)row * D, lane);
    ln16(v, p.in[17] + l * D, p.in[18] + l * D, lane);
    store16f(X1 + (size_t)row * D, v, lane);
    const int b = (p.tok0 + row) / SEQ;
    const float* mod = p.MOD + ((size_t)l * BATCH + b) * 6 * D;
    store_mod16(p.H + (size_t)row * D, v, mod + 3 * D, mod + 4 * D, lane);
}

DI unsigned ford(float f) { const unsigned u = __float_as_uint(f); return u ^ ((u >> 31) ? 0xffffffffu : 0x80000000u); }
DI float funord(unsigned o) { const unsigned u = o ^ ((o >> 31) ? 0x80000000u : 0xffffffffu); return __uint_as_float(u); }
constexpr int SKSTR = 272;

DI void p5_tile(const Params& p, int l, int tile, char* lds) {
    int tid_ = threadIdx.x; asm volatile("" : "+v"(tid_)); const int tid = tid_, lane = tid & 63, r = lane & 31, hh = lane >> 5;
    const int wv = __builtin_amdgcn_readfirstlane(tid >> 6);
    const int mt = tile >> 4, hp = tile & 15, m0 = mt * 128;
    const bf16* A = p.H + (size_t)m0 * D;
    const bf16* W = p.WpqT + ((size_t)l * 2048 + hp * 128) * D;
    f32x16 acc[4][1]; zero_acc(acc);
    int frow[4], grow[1];
#pragma unroll
    for (int x = 0; x < 4; ++x) frow[x] = 32 * x + r;
    grow[0] = 32 * wv + r;
    gemm_core<4, 1>(A, D, W, D, D, lds, acc, TILE_B, frow, 0, grow);
    bf16x8 xb[8];
#pragma unroll
    for (int s = 0; s < 8; ++s) {
        const int x = s >> 1, o = 8 * (s & 1);
        u32x4 w; w.x = pk2(acc[x][0][o], acc[x][0][o + 1]); w.y = pk2(acc[x][0][o + 2], acc[x][0][o + 3]); w.z = pk2(acc[x][0][o + 4], acc[x][0][o + 5]); w.w = pk2(acc[x][0][o + 6], acc[x][0][o + 7]);
        xb[s] = __builtin_bit_cast(bf16x8, w);
    }
    const bf16* sk = p.SKp + ((size_t)l * 16 + hp) * 128 * 128;
#pragma unroll
    for (int i = 0; i < 8; ++i) { const int q = tid + 256 * i, row = q >> 4, c = q & 15; *(u32x4*)(lds + row * SKSTR + c * 16) = *(const u32x4*)(sk + row * 128 + c * 8); }
    __syncthreads();
    unsigned L[16];
#pragma unroll
    for (int k = 0; k < 16; ++k) L[k] = 0u;
#pragma unroll
    for (int m2 = 0; m2 < 4; ++m2) {
        f32x16 st;
#pragma unroll
        for (int i = 0; i < 16; ++i) st[i] = 0.f;
#pragma unroll
        for (int s = 0; s < 8; ++s) {
            const bf16x8 a = *(const bf16x8*)(lds + (32 * m2 + r) * SKSTR + s * 32 + hh * 16);
            st = MFMA32(a, xb[s], st);
        }
#pragma unroll
        for (int i = 0; i < 16; ++i) {
            unsigned v = (ford(st[i]) & ~0x7fu) | (unsigned)(32 * m2 + crow(i, hh));
#pragma unroll
            for (int k = 0; k < 16; ++k) { const unsigned t = max(L[k], v); v = min(L[k], v); L[k] = t; }
        }
    }
    unsigned C[16];
#pragma unroll
    for (int k = 0; k < 16; ++k) C[k] = max(L[k], (unsigned)__shfl_xor((int)L[15 - k], 32));
#pragma unroll
    for (int d = 8; d >= 1; d >>= 1)
#pragma unroll
        for (int i = 0; i < 16; ++i) if ((i & d) == 0) { const unsigned a = max(C[i], C[i + d]), b = min(C[i], C[i + d]); C[i] = a; C[i + d] = b; }
    unsigned* dst = p.TOPK + ((size_t)(m0 + 32 * wv + r) * 16 + hp) * 16 + 8 * hh;
    u32x4 o0, o1;
    if (hh == 0) { o0 = (u32x4){C[0], C[1], C[2], C[3]}; o1 = (u32x4){C[4], C[5], C[6], C[7]}; }
    else { o0 = (u32x4){C[8], C[9], C[10], C[11]}; o1 = (u32x4){C[12], C[13], C[14], C[15]}; }
    *(u32x4*)dst = o0; *(u32x4*)(dst + 4) = o1;
}
typedef __bf16 bf16x2v __attribute__((ext_vector_type(2)));
DI float dot2(unsigned a, unsigned b, float c) { return __builtin_amdgcn_fdot2_f32_bf16(__builtin_bit_cast(bf16x2v, a), __builtin_bit_cast(bf16x2v, b), c, false); }
DI float gelu_erf(float a) { return 0.5f * a * (1.f + erff(a * 0.70710678118654752f)); }

DI void p6_unit(const Params& p, int l, int u, const float* X1, float* xout, char* lds) {
    int tid_ = threadIdx.x; asm volatile("" : "+v"(tid_)); const int tid = tid_, lane = tid & 63;
    const int wv = __builtin_amdgcn_readfirstlane(tid >> 6);
    unsigned* LA = (unsigned*)(lds + wv * 16384); unsigned* LB = LA + 1024; unsigned* Ee = LA + 2048; float* Eg = (float*)(LA + 3072);
    const int tokb = u * 32 + wv * 8;
    __syncthreads();
    {
        const int ti = lane >> 3, head = lane & 7;
        const unsigned* src = p.TOPK + ((size_t)(tokb + ti) * 16 + head * 2) * 16;
        unsigned A[16], B[16];
#pragma unroll
        for (int q = 0; q < 4; ++q) { const u32x4 a = *(const u32x4*)(src + 4 * q), b = *(const u32x4*)(src + 16 + 4 * q);
            A[4 * q] = a.x; A[4 * q + 1] = a.y; A[4 * q + 2] = a.z; A[4 * q + 3] = a.w; B[4 * q] = b.x; B[4 * q + 1] = b.y; B[4 * q + 2] = b.z; B[4 * q + 3] = b.w;
            *(u32x4*)(LA + lane * 16 + 4 * q) = a; *(u32x4*)(LB + lane * 16 + 4 * q) = b; }
        float sA[16], sB[16];
#pragma unroll
        for (int k = 0; k < 16; ++k) { sA[k] = funord(A[k] & ~0x7fu); sB[k] = funord(B[k] & ~0x7fu); }
        unsigned T[16];
#pragma unroll
        for (int k = 0; k < 16; ++k) T[k] = 0u;
#pragma unroll
        for (int a = 0; a < 16; ++a)
#pragma unroll
            for (int b = 0; b < 16; ++b)
                if ((a + 1) * (b + 1) <= 16) {
                    unsigned v = (ford(sA[a] + sB[b]) & ~0xffu) | (unsigned)(a * 16 + b);
#pragma unroll
                    for (int k = 0; k < 16; ++k) { const unsigned t = max(T[k], v); v = min(T[k], v); T[k] = t; }
                }
        float ex[16]; float sum = 0.f; const float mx = funord(T[0] & ~0xffu);
#pragma unroll
        for (int k = 0; k < 16; ++k) { ex[k] = __expf(funord(T[k] & ~0xffu) - mx); sum += ex[k]; }
        const float inv = 1.f / sum;
#pragma unroll
        for (int k = 0; k < 16; ++k) {
            const unsigned cid = T[k] & 0xffu, ia = LA[lane * 16 + (cid >> 4)] & 0x7fu, ib = LB[lane * 16 + (cid & 15u)] & 0x7fu;
            Ee[ti * 128 + head * 16 + k] = ia * 128u + ib; Eg[ti * 128 + head * 16 + k] = ex[k] * inv;
        }
    }
    const bf16* Ut = p.Ut; const bf16* Vt = p.Vt;
    const int jl = 4 * (lane >> 5) + 2 * ((lane >> 4) & 1) + ((lane >> 3) & 1);
    const bool b5 = lane & 32, b4 = lane & 16, b3 = lane & 8;
#pragma unroll 1
    for (int ti = 0; ti < 8; ++ti) {
        const int tok = tokb + ti;
        const u32x4 h0 = *(const u32x4*)(p.H + (size_t)tok * D + lane * 8), h1 = *(const u32x4*)(p.H + (size_t)tok * D + 512 + lane * 8);
        float y[16];
#pragma unroll
        for (int i = 0; i < 16; ++i) y[i] = 0.f;
#pragma unroll 1
        for (int bt = 0; bt < 16; ++bt) {
            u32x4 uu[8][2], vv[8][2];
#pragma unroll
            for (int j = 0; j < 8; ++j) {
                const unsigned e = __builtin_amdgcn_readfirstlane(Ee[ti * 128 + bt * 8 + j]);
                const bf16* ur = Ut + (size_t)e * D + lane * 8; const bf16* vr = Vt + (size_t)e * D + lane * 8;
                uu[j][0] = *(const u32x4*)ur; uu[j][1] = *(const u32x4*)(ur + 512);
                vv[j][0] = *(const u32x4*)vr; vv[j][1] = *(const u32x4*)(vr + 512);
            }
            float a[8];
#pragma unroll
            for (int j = 0; j < 8; ++j) {
                float s = dot2(h0.x, uu[j][0].x, 0.f); s = dot2(h0.y, uu[j][0].y, s); s = dot2(h0.z, uu[j][0].z, s); s = dot2(h0.w, uu[j][0].w, s);
                s = dot2(h1.x, uu[j][1].x, s); s = dot2(h1.y, uu[j][1].y, s); s = dot2(h1.z, uu[j][1].z, s); s = dot2(h1.w, uu[j][1].w, s);
                a[j] = s;
            }
            float k1[4], k2[2], k3;
#pragma unroll
            for (int i = 0; i < 4; ++i) { const float snd = b5 ? a[i] : a[4 + i]; const float rcv = __shfl_xor(snd, 32); k1[i] = (b5 ? a[4 + i] : a[i]) + rcv; }
#pragma unroll
            for (int i = 0; i < 2; ++i) { const float snd = b4 ? k1[i] : k1[2 + i]; const float rcv = __shfl_xor(snd, 16); k2[i] = (b4 ? k1[2 + i] : k1[i]) + rcv; }
            { const float snd = b3 ? k2[0] : k2[1]; const float rcv = __shfl_xor(snd, 8); k3 = (b3 ? k2[1] : k2[0]) + rcv; }
            k3 += __shfl_xor(k3, 4); k3 += __shfl_xor(k3, 2); k3 += __shfl_xor(k3, 1);
            const float w = Eg[ti * 128 + bt * 8 + jl] * gelu_erf(k3);
#pragma unroll
            for (int j = 0; j < 8; ++j) {
                const int src = 32 * (j >> 2) + 16 * ((j >> 1) & 1) + 8 * (j & 1);
                const float wj = __uint_as_float(__builtin_amdgcn_readlane(__float_as_uint(w), src));
                const unsigned w0[4] = {vv[j][0].x, vv[j][0].y, vv[j][0].z, vv[j][0].w}, w1[4] = {vv[j][1].x, vv[j][1].y, vv[j][1].z, vv[j][1].w};
#pragma unroll
                for (int i = 0; i < 4; ++i) { y[2 * i] += wj * bflo(w0[i]); y[2 * i + 1] += wj * bfhi(w0[i]); y[8 + 2 * i] += wj * bflo(w1[i]); y[8 + 2 * i + 1] += wj * bfhi(w1[i]); }
            }
        }
        const int b = (p.tok0 + tok) / SEQ;
        const float* mod = p.MOD + ((size_t)l * BATCH + b) * 6 * D;
        float v[16], gt[16];
        load16(v, X1 + (size_t)tok * D, lane); load16(gt, mod + 5 * D, lane);
#pragma unroll
        for (int i = 0; i < 16; ++i) v[i] = DN_ALPHA * v[i] + (1.f + gt[i]) * y[i];
        ln16(v, p.in[23] + l * D, p.in[24] + l * D, lane);
        store16f(xout + (size_t)tok * D, v, lane);
        if (l + 1 < DEPTH) { const float* modn = p.MOD + ((size_t)(l + 1) * BATCH + b) * 6 * D; store_mod16(p.H + (size_t)tok * D, v, modn, modn + D, lane); }
    }
}
typedef float f32x2v __attribute__((ext_vector_type(2)));
DI void table_row_fp8(const float* src, unsigned char* dst, float* inv_scale, int lane) {
    float v[16];
#pragma unroll
    for (int q = 0; q < 4; ++q) { const float4 t = *(const float4*)(src + lane * 16 + q * 4); v[4 * q] = t.x; v[4 * q + 1] = t.y; v[4 * q + 2] = t.z; v[4 * q + 3] = t.w; }
    float mx = 0.f;
#pragma unroll
    for (int i = 0; i < 16; ++i) mx = fmaxf(mx, fabsf(v[i]));
#pragma unroll
    for (int o = 1; o < 64; o <<= 1) mx = fmaxf(mx, __shfl_xor(mx, o));
    const float sc = (mx > 0.f) ? 448.f / mx : 1.f;
    u32x4 o;
    unsigned w[4];
#pragma unroll
    for (int q = 0; q < 4; ++q) { unsigned t = 0u; t = __builtin_amdgcn_cvt_pk_fp8_f32(v[4 * q] * sc, v[4 * q + 1] * sc, t, false); t = __builtin_amdgcn_cvt_pk_fp8_f32(v[4 * q + 2] * sc, v[4 * q + 3] * sc, t, true); w[q] = t; }
    o.x = w[0]; o.y = w[1]; o.z = w[2]; o.w = w[3];
    *(u32x4*)(dst + lane * 16) = o;
    if (lane == 0) *inv_scale = (mx > 0.f) ? mx * (1.f / 448.f) : 1.f;
}
DI void convert_tables_fp8(const Params& p, int l, int bid, int nb) {
    int t_ = threadIdx.x; asm volatile("" : "+v"(t_)); const int wv = t_ >> 6, lane = t_ & 63;
    const float* us = p.in[21] + (size_t)l * 16384 * D; const float* vs = p.in[22] + (size_t)l * 16384 * D;
    for (int row = bid * 4 + wv; row < 2 * 16384; row += nb * 4) {
        if (row < 16384) table_row_fp8(us + (size_t)row * D, p.U8 + (size_t)row * D, p.US + l * 16384 + row, lane);
        else { const int r2 = row - 16384; table_row_fp8(vs + (size_t)r2 * D, p.V8 + (size_t)r2 * D, p.VS + l * 16384 + r2, lane); }
    }
}
DI void load16c(float (&v)[16], const float* row, int lane) {
#pragma unroll
    for (int q = 0; q < 4; ++q) { const float4 t = *(const float4*)(row + lane * 16 + q * 4); v[4 * q] = t.x; v[4 * q + 1] = t.y; v[4 * q + 2] = t.z; v[4 * q + 3] = t.w; }
}
DI void ln16c(float (&v)[16], const float* g, const float* bta, int lane) {
    float s = 0.f;
#pragma unroll
    for (int i = 0; i < 16; ++i) s += v[i];
#pragma unroll
    for (int o = 1; o < 64; o <<= 1) s += __shfl_xor(s, o);
    const float mean = s * (1.f / D); float q = 0.f;
#pragma unroll
    for (int i = 0; i < 16; ++i) { v[i] -= mean; q += v[i] * v[i]; }
#pragma unroll
    for (int o = 1; o < 64; o <<= 1) q += __shfl_xor(q, o);
    const float rstd = rsqrtf(q * (1.f / D) + EPS);
    float gg[16], bb[16]; load16c(gg, g, lane); load16c(bb, bta, lane);
#pragma unroll
    for (int i = 0; i < 16; ++i) v[i] = v[i] * rstd * gg[i] + bb[i];
}
DI void store16c(float* row, const float (&v)[16], int lane) {
#pragma unroll
    for (int q = 0; q < 4; ++q) *(float4*)(row + lane * 16 + q * 4) = make_float4(v[4 * q], v[4 * q + 1], v[4 * q + 2], v[4 * q + 3]);
}
DI void store_mod16c(bf16* hrow, const float (&v)[16], const float* sh, const float* sc, int lane) {
    float s[16], h[16], o[16]; load16c(s, sc, lane); load16c(h, sh, lane);
#pragma unroll
    for (int i = 0; i < 16; ++i) o[i] = v[i] * (1.f + s[i]) + h[i];
    store16(hrow + lane * 16, o);
}

DI void p6f_unit(const Params& p, int l, int u, const float* X1, float* xout, char* lds) {
    int tid_ = threadIdx.x; asm volatile("" : "+v"(tid_)); const int tid = tid_, lane = tid & 63;
    const int wv = __builtin_amdgcn_readfirstlane(tid >> 6);
    unsigned* LA = (unsigned*)(lds + wv * 16384); unsigned* LB = LA + 1024; unsigned* Ee = LA + 2048; float* Eg = (float*)(LA + 3072); float* Es = (float*)LA;
    const int tokb = u * 32 + wv * 8;
    __syncthreads();
    {
        const int ti = lane >> 3, head = lane & 7;
        const unsigned* src = p.TOPK + ((size_t)(tokb + ti) * 16 + head * 2) * 16;
        unsigned A[16], B[16];
#pragma unroll
        for (int q = 0; q < 4; ++q) { const u32x4 a = *(const u32x4*)(src + 4 * q), b = *(const u32x4*)(src + 16 + 4 * q);
            A[4 * q] = a.x; A[4 * q + 1] = a.y; A[4 * q + 2] = a.z; A[4 * q + 3] = a.w; B[4 * q] = b.x; B[4 * q + 1] = b.y; B[4 * q + 2] = b.z; B[4 * q + 3] = b.w;
            *(u32x4*)(LA + lane * 16 + 4 * q) = a; *(u32x4*)(LB + lane * 16 + 4 * q) = b; }
        float sA[16], sB[16];
#pragma unroll
        for (int k = 0; k < 16; ++k) { sA[k] = funord(A[k] & ~0x7fu); sB[k] = funord(B[k] & ~0x7fu); }
        unsigned T[16];
#pragma unroll
        for (int k = 0; k < 16; ++k) T[k] = 0u;
#pragma unroll
        for (int a = 0; a < 16; ++a)
#pragma unroll
            for (int b = 0; b < 16; ++b)
                if ((a + 1) * (b + 1) <= 16) {
                    unsigned v = (ford(sA[a] + sB[b]) & ~0xffu) | (unsigned)(a * 16 + b);
#pragma unroll
                    for (int k = 0; k < 16; ++k) { const unsigned t = max(T[k], v); v = min(T[k], v); T[k] = t; }
                }
        float ex[16]; float sum = 0.f; const float mx = funord(T[0] & ~0xffu);
        unsigned ev[16];
#pragma unroll
        for (int k = 0; k < 16; ++k) { ex[k] = __expf(funord(T[k] & ~0xffu) - mx); sum += ex[k];
            const unsigned cid = T[k] & 0xffu; ev[k] = (LA[lane * 16 + (cid >> 4)] & 0x7fu) * 128u + (LB[lane * 16 + (cid & 15u)] & 0x7fu); }
        const float inv = 1.f / sum;
        const float* US = p.US + l * 16384; const float* VS = p.VS + l * 16384;
#pragma unroll
        for (int k = 0; k < 16; ++k) {
            const float su = US[ev[k]], sv = VS[ev[k]];
            Ee[ti * 128 + head * 16 + k] = ev[k]; Eg[ti * 128 + head * 16 + k] = ex[k] * inv * sv; Es[ti * 128 + head * 16 + k] = su;
        }
    }
    const unsigned char* U8 = p.U8; const unsigned char* V8 = p.V8;
    const int jl = 8 * (lane >> 5) + 4 * ((lane >> 4) & 1) + 2 * ((lane >> 3) & 1) + ((lane >> 2) & 1);
    const bool b5 = lane & 32, b4 = lane & 16, b3 = lane & 8, b2 = lane & 4;
#pragma unroll 1
    for (int ti = 0; ti < 8; ++ti) {
        const int tok = tokb + ti;
        const u32x4 h0 = *(const u32x4*)(p.H + (size_t)tok * D + lane * 16), h1 = *(const u32x4*)(p.H + (size_t)tok * D + lane * 16 + 8);
        const unsigned hw[8] = {h0.x, h0.y, h0.z, h0.w, h1.x, h1.y, h1.z, h1.w};
        f32x2v hf[8], y2[8];
#pragma unroll
        for (int i = 0; i < 8; ++i) { hf[i] = (f32x2v){bflo(hw[i]), bfhi(hw[i])}; y2[i] = (f32x2v){0.f, 0.f}; }
#pragma unroll 1
        for (int bt = 0; bt < 8; ++bt) {
            u32x4 uu[16], vv[16];
#pragma unroll
            for (int j = 0; j < 16; ++j) {
                const unsigned e = __builtin_amdgcn_readfirstlane(Ee[ti * 128 + bt * 16 + j]);
                uu[j] = *(const u32x4*)(U8 + (size_t)e * D + lane * 16);
                vv[j] = *(const u32x4*)(V8 + (size_t)e * D + lane * 16);
            }
            float a[16];
#pragma unroll
            for (int j = 0; j < 16; ++j) {
                const unsigned w[4] = {uu[j].x, uu[j].y, uu[j].z, uu[j].w};
                f32x2v acc = {0.f, 0.f};
#pragma unroll
                for (int q = 0; q < 4; ++q) { acc = __builtin_amdgcn_cvt_pk_f32_fp8(w[q], false) * hf[2 * q] + acc; acc = __builtin_amdgcn_cvt_pk_f32_fp8(w[q], true) * hf[2 * q + 1] + acc; }
                a[j] = acc.x + acc.y;
            }
            float k1[8], k2[4], k3[2], k4;
#pragma unroll
            for (int i = 0; i < 8; ++i) { const float snd = b5 ? a[i] : a[8 + i]; const float rcv = __shfl_xor(snd, 32); k1[i] = (b5 ? a[8 + i] : a[i]) + rcv; }
#pragma unroll
            for (int i = 0; i < 4; ++i) { const float snd = b4 ? k1[i] : k1[4 + i]; const float rcv = __shfl_xor(snd, 16); k2[i] = (b4 ? k1[4 + i] : k1[i]) + rcv; }
#pragma unroll
            for (int i = 0; i < 2; ++i) { const float snd = b3 ? k2[i] : k2[2 + i]; const float rcv = __shfl_xor(snd, 8); k3[i] = (b3 ? k2[2 + i] : k2[i]) + rcv; }
            { const float snd = b2 ? k3[0] : k3[1]; const float rcv = __shfl_xor(snd, 4); k4 = (b2 ? k3[1] : k3[0]) + rcv; }
            k4 += __shfl_xor(k4, 2); k4 += __shfl_xor(k4, 1);
            const int ei = ti * 128 + bt * 16 + jl;
            const float w = Eg[ei] * gelu_erf(k4 * Es[ei]);
#pragma unroll
            for (int j = 0; j < 16; ++j) {
                const int src = 32 * (j >> 3) + 16 * ((j >> 2) & 1) + 8 * ((j >> 1) & 1) + 4 * (j & 1);
                const float wj = __uint_as_float(__builtin_amdgcn_readlane(__float_as_uint(w), src));
                const f32x2v wj2 = {wj, wj};
                const unsigned wd[4] = {vv[j].x, vv[j].y, vv[j].z, vv[j].w};
#pragma unroll
                for (int q = 0; q < 4; ++q) { y2[2 * q] = __builtin_amdgcn_cvt_pk_f32_fp8(wd[q], false) * wj2 + y2[2 * q]; y2[2 * q + 1] = __builtin_amdgcn_cvt_pk_f32_fp8(wd[q], true) * wj2 + y2[2 * q + 1]; }
            }
        }
        const int b = (p.tok0 + tok) / SEQ;
        const float* mod = p.MOD + ((size_t)l * BATCH + b) * 6 * D;
        float v[16], gt[16];
        load16c(v, X1 + (size_t)tok * D, lane); load16c(gt, mod + 5 * D, lane);
#pragma unroll
        for (int i = 0; i < 8; ++i) { v[2 * i] = DN_ALPHA * v[2 * i] + (1.f + gt[2 * i]) * y2[i].x; v[2 * i + 1] = DN_ALPHA * v[2 * i + 1] + (1.f + gt[2 * i + 1]) * y2[i].y; }
        ln16c(v, p.in[23] + l * D, p.in[24] + l * D, lane);
        store16c(xout + (size_t)tok * D, v, lane);
        if (l + 1 < DEPTH) { const float* modn = p.MOD + ((size_t)(l + 1) * BATCH + b) * 6 * D; store_mod16c(p.H + (size_t)tok * D, v, modn, modn + D, lane); }
    }
}
#ifndef P6_NR
#define P6_NR 8
#endif
constexpr int NR = P6_NR, RSH = (NR == 16) ? 10 : (NR == 8) ? 11 : (NR == 4) ? 12 : (NR == 2) ? 13 : 14;

DI void p6x_combine(const Params& p, int l, int tokb, unsigned* LA, unsigned* LB, unsigned* Ee, float* Eg, float* Es, int lane) {
    const int ti = lane >> 3, head = lane & 7;
    const unsigned* src = p.TOPK + ((size_t)(tokb + ti) * 16 + head * 2) * 16;
    unsigned A[16], B[16];
#pragma unroll
    for (int q = 0; q < 4; ++q) { const u32x4 a = *(const u32x4*)(src + 4 * q), b = *(const u32x4*)(src + 16 + 4 * q);
        A[4 * q] = a.x; A[4 * q + 1] = a.y; A[4 * q + 2] = a.z; A[4 * q + 3] = a.w; B[4 * q] = b.x; B[4 * q + 1] = b.y; B[4 * q + 2] = b.z; B[4 * q + 3] = b.w;
        *(u32x4*)(LA + lane * 16 + 4 * q) = a; *(u32x4*)(LB + lane * 16 + 4 * q) = b; }
    float sA[16], sB[16];
#pragma unroll
    for (int k = 0; k < 16; ++k) { sA[k] = funord(A[k] & ~0x7fu); sB[k] = funord(B[k] & ~0x7fu); }
    unsigned T[16];
#pragma unroll
    for (int k = 0; k < 16; ++k) T[k] = 0u;
#pragma unroll
    for (int a = 0; a < 16; ++a)
#pragma unroll
        for (int b = 0; b < 16; ++b)
            if ((a + 1) * (b + 1) <= 16) {
                unsigned v = (ford(sA[a] + sB[b]) & ~0xffu) | (unsigned)(a * 16 + b);
#pragma unroll
                for (int k = 0; k < 16; ++k) { const unsigned t = max(T[k], v); v = min(T[k], v); T[k] = t; }
            }
    float ex[16]; float sum = 0.f; const float mx = funord(T[0] & ~0xffu);
    unsigned ev[16];
#pragma unroll
    for (int k = 0; k < 16; ++k) { ex[k] = __expf(funord(T[k] & ~0xffu) - mx); sum += ex[k];
        const unsigned cid = T[k] & 0xffu; ev[k] = (LA[lane * 16 + (cid >> 4)] & 0x7fu) * 128u + (LB[lane * 16 + (cid & 15u)] & 0x7fu); }
    const float inv = 1.f / sum;
    const float* US = p.US + l * 16384; const float* VS = p.VS + l * 16384;
    float su[16], gv[16];
#pragma unroll
    for (int k = 0; k < 16; ++k) { su[k] = US[ev[k]]; gv[k] = ex[k] * inv * VS[ev[k]]; }
    unsigned* cnt = LB; unsigned* off = LB + 8 * NR; unsigned* cur = LB + 16 * NR;
    for (int i = lane; i < 24 * NR; i += 64) LB[i] = 0u;
#pragma unroll
    for (int k = 0; k < 16; ++k) atomicAdd(&cnt[ti * NR + (ev[k] >> RSH)], 1u);
    {
#pragma unroll
        for (int rb = 0; rb < NR; rb += 8) {
            unsigned s = 0u;
#pragma unroll
            for (int r = 0; r < NR; ++r) { const unsigned c = cnt[ti * NR + r]; if (r < head + rb) s += c; }
            if (head + rb < NR) off[ti * NR + head + rb] = s;
        }
    }
#pragma unroll
    for (int k = 0; k < 16; ++k) {
        const int r = ev[k] >> RSH;
        const unsigned pos = off[ti * NR + r] + atomicAdd(&cur[ti * NR + r], 1u);
        Ee[ti * 128 + pos] = ev[k]; Eg[ti * 128 + pos] = gv[k]; Es[ti * 128 + pos] = su[k];
    }
}

DI float gelu_fast(float v) {
    const float av = fabsf(v), t = __builtin_amdgcn_rcpf(av * 0.2316418882f + 1.0f);
    float q = t * 0.5307027145f + (-0.7265760135f); q = q * t + 0.7107068705f; q = q * t + (-0.142248368f); q = q * t + 0.127414796f; q = q * t;
    const float e = __builtin_amdgcn_exp2f((v * v) * (-0.72134752044f));
    const float m = v * (q * e);
    return v < 0.f ? m : v - m;
}
template <bool DRY> DI void p6x_ids(unsigned (&en)[8], const unsigned* Ee, unsigned desc) {
    const int ebase = desc & 0x3ff, n = (desc >> 10) & 0xf;
#pragma unroll
    for (int j = 0; j < 8; ++j) en[j] = (__builtin_amdgcn_readfirstlane(Ee[ebase + (j < n ? j : 0)]) & (DRY ? 1023u : 0xffffu)) * (unsigned)D;
}
typedef __amdgpu_buffer_rsrc_t rsrc_t;
DI u32x4 rowload(rsrc_t r, int voff, unsigned soff) { return __builtin_amdgcn_raw_buffer_load_b128(r, voff, (int)soff, 0); }
DI void p6x_issue(u32x4 (&buf)[8], rsrc_t T8, const unsigned (&en)[8], int voff) {
#pragma unroll
    for (int j = 0; j < 8; ++j) buf[j] = rowload(T8, voff, en[j]);
}
template <int CTRL> DI float dppf(float v) { return __uint_as_float(__builtin_amdgcn_mov_dpp(__float_as_uint(v), CTRL, 0xf, 0xf, true)); }
DI float pair32(float x, float y) { auto r = __builtin_amdgcn_permlane32_swap(__float_as_uint(x), __float_as_uint(y), false, false); return __uint_as_float(r[0]) + __uint_as_float(r[1]); }
DI float pair16(float x, float y) { auto r = __builtin_amdgcn_permlane16_swap(__float_as_uint(x), __float_as_uint(y), false, false); return __uint_as_float(r[0]) + __uint_as_float(r[1]); }
DI float p6x_dots(u32x4 (&uu)[8], rsrc_t U8, const unsigned (&en)[8], bool refill, u32x4 (&hw)[2], const bf16* hnext, const float* Eg, const float* Es, unsigned desc,
                  int lane, int jl, bool b5, bool b4, bool b3) {
    const int ebase = desc & 0x3ff, n = (desc >> 10) & 0xf;
    float a[8];
    {
        f32x2v hf[8];
#pragma unroll
        for (int i = 0; i < 8; ++i) { const unsigned hwi = (i < 4) ? hw[0][i & 3] : hw[1][i & 3]; hf[i] = (f32x2v){bflo(hwi), bfhi(hwi)}; }
#pragma unroll
        for (int j = 0; j < 8; ++j) {
            f32x2v acc0 = __builtin_amdgcn_cvt_pk_f32_fp8(uu[j].x, false) * hf[0];
            f32x2v acc1 = __builtin_amdgcn_cvt_pk_f32_fp8(uu[j].x, true) * hf[1];
            acc0 = __builtin_amdgcn_cvt_pk_f32_fp8(uu[j].y, false) * hf[2] + acc0;
            acc1 = __builtin_amdgcn_cvt_pk_f32_fp8(uu[j].y, true) * hf[3] + acc1;
            acc0 = __builtin_amdgcn_cvt_pk_f32_fp8(uu[j].z, false) * hf[4] + acc0;
            acc1 = __builtin_amdgcn_cvt_pk_f32_fp8(uu[j].z, true) * hf[5] + acc1;
            acc0 = __builtin_amdgcn_cvt_pk_f32_fp8(uu[j].w, false) * hf[6] + acc0;
            acc1 = __builtin_amdgcn_cvt_pk_f32_fp8(uu[j].w, true) * hf[7] + acc1;
            acc0 += acc1;
            a[j] = acc0.x + acc0.y;
        }
    }
    __builtin_amdgcn_sched_barrier(0);
    hw[0] = *(const u32x4*)hnext; hw[1] = *(const u32x4*)(hnext + 8);
#pragma unroll
    for (int j = 0; j < 8; ++j) uu[j] = rowload(U8, lane * 16, en[j]);
    __builtin_amdgcn_sched_barrier(0);
    float k1[4], k2[2], k3;
#pragma unroll
    for (int i = 0; i < 4; ++i) k1[i] = pair32(a[i], a[4 + i]);
#pragma unroll
    for (int i = 0; i < 2; ++i) k2[i] = pair16(k1[i], k1[2 + i]);
    { const float snd = b3 ? k2[0] : k2[1]; k3 = (b3 ? k2[1] : k2[0]) + dppf<0x128>(snd); }
    k3 += dppf<0x141>(k3);
    k3 += dppf<0xB1>(k3);
    k3 += dppf<0x4E>(k3);
    const int ei = ebase + (jl < n ? jl : 0);
    return (jl < n) ? Eg[ei] * gelu_fast(k3 * Es[ei]) : 0.f;
}
DI void p6x_axpy(u32x4 (&vv)[8], rsrc_t V8, const unsigned (&en)[8], bool refill, float w, f32x2v (&y2)[8], int lane) {
#pragma unroll
    for (int j = 0; j < 8; ++j) {
        const int src = 32 * (j >> 2) + 16 * ((j >> 1) & 1) + 8 * (j & 1);
        const float wj = __uint_as_float(__builtin_amdgcn_readlane(__float_as_uint(w), src));
        const f32x2v wj2 = {wj, wj};
        const unsigned wd[4] = {vv[j].x, vv[j].y, vv[j].z, vv[j].w};
#pragma unroll
        for (int q = 0; q < 4; ++q) { y2[2 * q] = __builtin_amdgcn_cvt_pk_f32_fp8(wd[q], false) * wj2 + y2[2 * q]; y2[2 * q + 1] = __builtin_amdgcn_cvt_pk_f32_fp8(wd[q], true) * wj2 + y2[2 * q + 1]; }
    }
    __builtin_amdgcn_sched_barrier(0);
#pragma unroll
    for (int j = 0; j < 8; ++j) vv[j] = rowload(V8, lane * 16, en[j]);
    __builtin_amdgcn_sched_barrier(0);
}
#define P6X_AXPY(T) p6x_axpy(V, V8, en, more, w_, y2[T], lane)

template <bool DRY> DI void p6x_block(const Params& p, int l, int tok_first, int ntok, const float* X1, float* xout, char* lds) {
    int tid_ = threadIdx.x; asm volatile("" : "+v"(tid_)); const int tid = tid_, lane = tid & 63;
    const int wv = __builtin_amdgcn_readfirstlane(tid >> 6);
    unsigned* LA = (unsigned*)(lds + wv * 16384); unsigned* LB = LA + 1024; unsigned* Ee = LA + 2048; float* Eg = (float*)(LA + 3072); float* Es = (float*)LA;
    const unsigned* cnt = LB; const unsigned* off = LB + 8 * NR; unsigned* dl = LB + 24 * NR;
    const rsrc_t U8 = __builtin_amdgcn_make_buffer_rsrc((void*)p.U8, 0, 16384 * D, 0x00020000), V8 = __builtin_amdgcn_make_buffer_rsrc((void*)p.V8, 0, 16384 * D, 0x00020000);
    const int jl = 4 * (lane >> 5) + 2 * ((lane >> 4) & 1) + ((lane >> 3) & 1);
    const bool b5 = lane & 32, b4 = lane & 16, b3 = lane & 8;
    const int per_wave = ntok >> 2;
    __syncthreads();
#pragma unroll 1
    for (int g8 = 0; g8 < per_wave; g8 += 8) {
        const int tokb = tok_first + wv * per_wave + g8;
        { int lc = lane; asm volatile("" : "+v"(lc)); p6x_combine(p, l, tokb, LA, LB, Ee, Eg, Es, lc); }
#pragma unroll 1
        for (int sw = 0; sw < 2; ++sw) {
            int nd;
            {
                int lane_d = lane; asm volatile("" : "+v"(lane_d));
                const bool rev = ((g8 >> 3) * 2 + sw) & 1;
                const int rr = (lane_d >> 2) & (NR - 1), t = lane_d & 3, r = rev ? (NR - 1 - rr) : rr, ti = sw * 4 + t;
                const int n = (lane_d < 4 * NR) ? (int)cnt[ti * NR + r] : 0, base = (int)off[ti * NR + r];
                const int nbat = (n + 7) >> 3;
                int incl = nbat;
#pragma unroll
                for (int o = 1; o < 64; o <<= 1) { const int up = __shfl_up(incl, o); if (lane_d >= o) incl += up; }
                const int start = incl - nbat;
                for (int k = 0; k < nbat; ++k) { const int rem = n - 8 * k; dl[start + k] = ((unsigned)t << 14) | ((unsigned)(rem < 8 ? rem : 8) << 10) | (unsigned)(ti * 128 + base + 8 * k); }
                nd = __builtin_amdgcn_readlane(incl, 63);
            }
            f32x2v y2[4][8];
#pragma unroll
            for (int t = 0; t < 4; ++t)
#pragma unroll
                for (int i = 0; i < 8; ++i) y2[t][i] = (f32x2v){0.f, 0.f};
            const bf16* hbase = p.H + (size_t)(tokb + sw * 4) * D + lane * 16;
            u32x4 U[8], V[8]; unsigned en[8];
            unsigned dA = __builtin_amdgcn_readfirstlane(dl[0]);
            u32x4 hw[2];
            if (nd > 0) { p6x_ids<DRY>(en, Ee, dA); p6x_issue(U, U8, en, lane * 16); p6x_issue(V, V8, en, lane * 16); const bf16* hr = hbase + (size_t)(dA >> 14) * D; hw[0] = *(const u32x4*)hr; hw[1] = *(const u32x4*)(hr + 8); }
#pragma unroll 1
            for (int i = 0; i < nd; ++i) {
                const bool more = i + 1 < nd;
                const unsigned dB = __builtin_amdgcn_readfirstlane(dl[more ? i + 1 : i]);
                p6x_ids<DRY>(en, Ee, dB);
                const int t_ = (int)(dA >> 14);
                const float w_ = p6x_dots(U, U8, en, more, hw, hbase + (size_t)(dB >> 14) * D, Eg, Es, dA, lane, jl, b5, b4, b3);
                switch (t_) { case 0: P6X_AXPY(0); break; case 1: P6X_AXPY(1); break; case 2: P6X_AXPY(2); break; default: P6X_AXPY(3); break; }
                dA = dB;
            }
#pragma unroll
            for (int t = 0; t < 4; ++t) {
                int lane_e = lane; asm volatile("" : "+v"(lane_e));
                const int tok = tokb + sw * 4 + t;
                const int b = (p.tok0 + tok) / SEQ;
                const float* mod = p.MOD + ((size_t)l * BATCH + b) * 6 * D;
                float v[16], gt[16];
                load16c(v, X1 + (size_t)tok * D, lane_e); load16c(gt, mod + 5 * D, lane_e);
#pragma unroll
                for (int i = 0; i < 8; ++i) { v[2 * i] = DN_ALPHA * v[2 * i] + (1.f + gt[2 * i]) * y2[t][i].x; v[2 * i + 1] = DN_ALPHA * v[2 * i + 1] + (1.f + gt[2 * i + 1]) * y2[t][i].y; }
                ln16c(v, p.in[23] + l * D, p.in[24] + l * D, lane_e);
                if (DRY) {
#pragma unroll
                    for (int i = 0; i < 16; ++i) asm volatile("" :: "v"(v[i]));
                    continue; }
                store16c(xout + (size_t)tok * D, v, lane_e);
                if (l + 1 < DEPTH) { const float* modn = p.MOD + ((size_t)(l + 1) * BATCH + b) * 6 * D; store_mod16c(p.H + (size_t)tok * D, v, modn, modn + D, lane_e); }
                __builtin_amdgcn_sched_barrier(0);
            }
        }
    }
}

DI u32x4 p6a_rsrc(const unsigned char* base) {
    const unsigned long long a = (unsigned long long)base;
    u32x4 r; r.x = __builtin_amdgcn_readfirstlane((unsigned)a); r.y = __builtin_amdgcn_readfirstlane((unsigned)(a >> 32) & 0xffffu); r.z = 16384u * (unsigned)D; r.w = 0x00020000u;
    return r;
}
#ifndef P6_DRYMODE
#define P6_DRYMODE 0
#endif
template <bool DRY> DI void p6a_ids(unsigned (&en)[8], const unsigned* Ee, unsigned desc, int lane) {
    const int ebase = desc & 0x3ff, n = (desc >> 10) & 0xf, j = lane & 7;
    const unsigned ev = (Ee[ebase + (j < n ? j : 0)] & ((DRY && P6_DRYMODE == 1) ? 1023u : 0xffffu)) * (unsigned)D;
#pragma unroll
    for (int k = 0; k < 8; ++k) en[k] = __builtin_amdgcn_readlane(ev, k);
}
DI void p6a_load8(u32x4 (&b)[8], u32x4 rsrc, int voff, const unsigned (&so)[8]) {
    asm volatile("s_nop 4\n\t"
        "buffer_load_dwordx4 %0, %8, %9, %10 offen\n\t" "buffer_load_dwordx4 %1, %8, %9, %11 offen\n\t" "buffer_load_dwordx4 %2, %8, %9, %12 offen\n\t" "buffer_load_dwordx4 %3, %8, %9, %13 offen\n\t"
        "buffer_load_dwordx4 %4, %8, %9, %14 offen\n\t" "buffer_load_dwordx4 %5, %8, %9, %15 offen\n\t" "buffer_load_dwordx4 %6, %8, %9, %16 offen\n\t" "buffer_load_dwordx4 %7, %8, %9, %17 offen"
        : "=&v"(b[0]), "=&v"(b[1]), "=&v"(b[2]), "=&v"(b[3]), "=&v"(b[4]), "=&v"(b[5]), "=&v"(b[6]), "=&v"(b[7])
        : "v"(voff), "s"(rsrc), "s"(so[0]), "s"(so[1]), "s"(so[2]), "s"(so[3]), "s"(so[4]), "s"(so[5]), "s"(so[6]), "s"(so[7])
        : "memory");
}
DI void p6a_loadh(u32x4 (&h)[2], const bf16* src) {
    asm volatile("global_load_dwordx4 %0, %2, off\n\tglobal_load_dwordx4 %1, %2, off offset:16" : "=&v"(h[0]), "=&v"(h[1]) : "v"(src) : "memory");
}
DI void p6a_wait_hu(u32x4 (&h)[2], u32x4 (&b)[8]) {
    asm volatile("s_waitcnt vmcnt(8)" : "+v"(h[0]), "+v"(h[1]), "+v"(b[0]), "+v"(b[1]), "+v"(b[2]), "+v"(b[3]), "+v"(b[4]), "+v"(b[5]), "+v"(b[6]), "+v"(b[7]) :: "memory");
}
DI void p6a_wait_v(u32x4 (&b)[8]) {
    asm volatile("s_waitcnt vmcnt(10)" : "+v"(b[0]), "+v"(b[1]), "+v"(b[2]), "+v"(b[3]), "+v"(b[4]), "+v"(b[5]), "+v"(b[6]), "+v"(b[7]) :: "memory");
}
DI void p6a_drain(u32x4 (&h)[2], u32x4 (&u)[8], u32x4 (&v)[8]) {
    asm volatile("s_waitcnt vmcnt(0)" : "+v"(h[0]), "+v"(h[1]), "+v"(u[0]), "+v"(u[1]), "+v"(u[2]), "+v"(u[3]), "+v"(u[4]), "+v"(u[5]), "+v"(u[6]), "+v"(u[7]),
                                        "+v"(v[0]), "+v"(v[1]), "+v"(v[2]), "+v"(v[3]), "+v"(v[4]), "+v"(v[5]), "+v"(v[6]), "+v"(v[7]) :: "memory");
}
DI void p6a_dot8(float (&a)[8], const u32x4 (&uu)[8], const u32x4 (&hw)[2]) {
    f32x2v hf[8];
#pragma unroll
    for (int i = 0; i < 8; ++i) { const unsigned hwi = (i < 4) ? hw[0][i & 3] : hw[1][i & 3]; hf[i] = (f32x2v){bflo(hwi), bfhi(hwi)}; }
#pragma unroll
    for (int j = 0; j < 8; ++j) {
        f32x2v acc0 = __builtin_amdgcn_cvt_pk_f32_fp8(uu[j].x, false) * hf[0];
        f32x2v acc1 = __builtin_amdgcn_cvt_pk_f32_fp8(uu[j].x, true) * hf[1];
        acc0 = __builtin_amdgcn_cvt_pk_f32_fp8(uu[j].y, false) * hf[2] + acc0;
        acc1 = __builtin_amdgcn_cvt_pk_f32_fp8(uu[j].y, true) * hf[3] + acc1;
        acc0 = __builtin_amdgcn_cvt_pk_f32_fp8(uu[j].z, false) * hf[4] + acc0;
        acc1 = __builtin_amdgcn_cvt_pk_f32_fp8(uu[j].z, true) * hf[5] + acc1;
        acc0 = __builtin_amdgcn_cvt_pk_f32_fp8(uu[j].w, false) * hf[6] + acc0;
        acc1 = __builtin_amdgcn_cvt_pk_f32_fp8(uu[j].w, true) * hf[7] + acc1;
        acc0 += acc1;
        a[j] = acc0.x + acc0.y;
    }
}
DI float p6a_reduce_gate(const float (&a)[8], const float* Eg, const float* Es, unsigned desc, int jl, bool b3) {
    const int ebase = desc & 0x3ff, n = (desc >> 10) & 0xf;
    float k1[4], k2[2], k3;
#pragma unroll
    for (int i = 0; i < 4; ++i) k1[i] = pair32(a[i], a[4 + i]);
#pragma unroll
    for (int i = 0; i < 2; ++i) k2[i] = pair16(k1[i], k1[2 + i]);
    { const float snd = b3 ? k2[0] : k2[1]; k3 = (b3 ? k2[1] : k2[0]) + dppf<0x128>(snd); }
    k3 += dppf<0x141>(k3); k3 += dppf<0xB1>(k3); k3 += dppf<0x4E>(k3);
    const int ei = ebase + (jl < n ? jl : 0);
    return (jl < n) ? Eg[ei] * gelu_fast(k3 * Es[ei]) : 0.f;
}
DI void p6a_axpy8(const u32x4 (&vv)[8], float w, f32x2v (&y2)[8]) {
#pragma unroll
    for (int j = 0; j < 8; ++j) {
        const int src = 32 * (j >> 2) + 16 * ((j >> 1) & 1) + 8 * (j & 1);
        const float wj = __uint_as_float(__builtin_amdgcn_readlane(__float_as_uint(w), src));
        const f32x2v wj2 = {wj, wj};
        const unsigned wd[4] = {vv[j].x, vv[j].y, vv[j].z, vv[j].w};
#pragma unroll
        for (int q = 0; q < 4; ++q) { y2[2 * q] = __builtin_amdgcn_cvt_pk_f32_fp8(wd[q], false) * wj2 + y2[2 * q]; y2[2 * q + 1] = __builtin_amdgcn_cvt_pk_f32_fp8(wd[q], true) * wj2 + y2[2 * q + 1]; }
    }
}
template <bool DRY> DI void p6a_block(const Params& p, int l, int tok_first, int ntok, const float* X1, float* xout, char* lds) {
    int tid_ = threadIdx.x; asm volatile("" : "+v"(tid_)); const int tid = tid_, lane = tid & 63;
    const int wv = __builtin_amdgcn_readfirstlane(tid >> 6);
    unsigned* LA = (unsigned*)(lds + wv * 16384); unsigned* LB = LA + 1024; unsigned* Ee = LA + 2048; float* Eg = (float*)(LA + 3072); float* Es = (float*)LA;
    const unsigned* cnt = LB; const unsigned* off = LB + 8 * NR; unsigned* dl = LB + 24 * NR;
    const u32x4 rU = p6a_rsrc(p.U8), rV = p6a_rsrc(p.V8);
    const int jl = 4 * (lane >> 5) + 2 * ((lane >> 4) & 1) + ((lane >> 3) & 1);
    const bool b5 = lane & 32, b4 = lane & 16, b3 = lane & 8;
    const int per_wave = ntok >> 2;
    __syncthreads();
#pragma unroll 1
    for (int g8 = 0; g8 < per_wave; g8 += 8) {
        const int tokb = tok_first + wv * per_wave + g8;
        { int lc = lane; asm volatile("" : "+v"(lc)); p6x_combine(p, l, tokb, LA, LB, Ee, Eg, Es, lc); }
#pragma unroll 1
        for (int sw = 0; sw < 2; ++sw) {
            int nd;
            {
                int lane_d = lane; asm volatile("" : "+v"(lane_d));
                const bool rev = ((g8 >> 3) * 2 + sw) & 1;
                const int rr = (lane_d >> 2) & (NR - 1), t = lane_d & 3, r = rev ? (NR - 1 - rr) : rr, ti = sw * 4 + t;
                const int n = (lane_d < 4 * NR) ? (int)cnt[ti * NR + r] : 0, base = (int)off[ti * NR + r];
                const int nbat = (n + 7) >> 3;
                int incl = nbat;
#pragma unroll
                for (int o = 1; o < 64; o <<= 1) { const int up = __shfl_up(incl, o); if (lane_d >= o) incl += up; }
                const int start = incl - nbat;
                for (int k = 0; k < nbat; ++k) { const int rem = n - 8 * k; dl[start + k] = ((unsigned)t << 14) | ((unsigned)(rem < 8 ? rem : 8) << 10) | (unsigned)(ti * 128 + base + 8 * k); }
                nd = __builtin_amdgcn_readlane(incl, 63);
            }
            f32x2v y2[4][8];
#pragma unroll
            for (int t = 0; t < 4; ++t)
#pragma unroll
                for (int i = 0; i < 8; ++i) y2[t][i] = (f32x2v){0.f, 0.f};
            const bf16* hbase = p.H + (size_t)(tokb + sw * 4) * D + lane * 16;
            u32x4 U[8], V[8], hw[2]; unsigned en[8];
            asm volatile("s_waitcnt vmcnt(0)" ::: "memory");
            unsigned dA = __builtin_amdgcn_readfirstlane(dl[0]);
            { p6a_ids<DRY>(en, Ee, dA, lane); p6a_loadh(hw, hbase + (size_t)(dA >> 14) * D); p6a_load8(U, rU, lane * 16, en); p6a_load8(V, rV, lane * 16, en); }
#pragma unroll 1
            for (int i = 0; i < nd; ++i) {
                const unsigned dB = __builtin_amdgcn_readfirstlane(dl[i + 1 < nd ? i + 1 : i]);
                p6a_ids<DRY>(en, Ee, dB, lane);
                const int t_ = (int)(dA >> 14);
                if (!(DRY && P6_DRYMODE == 2)) p6a_wait_hu(hw, U);
                float a[8];
                if (DRY && P6_DRYMODE == 3) {
#pragma unroll
                    for (int j = 0; j < 8; ++j) a[j] = __uint_as_float(U[j].x); }
                else p6a_dot8(a, U, hw);
                __builtin_amdgcn_sched_barrier(0);
                if (!(DRY && P6_DRYMODE == 2)) { p6a_loadh(hw, hbase + (size_t)(dB >> 14) * D); p6a_load8(U, rU, lane * 16, en); }
                __builtin_amdgcn_sched_barrier(0);
                const float w_ = p6a_reduce_gate(a, Eg, Es, dA, jl, b3);
                if (!(DRY && P6_DRYMODE == 2)) p6a_wait_v(V);
                if (DRY && P6_DRYMODE == 3) { y2[0][0].x += w_ * __uint_as_float(V[0].x ^ V[1].x ^ V[2].x ^ V[3].x ^ V[4].x ^ V[5].x ^ V[6].x ^ V[7].x); } else
                switch (t_) { case 0: p6a_axpy8(V, w_, y2[0]); break; case 1: p6a_axpy8(V, w_, y2[1]); break; case 2: p6a_axpy8(V, w_, y2[2]); break; default: p6a_axpy8(V, w_, y2[3]); break; }
                __builtin_amdgcn_sched_barrier(0);
                if (!(DRY && P6_DRYMODE == 2)) p6a_load8(V, rV, lane * 16, en);
                __builtin_amdgcn_sched_barrier(0);
                dA = dB;
            }
            p6a_drain(hw, U, V);
#pragma unroll
            for (int t = 0; t < 4; ++t) {
                int lane_e = lane; asm volatile("" : "+v"(lane_e));
                const int tok = tokb + sw * 4 + t;
                const int b = (p.tok0 + tok) / SEQ;
                const float* mod = p.MOD + ((size_t)l * BATCH + b) * 6 * D;
                float v[16], gt[16];
                load16c(v, X1 + (size_t)tok * D, lane_e); load16c(gt, mod + 5 * D, lane_e);
#pragma unroll
                for (int i = 0; i < 8; ++i) { v[2 * i] = DN_ALPHA * v[2 * i] + (1.f + gt[2 * i]) * y2[t][i].x; v[2 * i + 1] = DN_ALPHA * v[2 * i + 1] + (1.f + gt[2 * i + 1]) * y2[t][i].y; }
                ln16c(v, p.in[23] + l * D, p.in[24] + l * D, lane_e);
                if (DRY) {
#pragma unroll
                    for (int i = 0; i < 16; ++i) asm volatile("" :: "v"(v[i]));
                    continue; }
                store16c(xout + (size_t)tok * D, v, lane_e);
                if (l + 1 < DEPTH) { const float* modn = p.MOD + ((size_t)(l + 1) * BATCH + b) * 6 * D; store_mod16c(p.H + (size_t)tok * D, v, modn, modn + D, lane_e); }
                __builtin_amdgcn_sched_barrier(0);
            }
        }
    }
}

#define P6B_DESC(i) ((unsigned)__builtin_amdgcn_readfirstlane(dl[(i) < nd ? (i) : nd - 1]))
#define P6B_RDESC(i) ((unsigned)__builtin_amdgcn_readfirstlane(dl[(i) < nd ? nd - 1 - (i) : 0]))
DI void p6b_wait16(u32x4 (&b)[8]) {
    asm volatile("s_waitcnt vmcnt(16)" : "+v"(b[0]), "+v"(b[1]), "+v"(b[2]), "+v"(b[3]), "+v"(b[4]), "+v"(b[5]), "+v"(b[6]), "+v"(b[7]) :: "memory");
}
DI void p6b_wait8(u32x4 (&b)[8]) {
    asm volatile("s_waitcnt vmcnt(8)" : "+v"(b[0]), "+v"(b[1]), "+v"(b[2]), "+v"(b[3]), "+v"(b[4]), "+v"(b[5]), "+v"(b[6]), "+v"(b[7]) :: "memory");
}
DI void p6b_drain2(u32x4 (&a)[8], u32x4 (&b)[8]) {
    asm volatile("s_waitcnt vmcnt(0)" : "+v"(a[0]), "+v"(a[1]), "+v"(a[2]), "+v"(a[3]), "+v"(a[4]), "+v"(a[5]), "+v"(a[6]), "+v"(a[7]),
                                        "+v"(b[0]), "+v"(b[1]), "+v"(b[2]), "+v"(b[3]), "+v"(b[4]), "+v"(b[5]), "+v"(b[6]), "+v"(b[7]) :: "memory");
}
DI void p6b_drain3(u32x4 (&a)[8], u32x4 (&b)[8], u32x4 (&c)[8]) {
    asm volatile("s_waitcnt vmcnt(0)" : "+v"(a[0]), "+v"(a[1]), "+v"(a[2]), "+v"(a[3]), "+v"(a[4]), "+v"(a[5]), "+v"(a[6]), "+v"(a[7]),
                                        "+v"(b[0]), "+v"(b[1]), "+v"(b[2]), "+v"(b[3]), "+v"(b[4]), "+v"(b[5]), "+v"(b[6]), "+v"(b[7]),
                                        "+v"(c[0]), "+v"(c[1]), "+v"(c[2]), "+v"(c[3]), "+v"(c[4]), "+v"(c[5]), "+v"(c[6]), "+v"(c[7]) :: "memory");
}
DI void p6b_dot8(float (&a)[8], const u32x4 (&uu)[8], const unsigned (&hw)[8]) {
    f32x2v hf[8];
#pragma unroll
    for (int i = 0; i < 8; ++i) hf[i] = (f32x2v){bflo(hw[i]), bfhi(hw[i])};
#pragma unroll
    for (int j = 0; j < 8; ++j) {
        f32x2v acc0 = __builtin_amdgcn_cvt_pk_f32_fp8(uu[j].x, false) * hf[0];
        f32x2v acc1 = __builtin_amdgcn_cvt_pk_f32_fp8(uu[j].x, true) * hf[1];
        acc0 = __builtin_amdgcn_cvt_pk_f32_fp8(uu[j].y, false) * hf[2] + acc0;
        acc1 = __builtin_amdgcn_cvt_pk_f32_fp8(uu[j].y, true) * hf[3] + acc1;
        acc0 = __builtin_amdgcn_cvt_pk_f32_fp8(uu[j].z, false) * hf[4] + acc0;
        acc1 = __builtin_amdgcn_cvt_pk_f32_fp8(uu[j].z, true) * hf[5] + acc1;
        acc0 = __builtin_amdgcn_cvt_pk_f32_fp8(uu[j].w, false) * hf[6] + acc0;
        acc1 = __builtin_amdgcn_cvt_pk_f32_fp8(uu[j].w, true) * hf[7] + acc1;
        acc0 += acc1;
        a[j] = acc0.x + acc0.y;
    }
}
DI void p6b_reduce_store(const float (&a)[8], float* Eg, const float* Es, unsigned desc, int lane, int jl, bool b3) {
    const int ebase = desc & 0x3ff, n = (desc >> 10) & 0xf;
    float k1[4], k2[2], k3;
#pragma unroll
    for (int i = 0; i < 4; ++i) k1[i] = pair32(a[i], a[4 + i]);
#pragma unroll
    for (int i = 0; i < 2; ++i) k2[i] = pair16(k1[i], k1[2 + i]);
    { const float snd = b3 ? k2[0] : k2[1]; k3 = (b3 ? k2[1] : k2[0]) + dppf<0x128>(snd); }
    k3 += dppf<0x141>(k3); k3 += dppf<0xB1>(k3); k3 += dppf<0x4E>(k3);
    if ((lane & 7) == 0 && jl < n) { const int ei = ebase + jl; Eg[ei] = Eg[ei] * gelu_fast(k3 * Es[ei]); }
}
DI void p6b_weights(float (&wj)[8], const float* Eg, unsigned desc, int lane) {
    const int ebase = desc & 0x3ff, n = (desc >> 10) & 0xf, j = lane & 7;
    const float wv = Eg[ebase + (j < n ? j : 0)];
#pragma unroll
    for (int k = 0; k < 8; ++k) { const float t = __uint_as_float(__builtin_amdgcn_readlane(__float_as_uint(wv), k)); wj[k] = (k < n) ? t : 0.f; }
}
DI void p6b_axpy8(const u32x4 (&vv)[8], const float (&wj)[8], f32x2v (&y2)[8]) {
#pragma unroll
    for (int j = 0; j < 8; ++j) {
        const f32x2v wj2 = {wj[j], wj[j]};
        const unsigned wd[4] = {vv[j].x, vv[j].y, vv[j].z, vv[j].w};
#pragma unroll
        for (int q = 0; q < 4; ++q) { y2[2 * q] = __builtin_amdgcn_cvt_pk_f32_fp8(wd[q], false) * wj2 + y2[2 * q]; y2[2 * q + 1] = __builtin_amdgcn_cvt_pk_f32_fp8(wd[q], true) * wj2 + y2[2 * q + 1]; }
    }
}
template <bool DRY> DI void p6b_block(const Params& p, int l, int tok_first, int ntok, const float* X1, float* xout, char* lds) {
    int tid_ = threadIdx.x; asm volatile("" : "+v"(tid_)); const int tid = tid_, lane = tid & 63;
    const int wv = __builtin_amdgcn_readfirstlane(tid >> 6);
    unsigned* LA = (unsigned*)(lds + wv * 16384); unsigned* LB = LA + 1024; unsigned* Ee = LA + 2048; float* Eg = (float*)(LA + 3072); float* Es = (float*)LA;
    const unsigned* cnt = LB; const unsigned* off = LB + 8 * NR; unsigned* dl = LB + 24 * NR;
    const u32x4 rU = p6a_rsrc(p.U8), rV = p6a_rsrc(p.V8);
    const int jl = 4 * (lane >> 5) + 2 * ((lane >> 4) & 1) + ((lane >> 3) & 1);
    const bool b5 = lane & 32, b4 = lane & 16, b3 = lane & 8;
    const int per_wave = ntok >> 2;
    __syncthreads();
#pragma unroll 1
    for (int g8 = 0; g8 < per_wave; g8 += 8) {
        const int tokb = tok_first + wv * per_wave + g8;
        { int lc = lane; asm volatile("" : "+v"(lc)); p6x_combine(p, l, tokb, LA, LB, Ee, Eg, Es, lc); }
#pragma unroll 1
        for (int sw = 0; sw < 2; ++sw) {
            int nd;
            {
                int lane_d = lane; asm volatile("" : "+v"(lane_d));
                const bool rev = ((g8 >> 3) * 2 + sw) & 1;
                const int rr = (lane_d >> 2) & (NR - 1), t = lane_d & 3, r = rev ? (NR - 1 - rr) : rr, ti = sw * 4 + t;
                const int n = (lane_d < 4 * NR) ? (int)cnt[ti * NR + r] : 0, base = (int)off[ti * NR + r];
                const int nbat = (n + 7) >> 3;
                int incl = nbat;
#pragma unroll
                for (int o = 1; o < 64; o <<= 1) { const int up = __shfl_up(incl, o); if (lane_d >= o) incl += up; }
                const int start = incl - nbat;
                for (int k = 0; k < nbat; ++k) { const int rem = n - 8 * k; dl[start + k] = ((unsigned)t << 14) | ((unsigned)(rem < 8 ? rem : 8) << 10) | (unsigned)(ti * 128 + base + 8 * k); }
                nd = __builtin_amdgcn_readlane(incl, 63);
            }
#ifndef P6B_NO_U
            {
                unsigned hw[4][8];
#pragma unroll
                for (int t = 0; t < 4; ++t) {
                    const bf16* hr = p.H + (size_t)(tokb + sw * 4 + t) * D + lane * 16;
                    const u32x4 h0 = *(const u32x4*)hr, h1 = *(const u32x4*)(hr + 8);
                    hw[t][0] = h0.x; hw[t][1] = h0.y; hw[t][2] = h0.z; hw[t][3] = h0.w; hw[t][4] = h1.x; hw[t][5] = h1.y; hw[t][6] = h1.z; hw[t][7] = h1.w;
                }
                u32x4 S0[8], S1[8]; unsigned en[8];
#pragma unroll
                for (int j = 0; j < 8; ++j) { S0[j] = (u32x4){0u, 0u, 0u, 0u}; S1[j] = S0[j]; }
                asm volatile("s_waitcnt vmcnt(0)" ::: "memory");
#pragma unroll
                for (int t = 0; t < 4; ++t)
#pragma unroll
                    for (int i = 0; i < 8; ++i) asm volatile("" : "+v"(hw[t][i]));
#define P6B_USTEP(S, I) do { const int i_ = (I); const unsigned d_ = P6B_DESC(i_ < 0 ? 0 : i_); if (i_ >= 0) p6b_wait8(S); \
                    if (i_ >= 0 && i_ < nd) { float a_[8]; \
                        switch ((int)(d_ >> 14)) { case 0: p6b_dot8(a_, S, hw[0]); break; case 1: p6b_dot8(a_, S, hw[1]); break; case 2: p6b_dot8(a_, S, hw[2]); break; default: p6b_dot8(a_, S, hw[3]); break; } \
                        __builtin_amdgcn_sched_barrier(0); \
                        p6a_ids<DRY>(en, Ee, P6B_DESC(i_ + 2), lane); p6a_load8(S, rU, lane * 16, en); \
                        __builtin_amdgcn_sched_barrier(0); \
                        p6b_reduce_store(a_, Eg, Es, d_, lane, jl, b3); } \
                    else { p6a_ids<DRY>(en, Ee, P6B_DESC(i_ + 2), lane); p6a_load8(S, rU, lane * 16, en); } } while (0)
#pragma unroll 1
                for (int i = -2; i < nd; i += 2) { P6B_USTEP(S0, i); P6B_USTEP(S1, i + 1); }
                p6b_drain2(S0, S1);
            }
#endif
            f32x2v y2[4][8];
            { float z_ = 0.f; asm volatile("" : "+v"(z_));
#pragma unroll
            for (int t = 0; t < 4; ++t)
#pragma unroll
                for (int i = 0; i < 8; ++i) y2[t][i] = (f32x2v){z_, z_}; }
#ifndef P6B_NO_V
            {
                u32x4 S0[8], S1[8]; unsigned en[8];
#pragma unroll
                for (int j = 0; j < 8; ++j) { S0[j] = (u32x4){0u, 0u, 0u, 0u}; S1[j] = S0[j]; }
#define P6B_VSTEP(S, I) do { const int i_ = (I); const unsigned d_ = P6B_RDESC(i_ < 0 ? 0 : i_); if (i_ >= 0) p6b_wait8(S); \
                    if (i_ >= 0 && i_ < nd) { float wj_[8]; p6b_weights(wj_, Eg, d_, lane); \
                        switch ((int)(d_ >> 14)) { case 0: p6b_axpy8(S, wj_, y2[0]); break; case 1: p6b_axpy8(S, wj_, y2[1]); break; case 2: p6b_axpy8(S, wj_, y2[2]); break; default: p6b_axpy8(S, wj_, y2[3]); break; } } \
                    __builtin_amdgcn_sched_barrier(0); \
                    p6a_ids<DRY>(en, Ee, P6B_RDESC(i_ + 2), lane); p6a_load8(S, rV, lane * 16, en); \
                    __builtin_amdgcn_sched_barrier(0); } while (0)
#pragma unroll 1
                for (int i = -2; i < nd; i += 2) { P6B_VSTEP(S0, i); P6B_VSTEP(S1, i + 1); }
                p6b_drain2(S0, S1);
            }
#endif
#pragma unroll 1
            for (int t = 0; t < 4; ++t) {
                int lane_e = lane; asm volatile("" : "+v"(lane_e));
                f32x2v yt[8];
                switch (t) {
                    case 0: _Pragma("unroll") for (int i = 0; i < 8; ++i) yt[i] = y2[0][i]; break;
                    case 1: _Pragma("unroll") for (int i = 0; i < 8; ++i) yt[i] = y2[1][i]; break;
                    case 2: _Pragma("unroll") for (int i = 0; i < 8; ++i) yt[i] = y2[2][i]; break;
                    default: _Pragma("unroll") for (int i = 0; i < 8; ++i) yt[i] = y2[3][i]; break;
                }
                const int tok = tokb + sw * 4 + t;
                const int b = (p.tok0 + tok) / SEQ;
                const float* mod = p.MOD + ((size_t)l * BATCH + b) * 6 * D;
                float v[16], gt[16];
                load16c(v, X1 + (size_t)tok * D, lane_e); load16c(gt, mod + 5 * D, lane_e);
#pragma unroll
                for (int i = 0; i < 8; ++i) { v[2 * i] = DN_ALPHA * v[2 * i] + (1.f + gt[2 * i]) * yt[i].x; v[2 * i + 1] = DN_ALPHA * v[2 * i + 1] + (1.f + gt[2 * i + 1]) * yt[i].y; }
                ln16c(v, p.in[23] + l * D, p.in[24] + l * D, lane_e);
                if (DRY) {
#pragma unroll
                    for (int i = 0; i < 16; ++i) asm volatile("" :: "v"(v[i]));
                    continue; }
                store16c(xout + (size_t)tok * D, v, lane_e);
                if (l + 1 < DEPTH) { const float* modn = p.MOD + ((size_t)(l + 1) * BATCH + b) * 6 * D; store_mod16c(p.H + (size_t)tok * D, v, modn, modn + D, lane_e); }
            }
        }
    }
}
#define XB_TMO      128
#define XB_XCNT(j)  (256  + 64 * (j))
#define XB_XSUB(j)  (1280 + 64 * (j))
#define XB_XGEN(j)  (2304 + 64 * (j))
#define XB_TOP      3328
#define XB_TOPGEN   3392
#define XCD_BAR_WORDS 3456
#define XB_SPIN_CAP (1u << 22)
#define LAS __attribute__((address_space(3)))
DI unsigned xb_ld(unsigned* p)              { return __hip_atomic_load(p, __ATOMIC_RELAXED, __HIP_MEMORY_SCOPE_AGENT); }
DI unsigned xb_add(unsigned* p, unsigned v) { return __hip_atomic_fetch_add(p, v, __ATOMIC_RELAXED, __HIP_MEMORY_SCOPE_AGENT); }
DI unsigned xb_xcc_id() { return (unsigned)__builtin_amdgcn_s_getreg((3 << 11) | 20) & 0xFu; }
#define XB_SPIN(cond, bar) do { unsigned _sp = 0; while (cond) { __builtin_amdgcn_s_sleep(1); \
    if ((++_sp & 255u) == 0u) { if (xb_ld(&(bar)[XB_TMO])) break; if (_sp > XB_SPIN_CAP) { atomicAdd(&(bar)[XB_TMO], 1u); break; } } } } while (0)
struct XcdBarrier { unsigned* bar; unsigned x; volatile LAS unsigned* st; };
DI XcdBarrier xcd_barrier_post(unsigned* bar, volatile LAS unsigned* st) {
    XcdBarrier b; b.bar = bar; b.x = xb_xcc_id(); b.st = st;
    if (threadIdx.x == 0) st[2] = xb_add(&bar[XB_XCNT(b.x)], 1u);
    return b;
}
DI void xcd_barrier_complete(unsigned* bar, unsigned x, unsigned& nloc, unsigned& nx) {
    const unsigned G = gridDim.x * gridDim.y * gridDim.z;
    unsigned sum, cnt, mine, sp = 0u;
    for (;;) {
        sum = 0u; cnt = 0u; mine = 0u;
#pragma unroll
        for (unsigned j = 0; j < 16; ++j) { const unsigned c = xb_ld(&bar[XB_XCNT(j)]); sum += c; cnt += (c > 0u) ? 1u : 0u; mine = (j == x) ? c : mine; }
        if (sum == G) break;
        __builtin_amdgcn_s_sleep(1);
        if ((++sp & 255u) == 0u) { if (xb_ld(&bar[XB_TMO])) break; if (sp > XB_SPIN_CAP) { atomicAdd(&bar[XB_TMO], 1u); break; } }
    }
    nloc = mine > 0u ? mine : 1u; nx = cnt > 0u ? cnt : 1u;
}
DI void xcd_barrier(const XcdBarrier& b) {
    asm volatile("s_waitcnt vmcnt(0)" ::: "memory");
    __syncthreads();
    if (threadIdx.x == 0) {
        unsigned* bar = b.bar;
        __builtin_amdgcn_s_waitcnt(0);
        unsigned nloc = b.st[0], nx = b.st[1];
        if (nloc == 0u) { xcd_barrier_complete(bar, b.x, nloc, nx); b.st[0] = nloc; b.st[1] = nx; }
        const unsigned old = xb_add(&bar[XB_XSUB(b.x)], 1u);
        const unsigned gen = old / nloc;
        if (old + 1u == (gen + 1u) * nloc) {
            __builtin_amdgcn_fence(__ATOMIC_RELEASE, "agent");
            asm volatile("s_waitcnt vmcnt(0)" ::: "memory");
            const unsigned og = xb_add(&bar[XB_TOP], 1u);
            const unsigned tg = og / nx;
            if (og + 1u == (tg + 1u) * nx) xb_add(&bar[XB_TOPGEN], 1u);
            else XB_SPIN(xb_ld(&bar[XB_TOPGEN]) == tg, bar);
            __builtin_amdgcn_fence(__ATOMIC_ACQUIRE, "agent");
            xb_add(&bar[XB_XGEN(b.x)], 1u);
            asm volatile("s_waitcnt vmcnt(0)" ::: "memory");
        } else {
            XB_SPIN(xb_ld(&bar[XB_XGEN(b.x)]) == gen, bar);
            __builtin_amdgcn_fence(__ATOMIC_ACQUIRE, "agent");
            asm volatile("s_waitcnt vmcnt(0)" ::: "memory");
        }
    }
    __syncthreads();
}
DI void ada_item(const Params& p, int item, char* lds) {
    int tid_ = threadIdx.x; asm volatile("" : "+v"(tid_)); const int tid = tid_, lane = tid & 63, wv = tid >> 6;
    float* cs = (float*)lds;
    float* part = cs + 4 * D;
    __syncthreads();
    for (int i = tid; i < BATCH * D; i += 256) { const float cv = p.in[1][i]; cs[i] = cv / (1.f + __expf(-cv)); }
    __syncthreads();
    const int col = item * 64 + lane, l = col / (6 * D), j = col % (6 * D);
    const float* w = p.in[2] + (size_t)l * D * 6 * D + j;
    float a0 = 0.f, a1 = 0.f, a2 = 0.f, a3 = 0.f;
#pragma unroll 4
    for (int k = wv * 256; k < wv * 256 + 256; ++k) { const float wk = w[(size_t)k * 6 * D]; a0 += cs[k] * wk; a1 += cs[D + k] * wk; a2 += cs[2 * D + k] * wk; a3 += cs[3 * D + k] * wk; }
    part[(wv * 4 + 0) * 64 + lane] = a0; part[(wv * 4 + 1) * 64 + lane] = a1; part[(wv * 4 + 2) * 64 + lane] = a2; part[(wv * 4 + 3) * 64 + lane] = a3;
    __syncthreads();
    {
        const float s = part[(0 * 4 + wv) * 64 + lane] + part[(1 * 4 + wv) * 64 + lane] + part[(2 * 4 + wv) * 64 + lane] + part[(3 * 4 + wv) * 64 + lane];
        p.MOD[((size_t)l * BATCH + wv) * 6 * D + j] = s + p.in[3][l * 6 * D + j];
    }
}

DI void rope_table_item(const Params& p, int idx) {
    const int pos = idx >> 4, i = idx & 15;
    const float inv = 1.0f / powf(10000.0f, (float)(2 * i) / 32.0f);
    const float ang = (float)pos * inv;
    double fr = (double)ang * 0.15915494309189535;
    fr -= rint(fr);
    const float f = (float)fr;
    p.COS[idx] = __builtin_amdgcn_cosf(f); p.SIN[idx] = __builtin_amdgcn_sinf(f);
}

DI void convert_tables(const Params& p, int l, int bid, int nb) {
    const float* us = p.in[21] + (size_t)l * 16384 * D; const float* vs = p.in[22] + (size_t)l * 16384 * D;
    const size_t n8 = (size_t)16384 * D / 8;
    for (size_t i = (size_t)bid * 256 + threadIdx.x; i < n8; i += (size_t)nb * 256) { cvt8(us, p.Ut, i); cvt8(vs, p.Vt, i); }
}

DI void prologue(const Params& p, char* lds) {
    int tid_ = threadIdx.x; asm volatile("" : "+v"(tid_)); const int tid = tid_, lane = tid & 63, wv = tid >> 6, bid = blockIdx.x, nb = gridDim.x;
    for (int it = bid; it < DEPTH * 6 * D / 64; it += nb) ada_item(p, it, lds);
    __syncthreads();
    float* scr = (float*)(lds + wv * 16384);
    const int n_win = (D / 64) * (WIN_N / 32), n_uq = 4 * 24, n_ukv = 2 * 32, n_wo = 16 * 32, n_pq = 16 * 64, per_l = n_win + n_uq + n_ukv + n_wo + n_pq;
    for (int it = bid * 4 + wv; it < DEPTH * per_l; it += nb * 4) {
        const int l = it / per_l; int r = it % per_l;
        if (r < n_win) { transpose_item(TK_WIN, p.in[4] + (size_t)l * D * D_IN, D_IN, D, WIN_N, p.WinT + (size_t)l * WIN_N * D, nullptr, scr, r, lane); continue; } r -= n_win;
        if (r < n_uq) { transpose_item(TK_WUQ, p.in[6] + (size_t)l * 256 * 768, 768, 256, 768, p.WuqT + (size_t)l * 768 * 256, p.in[5] + l * 256, scr, r, lane); continue; } r -= n_uq;
        if (r < n_ukv) { transpose_item(TK_WUKV, p.in[8] + (size_t)l * 128 * 1024, 1024, 128, 1024, p.WukvT + (size_t)l * 1024 * 128, p.in[7] + l * 128, scr, r, lane); continue; } r -= n_ukv;
        if (r < n_wo) { transpose_item(TK_WO, p.in[16] + (size_t)l * D * D, D, D, D, p.WoT + (size_t)l * D * D, nullptr, scr, r, lane); continue; } r -= n_wo;
        transpose_item(TK_WPQ, p.in[19] + (size_t)l * D * 2048, 2048, D, 2048, p.WpqT + (size_t)l * 2048 * D, nullptr, scr, r, lane);
    }
    for (int it = bid; it < DEPTH * 1028; it += nb) fold_pw_item(p, it / 1028, it % 1028);
    for (size_t i = (size_t)bid * 256 + tid; i < (size_t)DEPTH * 16 * 128 * 128; i += (size_t)nb * 256)
        p.SKp[i] = f2bf(p.in[20][(i & ~(size_t)127) + perm16((int)(i & 127))]);
    for (int i = bid * 256 + tid; i < SEQ * 16; i += nb * 256) rope_table_item(p, i);
    convert_tables_fp8(p, 0, bid, nb);
}

DI void modh_items(const Params& p, int bid, int nb) {
    const size_t n8 = (size_t)p.rows * D / 8;
    for (size_t i = (size_t)bid * 256 + threadIdx.x; i < n8; i += (size_t)nb * 256) {
        const size_t e = i * 8; const int row = (int)(e >> 10), col = (int)(e & 1023), b = row / SEQ;
        const float* mod = p.MOD + (size_t)b * 6 * D;
        const float4 x0 = *(const float4*)(p.in[0] + e), x1 = *(const float4*)(p.in[0] + e + 4);
        const float4 h0 = *(const float4*)(mod + col), h1 = *(const float4*)(mod + col + 4), s0 = *(const float4*)(mod + D + col), s1 = *(const float4*)(mod + D + col + 4);
        u32x4 o;
        o.x = pk2(x0.x * (1.f + s0.x) + h0.x, x0.y * (1.f + s0.y) + h0.y); o.y = pk2(x0.z * (1.f + s0.z) + h0.z, x0.w * (1.f + s0.w) + h0.w);
        o.z = pk2(x1.x * (1.f + s1.x) + h1.x, x1.y * (1.f + s1.y) + h1.y); o.w = pk2(x1.z * (1.f + s1.z) + h1.z, x1.w * (1.f + s1.w) + h1.w);
        *(u32x4*)(p.H + e) = o;
    }
}

#ifndef REP_P1
#define REP_P1 1
#endif
#ifndef REP_P2
#define REP_P2 1
#endif
#ifndef REP_P3
#define REP_P3 1
#endif
#ifndef REP_P4
#define REP_P4 1
#endif
#ifndef REP_P5
#define REP_P5 1
#endif
#ifndef REP_SYNC
#define REP_SYNC 1
#endif
typedef const __attribute__((address_space(4))) Params* kparams_t;
#define LOADP(q) const Params& q = p
#define GSYNC() do { for (int rs_ = 0; rs_ < REP_SYNC; ++rs_) { XcdBarrier xb_; xb_.bar = p.ctr + 4096; xb_.x = xb_xcc_id(); xb_.st = (volatile LAS unsigned*)(lds + LDS_TOTAL - 32); xcd_barrier(xb_); } } while (0)
__global__ void __launch_bounds__(256, 2) mega(Params p) {
    extern __shared__ __attribute__((aligned(16))) char lds[];
    cg::grid_group grid = cg::this_grid();
#define bid ((int)blockIdx.x)
#define nb ((int)gridDim.x)
#define rows NTOK
#define mtiles (NTOK / 128)
    {
        if (threadIdx.x < 4) ((volatile LAS unsigned*)(lds + LDS_TOTAL - 32))[threadIdx.x] = 0u;
        __syncthreads();
    }
    (void)xcd_barrier_post(p.ctr + 4096, (volatile LAS unsigned*)(lds + LDS_TOTAL - 32));
#ifndef REP_PRO
#define REP_PRO 1
#endif
    for (int rep = 0; rep < REP_PRO; ++rep) prologue(p, lds);
    grid.sync();
#ifndef REP_MODH
#define REP_MODH 1
#endif
    for (int rep = 0; rep < REP_MODH; ++rep) modh_items(p, bid, nb);
    GSYNC();
    for (int l = 0; l < DEPTH; ++l) {
        { LOADP(q);
        for (int rep = 0; rep < REP_P1; ++rep) for (int t = bid; t < mtiles * 12; t += nb) p1_tile(q, l, t, lds);
        if (l > 0) convert_tables_fp8(q, l, bid, nb);
        }
        GSYNC();
        { LOADP(q);
        for (int rep = 0; rep < REP_P2; ++rep) for (int t = bid; t < mtiles * 14; t += nb) { if (t < mtiles * 6) p2q_tile(q, l, t, lds); else p2kv_tile(q, l, t - mtiles * 6, lds); }
        }
        GSYNC();
        { LOADP(q);
        {
            const int nbt = rows / SEQ, nmla = nbt * 8 * 64, nswa = nbt * 4 * 64, nconv = rows / 32, ntot = nmla + nswa + nconv;
            int* su = (int*)(lds + LDS_TOTAL - 16);
            for (int rep = 0; rep < REP_P3; ++rep) { unsigned* ctr = q.ctr + l * 64 + rep * 16;
            for (;;) {
                __syncthreads();
                if (threadIdx.x == 0) *su = (int)atomicAdd(ctr, 1u);
                __syncthreads();
                const int u = *su;
                if (u >= ntot) break;
                if (u < nmla) mla_unit(q, u, lds);
                else if (u < nmla + nswa) swa_unit(q, l, u - nmla, lds);
                else conv_unit(q, l, u - nmla - nswa, lds);
            } }
        }
        }
        GSYNC();
        { LOADP(q);
        for (int rep = 0; rep < REP_P4; ++rep) for (int t = bid; t < mtiles * 8; t += nb) p4_tile(q, l, t, (l == 0) ? q.in[0] : q.XB, q.out, lds);
        }
        GSYNC();
        { LOADP(q);
        { int t_ = threadIdx.x; asm volatile("" : "+v"(t_)); const int wv = t_ >> 6, lane = t_ & 63; for (int r = bid * 4 + wv; r < rows; r += nb * 4) p4b_row(q, l, r, q.out, lane); }
        }
        GSYNC();
        { LOADP(q);
        for (int rep = 0; rep < REP_P5; ++rep) for (int t = bid; t < mtiles * 16; t += nb) p5_tile(q, l, t, lds);
        }
        GSYNC();
        { LOADP(q);
        {
            volatile LAS unsigned* cw = (volatile LAS unsigned*)(lds + LDS_TOTAL - 32);
            if (threadIdx.x == 0) { unsigned pre = 0u; const unsigned myx = xb_xcc_id(); unsigned* bar_ = q.ctr + 4096; for (unsigned j = 0; j < myx; ++j) pre += xb_ld(&bar_[XB_XCNT(j)]); cw[3] = pre + cw[2]; }
            __syncthreads();
            const int slot = (int)cw[3], per = rows / nb;
            if (per * nb == rows && (per & 31) == 0) {
#ifdef REP_P6
                for (int rep = 1; rep < REP_P6; ++rep) p6a_block<true>(q, l, slot * per, per, q.out, (l + 1 < DEPTH) ? q.XB : q.out, lds);
#endif
                p6a_block<false>(q, l, slot * per, per, q.out, (l + 1 < DEPTH) ? q.XB : q.out, lds); }
            else for (int u = bid; u < rows / 32; u += nb) p6f_unit(q, l, u, q.out, (l + 1 < DEPTH) ? q.XB : q.out, lds);
        }
        }
        if (l + 1 < DEPTH) GSYNC();
    }
}

#undef bid
#undef nb
#undef rows
#undef mtiles
extern "C" void kernel_launch(void* const* d_in, const int* in_sizes, int n_in, void* d_out, int out_size, void* d_ws, size_t ws_size, hipStream_t stream) {
    const size_t MiB = 1u << 20;
    char* ws = (char*)d_ws;
    Params P{};
    for (int i = 0; i < 25; ++i) P.in[i] = (const float*)d_in[i];
    P.out = (float*)d_out; P.rows = NTOK; P.tok0 = 0;
    size_t o = 0;
    auto take = [&](size_t mib) { char* r = ws + o; o += mib * MiB; return r; };
    char* ctl = take(1);
    P.ctr = (unsigned*)ctl; P.biasO = (float*)(ctl + 64 * 1024); P.MOD = (float*)(ctl + 128 * 1024);
    P.COS = (float*)take(1); P.SIN = P.COS + SEQ * 16;
    P.WinT = (bf16*)take(6); P.WuqT = (bf16*)take(1); P.WukvT = (bf16*)take(1); P.WoT = (bf16*)take(4); P.WpqT = (bf16*)take(8); P.SKp = (bf16*)take(1);
    P.U8 = (unsigned char*)take(16); P.V8 = (unsigned char*)take(16); P.US = (float*)take(1); P.VS = P.US + DEPTH * 16384;
    P.H = (bf16*)take(64); P.MIXIN = P.H;
    P.PROJ = (bf16*)take(80); P.Q = (bf16*)take(48); P.TOPK = (unsigned*)P.Q;
    P.KN = (bf16*)take(32); P.KR = (bf16*)take(2); P.VT = (bf16*)take(32); P.VsT = (bf16*)take(8);
    P.XB = (float*)take(128);
    if (o > ws_size) { fprintf(stderr, "kernel_launch: workspace too small: need %zu, have %zu\n", o, ws_size); return; }
    static int grid_blocks = 0;
    if (!grid_blocks) {
        int dev = 0, cus = 0, per_cu = 0;
        (void)hipGetDevice(&dev);
        (void)hipDeviceGetAttribute(&cus, hipDeviceAttributeMultiprocessorCount, dev);
        (void)hipFuncSetAttribute((const void*)mega, hipFuncAttributeMaxDynamicSharedMemorySize, LDS_TOTAL);
        (void)hipOccupancyMaxActiveBlocksPerMultiprocessor(&per_cu, mega, 256, LDS_TOTAL);
        if (per_cu > 2) per_cu = 2;
        if (per_cu < 1) per_cu = 1;
        grid_blocks = cus * per_cu;
    }
    (void)hipMemsetAsync(ctl, 0, 32768, stream);
    void* args[] = {(void*)&P};
    hipError_t e = hipLaunchCooperativeKernel((void*)mega, dim3(grid_blocks), dim3(256), args, LDS_TOTAL, stream);
    if (e != hipSuccess) fprintf(stderr, "cooperative launch failed: %s (grid %d)\n", hipGetErrorString(e), grid_blocks);
}
```

```cpp
#include <hip/hip_runtime.h>
#include <hip/hip_cooperative_groups.h>
#include <cstdio>
#include <cstdint>
namespace cg = cooperative_groups;

constexpr int D = 1024, BATCH = 4, SEQ = 8192, DEPTH = 2, NTOK = BATCH * SEQ;
constexpr int D_IN = 1440;
constexpr int OFF_CQ = 0, OFF_CKV = 256, OFF_KR = 384, OFF_CONV = 416, OFF_QS = 928, OFF_KS = 1184, OFF_VS = 1312;
constexpr float EPS = 1e-6f;
constexpr float DN_ALPHA = 1.41421356237309515f;

typedef __attribute__((ext_vector_type(8))) short bf16x8;
typedef __attribute__((ext_vector_type(16))) float f32x16;
typedef __attribute__((ext_vector_type(4))) unsigned u32x4;
typedef __attribute__((ext_vector_type(2))) unsigned u32x2;
typedef float f32x2_t __attribute__((ext_vector_type(2)));
typedef __bf16 bf16x2_t __attribute__((ext_vector_type(2)));
typedef unsigned short bf16;
#define DI __device__ __forceinline__
#define MFMA32(a, b, c) __builtin_amdgcn_mfma_f32_32x32x16_bf16((a), (b), (c), 0, 0, 0)

DI unsigned pk2(float lo, float hi) { f32x2_t v = {lo, hi}; bf16x2_t b = __builtin_convertvector(v, bf16x2_t); return __builtin_bit_cast(unsigned, b); }
DI bf16 f2bf(float f) { return (bf16)(pk2(f, 0.f) & 0xffffu); }
DI float bf2f(bf16 b) { return __uint_as_float((unsigned)b << 16); }
typedef float f32x2v __attribute__((ext_vector_type(2)));
DI float bflo(unsigned u) { return __uint_as_float(u << 16); }
DI float bfhi(unsigned u) { return __uint_as_float(u & 0xffff0000u); }
DI int crow(int reg, int hh) { return (reg & 3) + 8 * (reg >> 2) + 4 * hh; }
DI int cperm_lin(int rho) { return 16 * ((rho >> 2) & 1) + (rho & 3) + 4 * (rho >> 3); }
DI int cperm_rope(int rho) { int hh = (rho >> 2) & 1, reg = (rho & 3) + 4 * (rho >> 3); return (reg < 8) ? 8 * hh + reg : 16 + 8 * hh + (reg - 8); }
DI int perm16(int p) { int g = (p >> 2) & 3; g = (g == 1) ? 2 : (g == 2) ? 1 : g; return (p & ~15) | (g << 2) | (p & 3); }

constexpr float LOG2E = 1.4426950408889634f;
constexpr int PROJ_LD = 1280;
constexpr int WIN_N = 1536;
constexpr int TS = 144;
constexpr int TILE_B = 128 * TS;
constexpr int STAGE_B = 2 * TILE_B;
constexpr int LDS_BYTES = 2 * STAGE_B;

struct Params {
    const float* in[25];
    float* out;
    bf16 *WinT, *WuqT, *WukvT, *WoT, *WpqT, *SKp, *Ut, *Vt;
    float* biasO;
    float* MOD;
    float* COS; float* SIN;
    bf16 *H, *PROJ, *Q, *KN, *KR, *VT, *VsT, *MIXIN;
    float* XB;
    unsigned* TOPK;
    float* STATS;
    unsigned char *U8, *V8; float *US, *VS;
    unsigned* ctr;
    int rows;
    int tok0;
};

enum { TK_WIN = 0, TK_WUQ = 1, TK_WUKV = 2, TK_WO = 3, TK_WPQ = 4 };
DI void transpose_item(int kind, const float* W, int ldin, int K, int Nout, bf16* WT, const float* rowscale, float* scr, int item, int lane) {
    const int nblk = Nout / 32, kb = item / nblk, nb = item % nblk, k0 = 64 * kb, n0 = 32 * nb;
    int src0 = n0; float cs = 1.f;
    if (kind == TK_WIN) {
        if (n0 < 384) src0 = n0;
        else if (n0 < 896) src0 = 416 + (n0 - 384);
        else if (n0 < 1152) { src0 = 928 + (n0 - 896); cs = 0.125f * LOG2E; }
        else if (n0 < 1280) src0 = 1184 + (n0 - 1152);
        else if (n0 < 1408) src0 = 1312 + (n0 - 1280);
        else if (n0 < 1440) src0 = 384 + (n0 - 1408);
        else src0 = -1;
    } else if (kind == TK_WUQ) cs = 0.10206207261596577f * LOG2E;
#pragma unroll
    for (int i = 0; i < 32; ++i) {
        const int kk = 2 * i + (lane >> 5);
        float v = (src0 >= 0) ? W[(size_t)(k0 + kk) * ldin + src0 + (lane & 31)] : 0.f;
        if (rowscale) v *= rowscale[k0 + kk];
        scr[kk * 33 + (lane & 31)] = v * cs;
    }
    __builtin_amdgcn_s_waitcnt(0xc07f); asm volatile("" ::: "memory");
    const int c = lane & 7;
#pragma unroll
    for (int j = 0; j < 4; ++j) {
        const int n = (lane >> 3) + 8 * j; const float* s = scr + (8 * c) * 33 + n;
        u32x4 o; o.x = pk2(s[0], s[33]); o.y = pk2(s[66], s[99]); o.z = pk2(s[132], s[165]); o.w = pk2(s[198], s[231]);
        if (!(kind == TK_WO && k0 + 8 * c >= 512 && k0 + 8 * c < 768))
            *(u32x4*)(WT + (size_t)(n0 + n) * K + k0 + 8 * c) = o;
    }
    __builtin_amdgcn_s_waitcnt(0xc07f); asm volatile("" ::: "memory");
}

DI void cvt8(const float* src, bf16* dst, size_t i8) {
    const float4 a = ((const float4*)src)[2 * i8], b = ((const float4*)src)[2 * i8 + 1];
    u32x4 o; o.x = pk2(a.x, a.y); o.y = pk2(a.z, a.w); o.z = pk2(b.x, b.y); o.w = pk2(b.z, b.w);
    ((u32x4*)dst)[i8] = o;
}

struct TileRegs { u32x4 v[4]; };
DI void gload_tile(TileRegs& t, const bf16* base, int ld, int k0, int tid) {
#pragma unroll
    for (int i = 0; i < 4; ++i) { const int q = tid + 256 * i, row = q >> 3, kc = q & 7; t.v[i] = *(const u32x4*)(base + (size_t)row * ld + k0 + kc * 8); }
}
DI void sstore_tile(const TileRegs& t, char* lds, int tid) {
#pragma unroll
    for (int i = 0; i < 4; ++i) { const int q = tid + 256 * i, row = q >> 3, kc = q & 7; *(u32x4*)(lds + row * TS + kc * 16) = t.v[i]; }
}
template <int NF, int NG>
DI void gemm_core2(const bf16* A, int lda, const bf16* W, int ldw, int K, char* lds, f32x16 (&acc)[NF][NG], int fo, const int (&frow)[NF], int go, const int (&grow)[NG]) {
    int tid_ = threadIdx.x; asm volatile("" : "+v"(tid_)); const int tid = tid_, hh = (tid & 63) >> 5;
    const int nk = K / 64;
    TileRegs ta0, tw0, ta1, tw1;
    gload_tile(ta0, A, lda, 0, tid); gload_tile(tw0, W, ldw, 0, tid);
    gload_tile(ta1, A, lda, 64, tid); gload_tile(tw1, W, ldw, 64, tid);
    __syncthreads();
    sstore_tile(ta0, lds, tid); sstore_tile(tw0, lds + TILE_B, tid);
    if (2 < nk) { gload_tile(ta0, A, lda, 128, tid); gload_tile(tw0, W, ldw, 128, tid); }
    __syncthreads();
#define GEMM_STEP(KS, TA, TW, TAN, TWN) do { \
        char* cur = lds + ((KS) & 1) * STAGE_B; \
        _Pragma("unroll") for (int kk = 0; kk < 4; ++kk) { \
            bf16x8 f[NF], g[NG]; \
            _Pragma("unroll") for (int x = 0; x < NF; ++x) f[x] = *(const bf16x8*)(cur + fo + frow[x] * TS + kk * 32 + hh * 16); \
            _Pragma("unroll") for (int y = 0; y < NG; ++y) g[y] = *(const bf16x8*)(cur + go + grow[y] * TS + kk * 32 + hh * 16); \
            _Pragma("unroll") for (int x = 0; x < NF; ++x) _Pragma("unroll") for (int y = 0; y < NG; ++y) acc[x][y] = MFMA32(f[x], g[y], acc[x][y]); } \
        if ((KS) + 1 < nk) { char* nxt = lds + (((KS) + 1) & 1) * STAGE_B; sstore_tile(TAN, nxt, tid); sstore_tile(TWN, nxt + TILE_B, tid); \
            if ((KS) + 3 < nk) { gload_tile(TAN, A, lda, ((KS) + 3) * 64, tid); gload_tile(TWN, W, ldw, ((KS) + 3) * 64, tid); } } \
        __syncthreads(); } while (0)
    for (int ks = 0; ks < nk; ks += 2) { GEMM_STEP(ks, ta0, tw0, ta1, tw1); GEMM_STEP(ks + 1, ta1, tw1, ta0, tw0); }
#undef GEMM_STEP
}

template <int NF, int NG>
DI void gemm_core(const bf16* A, int lda, const bf16* W, int ldw, int K, char* lds, f32x16 (&acc)[NF][NG], int fo, const int (&frow)[NF], int go, const int (&grow)[NG]) {
    int tid_ = threadIdx.x; asm volatile("" : "+v"(tid_)); const int tid = tid_, hh = (tid & 63) >> 5;
    TileRegs ta, tw;
    gload_tile(ta, A, lda, 0, tid); gload_tile(tw, W, ldw, 0, tid);
    __syncthreads();
    sstore_tile(ta, lds, tid); sstore_tile(tw, lds + TILE_B, tid);
    __syncthreads();
    const int nk = K / 64;
    for (int ks = 0; ks < nk; ++ks) {
        char* cur = lds + (ks & 1) * STAGE_B;
        if (ks + 1 < nk) { gload_tile(ta, A, lda, (ks + 1) * 64, tid); gload_tile(tw, W, ldw, (ks + 1) * 64, tid); }
#pragma unroll
        for (int kk = 0; kk < 4; ++kk) {
            bf16x8 f[NF], g[NG];
#pragma unroll
            for (int x = 0; x < NF; ++x) f[x] = *(const bf16x8*)(cur + fo + frow[x] * TS + kk * 32 + hh * 16);
#pragma unroll
            for (int y = 0; y < NG; ++y) g[y] = *(const bf16x8*)(cur + go + grow[y] * TS + kk * 32 + hh * 16);
#pragma unroll
            for (int x = 0; x < NF; ++x)
#pragma unroll
                for (int y = 0; y < NG; ++y) acc[x][y] = MFMA32(f[x], g[y], acc[x][y]);
        }
        if (ks + 1 < nk) { char* nxt = lds + ((ks + 1) & 1) * STAGE_B; sstore_tile(ta, nxt, tid); sstore_tile(tw, nxt + TILE_B, tid); }
        __syncthreads();
    }
}

#define LAS3 __attribute__((address_space(3)))
constexpr int GT = 128 * 128;
DI void glds_tile(const bf16* base, int ld, int k0, char* tile, int wv, int lane) {
#pragma unroll
    for (int i = 0; i < 4; ++i) {
        const int row0 = 32 * wv + 8 * i, rr = lane >> 3;
        const bf16* src = base + (size_t)(row0 + rr) * ld + k0 + (((lane & 7) ^ rr) << 3);
        __builtin_amdgcn_global_load_lds((const void*)src, (LAS3 void*)(tile + row0 * 128), 16, 0, 0);
    }
}
template <int NF, int NG>
DI void gemm_core3(const bf16* A, int lda, const bf16* W, int ldw, int K, char* lds, f32x16 (&acc)[NF][NG], int fo, const int (&frow)[NF], int go, const int (&grow)[NG]) {
    int tid_ = threadIdx.x; asm volatile("" : "+v"(tid_)); const int tid = tid_, lane = tid & 63, hh = lane >> 5;
    const int wv = __builtin_amdgcn_readfirstlane(tid >> 6);
    const int nk = K / 64;
    const int fof = fo ? GT : 0, gof = go ? GT : 0;
    int foff[NF], goff[NG], fsw[NF], gsw[NG];
#pragma unroll
    for (int x = 0; x < NF; ++x) { foff[x] = fof + frow[x] * 128; fsw[x] = frow[x] & 7; }
#pragma unroll
    for (int y = 0; y < NG; ++y) { goff[y] = gof + grow[y] * 128; gsw[y] = grow[y] & 7; }
    __syncthreads();
    glds_tile(A, lda, 0, lds, wv, lane); glds_tile(W, ldw, 0, lds + GT, wv, lane);
    __syncthreads();
    for (int ks = 0; ks < nk; ++ks) {
        char* cur = lds + (ks & 1) * (2 * GT);
        if (ks + 1 < nk) { char* nxt = lds + ((ks + 1) & 1) * (2 * GT); glds_tile(A, lda, (ks + 1) * 64, nxt, wv, lane); glds_tile(W, ldw, (ks + 1) * 64, nxt + GT, wv, lane); }
#pragma unroll
        for (int kk = 0; kk < 4; ++kk) {
            bf16x8 f[NF], g[NG];
#pragma unroll
            for (int x = 0; x < NF; ++x) f[x] = *(const bf16x8*)(cur + foff[x] + ((((kk << 1) | hh) ^ fsw[x]) << 4));
#pragma unroll
            for (int y = 0; y < NG; ++y) g[y] = *(const bf16x8*)(cur + goff[y] + ((((kk << 1) | hh) ^ gsw[y]) << 4));
#pragma unroll
            for (int x = 0; x < NF; ++x)
#pragma unroll
                for (int y = 0; y < NG; ++y) acc[x][y] = MFMA32(f[x], g[y], acc[x][y]);
        }
        __syncthreads();
    }
}

#ifndef GEMM_CORE
#define GEMM_CORE gemm_core3
#endif
template <int NF, int NG> DI void zero_acc(f32x16 (&acc)[NF][NG]) {
#pragma unroll
    for (int x = 0; x < NF; ++x)
#pragma unroll
        for (int y = 0; y < NG; ++y)
#pragma unroll
            for (int r = 0; r < 16; ++r) acc[x][y][r] = 0.f;
}

DI void store16(bf16* dst, const float* v) {
    u32x4 a, b;
    a.x = pk2(v[0], v[1]); a.y = pk2(v[2], v[3]); a.z = pk2(v[4], v[5]); a.w = pk2(v[6], v[7]);
    b.x = pk2(v[8], v[9]); b.y = pk2(v[10], v[11]); b.z = pk2(v[12], v[13]); b.w = pk2(v[14], v[15]);
    *(u32x4*)dst = a; *(u32x4*)(dst + 8) = b;
}
DI void store8(bf16* dst, const float* v) {
    u32x4 a; a.x = pk2(v[0], v[1]); a.y = pk2(v[2], v[3]); a.z = pk2(v[4], v[5]); a.w = pk2(v[6], v[7]);
    *(u32x4*)dst = a;
}
DI void store_vt(bf16* dst, const f32x16& a, int hh) {
    float v0[8], v1[8];
#pragma unroll
    for (int i = 0; i < 8; ++i) { v0[i] = a[i]; v1[i] = a[8 + i]; }
    store8(dst + 8 * hh, v0); store8(dst + 16 + 8 * hh, v1);
}

DI void p1_tile(const Params& p, int l, int tile, char* lds) {
    int tid_ = threadIdx.x; asm volatile("" : "+v"(tid_)); const int tid = tid_, lane = tid & 63, r = lane & 31, hh = lane >> 5;
    const int wv = __builtin_amdgcn_readfirstlane(tid >> 6), wm = wv >> 1, wn = wv & 1;
    const int mt = tile / 12, nt = tile % 12, m0 = mt * 128, n0 = nt * 128;
    const bf16* A = p.H + (size_t)m0 * D;
    const bf16* W = p.WinT + ((size_t)l * WIN_N + n0) * D;
    f32x16 acc[2][2]; zero_acc(acc);
    int frow[2], grow[2];
    const bool kr = (nt == 11);
    int fo, go;
    if (nt == 10) { fo = 0; go = TILE_B; frow[0] = 64 * wm + r; frow[1] = frow[0] + 32; grow[0] = 64 * wn + r; grow[1] = grow[0] + 32; }
    else { fo = TILE_B; go = 0; frow[0] = 64 * wn + (kr ? cperm_rope(r) : cperm_lin(r)); frow[1] = 64 * wn + 32 + cperm_lin(r); grow[0] = 64 * wm + r; grow[1] = grow[0] + 32; }
    GEMM_CORE<2, 2>(A, D, W, D, D, lds, acc, fo, frow, go, grow);
    if (nt == 10) {
#pragma unroll
        for (int x = 0; x < 2; ++x)
#pragma unroll
            for (int y = 0; y < 2; ++y) {
                const int tok = m0 + 64 * wm + 32 * x, b = tok / SEQ, s0 = tok % SEQ, d = 32 * y + r;
                store_vt(p.VsT + ((size_t)(b * 2 + wn) * 64 + d) * SEQ + s0, acc[x][y], hh);
            }
    } else {
        if (!kr) {
#pragma unroll
            for (int x = 0; x < 2; ++x)
#pragma unroll
                for (int y = 0; y < 2; ++y) {
                    const int tok = m0 + 64 * wm + 32 * y + r, col = n0 + 64 * wn + 32 * x + 16 * hh;
                    float v[16];
#pragma unroll
                    for (int i = 0; i < 16; ++i) v[i] = acc[x][y][i];
                    store16(p.PROJ + (size_t)tok * PROJ_LD + col, v);
                }
        } else if (wn == 0) {
#pragma unroll
            for (int y = 0; y < 2; ++y) {
                const int tok = m0 + 64 * wm + 32 * y + r, pos = tok % SEQ;
                const float4 c0 = *(const float4*)(p.COS + pos * 16 + 8 * hh), c1 = *(const float4*)(p.COS + pos * 16 + 8 * hh + 4);
                const float4 s0 = *(const float4*)(p.SIN + pos * 16 + 8 * hh), s1 = *(const float4*)(p.SIN + pos * 16 + 8 * hh + 4);
                const float cs[8] = {c0.x, c0.y, c0.z, c0.w, c1.x, c1.y, c1.z, c1.w}, sn[8] = {s0.x, s0.y, s0.z, s0.w, s1.x, s1.y, s1.z, s1.w};
                float o1[8], o2[8];
#pragma unroll
                for (int i = 0; i < 8; ++i) { const float t1 = acc[0][y][i], t2 = acc[0][y][8 + i]; o1[i] = t1 * cs[i] - t2 * sn[i]; o2[i] = t1 * sn[i] + t2 * cs[i]; }
                store8(p.KR + (size_t)tok * 32 + 8 * hh, o1); store8(p.KR + (size_t)tok * 32 + 16 + 8 * hh, o2);
            }
        }
    }
}
constexpr int LDS_RS_OFF = LDS_BYTES;
constexpr int LDS_TOTAL = LDS_BYTES + 1024;

template <int W> DI void row_rms(const bf16* A, int lda, float* rs, int tid) {
    const int row = tid >> 1, half = tid & 1;
    const u32x4* p = (const u32x4*)(A + (size_t)row * lda + half * (W / 2));
    float ss = 0.f;
#pragma unroll
    for (int i = 0; i < W / 16; ++i) { const u32x4 v = p[i];
        ss += bflo(v.x) * bflo(v.x) + bfhi(v.x) * bfhi(v.x) + bflo(v.y) * bflo(v.y) + bfhi(v.y) * bfhi(v.y)
            + bflo(v.z) * bflo(v.z) + bfhi(v.z) * bfhi(v.z) + bflo(v.w) * bflo(v.w) + bfhi(v.w) * bfhi(v.w); }
    ss += __shfl_xor(ss, 1);
    if (half == 0) rs[row] = rsqrtf(ss * (1.f / W) + EPS);
}

DI void p2q_tile(const Params& p, int l, int tile, char* lds) {
    int tid_ = threadIdx.x; asm volatile("" : "+v"(tid_)); const int tid = tid_, lane = tid & 63, r = lane & 31, hh = lane >> 5;
    const int wv = __builtin_amdgcn_readfirstlane(tid >> 6), wm = wv >> 1, wn = wv & 1;
    const int mt = tile / 6, nt = tile % 6, m0 = mt * 128, n0 = nt * 128;
    const bf16* A = p.PROJ + (size_t)m0 * PROJ_LD;
    const bf16* W = p.WuqT + ((size_t)l * 768 + n0) * 256;
    float* rs = (float*)(lds + LDS_RS_OFF);
    __syncthreads();
    row_rms<256>(A, PROJ_LD, rs, tid);
    f32x16 acc[2][2]; zero_acc(acc);
    int frow[2], grow[2]; bool rope[2];
#pragma unroll
    for (int x = 0; x < 2; ++x) { rope[x] = (((n0 + 64 * wn + 32 * x) >> 5) % 3) == 2; frow[x] = 64 * wn + 32 * x + (rope[x] ? cperm_rope(r) : cperm_lin(r)); }
    grow[0] = 64 * wm + r; grow[1] = grow[0] + 32;
    GEMM_CORE<2, 2>(A, PROJ_LD, W, 256, 256, lds, acc, TILE_B, frow, 0, grow);
#pragma unroll
    for (int y = 0; y < 2; ++y) {
        const int tl = 64 * wm + 32 * y + r, tok = m0 + tl, pos = tok % SEQ;
        const float sc = rs[tl];
#pragma unroll
        for (int x = 0; x < 2; ++x) {
            bf16* dst = p.Q + (size_t)tok * 768 + n0 + 64 * wn + 32 * x;
            if (rope[x]) {
                const float4 c0 = *(const float4*)(p.COS + pos * 16 + 8 * hh), c1 = *(const float4*)(p.COS + pos * 16 + 8 * hh + 4);
                const float4 s0 = *(const float4*)(p.SIN + pos * 16 + 8 * hh), s1 = *(const float4*)(p.SIN + pos * 16 + 8 * hh + 4);
                const float cs[8] = {c0.x, c0.y, c0.z, c0.w, c1.x, c1.y, c1.z, c1.w}, sn[8] = {s0.x, s0.y, s0.z, s0.w, s1.x, s1.y, s1.z, s1.w};
                float o1[8], o2[8];
#pragma unroll
                for (int i = 0; i < 8; ++i) { const float t1 = acc[x][y][i] * sc, t2 = acc[x][y][8 + i] * sc; o1[i] = t1 * cs[i] - t2 * sn[i]; o2[i] = t1 * sn[i] + t2 * cs[i]; }
                store8(dst + 8 * hh, o1); store8(dst + 16 + 8 * hh, o2);
            } else {
                float v[16];
#pragma unroll
                for (int i = 0; i < 16; ++i) v[i] = acc[x][y][i] * sc;
                store16(dst + 16 * hh, v);
            }
        }
    }
}

DI void p2kv_tile(const Params& p, int l, int tile, char* lds) {
    int tid_ = threadIdx.x; asm volatile("" : "+v"(tid_)); const int tid = tid_, lane = tid & 63, r = lane & 31, hh = lane >> 5;
    const int wv = __builtin_amdgcn_readfirstlane(tid >> 6), wm = wv >> 1, wn = wv & 1;
    const int mt = tile >> 3, h = tile & 7, m0 = mt * 128, n0 = h * 128;
    const bf16* A = p.PROJ + (size_t)m0 * PROJ_LD + 256;
    const bf16* W = p.WukvT + ((size_t)l * 1024 + n0) * 128;
    float* rs = (float*)(lds + LDS_RS_OFF);
    __syncthreads();
    row_rms<128>(A, PROJ_LD, rs, tid);
    f32x16 acc[2][2]; zero_acc(acc);
    int frow[2], grow[2];
    int fo, go;
    if (wn == 0) { fo = TILE_B; go = 0; frow[0] = cperm_lin(r); frow[1] = 32 + cperm_lin(r); grow[0] = 64 * wm + r; grow[1] = grow[0] + 32; }
    else         { fo = 0; go = TILE_B; frow[0] = 64 * wm + r; frow[1] = frow[0] + 32; grow[0] = 64 + r; grow[1] = 96 + r; }
    GEMM_CORE<2, 2>(A, PROJ_LD, W, 128, 128, lds, acc, fo, frow, go, grow);
    if (wn == 0) {
#pragma unroll
        for (int y = 0; y < 2; ++y) {
            const int tl = 64 * wm + 32 * y + r, tok = m0 + tl; const float sc = rs[tl];
#pragma unroll
            for (int x = 0; x < 2; ++x) {
                float v[16];
#pragma unroll
                for (int i = 0; i < 16; ++i) v[i] = acc[x][y][i] * sc;
                store16(p.KN + (size_t)tok * 512 + h * 64 + 32 * x + 16 * hh, v);
            }
        }
    } else {
#pragma unroll
        for (int x = 0; x < 2; ++x) {
            const int tl0 = 64 * wm + 32 * x, tok0 = m0 + tl0, b = tok0 / SEQ, s0 = tok0 % SEQ;
#pragma unroll
            for (int y = 0; y < 2; ++y) {
                f32x16 a = acc[x][y];
#pragma unroll
                for (int i = 0; i < 16; ++i) a[i] *= rs[tl0 + crow(i, hh)];
                store_vt(p.VT + ((size_t)(b * 8 + h) * 64 + 32 * y + r) * SEQ + s0, a, hh);
            }
        }
    }
}
constexpr int VSTR = 144;
template <int KD> struct AttnCfg { static constexpr int KSTR = KD * 2 + 16; static constexpr int BUF = 64 * KSTR + 64 * VSTR; };

template <int KD, int MODE, int ABL = 0>
DI void attn_unit(const bf16* Qp, int qld, const bf16* K1, int k1ld, const bf16* K2, const bf16* VTp, bf16* Op, int b, int qb, float sink_l2, char* lds) {
    constexpr int KSTR = AttnCfg<KD>::KSTR, BUF = AttnCfg<KD>::BUF, NKS = KD / 16;
    int tid_ = threadIdx.x; asm volatile("" : "+v"(tid_)); const int tid = tid_, lane = tid & 63, r = lane & 31, hh = lane >> 5;
    const int wv = __builtin_amdgcn_readfirstlane(tid >> 6);
    const int q0 = qb * 128, qpos = q0 + 32 * wv + r;
    const size_t rowb = (size_t)b * SEQ;
    bf16x8 qf[NKS];
#pragma unroll
    for (int ks = 0; ks < NKS; ++ks) qf[ks] = *(const bf16x8*)(Qp + (rowb + qpos) * qld + ks * 16 + hh * 8);
#pragma unroll
    for (int ks = 0; ks < NKS; ++ks) asm volatile("" : "+v"(qf[ks]));
    const int kstart = (MODE == 0) ? 0 : (q0 >= 128 ? q0 - 128 : 0);
    const int nt = (q0 + 128 - kstart) / 64;
    f32x16 ot[2];
#pragma unroll
    for (int i = 0; i < 16; ++i) { ot[0][i] = 0.f; ot[1][i] = 0.f; }
    float m = (MODE == 0) ? -INFINITY : sink_l2, l = (MODE == 1 && hh == 0) ? 1.f : 0.f;
    u32x4 sk[3], sv[2];
    auto gload = [&](int t) {
        const int key0 = kstart + 64 * t;
#pragma unroll
        for (int i = 0; i < 2; ++i) { const int q = tid + 256 * i, row = q >> 3, c = q & 7;
            sk[i] = *(const u32x4*)(K1 + (rowb + key0 + row) * k1ld + c * 8);
            sv[i] = *(const u32x4*)(VTp + (size_t)row * SEQ + key0 + c * 8); }
        if (KD == 96) { const int row = tid >> 2, c = tid & 3; sk[2] = *(const u32x4*)(K2 + (rowb + key0 + row) * 32 + c * 8); }
    };
    auto sstore = [&](char* buf) {
#pragma unroll
        for (int i = 0; i < 2; ++i) { const int q = tid + 256 * i, row = q >> 3, c = q & 7;
            *(u32x4*)(buf + row * KSTR + c * 16) = sk[i];
            *(u32x4*)(buf + 64 * KSTR + row * VSTR + c * 16) = sv[i]; }
        if (KD == 96) { const int row = tid >> 2, c = tid & 3; *(u32x4*)(buf + row * KSTR + 128 + c * 16) = sk[2]; }
    };
    gload(0);
    __syncthreads();
    sstore(lds);
    __syncthreads();
    for (int t = 0; t < nt; ++t) {
        const char* cur = lds + (t & 1) * BUF;
        if (!(ABL & 8)) if (t + 1 < nt) gload(t + 1);
        const int key0 = kstart + 64 * t;
        f32x16 st[2];
        bf16x8 kf[2][NKS];
#pragma unroll
        for (int mt = 0; mt < 2; ++mt)
#pragma unroll
            for (int ks = 0; ks < NKS; ++ks) kf[mt][ks] = *(const bf16x8*)(cur + (mt * 32 + r) * KSTR + ks * 32 + hh * 16);
        __builtin_amdgcn_sched_barrier(0);
#pragma unroll
        for (int mt = 0; mt < 2; ++mt) {
#pragma unroll
            for (int i = 0; i < 16; ++i) st[mt][i] = 0.f;
#pragma unroll
            for (int ks = 0; ks < NKS; ++ks) { if (ABL & 2) { asm volatile("" :: "v"(kf[mt][ks])); st[mt][ks] += 1.f; } else st[mt] = MFMA32(kf[mt][ks], qf[ks], st[mt]); }
        }
        const char* vt = cur + 64 * KSTR;
        bf16x8 vf[2][4];
#pragma unroll
        for (int mt = 0; mt < 2; ++mt)
#pragma unroll
            for (int s = 0; s < 4; ++s) vf[mt][s] = *(const bf16x8*)(vt + (mt * 32 + r) * VSTR + s * 32 + hh * 16);
        __builtin_amdgcn_sched_barrier(0);
        const bool need_mask = (MODE == 1) || (key0 + 63 > q0 + 32 * wv);
        if (need_mask) {
#pragma unroll
            for (int mt = 0; mt < 2; ++mt)
#pragma unroll
                for (int i = 0; i < 16; ++i) {
                    const int key = key0 + mt * 32 + crow(i, hh);
                    const bool ok = (MODE == 0) ? (key <= qpos) : (key <= qpos && key > qpos - 128);
                    if (!ok) st[mt][i] = -INFINITY;
                }
        }
        float mx = st[0][0];
#pragma unroll
        for (int i = 1; i < 16; ++i) mx = fmaxf(mx, st[0][i]);
#pragma unroll
        for (int i = 0; i < 16; ++i) mx = fmaxf(mx, st[1][i]);
        { auto rr = __builtin_amdgcn_permlane32_swap(__float_as_uint(mx), __float_as_uint(mx), false, false); mx = fmaxf(__uint_as_float(rr[0]), __uint_as_float(rr[1])); }
        const float mn = fmaxf(m, mx);
        const float alpha = __builtin_amdgcn_exp2f(m - mn);
        m = mn;
        float ps = 0.f;
#pragma unroll
        for (int mt = 0; mt < 2; ++mt)
#pragma unroll
            for (int i = 0; i < 16; ++i) { const float pv = (ABL & 1) ? (st[mt][i] - mn) : __builtin_amdgcn_exp2f(st[mt][i] - mn); st[mt][i] = pv; ps += pv; }
        l = l * alpha + ps;
#pragma unroll
        for (int i = 0; i < 16; ++i) { ot[0][i] *= alpha; ot[1][i] *= alpha; }
        bf16x8 pb[4];
#pragma unroll
        for (int s = 0; s < 4; ++s) {
            const int mt = s >> 1, o = 8 * (s & 1);
            u32x4 w; w.x = pk2(st[mt][o], st[mt][o + 1]); w.y = pk2(st[mt][o + 2], st[mt][o + 3]); w.z = pk2(st[mt][o + 4], st[mt][o + 5]); w.w = pk2(st[mt][o + 6], st[mt][o + 7]);
            pb[s] = __builtin_bit_cast(bf16x8, w);
        }
        __builtin_amdgcn_sched_barrier(0);
#pragma unroll
        for (int mt = 0; mt < 2; ++mt)
#pragma unroll
            for (int s = 0; s < 4; ++s) { if (ABL & 4) { asm volatile("" :: "v"(vf[mt][s]), "v"(pb[s])); ot[mt][s] += 1.f; } else ot[mt] = MFMA32(vf[mt][s], pb[s], ot[mt]); }
        if (!(ABL & 8)) if (t + 1 < nt) sstore(lds + ((t + 1) & 1) * BUF);
        __syncthreads();
    }
    { auto rr = __builtin_amdgcn_permlane32_swap(__float_as_uint(l), __float_as_uint(l), false, false); l = __uint_as_float(rr[0]) + __uint_as_float(rr[1]); }
    const float inv = 1.f / l;
    bf16* orow = Op + (rowb + qpos) * 1024;
#pragma unroll
    for (int mt = 0; mt < 2; ++mt)
#pragma unroll
        for (int g = 0; g < 4; ++g) {
            u32x2 w; w.x = pk2(ot[mt][4 * g] * inv, ot[mt][4 * g + 1] * inv); w.y = pk2(ot[mt][4 * g + 2] * inv, ot[mt][4 * g + 3] * inv);
            *(u32x2*)(orow + mt * 32 + 8 * g + 4 * hh) = w;
        }
}

template <int ABL = 0> DI void mla_unit(const Params& p, int u, char* lds) {
    const int nbh = (p.rows / SEQ) * 8, qb = 63 - u / nbh, bh = u % nbh, b = bh >> 3, h = bh & 7;
    attn_unit<96, 0, ABL>(p.Q + h * 96, 768, p.KN + h * 64, 512, p.KR, p.VT + (size_t)bh * 64 * SEQ, p.MIXIN + h * 64, b, qb, 0.f, lds);
}
DI void swa_unit(const Params& p, int l, int u, char* lds) {
    const int qb = u & 63, bh = u >> 6, b = bh >> 2, hq = bh & 3, kvh = hq >> 1;
    attn_unit<64, 1>(p.PROJ + 896 + hq * 64, PROJ_LD, p.PROJ + 1152 + kvh * 64, PROJ_LD, nullptr, p.VsT + (size_t)(b * 2 + kvh) * 64 * SEQ, p.MIXIN + 768 + hq * 64, b, qb,
                     p.in[15][l * 4 + hq] * LOG2E, lds);
}

DI void conv_unit(const Params& p, int l, int u, char* lds) {
    int tid_ = threadIdx.x; asm volatile("" : "+v"(tid_)); const int tid = tid_, lane = tid & 63, wv = tid >> 6;
    const int tok0 = u * 32, pos0 = tok0 % SEQ;
    bf16* glu = (bf16*)lds;
    float* hc = (float*)(lds + 62 * 512);
    __syncthreads();
    for (int it = tid; it < 62 * 32; it += 256) {
        const int row = it >> 5, c8 = (it & 31) * 8, pos = pos0 - 30 + row;
        u32x4 o = {0u, 0u, 0u, 0u};
        if (pos >= 0) {
            const bf16* src = p.PROJ + (size_t)(tok0 - 30 + row) * PROJ_LD + 384 + c8;
            const u32x4 a = *(const u32x4*)src, g = *(const u32x4*)(src + 256);
            const unsigned av[4] = {a.x, a.y, a.z, a.w}, gv[4] = {g.x, g.y, g.z, g.w}; unsigned ov[4];
#pragma unroll
            for (int i = 0; i < 4; ++i) {
                const float g0 = bflo(gv[i]), g1 = bfhi(gv[i]);
                ov[i] = pk2(bflo(av[i]) / (1.f + __expf(-g0)), bfhi(av[i]) / (1.f + __expf(-g1)));
            }
            o.x = ov[0]; o.y = ov[1]; o.z = ov[2]; o.w = ov[3];
        }
        *(u32x4*)(glu + row * 256 + c8) = o;
    }
    __syncthreads();
    {
        const int c = tid;
        float w[31];
        const float* wd = p.in[9] + (size_t)l * 31 * 256 + c;
#pragma unroll
        for (int k = 0; k < 31; ++k) w[k] = wd[k * 256];
        const float bd = p.in[10][l * 256 + c];
#pragma unroll 1
        for (int ch = 0; ch < 4; ++ch) {
            float g[38], acc[8];
#pragma unroll
            for (int i = 0; i < 38; ++i) g[i] = bf2f(glu[(ch * 8 + i) * 256 + c]);
#pragma unroll
            for (int tt = 0; tt < 8; ++tt) { acc[tt] = bd;
#pragma unroll
                for (int k = 0; k < 31; ++k) acc[tt] += w[k] * g[tt + k]; }
#pragma unroll
            for (int tt = 0; tt < 8; ++tt) hc[(ch * 8 + tt) * 256 + c] = acc[tt];
        }
    }
    __syncthreads();
    {
        const float4 gg = *(const float4*)(p.in[11] + l * 256 + lane * 4), bb = *(const float4*)(p.in[12] + l * 256 + lane * 4);
#pragma unroll 1
        for (int i = 0; i < 8; ++i) {
            const int t = wv * 8 + i;
            const float4 v = *(const float4*)(hc + t * 256 + lane * 4);
            float s = v.x + v.y + v.z + v.w;
#pragma unroll
            for (int o = 1; o < 64; o <<= 1) s += __shfl_xor(s, o);
            const float mean = s * (1.f / 256.f);
            const float d0 = v.x - mean, d1 = v.y - mean, d2 = v.z - mean, d3 = v.w - mean;
            float q = d0 * d0 + d1 * d1 + d2 * d2 + d3 * d3;
#pragma unroll
            for (int o = 1; o < 64; o <<= 1) q += __shfl_xor(q, o);
            const float rstd = rsqrtf(q * (1.f / 256.f) + EPS);
            float y0 = d0 * rstd * gg.x + bb.x, y1 = d1 * rstd * gg.y + bb.y, y2 = d2 * rstd * gg.z + bb.z, y3 = d3 * rstd * gg.w + bb.w;
            y0 = y0 / (1.f + __expf(-y0)); y1 = y1 / (1.f + __expf(-y1)); y2 = y2 / (1.f + __expf(-y2)); y3 = y3 / (1.f + __expf(-y3));
            u32x2 w; w.x = pk2(y0, y1); w.y = pk2(y2, y3);
            *(u32x2*)(p.MIXIN + (size_t)(tok0 + t) * 1024 + 512 + lane * 4) = w;
        }
    }
}

constexpr int MSLOT = 20480, MKR = 8192, MVT = 12288;
DI u32x4 mla_rsrc(const void* base, unsigned bytes) {
    const unsigned long long a = (unsigned long long)base;
    u32x4 r; r.x = __builtin_amdgcn_readfirstlane((unsigned)a); r.y = __builtin_amdgcn_readfirstlane((unsigned)(a >> 32) & 0xffffu); r.z = bytes; r.w = 0x00020000u;
    return r;
}
DI void mla_dma(unsigned m0v, int voff, u32x4 rsrc, unsigned soff) {
    asm volatile("s_nop 4\n\ts_mov_b32 m0, %0\n\ts_nop 0\n\tbuffer_load_dwordx4 %1, %2, %3 offen lds" :: "s"(m0v), "v"(voff), "s"(rsrc), "s"(soff) : "m0", "memory");
}
template <int ABL = 0>
DI void mla_attn_dma(const bf16* Qp, const bf16* Kn, const bf16* Kr, const bf16* VTp, bf16* Op, int b, int qb, char* lds) {
    int tid_ = threadIdx.x; asm volatile("" : "+v"(tid_)); const int tid = tid_, lane = tid & 63, r = lane & 31, hh = lane >> 5;
    const int wv = __builtin_amdgcn_readfirstlane(tid >> 6);
    const int q0 = qb * 128, qpos = q0 + 32 * wv + r;
    const size_t rowb = (size_t)b * SEQ;
    const int nt = (q0 + 128) / 64;
    const u32x4 rKn = mla_rsrc(Kn + rowb * 512, (unsigned)SEQ * 1024u), rKr = mla_rsrc(Kr + rowb * 32, (unsigned)SEQ * 64u), rVt = mla_rsrc(VTp, 64u * (unsigned)SEQ * 2u);
    const int l8 = lane >> 3, l4 = lane >> 2;
    const int vkn = l8 * 1024 + (((lane & 7) ^ l8) << 4), vkr = l4 * 64 + (((lane & 3) ^ ((l4 >> 2) & 3)) << 4), vvt = l8 * (SEQ * 2) + (((lane & 7) ^ l8) << 4);
    const unsigned ldsb = (unsigned)(size_t)(LAS3 char*)lds;
    const unsigned mkn = __builtin_amdgcn_readfirstlane(ldsb + 2048u * wv), mkr = __builtin_amdgcn_readfirstlane(ldsb + MKR + 1024u * wv), mvt = __builtin_amdgcn_readfirstlane(ldsb + MVT + 2048u * wv);
    auto dma = [&](int t, unsigned slot) {
        const unsigned key0 = 64u * t, so = slot * MSLOT;
        const unsigned skn = (key0 + 16u * wv) * 1024u, skr = (key0 + 16u * wv) * 64u, svt = (16u * wv * SEQ + key0) * 2u;
        mla_dma(mkn + so, vkn, rKn, skn); mla_dma(mkn + so + 1024u, vkn, rKn, skn + 8u * 1024u);
        mla_dma(mkr + so, vkr, rKr, skr);
        mla_dma(mvt + so, vvt, rVt, svt); mla_dma(mvt + so + 1024u, vvt, rVt, svt + 8u * SEQ * 2u);
    };
    dma(0, 0); if (nt > 1) dma(1, 1);
    bf16x8 qf[6];
#pragma unroll
    for (int ks = 0; ks < 6; ++ks) qf[ks] = *(const bf16x8*)(Qp + (rowb + qpos) * 768 + ks * 16 + hh * 8);
#pragma unroll
    for (int ks = 0; ks < 6; ++ks) asm volatile("" : "+v"(qf[ks]));
    asm volatile("s_waitcnt vmcnt(0)" ::: "memory");
    __syncthreads();
    f32x16 ot[2];
#pragma unroll
    for (int i = 0; i < 16; ++i) { ot[0][i] = 0.f; ot[1][i] = 0.f; }
    float m = -INFINITY, l = 0.f;
    const int sw7 = r & 7, sw3 = (r >> 2) & 3;
    unsigned slot = 0;
    for (int t = 0; t < nt; ++t) {
        const char* cur = lds + slot * MSLOT;
        const unsigned slot2 = (slot >= 1) ? slot - 1 : 2;
        if (!(ABL & 8)) if (t + 2 < nt) dma(t + 2, slot2);
        const int key0 = 64 * t;
        f32x16 st[2];
        bf16x8 kf[2][6];
#pragma unroll
        for (int mt = 0; mt < 2; ++mt) {
#pragma unroll
            for (int ks = 0; ks < 4; ++ks) kf[mt][ks] = *(const bf16x8*)(cur + (mt * 32 + r) * 128 + ((((ks << 1) | hh) ^ sw7) << 4));
#pragma unroll
            for (int ks = 4; ks < 6; ++ks) kf[mt][ks] = *(const bf16x8*)(cur + MKR + (mt * 32 + r) * 64 + ((((((ks - 4) << 1) | hh)) ^ sw3) << 4));
        }
        __builtin_amdgcn_sched_barrier(0);
#pragma unroll
        for (int mt = 0; mt < 2; ++mt) {
#pragma unroll
            for (int i = 0; i < 16; ++i) st[mt][i] = 0.f;
#pragma unroll
            for (int ks = 0; ks < 6; ++ks) { if (ABL & 2) { asm volatile("" :: "v"(kf[mt][ks])); st[mt][ks] += 1.f; } else st[mt] = MFMA32(kf[mt][ks], qf[ks], st[mt]); }
        }
        const char* vt = cur + MVT;
        bf16x8 vf[2][4];
#pragma unroll
        for (int mt = 0; mt < 2; ++mt)
#pragma unroll
            for (int s = 0; s < 4; ++s) vf[mt][s] = *(const bf16x8*)(vt + (mt * 32 + r) * 128 + ((((s << 1) | hh) ^ sw7) << 4));
        __builtin_amdgcn_sched_barrier(0);
        if (key0 + 63 > q0 + 32 * wv) {
#pragma unroll
            for (int mt = 0; mt < 2; ++mt)
#pragma unroll
                for (int i = 0; i < 16; ++i) { const int key = key0 + mt * 32 + crow(i, hh); if (key > qpos) st[mt][i] = -INFINITY; }
        }
        float mx = st[0][0];
#pragma unroll
        for (int i = 1; i < 16; ++i) mx = fmaxf(mx, st[0][i]);
#pragma unroll
        for (int i = 0; i < 16; ++i) mx = fmaxf(mx, st[1][i]);
        { auto rr = __builtin_amdgcn_permlane32_swap(__float_as_uint(mx), __float_as_uint(mx), false, false); mx = fmaxf(__uint_as_float(rr[0]), __uint_as_float(rr[1])); }
        const float mn = fmaxf(m, mx);
        const float alpha = __builtin_amdgcn_exp2f(m - mn);
        m = mn;
        float ps = 0.f;
#pragma unroll
        for (int mt = 0; mt < 2; ++mt)
#pragma unroll
            for (int i = 0; i < 16; ++i) { const float pv = (ABL & 1) ? (st[mt][i] - mn) : __builtin_amdgcn_exp2f(st[mt][i] - mn); st[mt][i] = pv; ps += pv; }
        l = l * alpha + ps;
#pragma unroll
        for (int i = 0; i < 16; ++i) { ot[0][i] *= alpha; ot[1][i] *= alpha; }
        bf16x8 pb[4];
#pragma unroll
        for (int s = 0; s < 4; ++s) {
            const int mt = s >> 1, o = 8 * (s & 1);
            u32x4 w; w.x = pk2(st[mt][o], st[mt][o + 1]); w.y = pk2(st[mt][o + 2], st[mt][o + 3]); w.z = pk2(st[mt][o + 4], st[mt][o + 5]); w.w = pk2(st[mt][o + 6], st[mt][o + 7]);
            pb[s] = __builtin_bit_cast(bf16x8, w);
        }
        __builtin_amdgcn_sched_barrier(0);
#pragma unroll
        for (int mt = 0; mt < 2; ++mt)
#pragma unroll
            for (int s = 0; s < 4; ++s) { if (ABL & 4) { asm volatile("" :: "v"(vf[mt][s]), "v"(pb[s])); ot[mt][s] += 1.f; } else ot[mt] = MFMA32(vf[mt][s], pb[s], ot[mt]); }
        if (t + 2 < nt && !(ABL & 8)) asm volatile("s_waitcnt vmcnt(5)" ::: "memory"); else asm volatile("s_waitcnt vmcnt(0)" ::: "memory");
        __syncthreads();
        slot = (slot == 2) ? 0 : slot + 1;
    }
    { auto rr = __builtin_amdgcn_permlane32_swap(__float_as_uint(l), __float_as_uint(l), false, false); l = __uint_as_float(rr[0]) + __uint_as_float(rr[1]); }
    const float inv = 1.f / l;
    bf16* orow = Op + (rowb + qpos) * 1024;
#pragma unroll
    for (int mt = 0; mt < 2; ++mt)
#pragma unroll
        for (int g = 0; g < 4; ++g) {
            u32x2 w; w.x = pk2(ot[mt][4 * g] * inv, ot[mt][4 * g + 1] * inv); w.y = pk2(ot[mt][4 * g + 2] * inv, ot[mt][4 * g + 3] * inv);
            *(u32x2*)(orow + mt * 32 + 8 * g + 4 * hh) = w;
        }
}
template <int ABL = 0> DI void mla_unit2(const Params& p, int u, char* lds) {
    const int nbh = (p.rows / SEQ) * 8, qb = 63 - u / nbh, bh = u % nbh, b = bh >> 3, h = bh & 7;
    mla_attn_dma<ABL>(p.Q + h * 96, p.KN + h * 64, p.KR, p.VT + (size_t)bh * 64 * SEQ, p.MIXIN + h * 64, b, qb, lds);
}

constexpr int KSLOT = 12288, VRING = 3 * KSLOT, VSLOT = 8192;
#define SB0() __builtin_amdgcn_sched_barrier(0)
template <int ABL = 0>
DI void mla_attn_pipe(const bf16* Qp, const bf16* Kn, const bf16* Kr, const bf16* VTp, bf16* Op, int b, int qb, char* lds) {
    int tid_ = threadIdx.x; asm volatile("" : "+v"(tid_)); const int tid = tid_, lane = tid & 63, r = lane & 31, hh = lane >> 5;
    const int wv = __builtin_amdgcn_readfirstlane(tid >> 6);
    const int q0 = qb * 128, qpos = q0 + 32 * wv + r;
    const size_t rowb = (size_t)b * SEQ;
    const int nt = (q0 + 128) / 64;
    const u32x4 rKn = mla_rsrc(Kn + rowb * 512, (unsigned)SEQ * 1024u), rKr = mla_rsrc(Kr + rowb * 32, (unsigned)SEQ * 64u), rVt = mla_rsrc(VTp, 64u * (unsigned)SEQ * 2u);
    const int l8 = lane >> 3, l4 = lane >> 2;
    const int vkn = l8 * 1024 + (((lane & 7) ^ l8) << 4), vkr = l4 * 64 + (((lane & 3) ^ ((l4 >> 2) & 3)) << 4), vvt = l8 * (SEQ * 2) + (((lane & 7) ^ l8) << 4);
    const unsigned ldsb = (unsigned)(size_t)(LAS3 char*)lds;
    const unsigned mkn = __builtin_amdgcn_readfirstlane(ldsb + 2048u * wv), mkr = __builtin_amdgcn_readfirstlane(ldsb + 8192u + 1024u * wv), mvt = __builtin_amdgcn_readfirstlane(ldsb + VRING + 2048u * wv);
    auto dmaK = [&](int t, unsigned slot) {
        const unsigned key0 = 64u * t, so = slot * KSLOT;
        const unsigned skn = (key0 + 16u * wv) * 1024u, skr = (key0 + 16u * wv) * 64u;
        mla_dma(mkn + so, vkn, rKn, skn); mla_dma(mkn + so + 1024u, vkn, rKn, skn + 8u * 1024u); mla_dma(mkr + so, vkr, rKr, skr);
    };
    auto dmaV = [&](int t, unsigned slot) {
        const unsigned key0 = 64u * t, so = slot * VSLOT, svt = (16u * wv * SEQ + key0) * 2u;
        mla_dma(mvt + so, vvt, rVt, svt); mla_dma(mvt + so + 1024u, vvt, rVt, svt + 8u * SEQ * 2u);
    };
    dmaK(0, 0); dmaK(1, 1); if (nt > 2) dmaK(2, 2);
    dmaV(0, 0); dmaV(1, 1);
    bf16x8 qf[6];
#pragma unroll
    for (int ks = 0; ks < 6; ++ks) qf[ks] = *(const bf16x8*)(Qp + (rowb + qpos) * 768 + ks * 16 + hh * 8);
#pragma unroll
    for (int ks = 0; ks < 6; ++ks) asm volatile("" : "+v"(qf[ks]));
    asm volatile("s_waitcnt vmcnt(0)" ::: "memory");
    __syncthreads();
    const int sw7 = r & 7, sw3 = (r >> 2) & 3;
    f32x16 ot[2], sA[2], sB[2];
#pragma unroll
    for (int i = 0; i < 16; ++i) { ot[0][i] = 0.f; ot[1][i] = 0.f; }
    float m = -INFINITY, l = 0.f;
#define MLA_KFRAG(KB, MT, KS) (((KS) < 4) ? *(const bf16x8*)((KB) + ((MT) * 32 + r) * 128 + (((((KS) << 1) | hh) ^ sw7) << 4)) \
                                          : *(const bf16x8*)((KB) + 8192 + ((MT) * 32 + r) * 64 + ((((((KS) - 4) << 1) | hh) ^ sw3) << 4)))
#define MLA_MASK(X, T) do { const int key0_ = 64 * (T); if (key0_ + 63 > q0 + 32 * wv) { \
        _Pragma("unroll") for (int mt_ = 0; mt_ < 2; ++mt_) _Pragma("unroll") for (int i_ = 0; i_ < 16; ++i_) { const int key_ = key0_ + mt_ * 32 + crow(i_, hh); if (key_ > qpos) X[mt_][i_] = -INFINITY; } } } while (0)
    float mxc;
    {
        const char* kb = lds;
        bf16x8 kf[2][6];
#pragma unroll
        for (int mt = 0; mt < 2; ++mt)
#pragma unroll
            for (int ks = 0; ks < 6; ++ks) kf[mt][ks] = MLA_KFRAG(kb, mt, ks);
        SB0();
#pragma unroll
        for (int mt = 0; mt < 2; ++mt) {
#pragma unroll
            for (int i = 0; i < 16; ++i) sA[mt][i] = 0.f;
#pragma unroll
            for (int ks = 0; ks < 6; ++ks) sA[mt] = MFMA32(kf[mt][ks], qf[ks], sA[mt]);
        }
        if (nt == 2) MLA_MASK(sA, 0);
        float a = sA[0][0], c = sA[1][0];
#pragma unroll
        for (int i = 1; i < 16; ++i) { a = fmaxf(a, sA[0][i]); c = fmaxf(c, sA[1][i]); }
        mxc = fmaxf(a, c);
    }
#define MLA_SM_HEAD(C) \
        float mx_ = mxc; { auto rr_ = __builtin_amdgcn_permlane32_swap(__float_as_uint(mx_), __float_as_uint(mx_), false, false); mx_ = fmaxf(__uint_as_float(rr_[0]), __uint_as_float(rr_[1])); } \
        const float mn_ = fmaxf(m, mx_); const float alpha_ = __builtin_amdgcn_exp2f(m - mn_); m = mn_; const f32x2v nm2_ = {-mn_, -mn_}; f32x2v ps2_ = {0.f, 0.f};
#define MLA_SM_EXP4(C, MT, I0) do { \
        f32x2v nmp_ = nm2_; asm volatile("" : "+v"(nmp_)); \
        f32x2v x0_ = (f32x2v){C[MT][I0], C[MT][(I0) + 1]} + nmp_, x1_ = (f32x2v){C[MT][(I0) + 2], C[MT][(I0) + 3]} + nmp_; \
        if (!(ABL & 1)) { x0_.x = __builtin_amdgcn_exp2f(x0_.x); x0_.y = __builtin_amdgcn_exp2f(x0_.y); x1_.x = __builtin_amdgcn_exp2f(x1_.x); x1_.y = __builtin_amdgcn_exp2f(x1_.y); } \
        ps2_ += x0_; ps2_ += x1_; asm volatile("" : "+v"(x0_), "+v"(x1_), "+v"(ps2_)); \
        C[MT][I0] = x0_.x; C[MT][(I0) + 1] = x0_.y; C[MT][(I0) + 2] = x1_.x; C[MT][(I0) + 3] = x1_.y; } while (0)
#define MLA_SM_TAIL(C) \
        l = l * alpha_ + (ps2_.x + ps2_.y); \
        _Pragma("unroll") for (int i_ = 0; i_ < 16; ++i_) { ot[0][i_] *= alpha_; ot[1][i_] *= alpha_; } \
        bf16x8 pb[4]; \
        _Pragma("unroll") for (int s_ = 0; s_ < 4; ++s_) { const int mt_ = s_ >> 1, o_ = 8 * (s_ & 1); \
            u32x4 w_; w_.x = pk2(C[mt_][o_], C[mt_][o_ + 1]); w_.y = pk2(C[mt_][o_ + 2], C[mt_][o_ + 3]); w_.z = pk2(C[mt_][o_ + 4], C[mt_][o_ + 5]); w_.w = pk2(C[mt_][o_ + 6], C[mt_][o_ + 7]); \
            pb[s_] = __builtin_bit_cast(bf16x8, w_); }
#define MLA_STEP(C, N, T) do { const int t_ = (T); \
        if (!(ABL & 8)) { if (t_ + 3 < nt) dmaK(t_ + 3, ks0); if (t_ + 2 < nt) dmaV(t_ + 2, vs2); } \
        const char* kb_ = lds + ks1 * KSLOT; const char* vb_ = lds + VRING + vs0 * VSLOT; \
        bf16x8 kf_[2][6], vf_[2][4], pb[4]; \
        _Pragma("unroll") for (int ks_ = 0; ks_ < 6; ++ks_) kf_[0][ks_] = MLA_KFRAG(kb_, 0, ks_); \
        MLA_SM_HEAD(C) \
        _Pragma("unroll") for (int i_ = 0; i_ < 16; ++i_) { N[0][i_] = 0.f; N[1][i_] = 0.f; } \
        SB0(); \
        _Pragma("unroll") for (int s_ = 0; s_ < 12; ++s_) { \
            if (s_ < 6) { N[0] = MFMA32(kf_[0][s_], qf[s_], N[0]); kf_[1][s_] = MLA_KFRAG(kb_, 1, s_); } \
            else { N[1] = MFMA32(kf_[1][s_ - 6], qf[s_ - 6], N[1]); \
                   if (s_ < 10) { const int g_ = s_ - 6; vf_[0][g_] = *(const bf16x8*)(vb_ + r * 128 + ((((g_ << 1) | hh) ^ sw7) << 4)); vf_[1][g_] = *(const bf16x8*)(vb_ + (32 + r) * 128 + ((((g_ << 1) | hh) ^ sw7) << 4)); } } \
            if (s_ < 8) { MLA_SM_EXP4(C, (s_ >> 2), 4 * (s_ & 3)); if (s_ == 7) l = l * alpha_ + (ps2_.x + ps2_.y); } \
            else { const int j_ = s_ - 8, mt_ = j_ >> 1, o_ = 8 * (j_ & 1); float al_ = alpha_; asm volatile("" : "+v"(al_)); \
                _Pragma("unroll") for (int i_ = 4 * j_; i_ < 4 * j_ + 4; ++i_) { ot[0][i_] *= al_; ot[1][i_] *= al_; } \
                u32x4 w_; w_.x = pk2(C[mt_][o_], C[mt_][o_ + 1]); w_.y = pk2(C[mt_][o_ + 2], C[mt_][o_ + 3]); w_.z = pk2(C[mt_][o_ + 4], C[mt_][o_ + 5]); w_.w = pk2(C[mt_][o_ + 6], C[mt_][o_ + 7]); \
                asm volatile("" : "+v"(w_)); pb[j_] = __builtin_bit_cast(bf16x8, w_); } \
            SB0(); } \
        if (t_ + 1 >= nt - 2) MLA_MASK(N, t_ + 1); \
        SB0(); \
        float a_ = N[0][0], c_ = N[1][0]; \
        _Pragma("unroll") for (int s_ = 0; s_ < 4; ++s_) { \
            ot[0] = MFMA32(vf_[0][s_], pb[s_], ot[0]); \
            _Pragma("unroll") for (int i_ = 4 * s_; i_ < 4 * s_ + 4; ++i_) { if (i_ > 0) a_ = fmaxf(a_, N[0][i_]); } \
            asm volatile("" : "+v"(a_)); SB0(); \
            ot[1] = MFMA32(vf_[1][s_], pb[s_], ot[1]); \
            _Pragma("unroll") for (int i_ = 4 * s_; i_ < 4 * s_ + 4; ++i_) { if (i_ > 0) c_ = fmaxf(c_, N[1][i_]); } \
            asm volatile("" : "+v"(c_)); SB0(); } \
        mxc = fmaxf(a_, c_); \
        if (ABL & 8) asm volatile("s_waitcnt vmcnt(0)" ::: "memory"); \
        else if (t_ + 3 < nt) asm volatile("s_waitcnt vmcnt(5)" ::: "memory"); else if (t_ + 2 < nt) asm volatile("s_waitcnt vmcnt(2)" ::: "memory"); else asm volatile("s_waitcnt vmcnt(0)" ::: "memory"); \
        __syncthreads(); \
        ks0 = (ks0 == 2) ? 0 : ks0 + 1; ks1 = (ks1 == 2) ? 0 : ks1 + 1; vs0 = (vs0 == 2) ? 0 : vs0 + 1; vs2 = (vs2 == 2) ? 0 : vs2 + 1; } while (0)
    unsigned ks0 = 0, ks1 = 1, vs0 = 0, vs2 = 2;
    for (int t = 0; t + 2 < nt; t += 2) { MLA_STEP(sA, sB, t); MLA_STEP(sB, sA, t + 1); }
    MLA_STEP(sA, sB, nt - 2);
    {
        const char* vb_ = lds + VRING + vs0 * VSLOT;
        bf16x8 vf_[2][4];
#pragma unroll
        for (int mt = 0; mt < 2; ++mt)
#pragma unroll
            for (int s = 0; s < 4; ++s) vf_[mt][s] = *(const bf16x8*)(vb_ + (mt * 32 + r) * 128 + ((((s << 1) | hh) ^ sw7) << 4));
        MLA_SM_HEAD(sB)
#pragma unroll
        for (int g = 0; g < 4; ++g) { MLA_SM_EXP4(sB, 0, 4 * g); MLA_SM_EXP4(sB, 1, 4 * g); }
        MLA_SM_TAIL(sB)
#pragma unroll
        for (int mt = 0; mt < 2; ++mt)
#pragma unroll
            for (int s = 0; s < 4; ++s) ot[mt] = MFMA32(vf_[mt][s], pb[s], ot[mt]);
    }
#undef MLA_STEP
    { auto rr = __builtin_amdgcn_permlane32_swap(__float_as_uint(l), __float_as_uint(l), false, false); l = __uint_as_float(rr[0]) + __uint_as_float(rr[1]); }
    const float inv = 1.f / l;
    bf16* orow = Op + (rowb + qpos) * 1024;
#pragma unroll
    for (int mt = 0; mt < 2; ++mt)
#pragma unroll
        for (int g = 0; g < 4; ++g) {
            u32x2 w; w.x = pk2(ot[mt][4 * g] * inv, ot[mt][4 * g + 1] * inv); w.y = pk2(ot[mt][4 * g + 2] * inv, ot[mt][4 * g + 3] * inv);
            *(u32x2*)(orow + mt * 32 + 8 * g + 4 * hh) = w;
        }
}
template <int ABL = 0> DI void mla_unit3(const Params& p, int u, char* lds) {
    if (ABL & 32) return;
    const int nbh = (p.rows / SEQ) * 8, qb = 63 - u / nbh, bh = u % nbh, b = bh >> 3, h = bh & 7;
    mla_attn_pipe<ABL>(p.Q + h * 96, p.KN + h * 64, p.KR, p.VT + (size_t)bh * 64 * SEQ, p.MIXIN + h * 64, b, qb, lds);
}

constexpr float MLA_THR = 8.f;
template <int ABL = 0>
DI void mla_attn_pipe2(const bf16* Qp, const bf16* Kn, const bf16* Kr, const bf16* VTp, bf16* Op, int b, int qb, char* lds) {
    int tid_ = threadIdx.x; asm volatile("" : "+v"(tid_)); const int tid = tid_, lane = tid & 63, r = lane & 31, hh = lane >> 5;
    const int wv = __builtin_amdgcn_readfirstlane(tid >> 6);
    const int q0 = qb * 128, qpos = q0 + 32 * wv + r;
    const size_t rowb = (size_t)b * SEQ;
    const int nt = (q0 + 128) / 64;
    const u32x4 rKn = mla_rsrc(Kn + rowb * 512, (unsigned)SEQ * 1024u), rKr = mla_rsrc(Kr + rowb * 32, (unsigned)SEQ * 64u), rVt = mla_rsrc(VTp, 64u * (unsigned)SEQ * 2u);
    const int l8 = lane >> 3, l4 = lane >> 2;
    const int vkn = l8 * 1024 + (((lane & 7) ^ l8) << 4), vkr = l4 * 64 + (((lane & 3) ^ ((l4 >> 2) & 3)) << 4), vvt = l8 * (SEQ * 2) + (((lane & 7) ^ l8) << 4);
    const unsigned ldsb = (unsigned)(size_t)(LAS3 char*)lds;
    const unsigned mkn = __builtin_amdgcn_readfirstlane(ldsb + 2048u * wv), mkr = __builtin_amdgcn_readfirstlane(ldsb + 8192u + 1024u * wv), mvt = __builtin_amdgcn_readfirstlane(ldsb + VRING + 2048u * wv);
    auto dmaK = [&](int t, unsigned slot) {
        const unsigned key0 = 64u * t, so = slot * KSLOT;
        const unsigned skn = (key0 + 16u * wv) * 1024u, skr = (key0 + 16u * wv) * 64u;
        mla_dma(mkn + so, vkn, rKn, skn); mla_dma(mkn + so + 1024u, vkn, rKn, skn + 8u * 1024u); mla_dma(mkr + so, vkr, rKr, skr);
    };
    auto dmaV = [&](int t, unsigned slot) {
        const unsigned key0 = 64u * t, so = slot * VSLOT, svt = (16u * wv * SEQ + key0) * 2u;
        mla_dma(mvt + so, vvt, rVt, svt); mla_dma(mvt + so + 1024u, vvt, rVt, svt + 8u * SEQ * 2u);
    };
    dmaK(0, 0); dmaK(1, 1); if (nt > 2) dmaK(2, 2);
    dmaV(0, 0); dmaV(1, 1);
    bf16x8 qf[6];
#pragma unroll
    for (int ks = 0; ks < 6; ++ks) qf[ks] = *(const bf16x8*)(Qp + (rowb + qpos) * 768 + ks * 16 + hh * 8);
#pragma unroll
    for (int ks = 0; ks < 6; ++ks) asm volatile("" : "+v"(qf[ks]));
    asm volatile("s_waitcnt vmcnt(0)" ::: "memory");
    __syncthreads();
    const int sw7 = r & 7, sw3 = (r >> 2) & 3;
    f32x16 ot[2], lacc, sA[2], sB[2];
#pragma unroll
    for (int i = 0; i < 16; ++i) { ot[0][i] = 0.f; ot[1][i] = 0.f; lacc[i] = 0.f; }
    float m = -INFINITY;
    bf16x8 ones; { u32x4 o_; o_.x = 0x3F803F80u; o_.y = o_.x; o_.z = o_.x; o_.w = o_.x; asm volatile("" : "+v"(o_)); ones = __builtin_bit_cast(bf16x8, o_); }
    float mxc;
    {
        const char* kb = lds;
        bf16x8 kf[2][6];
#pragma unroll
        for (int mt = 0; mt < 2; ++mt)
#pragma unroll
            for (int ks = 0; ks < 6; ++ks) kf[mt][ks] = MLA_KFRAG(kb, mt, ks);
        SB0();
#pragma unroll
        for (int mt = 0; mt < 2; ++mt) {
#pragma unroll
            for (int i = 0; i < 16; ++i) sA[mt][i] = 0.f;
#pragma unroll
            for (int ks = 0; ks < 6; ++ks) sA[mt] = MFMA32(kf[mt][ks], qf[ks], sA[mt]);
        }
        if (nt == 2) MLA_MASK(sA, 0);
        float a = sA[0][0], c = sA[1][0];
#pragma unroll
        for (int i = 1; i < 16; ++i) { a = fmaxf(a, sA[0][i]); c = fmaxf(c, sA[1][i]); }
        mxc = fmaxf(a, c);
    }
#define MLB_HEAD() \
        { float mx_ = mxc; { auto rr_ = __builtin_amdgcn_permlane32_swap(__float_as_uint(mx_), __float_as_uint(mx_), false, false); mx_ = fmaxf(__uint_as_float(rr_[0]), __uint_as_float(rr_[1])); } \
          const bool upd_ = mx_ > m + MLA_THR; \
          if (__builtin_amdgcn_ballot_w64(upd_) != 0ull) { \
              const float mn_ = upd_ ? mx_ : m; const float alpha_ = __builtin_amdgcn_exp2f(m - mn_); m = mn_; \
              _Pragma("unroll") for (int i_ = 0; i_ < 16; ++i_) { ot[0][i_] *= alpha_; ot[1][i_] *= alpha_; lacc[i_] *= alpha_; } } }
#define MLB_EXP4(C, MT, I0) do { \
        float mp_ = m; asm volatile("" : "+v"(mp_)); \
        float x0_ = C[MT][I0] - mp_, x1_ = C[MT][(I0) + 1] - mp_, x2_ = C[MT][(I0) + 2] - mp_, x3_ = C[MT][(I0) + 3] - mp_; \
        if (!(ABL & 1)) { x0_ = __builtin_amdgcn_exp2f(x0_); x1_ = __builtin_amdgcn_exp2f(x1_); x2_ = __builtin_amdgcn_exp2f(x2_); x3_ = __builtin_amdgcn_exp2f(x3_); } \
        asm volatile("" : "+v"(x0_), "+v"(x1_), "+v"(x2_), "+v"(x3_)); \
        C[MT][I0] = x0_; C[MT][(I0) + 1] = x1_; C[MT][(I0) + 2] = x2_; C[MT][(I0) + 3] = x3_; } while (0)
#define MLB_PACK(C, J, PB) do { const int mt_ = (J) >> 1, o_ = 8 * ((J) & 1); \
        u32x4 w_; w_.x = pk2(C[mt_][o_], C[mt_][o_ + 1]); w_.y = pk2(C[mt_][o_ + 2], C[mt_][o_ + 3]); w_.z = pk2(C[mt_][o_ + 4], C[mt_][o_ + 5]); w_.w = pk2(C[mt_][o_ + 6], C[mt_][o_ + 7]); \
        asm volatile("" : "+v"(w_)); PB[J] = __builtin_bit_cast(bf16x8, w_); } while (0)
#define MLB_STEP(C, N, T) do { const int t_ = (T); \
        if (!(ABL & 8)) { if (t_ + 3 < nt) dmaK(t_ + 3, ks0); if (t_ + 2 < nt) dmaV(t_ + 2, vs2); } \
        const char* kb_ = lds + ks1 * KSLOT; const char* vb_ = lds + VRING + vs0 * VSLOT; \
        bf16x8 kf_[2][6], vf_[2][4], pb[4]; \
        _Pragma("unroll") for (int ks_ = 0; ks_ < 6; ++ks_) kf_[0][ks_] = MLA_KFRAG(kb_, 0, ks_); \
        MLB_HEAD() \
        _Pragma("unroll") for (int i_ = 0; i_ < 16; ++i_) { N[0][i_] = 0.f; N[1][i_] = 0.f; } \
        SB0(); \
        _Pragma("unroll") for (int s_ = 0; s_ < 12; ++s_) { \
            if (s_ < 6) { N[0] = MFMA32(kf_[0][s_], qf[s_], N[0]); kf_[1][s_] = MLA_KFRAG(kb_, 1, s_); } \
            else { N[1] = MFMA32(kf_[1][s_ - 6], qf[s_ - 6], N[1]); \
                   if (s_ < 10) { const int g_ = s_ - 6; vf_[0][g_] = *(const bf16x8*)(vb_ + r * 128 + ((((g_ << 1) | hh) ^ sw7) << 4)); vf_[1][g_] = *(const bf16x8*)(vb_ + (32 + r) * 128 + ((((g_ << 1) | hh) ^ sw7) << 4)); } } \
            if (s_ < 8) MLB_EXP4(C, (s_ >> 2), 4 * (s_ & 3)); else MLB_PACK(C, s_ - 8, pb); \
            SB0(); } \
        if (t_ + 1 >= nt - 2) MLA_MASK(N, t_ + 1); \
        SB0(); \
        float a_ = N[0][0], c_ = N[1][0]; \
        _Pragma("unroll") for (int s_ = 0; s_ < 4; ++s_) { \
            ot[0] = MFMA32(vf_[0][s_], pb[s_], ot[0]); \
            _Pragma("unroll") for (int i_ = 4 * s_; i_ < 4 * s_ + 3; ++i_) { if (i_ > 0) a_ = fmaxf(a_, N[0][i_]); } \
            asm volatile("" : "+v"(a_)); SB0(); \
            ot[1] = MFMA32(vf_[1][s_], pb[s_], ot[1]); \
            _Pragma("unroll") for (int i_ = 4 * s_; i_ < 4 * s_ + 3; ++i_) { if (i_ > 0) c_ = fmaxf(c_, N[1][i_]); } \
            asm volatile("" : "+v"(c_)); SB0(); \
            lacc = MFMA32(ones, pb[s_], lacc); \
            a_ = fmaxf(a_, N[0][4 * s_ + 3]); c_ = fmaxf(c_, N[1][4 * s_ + 3]); \
            asm volatile("" : "+v"(a_), "+v"(c_)); SB0(); } \
        mxc = fmaxf(a_, c_); \
        if (ABL & 8) asm volatile("s_waitcnt vmcnt(0)" ::: "memory"); \
        else if (t_ + 3 < nt) asm volatile("s_waitcnt vmcnt(5)" ::: "memory"); else if (t_ + 2 < nt) asm volatile("s_waitcnt vmcnt(2)" ::: "memory"); else asm volatile("s_waitcnt vmcnt(0)" ::: "memory"); \
        __syncthreads(); \
        ks0 = (ks0 == 2) ? 0 : ks0 + 1; ks1 = (ks1 == 2) ? 0 : ks1 + 1; vs0 = (vs0 == 2) ? 0 : vs0 + 1; vs2 = (vs2 == 2) ? 0 : vs2 + 1; } while (0)
    unsigned ks0 = 0, ks1 = 1, vs0 = 0, vs2 = 2;
    for (int t = 0; t + 2 < nt; t += 2) { MLB_STEP(sA, sB, t); MLB_STEP(sB, sA, t + 1); }
    MLB_STEP(sA, sB, nt - 2);
    {
        const char* vb_ = lds + VRING + vs0 * VSLOT;
        bf16x8 vf_[2][4], pb[4];
#pragma unroll
        for (int mt = 0; mt < 2; ++mt)
#pragma unroll
            for (int s = 0; s < 4; ++s) vf_[mt][s] = *(const bf16x8*)(vb_ + (mt * 32 + r) * 128 + ((((s << 1) | hh) ^ sw7) << 4));
        MLB_HEAD()
#pragma unroll
        for (int g = 0; g < 4; ++g) { MLB_EXP4(sB, 0, 4 * g); MLB_EXP4(sB, 1, 4 * g); }
#pragma unroll
        for (int j = 0; j < 4; ++j) MLB_PACK(sB, j, pb);
#pragma unroll
        for (int s = 0; s < 4; ++s) { ot[0] = MFMA32(vf_[0][s], pb[s], ot[0]); ot[1] = MFMA32(vf_[1][s], pb[s], ot[1]); lacc = MFMA32(ones, pb[s], lacc); }
    }
#undef MLB_STEP
    const float inv = 1.f / lacc[0];
    bf16* orow = Op + (rowb + qpos) * 1024;
#pragma unroll
    for (int mt = 0; mt < 2; ++mt)
#pragma unroll
        for (int g = 0; g < 4; ++g) {
            u32x2 w; w.x = pk2(ot[mt][4 * g] * inv, ot[mt][4 * g + 1] * inv); w.y = pk2(ot[mt][4 * g + 2] * inv, ot[mt][4 * g + 3] * inv);
            *(u32x2*)(orow + mt * 32 + 8 * g + 4 * hh) = w;
        }
}
template <int ABL = 0> DI void mla_unit4(const Params& p, int u, char* lds) {
    if (ABL & 32) return;
    const int nbh = (p.rows / SEQ) * 8, qb = 63 - u / nbh, bh = u % nbh, b = bh >> 3, h = bh & 7;
    mla_attn_pipe2<ABL>(p.Q + h * 96, p.KN + h * 64, p.KR, p.VT + (size_t)bh * 64 * SEQ, p.MIXIN + h * 64, b, qb, lds);
}
DI void fold_pw_item(const Params& p, int l, int item) {
    const int tid = threadIdx.x;
    const float* wo = p.in[16] + (size_t)l * D * D + (size_t)512 * D;
    if (item < 1024) {
        const int kp = item >> 2, n = (item & 3) * 256 + tid;
        const float* wp = p.in[13] + (size_t)l * 256 * 256 + (size_t)kp * 256;
        float acc = 0.f;
        for (int j = 0; j < 256; ++j) acc += wp[j] * wo[(size_t)j * D + n];
        p.WoT[((size_t)l * D + n) * D + 512 + kp] = f2bf(acc);
    } else {
        const int n = (item - 1024) * 256 + tid;
        const float* bp = p.in[14] + l * 256;
        float acc = 0.f;
        for (int j = 0; j < 256; ++j) acc += bp[j] * wo[(size_t)j * D + n];
        p.biasO[l * D + n] = acc;
    }
}

DI void p4_tile(const Params& p, int l, int tile, const float* xin, float* X1, char* lds) {
    int tid_ = threadIdx.x; asm volatile("" : "+v"(tid_)); const int tid = tid_, lane = tid & 63, r = lane & 31, hh = lane >> 5;
    const int wv = __builtin_amdgcn_readfirstlane(tid >> 6), wm = wv >> 1, wn = wv & 1;
    const int mt = tile >> 3, nt = tile & 7, m0 = mt * 128, n0 = nt * 128;
    const bf16* A = p.MIXIN + (size_t)m0 * D;
    const bf16* W = p.WoT + ((size_t)l * D + n0) * D;
    f32x16 acc[2][2]; zero_acc(acc);
    int frow[2], grow[2];
    frow[0] = 64 * wm + r; frow[1] = frow[0] + 32; grow[0] = 64 * wn + r; grow[1] = grow[0] + 32;
    GEMM_CORE<2, 2>(A, D, W, D, D, lds, acc, 0, frow, TILE_B, grow);
    const int b = (p.tok0 + m0) / SEQ;
    const float* gt = p.MOD + ((size_t)l * BATCH + b) * 6 * D + 2 * D;
#pragma unroll
    for (int y = 0; y < 2; ++y) {
        const int col = n0 + 64 * wn + 32 * y + r;
        const float g1 = 1.f + gt[col], bo = p.biasO[l * D + col];
#pragma unroll
        for (int x = 0; x < 2; ++x) {
            const size_t base = (size_t)(m0 + 64 * wm + 32 * x + 4 * hh) * D + col;
            float xv[16];
#pragma unroll
            for (int i = 0; i < 16; ++i) xv[i] = xin[base + (size_t)((i & 3) + 8 * (i >> 2)) * D];
#pragma unroll
            for (int i = 0; i < 16; ++i) X1[base + (size_t)((i & 3) + 8 * (i >> 2)) * D] = DN_ALPHA * xv[i] + g1 * (acc[x][y][i] + bo);
        }
    }
}

DI void ln16(float (&v)[16], const float* g, const float* bta, int lane) {
    float s = 0.f;
#pragma unroll
    for (int i = 0; i < 16; ++i) s += v[i];
#pragma unroll
    for (int o = 1; o < 64; o <<= 1) s += __shfl_xor(s, o);
    const float mean = s * (1.f / D); float q = 0.f;
#pragma unroll
    for (int i = 0; i < 16; ++i) { v[i] -= mean; q += v[i] * v[i]; }
#pragma unroll
    for (int o = 1; o < 64; o <<= 1) q += __shfl_xor(q, o);
    const float rstd = rsqrtf(q * (1.f / D) + EPS);
#pragma unroll
    for (int hf = 0; hf < 2; ++hf)
#pragma unroll
        for (int q4 = 0; q4 < 2; ++q4) {
            const int c = hf * 512 + lane * 8 + q4 * 4;
            const float4 gg = *(const float4*)(g + c), bb = *(const float4*)(bta + c);
            const int i = hf * 8 + q4 * 4;
            v[i] = v[i] * rstd * gg.x + bb.x; v[i + 1] = v[i + 1] * rstd * gg.y + bb.y; v[i + 2] = v[i + 2] * rstd * gg.z + bb.z; v[i + 3] = v[i + 3] * rstd * gg.w + bb.w;
        }
}
DI void load16(float (&v)[16], const float* row, int lane) {
#pragma unroll
    for (int hf = 0; hf < 2; ++hf)
#pragma unroll
        for (int q4 = 0; q4 < 2; ++q4) { const float4 t = *(const float4*)(row + hf * 512 + lane * 8 + q4 * 4); const int i = hf * 8 + q4 * 4; v[i] = t.x; v[i + 1] = t.y; v[i + 2] = t.z; v[i + 3] = t.w; }
}
DI void store16f(float* row, const float (&v)[16], int lane) {
#pragma unroll
    for (int hf = 0; hf < 2; ++hf)
#pragma unroll
        for (int q4 = 0; q4 < 2; ++q4) { const int i = hf * 8 + q4 * 4; *(float4*)(row + hf * 512 + lane * 8 + q4 * 4) = make_float4(v[i], v[i + 1], v[i + 2], v[i + 3]); }
}
DI void store_mod16(bf16* hrow, const float (&v)[16], const float* sh, const float* sc, int lane) {
#pragma unroll
    for (int hf = 0; hf < 2; ++hf) {
        float o[8];
#pragma unroll
        for (int q4 = 0; q4 < 2; ++q4) {
            const int c = hf * 512 + lane * 8 + q4 * 4, i = hf * 8 + q4 * 4;
            const float4 s4 = *(const float4*)(sc + c), h4 = *(const float4*)(sh + c);
            o[q4 * 4] = v[i] * (1.f + s4.x) + h4.x; o[q4 * 4 + 1] = v[i + 1] * (1.f + s4.y) + h4.y; o[q4 * 4 + 2] = v[i + 2] * (1.f + s4.z) + h4.z; o[q4 * 4 + 3] = v[i + 3] * (1.f + s4.w) + h4.w;
        }
        store8(hrow + hf * 512 + lane * 8, o);
    }
}
DI void p4b_row(const Params& p, int l, int row, float* X1, int lane) {
    float v[16];
    load16(v, X1 + (size_t)row * D, lane);
    float s = 0.f;
#pragma unroll
    for (int i = 0; i < 16; ++i) s += v[i];
#pragma unroll
    for (int o = 1; o < 64; o <<= 1) s += __shfl_xor(s, o);
    const float mean = s * (1.f / D); float q = 0.f;
#pragma unroll
    for (int i = 0; i < 16; ++i) { v[i] -= mean; q += v[i] * v[i]; }
#pragma unroll
    for (int o = 1; o < 64; o <<= 1) q += __shfl_xor(q, o);
    const float rstd = rsqrtf(q * (1.f / D) + EPS);
    if (lane == 0) { p.STATS[2 * (size_t)row] = mean; p.STATS[2 * (size_t)row + 1] = rstd; }
    const float* g = p.in[17] + l * D; const float* bta = p.in[18] + l * D;
#pragma unroll
    for (int hf = 0; hf < 2; ++hf)
#pragma unroll
        for (int q4 = 0; q4 < 2; ++q4) {
            const int c = hf * 512 + lane * 8 + q4 * 4;
            const float4 gg = *(const float4*)(g + c), bb = *(const float4*)(bta + c);
            const int i = hf * 8 + q4 * 4;
            v[i] = v[i] * rstd * gg.x + bb.x; v[i + 1] = v[i + 1] * rstd * gg.y + bb.y; v[i + 2] = v[i + 2] * rstd * gg.z + bb.z; v[i + 3] = v[i + 3] * rstd * gg.w + bb.w;
        }
    const int b = (p.tok0 + row) / SEQ;
    const float* mod = p.MOD + ((size_t)l * BATCH + b) * 6 * D;
    store_mod16(p.H + (size_t)row * D, v, mod + 3 * D, mod + 4 * D, lane);
}

DI unsigned ford(float f) { const unsigned u = __float_as_uint(f); return u ^ ((u >> 31) ? 0xffffffffu : 0x80000000u); }
DI float funord(unsigned o) { const unsigned u = o ^ ((o >> 31) ? 0x80000000u : 0xffffffffu); return __uint_as_float(u); }
constexpr int SKSTR = 272;

DI void p5_tile(const Params& p, int l, int tile, char* lds) {
    int tid_ = threadIdx.x; asm volatile("" : "+v"(tid_)); const int tid = tid_, lane = tid & 63, r = lane & 31, hh = lane >> 5;
    const int wv = __builtin_amdgcn_readfirstlane(tid >> 6);
    const int mt = tile >> 4, hp = tile & 15, m0 = mt * 128;
    const bf16* A = p.H + (size_t)m0 * D;
    const bf16* W = p.WpqT + ((size_t)l * 2048 + hp * 128) * D;
    f32x16 acc[4][1]; zero_acc(acc);
    int frow[4], grow[1];
#pragma unroll
    for (int x = 0; x < 4; ++x) frow[x] = 32 * x + r;
    grow[0] = 32 * wv + r;
    GEMM_CORE<4, 1>(A, D, W, D, D, lds, acc, TILE_B, frow, 0, grow);
    bf16x8 xb[8];
#pragma unroll
    for (int s = 0; s < 8; ++s) {
        const int x = s >> 1, o = 8 * (s & 1);
        u32x4 w; w.x = pk2(acc[x][0][o], acc[x][0][o + 1]); w.y = pk2(acc[x][0][o + 2], acc[x][0][o + 3]); w.z = pk2(acc[x][0][o + 4], acc[x][0][o + 5]); w.w = pk2(acc[x][0][o + 6], acc[x][0][o + 7]);
        xb[s] = __builtin_bit_cast(bf16x8, w);
    }
    const bf16* sk = p.SKp + ((size_t)l * 16 + hp) * 128 * 128;
#pragma unroll
    for (int i = 0; i < 8; ++i) { const int q = tid + 256 * i, row = q >> 4, c = q & 15; *(u32x4*)(lds + row * SKSTR + c * 16) = *(const u32x4*)(sk + row * 128 + c * 8); }
    __syncthreads();
    unsigned L[16];
#pragma unroll
    for (int k = 0; k < 16; ++k) L[k] = 0u;
#pragma unroll
    for (int m2 = 0; m2 < 4; ++m2) {
        f32x16 st;
#pragma unroll
        for (int i = 0; i < 16; ++i) st[i] = 0.f;
#pragma unroll
        for (int s = 0; s < 8; ++s) {
            const bf16x8 a = *(const bf16x8*)(lds + (32 * m2 + r) * SKSTR + s * 32 + hh * 16);
            st = MFMA32(a, xb[s], st);
        }
#pragma unroll
        for (int i = 0; i < 16; ++i) {
            unsigned v = (ford(st[i]) & ~0x7fu) | (unsigned)(32 * m2 + crow(i, hh));
#pragma unroll
            for (int k = 0; k < 16; ++k) { const unsigned t = max(L[k], v); v = min(L[k], v); L[k] = t; }
        }
    }
    unsigned C[16];
#pragma unroll
    for (int k = 0; k < 16; ++k) C[k] = max(L[k], (unsigned)__shfl_xor((int)L[15 - k], 32));
#pragma unroll
    for (int d = 8; d >= 1; d >>= 1)
#pragma unroll
        for (int i = 0; i < 16; ++i) if ((i & d) == 0) { const unsigned a = max(C[i], C[i + d]), b = min(C[i], C[i + d]); C[i] = a; C[i + d] = b; }
    unsigned* dst = p.TOPK + ((size_t)(m0 + 32 * wv + r) * 16 + hp) * 16 + 8 * hh;
    u32x4 o0, o1;
    if (hh == 0) { o0 = (u32x4){C[0], C[1], C[2], C[3]}; o1 = (u32x4){C[4], C[5], C[6], C[7]}; }
    else { o0 = (u32x4){C[8], C[9], C[10], C[11]}; o1 = (u32x4){C[12], C[13], C[14], C[15]}; }
    *(u32x4*)dst = o0; *(u32x4*)(dst + 4) = o1;
}
typedef __bf16 bf16x2v __attribute__((ext_vector_type(2)));
DI float dot2(unsigned a, unsigned b, float c) { return __builtin_amdgcn_fdot2_f32_bf16(__builtin_bit_cast(bf16x2v, a), __builtin_bit_cast(bf16x2v, b), c, false); }
DI float gelu_erf(float a) { return 0.5f * a * (1.f + erff(a * 0.70710678118654752f)); }

DI void p6_unit(const Params& p, int l, int u, const float* X1, float* xout, char* lds) {
    int tid_ = threadIdx.x; asm volatile("" : "+v"(tid_)); const int tid = tid_, lane = tid & 63;
    const int wv = __builtin_amdgcn_readfirstlane(tid >> 6);
    unsigned* LA = (unsigned*)(lds + wv * 16384); unsigned* LB = LA + 1024; unsigned* Ee = LA + 2048; float* Eg = (float*)(LA + 3072);
    const int tokb = u * 32 + wv * 8;
    __syncthreads();
    {
        const int ti = lane >> 3, head = lane & 7;
        const unsigned* src = p.TOPK + ((size_t)(tokb + ti) * 16 + head * 2) * 16;
        unsigned A[16], B[16];
#pragma unroll
        for (int q = 0; q < 4; ++q) { const u32x4 a = *(const u32x4*)(src + 4 * q), b = *(const u32x4*)(src + 16 + 4 * q);
            A[4 * q] = a.x; A[4 * q + 1] = a.y; A[4 * q + 2] = a.z; A[4 * q + 3] = a.w; B[4 * q] = b.x; B[4 * q + 1] = b.y; B[4 * q + 2] = b.z; B[4 * q + 3] = b.w;
            *(u32x4*)(LA + lane * 16 + 4 * q) = a; *(u32x4*)(LB + lane * 16 + 4 * q) = b; }
        float sA[16], sB[16];
#pragma unroll
        for (int k = 0; k < 16; ++k) { sA[k] = funord(A[k] & ~0x7fu); sB[k] = funord(B[k] & ~0x7fu); }
        unsigned T[16];
#pragma unroll
        for (int k = 0; k < 16; ++k) T[k] = 0u;
#pragma unroll
        for (int a = 0; a < 16; ++a)
#pragma unroll
            for (int b = 0; b < 16; ++b)
                if ((a + 1) * (b + 1) <= 16) {
                    unsigned v = (ford(sA[a] + sB[b]) & ~0xffu) | (unsigned)(a * 16 + b);
#pragma unroll
                    for (int k = 0; k < 16; ++k) { const unsigned t = max(T[k], v); v = min(T[k], v); T[k] = t; }
                }
        float ex[16]; float sum = 0.f; const float mx = funord(T[0] & ~0xffu);
#pragma unroll
        for (int k = 0; k < 16; ++k) { ex[k] = __expf(funord(T[k] & ~0xffu) - mx); sum += ex[k]; }
        const float inv = 1.f / sum;
#pragma unroll
        for (int k = 0; k < 16; ++k) {
            const unsigned cid = T[k] & 0xffu, ia = LA[lane * 16 + (cid >> 4)] & 0x7fu, ib = LB[lane * 16 + (cid & 15u)] & 0x7fu;
            Ee[ti * 128 + head * 16 + k] = ia * 128u + ib; Eg[ti * 128 + head * 16 + k] = ex[k] * inv;
        }
    }
    const bf16* Ut = p.Ut; const bf16* Vt = p.Vt;
    const int jl = 4 * (lane >> 5) + 2 * ((lane >> 4) & 1) + ((lane >> 3) & 1);
    const bool b5 = lane & 32, b4 = lane & 16, b3 = lane & 8;
#pragma unroll 1
    for (int ti = 0; ti < 8; ++ti) {
        const int tok = tokb + ti;
        const u32x4 h0 = *(const u32x4*)(p.H + (size_t)tok * D + lane * 8), h1 = *(const u32x4*)(p.H + (size_t)tok * D + 512 + lane * 8);
        float y[16];
#pragma unroll
        for (int i = 0; i < 16; ++i) y[i] = 0.f;
#pragma unroll 1
        for (int bt = 0; bt < 16; ++bt) {
            u32x4 uu[8][2], vv[8][2];
#pragma unroll
            for (int j = 0; j < 8; ++j) {
                const unsigned e = __builtin_amdgcn_readfirstlane(Ee[ti * 128 + bt * 8 + j]);
                const bf16* ur = Ut + (size_t)e * D + lane * 8; const bf16* vr = Vt + (size_t)e * D + lane * 8;
                uu[j][0] = *(const u32x4*)ur; uu[j][1] = *(const u32x4*)(ur + 512);
                vv[j][0] = *(const u32x4*)vr; vv[j][1] = *(const u32x4*)(vr + 512);
            }
            float a[8];
#pragma unroll
            for (int j = 0; j < 8; ++j) {
                float s = dot2(h0.x, uu[j][0].x, 0.f); s = dot2(h0.y, uu[j][0].y, s); s = dot2(h0.z, uu[j][0].z, s); s = dot2(h0.w, uu[j][0].w, s);
                s = dot2(h1.x, uu[j][1].x, s); s = dot2(h1.y, uu[j][1].y, s); s = dot2(h1.z, uu[j][1].z, s); s = dot2(h1.w, uu[j][1].w, s);
                a[j] = s;
            }
            float k1[4], k2[2], k3;
#pragma unroll
            for (int i = 0; i < 4; ++i) { const float snd = b5 ? a[i] : a[4 + i]; const float rcv = __shfl_xor(snd, 32); k1[i] = (b5 ? a[4 + i] : a[i]) + rcv; }
#pragma unroll
            for (int i = 0; i < 2; ++i) { const float snd = b4 ? k1[i] : k1[2 + i]; const float rcv = __shfl_xor(snd, 16); k2[i] = (b4 ? k1[2 + i] : k1[i]) + rcv; }
            { const float snd = b3 ? k2[0] : k2[1]; const float rcv = __shfl_xor(snd, 8); k3 = (b3 ? k2[1] : k2[0]) + rcv; }
            k3 += __shfl_xor(k3, 4); k3 += __shfl_xor(k3, 2); k3 += __shfl_xor(k3, 1);
            const float w = Eg[ti * 128 + bt * 8 + jl] * gelu_erf(k3);
#pragma unroll
            for (int j = 0; j < 8; ++j) {
                const int src = 32 * (j >> 2) + 16 * ((j >> 1) & 1) + 8 * (j & 1);
                const float wj = __uint_as_float(__builtin_amdgcn_readlane(__float_as_uint(w), src));
                const unsigned w0[4] = {vv[j][0].x, vv[j][0].y, vv[j][0].z, vv[j][0].w}, w1[4] = {vv[j][1].x, vv[j][1].y, vv[j][1].z, vv[j][1].w};
#pragma unroll
                for (int i = 0; i < 4; ++i) { y[2 * i] += wj * bflo(w0[i]); y[2 * i + 1] += wj * bfhi(w0[i]); y[8 + 2 * i] += wj * bflo(w1[i]); y[8 + 2 * i + 1] += wj * bfhi(w1[i]); }
            }
        }
        const int b = (p.tok0 + tok) / SEQ;
        const float* mod = p.MOD + ((size_t)l * BATCH + b) * 6 * D;
        float v[16], gt[16];
        load16(v, X1 + (size_t)tok * D, lane); load16(gt, mod + 5 * D, lane);
#pragma unroll
        for (int i = 0; i < 16; ++i) v[i] = DN_ALPHA * v[i] + (1.f + gt[i]) * y[i];
        ln16(v, p.in[23] + l * D, p.in[24] + l * D, lane);
        store16f(xout + (size_t)tok * D, v, lane);
        if (l + 1 < DEPTH) { const float* modn = p.MOD + ((size_t)(l + 1) * BATCH + b) * 6 * D; store_mod16(p.H + (size_t)tok * D, v, modn, modn + D, lane); }
    }
}
DI void table_row_fp8(const float* src, unsigned char* dst, float* inv_scale, int lane) {
    float v[16];
#pragma unroll
    for (int q = 0; q < 4; ++q) { const float4 t = *(const float4*)(src + lane * 16 + q * 4); v[4 * q] = t.x; v[4 * q + 1] = t.y; v[4 * q + 2] = t.z; v[4 * q + 3] = t.w; }
    float mx = 0.f;
#pragma unroll
    for (int i = 0; i < 16; ++i) mx = fmaxf(mx, fabsf(v[i]));
#pragma unroll
    for (int o = 1; o < 64; o <<= 1) mx = fmaxf(mx, __shfl_xor(mx, o));
    const float sc = (mx > 0.f) ? 448.f / mx : 1.f;
    u32x4 o;
    unsigned w[4];
#pragma unroll
    for (int q = 0; q < 4; ++q) { unsigned t = 0u; t = __builtin_amdgcn_cvt_pk_fp8_f32(v[4 * q] * sc, v[4 * q + 1] * sc, t, false); t = __builtin_amdgcn_cvt_pk_fp8_f32(v[4 * q + 2] * sc, v[4 * q + 3] * sc, t, true); w[q] = t; }
    o.x = w[0]; o.y = w[1]; o.z = w[2]; o.w = w[3];
    *(u32x4*)(dst + lane * 16) = o;
    if (lane == 0) *inv_scale = (mx > 0.f) ? mx * (1.f / 448.f) : 1.f;
}
DI void convert_tables_fp8(const Params& p, int l, int bid, int nb) {
    int t_ = threadIdx.x; asm volatile("" : "+v"(t_)); const int wv = t_ >> 6, lane = t_ & 63;
    const float* us = p.in[21] + (size_t)l * 16384 * D; const float* vs = p.in[22] + (size_t)l * 16384 * D;
    for (int row = bid * 4 + wv; row < 2 * 16384; row += nb * 4) {
        if (row < 16384) table_row_fp8(us + (size_t)row * D, p.U8 + (size_t)row * D, p.US + l * 16384 + row, lane);
        else { const int r2 = row - 16384; table_row_fp8(vs + (size_t)r2 * D, p.V8 + (size_t)r2 * D, p.VS + l * 16384 + r2, lane); }
    }
}
DI void load16c(float (&v)[16], const float* row, int lane) {
#pragma unroll
    for (int q = 0; q < 4; ++q) { const float4 t = *(const float4*)(row + lane * 16 + q * 4); v[4 * q] = t.x; v[4 * q + 1] = t.y; v[4 * q + 2] = t.z; v[4 * q + 3] = t.w; }
}
DI void ln16c(float (&v)[16], const float* g, const float* bta, int lane) {
    float s = 0.f;
#pragma unroll
    for (int i = 0; i < 16; ++i) s += v[i];
#pragma unroll
    for (int o = 1; o < 64; o <<= 1) s += __shfl_xor(s, o);
    const float mean = s * (1.f / D); float q = 0.f;
#pragma unroll
    for (int i = 0; i < 16; ++i) { v[i] -= mean; q += v[i] * v[i]; }
#pragma unroll
    for (int o = 1; o < 64; o <<= 1) q += __shfl_xor(q, o);
    const float rstd = rsqrtf(q * (1.f / D) + EPS);
    float gg[16], bb[16]; load16c(gg, g, lane); load16c(bb, bta, lane);
#pragma unroll
    for (int i = 0; i < 16; ++i) v[i] = v[i] * rstd * gg[i] + bb[i];
}
DI void store16c(float* row, const float (&v)[16], int lane) {
#pragma unroll
    for (int q = 0; q < 4; ++q) *(float4*)(row + lane * 16 + q * 4) = make_float4(v[4 * q], v[4 * q + 1], v[4 * q + 2], v[4 * q + 3]);
}
DI void store_mod16c(bf16* hrow, const float (&v)[16], const float* sh, const float* sc, int lane) {
    float s[16], h[16], o[16]; load16c(s, sc, lane); load16c(h, sh, lane);
#pragma unroll
    for (int i = 0; i < 16; ++i) o[i] = v[i] * (1.f + s[i]) + h[i];
    store16(hrow + lane * 16, o);
}

DI void p6f_unit(const Params& p, int l, int u, const float* X1, float* xout, char* lds) {
    int tid_ = threadIdx.x; asm volatile("" : "+v"(tid_)); const int tid = tid_, lane = tid & 63;
    const int wv = __builtin_amdgcn_readfirstlane(tid >> 6);
    unsigned* LA = (unsigned*)(lds + wv * 16384); unsigned* LB = LA + 1024; unsigned* Ee = LA + 2048; float* Eg = (float*)(LA + 3072); float* Es = (float*)LA;
    const int tokb = u * 32 + wv * 8;
    __syncthreads();
    {
        const int ti = lane >> 3, head = lane & 7;
        const unsigned* src = p.TOPK + ((size_t)(tokb + ti) * 16 + head * 2) * 16;
        unsigned A[16], B[16];
#pragma unroll
        for (int q = 0; q < 4; ++q) { const u32x4 a = *(const u32x4*)(src + 4 * q), b = *(const u32x4*)(src + 16 + 4 * q);
            A[4 * q] = a.x; A[4 * q + 1] = a.y; A[4 * q + 2] = a.z; A[4 * q + 3] = a.w; B[4 * q] = b.x; B[4 * q + 1] = b.y; B[4 * q + 2] = b.z; B[4 * q + 3] = b.w;
            *(u32x4*)(LA + lane * 16 + 4 * q) = a; *(u32x4*)(LB + lane * 16 + 4 * q) = b; }
        float sA[16], sB[16];
#pragma unroll
        for (int k = 0; k < 16; ++k) { sA[k] = funord(A[k] & ~0x7fu); sB[k] = funord(B[k] & ~0x7fu); }
        unsigned T[16];
#pragma unroll
        for (int k = 0; k < 16; ++k) T[k] = 0u;
#pragma unroll
        for (int a = 0; a < 16; ++a)
#pragma unroll
            for (int b = 0; b < 16; ++b)
                if ((a + 1) * (b + 1) <= 16) {
                    unsigned v = (ford(sA[a] + sB[b]) & ~0xffu) | (unsigned)(a * 16 + b);
#pragma unroll
                    for (int k = 0; k < 16; ++k) { const unsigned t = max(T[k], v); v = min(T[k], v); T[k] = t; }
                }
        float ex[16]; float sum = 0.f; const float mx = funord(T[0] & ~0xffu);
        unsigned ev[16];
#pragma unroll
        for (int k = 0; k < 16; ++k) { ex[k] = __expf(funord(T[k] & ~0xffu) - mx); sum += ex[k];
            const unsigned cid = T[k] & 0xffu; ev[k] = (LA[lane * 16 + (cid >> 4)] & 0x7fu) * 128u + (LB[lane * 16 + (cid & 15u)] & 0x7fu); }
        const float inv = 1.f / sum;
        const float* US = p.US + l * 16384; const float* VS = p.VS + l * 16384;
#pragma unroll
        for (int k = 0; k < 16; ++k) {
            const float su = US[ev[k]], sv = VS[ev[k]];
            Ee[ti * 128 + head * 16 + k] = ev[k]; Eg[ti * 128 + head * 16 + k] = ex[k] * inv * sv; Es[ti * 128 + head * 16 + k] = su;
        }
    }
    const unsigned char* U8 = p.U8; const unsigned char* V8 = p.V8;
    const int jl = 8 * (lane >> 5) + 4 * ((lane >> 4) & 1) + 2 * ((lane >> 3) & 1) + ((lane >> 2) & 1);
    const bool b5 = lane & 32, b4 = lane & 16, b3 = lane & 8, b2 = lane & 4;
#pragma unroll 1
    for (int ti = 0; ti < 8; ++ti) {
        const int tok = tokb + ti;
        const u32x4 h0 = *(const u32x4*)(p.H + (size_t)tok * D + lane * 16), h1 = *(const u32x4*)(p.H + (size_t)tok * D + lane * 16 + 8);
        const unsigned hw[8] = {h0.x, h0.y, h0.z, h0.w, h1.x, h1.y, h1.z, h1.w};
        f32x2v hf[8], y2[8];
#pragma unroll
        for (int i = 0; i < 8; ++i) { hf[i] = (f32x2v){bflo(hw[i]), bfhi(hw[i])}; y2[i] = (f32x2v){0.f, 0.f}; }
#pragma unroll 1
        for (int bt = 0; bt < 8; ++bt) {
            u32x4 uu[16], vv[16];
#pragma unroll
            for (int j = 0; j < 16; ++j) {
                const unsigned e = __builtin_amdgcn_readfirstlane(Ee[ti * 128 + bt * 16 + j]);
                uu[j] = *(const u32x4*)(U8 + (size_t)e * D + lane * 16);
                vv[j] = *(const u32x4*)(V8 + (size_t)e * D + lane * 16);
            }
            float a[16];
#pragma unroll
            for (int j = 0; j < 16; ++j) {
                const unsigned w[4] = {uu[j].x, uu[j].y, uu[j].z, uu[j].w};
                f32x2v acc = {0.f, 0.f};
#pragma unroll
                for (int q = 0; q < 4; ++q) { acc = __builtin_amdgcn_cvt_pk_f32_fp8(w[q], false) * hf[2 * q] + acc; acc = __builtin_amdgcn_cvt_pk_f32_fp8(w[q], true) * hf[2 * q + 1] + acc; }
                a[j] = acc.x + acc.y;
            }
            float k1[8], k2[4], k3[2], k4;
#pragma unroll
            for (int i = 0; i < 8; ++i) { const float snd = b5 ? a[i] : a[8 + i]; const float rcv = __shfl_xor(snd, 32); k1[i] = (b5 ? a[8 + i] : a[i]) + rcv; }
#pragma unroll
            for (int i = 0; i < 4; ++i) { const float snd = b4 ? k1[i] : k1[4 + i]; const float rcv = __shfl_xor(snd, 16); k2[i] = (b4 ? k1[4 + i] : k1[i]) + rcv; }
#pragma unroll
            for (int i = 0; i < 2; ++i) { const float snd = b3 ? k2[i] : k2[2 + i]; const float rcv = __shfl_xor(snd, 8); k3[i] = (b3 ? k2[2 + i] : k2[i]) + rcv; }
            { const float snd = b2 ? k3[0] : k3[1]; const float rcv = __shfl_xor(snd, 4); k4 = (b2 ? k3[1] : k3[0]) + rcv; }
            k4 += __shfl_xor(k4, 2); k4 += __shfl_xor(k4, 1);
            const int ei = ti * 128 + bt * 16 + jl;
            const float w = Eg[ei] * gelu_erf(k4 * Es[ei]);
#pragma unroll
            for (int j = 0; j < 16; ++j) {
                const int src = 32 * (j >> 3) + 16 * ((j >> 2) & 1) + 8 * ((j >> 1) & 1) + 4 * (j & 1);
                const float wj = __uint_as_float(__builtin_amdgcn_readlane(__float_as_uint(w), src));
                const f32x2v wj2 = {wj, wj};
                const unsigned wd[4] = {vv[j].x, vv[j].y, vv[j].z, vv[j].w};
#pragma unroll
                for (int q = 0; q < 4; ++q) { y2[2 * q] = __builtin_amdgcn_cvt_pk_f32_fp8(wd[q], false) * wj2 + y2[2 * q]; y2[2 * q + 1] = __builtin_amdgcn_cvt_pk_f32_fp8(wd[q], true) * wj2 + y2[2 * q + 1]; }
            }
        }
        const int b = (p.tok0 + tok) / SEQ;
        const float* mod = p.MOD + ((size_t)l * BATCH + b) * 6 * D;
        float v[16], gt[16];
        load16c(v, X1 + (size_t)tok * D, lane); load16c(gt, mod + 5 * D, lane);
        {
            const float mean1 = p.STATS[2 * (size_t)tok], rstd1 = p.STATS[2 * (size_t)tok + 1];
            float g1[16], b1[16]; load16c(g1, p.in[17] + l * D, lane); load16c(b1, p.in[18] + l * D, lane);
#pragma unroll
            for (int i = 0; i < 16; ++i) v[i] = (v[i] - mean1) * rstd1 * g1[i] + b1[i];
        }
#pragma unroll
        for (int i = 0; i < 8; ++i) { v[2 * i] = DN_ALPHA * v[2 * i] + (1.f + gt[2 * i]) * y2[i].x; v[2 * i + 1] = DN_ALPHA * v[2 * i + 1] + (1.f + gt[2 * i + 1]) * y2[i].y; }
        ln16c(v, p.in[23] + l * D, p.in[24] + l * D, lane);
        store16c(xout + (size_t)tok * D, v, lane);
        if (l + 1 < DEPTH) { const float* modn = p.MOD + ((size_t)(l + 1) * BATCH + b) * 6 * D; store_mod16c(p.H + (size_t)tok * D, v, modn, modn + D, lane); }
    }
}
#ifndef P6_NR
#define P6_NR 8
#endif
constexpr int NR = P6_NR, RSH = (NR == 16) ? 10 : (NR == 8) ? 11 : (NR == 4) ? 12 : (NR == 2) ? 13 : 14;

DI void p6x_combine(const Params& p, int l, int tokb, unsigned* LA, unsigned* LB, unsigned* Ee, float* Eg, float* Es, int lane) {
    const int ti = lane >> 3, head = lane & 7;
    const unsigned* src = p.TOPK + ((size_t)(tokb + ti) * 16 + head * 2) * 16;
    unsigned A[16], B[16];
#pragma unroll
    for (int q = 0; q < 4; ++q) { const u32x4 a = *(const u32x4*)(src + 4 * q), b = *(const u32x4*)(src + 16 + 4 * q);
        A[4 * q] = a.x; A[4 * q + 1] = a.y; A[4 * q + 2] = a.z; A[4 * q + 3] = a.w; B[4 * q] = b.x; B[4 * q + 1] = b.y; B[4 * q + 2] = b.z; B[4 * q + 3] = b.w;
        *(u32x4*)(LA + lane * 16 + 4 * q) = a; *(u32x4*)(LB + lane * 16 + 4 * q) = b; }
    float sA[16], sB[16];
#pragma unroll
    for (int k = 0; k < 16; ++k) { sA[k] = funord(A[k] & ~0x7fu); sB[k] = funord(B[k] & ~0x7fu); }
    unsigned T[16];
#pragma unroll
    for (int k = 0; k < 16; ++k) T[k] = 0u;
#pragma unroll
    for (int a = 0; a < 16; ++a)
#pragma unroll
        for (int b = 0; b < 16; ++b)
            if ((a + 1) * (b + 1) <= 16) {
                unsigned v = (ford(sA[a] + sB[b]) & ~0xffu) | (unsigned)(a * 16 + b);
#pragma unroll
                for (int k = 0; k < 16; ++k) { const unsigned t = max(T[k], v); v = min(T[k], v); T[k] = t; }
            }
    float ex[16]; float sum = 0.f; const float mx = funord(T[0] & ~0xffu);
    unsigned ev[16];
#pragma unroll
    for (int k = 0; k < 16; ++k) { ex[k] = __expf(funord(T[k] & ~0xffu) - mx); sum += ex[k];
        const unsigned cid = T[k] & 0xffu; ev[k] = (LA[lane * 16 + (cid >> 4)] & 0x7fu) * 128u + (LB[lane * 16 + (cid & 15u)] & 0x7fu); }
    const float inv = 1.f / sum;
    const float* US = p.US + l * 16384; const float* VS = p.VS + l * 16384;
    float su[16], gv[16];
#pragma unroll
    for (int k = 0; k < 16; ++k) { su[k] = US[ev[k]]; gv[k] = ex[k] * inv * VS[ev[k]]; }
    unsigned* cnt = LB; unsigned* off = LB + 8 * NR; unsigned* cur = LB + 16 * NR;
    for (int i = lane; i < 24 * NR; i += 64) LB[i] = 0u;
#pragma unroll
    for (int k = 0; k < 16; ++k) atomicAdd(&cnt[ti * NR + (ev[k] >> RSH)], 1u);
    {
#pragma unroll
        for (int rb = 0; rb < NR; rb += 8) {
            unsigned s = 0u;
#pragma unroll
            for (int r = 0; r < NR; ++r) { const unsigned c = cnt[ti * NR + r]; if (r < head + rb) s += c; }
            if (head + rb < NR) off[ti * NR + head + rb] = s;
        }
    }
#pragma unroll
    for (int k = 0; k < 16; ++k) {
        const int r = ev[k] >> RSH;
        const unsigned pos = off[ti * NR + r] + atomicAdd(&cur[ti * NR + r], 1u);
        Ee[ti * 128 + pos] = ev[k]; Eg[ti * 128 + pos] = gv[k]; Es[ti * 128 + pos] = su[k];
    }
}

DI float gelu_fast(float v) {
    const float av = fabsf(v), t = __builtin_amdgcn_rcpf(av * 0.2316418882f + 1.0f);
    float q = t * 0.5307027145f + (-0.7265760135f); q = q * t + 0.7107068705f; q = q * t + (-0.142248368f); q = q * t + 0.127414796f; q = q * t;
    const float e = __builtin_amdgcn_exp2f((v * v) * (-0.72134752044f));
    const float m = v * (q * e);
    return v < 0.f ? m : v - m;
}
template <bool DRY> DI void p6x_ids(unsigned (&en)[8], const unsigned* Ee, unsigned desc) {
    const int ebase = desc & 0x3ff, n = (desc >> 10) & 0xf;
#pragma unroll
    for (int j = 0; j < 8; ++j) en[j] = (__builtin_amdgcn_readfirstlane(Ee[ebase + (j < n ? j : 0)]) & (DRY ? 1023u : 0xffffu)) * (unsigned)D;
}
typedef __amdgpu_buffer_rsrc_t rsrc_t;
DI u32x4 rowload(rsrc_t r, int voff, unsigned soff) { return __builtin_amdgcn_raw_buffer_load_b128(r, voff, (int)soff, 0); }
DI void p6x_issue(u32x4 (&buf)[8], rsrc_t T8, const unsigned (&en)[8], int voff) {
#pragma unroll
    for (int j = 0; j < 8; ++j) buf[j] = rowload(T8, voff, en[j]);
}
template <int CTRL> DI float dppf(float v) { return __uint_as_float(__builtin_amdgcn_mov_dpp(__float_as_uint(v), CTRL, 0xf, 0xf, true)); }
DI float pair32(float x, float y) { auto r = __builtin_amdgcn_permlane32_swap(__float_as_uint(x), __float_as_uint(y), false, false); return __uint_as_float(r[0]) + __uint_as_float(r[1]); }
DI float pair16(float x, float y) { auto r = __builtin_amdgcn_permlane16_swap(__float_as_uint(x), __float_as_uint(y), false, false); return __uint_as_float(r[0]) + __uint_as_float(r[1]); }
DI float p6x_dots(u32x4 (&uu)[8], rsrc_t U8, const unsigned (&en)[8], bool refill, u32x4 (&hw)[2], const bf16* hnext, const float* Eg, const float* Es, unsigned desc,
                  int lane, int jl, bool b5, bool b4, bool b3) {
    const int ebase = desc & 0x3ff, n = (desc >> 10) & 0xf;
    float a[8];
    {
        f32x2v hf[8];
#pragma unroll
        for (int i = 0; i < 8; ++i) { const unsigned hwi = (i < 4) ? hw[0][i & 3] : hw[1][i & 3]; hf[i] = (f32x2v){bflo(hwi), bfhi(hwi)}; }
#pragma unroll
        for (int j = 0; j < 8; ++j) {
            f32x2v acc0 = __builtin_amdgcn_cvt_pk_f32_fp8(uu[j].x, false) * hf[0];
            f32x2v acc1 = __builtin_amdgcn_cvt_pk_f32_fp8(uu[j].x, true) * hf[1];
            acc0 = __builtin_amdgcn_cvt_pk_f32_fp8(uu[j].y, false) * hf[2] + acc0;
            acc1 = __builtin_amdgcn_cvt_pk_f32_fp8(uu[j].y, true) * hf[3] + acc1;
            acc0 = __builtin_amdgcn_cvt_pk_f32_fp8(uu[j].z, false) * hf[4] + acc0;
            acc1 = __builtin_amdgcn_cvt_pk_f32_fp8(uu[j].z, true) * hf[5] + acc1;
            acc0 = __builtin_amdgcn_cvt_pk_f32_fp8(uu[j].w, false) * hf[6] + acc0;
            acc1 = __builtin_amdgcn_cvt_pk_f32_fp8(uu[j].w, true) * hf[7] + acc1;
            acc0 += acc1;
            a[j] = acc0.x + acc0.y;
        }
    }
    __builtin_amdgcn_sched_barrier(0);
    hw[0] = *(const u32x4*)hnext; hw[1] = *(const u32x4*)(hnext + 8);
#pragma unroll
    for (int j = 0; j < 8; ++j) uu[j] = rowload(U8, lane * 16, en[j]);
    __builtin_amdgcn_sched_barrier(0);
    float k1[4], k2[2], k3;
#pragma unroll
    for (int i = 0; i < 4; ++i) k1[i] = pair32(a[i], a[4 + i]);
#pragma unroll
    for (int i = 0; i < 2; ++i) k2[i] = pair16(k1[i], k1[2 + i]);
    { const float snd = b3 ? k2[0] : k2[1]; k3 = (b3 ? k2[1] : k2[0]) + dppf<0x128>(snd); }
    k3 += dppf<0x141>(k3);
    k3 += dppf<0xB1>(k3);
    k3 += dppf<0x4E>(k3);
    const int ei = ebase + (jl < n ? jl : 0);
    return (jl < n) ? Eg[ei] * gelu_fast(k3 * Es[ei]) : 0.f;
}
DI void p6x_axpy(u32x4 (&vv)[8], rsrc_t V8, const unsigned (&en)[8], bool refill, float w, f32x2v (&y2)[8], int lane) {
#pragma unroll
    for (int j = 0; j < 8; ++j) {
        const int src = 32 * (j >> 2) + 16 * ((j >> 1) & 1) + 8 * (j & 1);
        const float wj = __uint_as_float(__builtin_amdgcn_readlane(__float_as_uint(w), src));
        const f32x2v wj2 = {wj, wj};
        const unsigned wd[4] = {vv[j].x, vv[j].y, vv[j].z, vv[j].w};
#pragma unroll
        for (int q = 0; q < 4; ++q) { y2[2 * q] = __builtin_amdgcn_cvt_pk_f32_fp8(wd[q], false) * wj2 + y2[2 * q]; y2[2 * q + 1] = __builtin_amdgcn_cvt_pk_f32_fp8(wd[q], true) * wj2 + y2[2 * q + 1]; }
    }
    __builtin_amdgcn_sched_barrier(0);
#pragma unroll
    for (int j = 0; j < 8; ++j) vv[j] = rowload(V8, lane * 16, en[j]);
    __builtin_amdgcn_sched_barrier(0);
}
#define P6X_AXPY(T) p6x_axpy(V, V8, en, more, w_, y2[T], lane)

template <bool DRY> DI void p6x_block(const Params& p, int l, int tok_first, int ntok, const float* X1, float* xout, char* lds) {
    int tid_ = threadIdx.x; asm volatile("" : "+v"(tid_)); const int tid = tid_, lane = tid & 63;
    const int wv = __builtin_amdgcn_readfirstlane(tid >> 6);
    unsigned* LA = (unsigned*)(lds + wv * 16384); unsigned* LB = LA + 1024; unsigned* Ee = LA + 2048; float* Eg = (float*)(LA + 3072); float* Es = (float*)LA;
    const unsigned* cnt = LB; const unsigned* off = LB + 8 * NR; unsigned* dl = LB + 24 * NR;
    const rsrc_t U8 = __builtin_amdgcn_make_buffer_rsrc((void*)p.U8, 0, 16384 * D, 0x00020000), V8 = __builtin_amdgcn_make_buffer_rsrc((void*)p.V8, 0, 16384 * D, 0x00020000);
    const int jl = 4 * (lane >> 5) + 2 * ((lane >> 4) & 1) + ((lane >> 3) & 1);
    const bool b5 = lane & 32, b4 = lane & 16, b3 = lane & 8;
    const int per_wave = ntok >> 2;
    __syncthreads();
#pragma unroll 1
    for (int g8 = 0; g8 < per_wave; g8 += 8) {
        const int tokb = tok_first + wv * per_wave + g8;
        { int lc = lane; asm volatile("" : "+v"(lc)); p6x_combine(p, l, tokb, LA, LB, Ee, Eg, Es, lc); }
#pragma unroll 1
        for (int sw = 0; sw < 2; ++sw) {
            int nd;
            {
                int lane_d = lane; asm volatile("" : "+v"(lane_d));
                const bool rev = ((g8 >> 3) * 2 + sw) & 1;
                const int rr = (lane_d >> 2) & (NR - 1), t = lane_d & 3, r = rev ? (NR - 1 - rr) : rr, ti = sw * 4 + t;
                const int n = (lane_d < 4 * NR) ? (int)cnt[ti * NR + r] : 0, base = (int)off[ti * NR + r];
                const int nbat = (n + 7) >> 3;
                int incl = nbat;
#pragma unroll
                for (int o = 1; o < 64; o <<= 1) { const int up = __shfl_up(incl, o); if (lane_d >= o) incl += up; }
                const int start = incl - nbat;
                for (int k = 0; k < nbat; ++k) { const int rem = n - 8 * k; dl[start + k] = ((unsigned)t << 14) | ((unsigned)(rem < 8 ? rem : 8) << 10) | (unsigned)(ti * 128 + base + 8 * k); }
                nd = __builtin_amdgcn_readlane(incl, 63);
            }
            f32x2v y2[4][8];
#pragma unroll
            for (int t = 0; t < 4; ++t)
#pragma unroll
                for (int i = 0; i < 8; ++i) y2[t][i] = (f32x2v){0.f, 0.f};
            const bf16* hbase = p.H + (size_t)(tokb + sw * 4) * D + lane * 16;
            u32x4 U[8], V[8]; unsigned en[8];
            unsigned dA = __builtin_amdgcn_readfirstlane(dl[0]);
            u32x4 hw[2];
            if (nd > 0) { p6x_ids<DRY>(en, Ee, dA); p6x_issue(U, U8, en, lane * 16); p6x_issue(V, V8, en, lane * 16); const bf16* hr = hbase + (size_t)(dA >> 14) * D; hw[0] = *(const u32x4*)hr; hw[1] = *(const u32x4*)(hr + 8); }
#pragma unroll 1
            for (int i = 0; i < nd; ++i) {
                const bool more = i + 1 < nd;
                const unsigned dB = __builtin_amdgcn_readfirstlane(dl[more ? i + 1 : i]);
                p6x_ids<DRY>(en, Ee, dB);
                const int t_ = (int)(dA >> 14);
                const float w_ = p6x_dots(U, U8, en, more, hw, hbase + (size_t)(dB >> 14) * D, Eg, Es, dA, lane, jl, b5, b4, b3);
                switch (t_) { case 0: P6X_AXPY(0); break; case 1: P6X_AXPY(1); break; case 2: P6X_AXPY(2); break; default: P6X_AXPY(3); break; }
                dA = dB;
            }
#pragma unroll
            for (int t = 0; t < 4; ++t) {
                int lane_e = lane; asm volatile("" : "+v"(lane_e));
                const int tok = tokb + sw * 4 + t;
                const int b = (p.tok0 + tok) / SEQ;
                const float* mod = p.MOD + ((size_t)l * BATCH + b) * 6 * D;
                float v[16], gt[16];
                load16c(v, X1 + (size_t)tok * D, lane_e); load16c(gt, mod + 5 * D, lane_e);
#pragma unroll
                for (int i = 0; i < 8; ++i) { v[2 * i] = DN_ALPHA * v[2 * i] + (1.f + gt[2 * i]) * y2[t][i].x; v[2 * i + 1] = DN_ALPHA * v[2 * i + 1] + (1.f + gt[2 * i + 1]) * y2[t][i].y; }
                ln16c(v, p.in[23] + l * D, p.in[24] + l * D, lane_e);
                if (DRY) {
#pragma unroll
                    for (int i = 0; i < 16; ++i) asm volatile("" :: "v"(v[i]));
                    continue; }
                store16c(xout + (size_t)tok * D, v, lane_e);
                if (l + 1 < DEPTH) { const float* modn = p.MOD + ((size_t)(l + 1) * BATCH + b) * 6 * D; store_mod16c(p.H + (size_t)tok * D, v, modn, modn + D, lane_e); }
                __builtin_amdgcn_sched_barrier(0);
            }
        }
    }
}
#ifdef P6_NOPTAIL
#define P6_TAILNOP "\n\ts_nop 7\n\ts_nop 7\n\ts_nop 7\n\ts_nop 7\n\ts_nop 7\n\ts_nop 7\n\ts_nop 7\n\ts_nop 7"
#else
#define P6_TAILNOP
#endif
#ifdef P6C_SAFE
#define P6C_W10 "s_waitcnt vmcnt(0)"
#else
#define P6C_W10 "s_waitcnt vmcnt(10)"
#endif

DI u32x4 p6a_rsrc(const unsigned char* base) {
    const unsigned long long a = (unsigned long long)base;
    u32x4 r; r.x = __builtin_amdgcn_readfirstlane((unsigned)a); r.y = __builtin_amdgcn_readfirstlane((unsigned)(a >> 32) & 0xffffu); r.z = 16384u * (unsigned)D; r.w = 0x00020000u;
    return r;
}
#ifndef P6_DRYMODE
#define P6_DRYMODE 0
#endif
#ifndef P6_FULLBATCH
#define P6_FULLBATCH 0
#endif
#ifndef P6_LDMOD
#define P6_LDMOD ""
#endif
#ifndef P6_SWEEPSYNC
#define P6_SWEEPSYNC 0
#endif
#ifndef P6_DRYMASK
#define P6_DRYMASK 0
#endif
template <bool DRY> DI void p6a_ids(unsigned (&en)[8], const unsigned* Ee, unsigned desc, int lane) {
    const int ebase = desc & 0x3ff, n = (desc >> 10) & 0xf, j = lane & 7;
    const unsigned ev = (Ee[ebase + (j < n ? j : 0)] & ((DRY && (P6_DRYMODE == 1 || P6_DRYMASK)) ? 1023u : 0xffffu)) * (unsigned)D;
#pragma unroll
    for (int k = 0; k < 8; ++k) en[k] = __builtin_amdgcn_readlane(ev, k);
}
DI void p6a_load8(u32x4 (&b)[8], u32x4 rsrc, int voff, const unsigned (&so)[8]) {
    asm volatile("s_nop 4\n\t"
        "buffer_load_dwordx4 %0, %8, %9, %10 offen" P6_LDMOD "\n\t" "buffer_load_dwordx4 %1, %8, %9, %11 offen" P6_LDMOD "\n\t" "buffer_load_dwordx4 %2, %8, %9, %12 offen" P6_LDMOD "\n\t" "buffer_load_dwordx4 %3, %8, %9, %13 offen" P6_LDMOD "\n\t"
        "buffer_load_dwordx4 %4, %8, %9, %14 offen" P6_LDMOD "\n\t" "buffer_load_dwordx4 %5, %8, %9, %15 offen" P6_LDMOD "\n\t" "buffer_load_dwordx4 %6, %8, %9, %16 offen" P6_LDMOD "\n\t" "buffer_load_dwordx4 %7, %8, %9, %17 offen" P6_LDMOD P6_TAILNOP
        : "=&v"(b[0]), "=&v"(b[1]), "=&v"(b[2]), "=&v"(b[3]), "=&v"(b[4]), "=&v"(b[5]), "=&v"(b[6]), "=&v"(b[7])
        : "v"(voff), "s"(rsrc), "s"(so[0]), "s"(so[1]), "s"(so[2]), "s"(so[3]), "s"(so[4]), "s"(so[5]), "s"(so[6]), "s"(so[7])
        : "memory");
}
DI void p6a_loadh(u32x4 (&h)[2], const bf16* src) {
    asm volatile("global_load_dwordx4 %0, %2, off\n\tglobal_load_dwordx4 %1, %2, off offset:16" : "=&v"(h[0]), "=&v"(h[1]) : "v"(src) : "memory");
}
DI void p6a_wait_hu(u32x4 (&h)[2], u32x4 (&b)[8]) {
    asm volatile("s_waitcnt vmcnt(8)" : "+v"(h[0]), "+v"(h[1]), "+v"(b[0]), "+v"(b[1]), "+v"(b[2]), "+v"(b[3]), "+v"(b[4]), "+v"(b[5]), "+v"(b[6]), "+v"(b[7]) :: "memory");
}
DI void p6a_wait_v(u32x4 (&b)[8]) {
    asm volatile(P6C_W10  : "+v"(b[0]), "+v"(b[1]), "+v"(b[2]), "+v"(b[3]), "+v"(b[4]), "+v"(b[5]), "+v"(b[6]), "+v"(b[7]) :: "memory");
}
DI void p6a_drain(u32x4 (&h)[2], u32x4 (&u)[8], u32x4 (&v)[8]) {
    asm volatile("s_waitcnt vmcnt(0)" : "+v"(h[0]), "+v"(h[1]), "+v"(u[0]), "+v"(u[1]), "+v"(u[2]), "+v"(u[3]), "+v"(u[4]), "+v"(u[5]), "+v"(u[6]), "+v"(u[7]),
                                        "+v"(v[0]), "+v"(v[1]), "+v"(v[2]), "+v"(v[3]), "+v"(v[4]), "+v"(v[5]), "+v"(v[6]), "+v"(v[7]) :: "memory");
}
DI void p6a_dot8(float (&a)[8], const u32x4 (&uu)[8], const u32x4 (&hw)[2]) {
    f32x2v hf[8];
#pragma unroll
    for (int i = 0; i < 8; ++i) { const unsigned hwi = (i < 4) ? hw[0][i & 3] : hw[1][i & 3]; hf[i] = (f32x2v){bflo(hwi), bfhi(hwi)}; }
#pragma unroll
    for (int j = 0; j < 8; ++j) {
        f32x2v acc0 = __builtin_amdgcn_cvt_pk_f32_fp8(uu[j].x, false) * hf[0];
        f32x2v acc1 = __builtin_amdgcn_cvt_pk_f32_fp8(uu[j].x, true) * hf[1];
        acc0 = __builtin_amdgcn_cvt_pk_f32_fp8(uu[j].y, false) * hf[2] + acc0;
        acc1 = __builtin_amdgcn_cvt_pk_f32_fp8(uu[j].y, true) * hf[3] + acc1;
        acc0 = __builtin_amdgcn_cvt_pk_f32_fp8(uu[j].z, false) * hf[4] + acc0;
        acc1 = __builtin_amdgcn_cvt_pk_f32_fp8(uu[j].z, true) * hf[5] + acc1;
        acc0 = __builtin_amdgcn_cvt_pk_f32_fp8(uu[j].w, false) * hf[6] + acc0;
        acc1 = __builtin_amdgcn_cvt_pk_f32_fp8(uu[j].w, true) * hf[7] + acc1;
        acc0 += acc1;
        a[j] = acc0.x + acc0.y;
    }
}
DI float p6a_reduce_gate(const float (&a)[8], const float* Eg, const float* Es, unsigned desc, int jl, bool b3) {
    const int ebase = desc & 0x3ff, n = (desc >> 10) & 0xf;
    float k1[4], k2[2], k3;
#pragma unroll
    for (int i = 0; i < 4; ++i) k1[i] = pair32(a[i], a[4 + i]);
#pragma unroll
    for (int i = 0; i < 2; ++i) k2[i] = pair16(k1[i], k1[2 + i]);
    { const float snd = b3 ? k2[0] : k2[1]; k3 = (b3 ? k2[1] : k2[0]) + dppf<0x128>(snd); }
    k3 += dppf<0x141>(k3); k3 += dppf<0xB1>(k3); k3 += dppf<0x4E>(k3);
    const int ei = ebase + (jl < n ? jl : 0);
    return (jl < n) ? Eg[ei] * gelu_fast(k3 * Es[ei]) : 0.f;
}
DI void p6a_axpy8(const u32x4 (&vv)[8], float w, f32x2v (&y2)[8]) {
#pragma unroll
    for (int j = 0; j < 8; ++j) {
        const int src = 32 * (j >> 2) + 16 * ((j >> 1) & 1) + 8 * (j & 1);
        const float wj = __uint_as_float(__builtin_amdgcn_readlane(__float_as_uint(w), src));
        const f32x2v wj2 = {wj, wj};
        const unsigned wd[4] = {vv[j].x, vv[j].y, vv[j].z, vv[j].w};
#pragma unroll
        for (int q = 0; q < 4; ++q) { y2[2 * q] = __builtin_amdgcn_cvt_pk_f32_fp8(wd[q], false) * wj2 + y2[2 * q]; y2[2 * q + 1] = __builtin_amdgcn_cvt_pk_f32_fp8(wd[q], true) * wj2 + y2[2 * q + 1]; }
    }
}
template <bool DRY> DI void p6a_block(const Params& p, int l, int tok_first, int ntok, const float* X1, float* xout, char* lds) {
    int tid_ = threadIdx.x; asm volatile("" : "+v"(tid_)); const int tid = tid_, lane = tid & 63;
    const int wv = __builtin_amdgcn_readfirstlane(tid >> 6);
    unsigned* LA = (unsigned*)(lds + wv * 16384); unsigned* LB = LA + 1024; unsigned* Ee = LA + 2048; float* Eg = (float*)(LA + 3072); float* Es = (float*)LA;
    const unsigned* cnt = LB; const unsigned* off = LB + 8 * NR; unsigned* dl = LB + 24 * NR;
    const u32x4 rU = p6a_rsrc(p.U8), rV = p6a_rsrc(p.V8);
    const int jl = 4 * (lane >> 5) + 2 * ((lane >> 4) & 1) + ((lane >> 3) & 1);
    const bool b5 = lane & 32, b4 = lane & 16, b3 = lane & 8;
    const int per_wave = ntok >> 2;
    __syncthreads();
#pragma unroll 1
    for (int g8 = 0; g8 < per_wave; g8 += 8) {
        const int tokb = tok_first + wv * per_wave + g8;
        { int lc = lane; asm volatile("" : "+v"(lc)); p6x_combine(p, l, tokb, LA, LB, Ee, Eg, Es, lc); }
#pragma unroll 1
        for (int sw = 0; sw < 2; ++sw) {
            int nd;
#if P6_FULLBATCH
            {
                int lane_d = lane; asm volatile("" : "+v"(lane_d));
                const bool rev = ((g8 >> 3) * 2 + sw) & 1;
                const int kk = lane_d >> 2, t = lane_d & 3, k = rev ? (15 - kk) : kk, ti = sw * 4 + t;
                dl[lane_d] = ((unsigned)t << 14) | (8u << 10) | (unsigned)(ti * 128 + 8 * k);
                nd = 64; asm volatile("" : "+s"(nd));
            }
#else
            {
                int lane_d = lane; asm volatile("" : "+v"(lane_d));
                const bool rev = ((g8 >> 3) * 2 + sw) & 1;
                const int rr = (lane_d >> 2) & (NR - 1), t = lane_d & 3, r = rev ? (NR - 1 - rr) : rr, ti = sw * 4 + t;
                const int n = (lane_d < 4 * NR) ? (int)cnt[ti * NR + r] : 0, base = (int)off[ti * NR + r];
                const int nbat = (n + 7) >> 3;
                int incl = nbat;
#pragma unroll
                for (int o = 1; o < 64; o <<= 1) { const int up = __shfl_up(incl, o); if (lane_d >= o) incl += up; }
                const int start = incl - nbat;
                for (int k = 0; k < nbat; ++k) { const int rem = n - 8 * k; dl[start + k] = ((unsigned)t << 14) | ((unsigned)(rem < 8 ? rem : 8) << 10) | (unsigned)(ti * 128 + base + 8 * k); }
                nd = __builtin_amdgcn_readlane(incl, 63);
            }
#endif
#if P6_SWEEPSYNC
            { XcdBarrier xb_; xb_.bar = p.ctr + 4096; xb_.x = xb_xcc_id(); xb_.st = (volatile LAS unsigned*)(lds + LDS_TOTAL - 32); xcd_barrier(xb_); }
#endif
            f32x2v y2[4][8];
#pragma unroll
            for (int t = 0; t < 4; ++t)
#pragma unroll
                for (int i = 0; i < 8; ++i) y2[t][i] = (f32x2v){0.f, 0.f};
            const bf16* hbase = p.H + (size_t)(tokb + sw * 4) * D + lane * 16;
            u32x4 U[8], V[8], hw[2]; unsigned en[8];
            asm volatile("s_waitcnt vmcnt(0)" ::: "memory");
            unsigned dA = __builtin_amdgcn_readfirstlane(dl[0]);
            { p6a_ids<DRY>(en, Ee, dA, lane); p6a_loadh(hw, hbase + (size_t)(dA >> 14) * D); p6a_load8(U, rU, lane * 16, en); p6a_load8(V, rV, lane * 16, en); }
#pragma unroll 1
            for (int i = 0; i < nd; ++i) {
                const unsigned dB = __builtin_amdgcn_readfirstlane(dl[i + 1 < nd ? i + 1 : i]);
                p6a_ids<DRY>(en, Ee, dB, lane);
                const int t_ = (int)(dA >> 14);
                if (DRY && P6_DRYMODE == 4) p6a_drain(hw, U, V); else if (!(DRY && P6_DRYMODE == 2)) p6a_wait_hu(hw, U);
                float a[8];
                if (DRY && (P6_DRYMODE == 3 || P6_DRYMODE == 4)) {
#pragma unroll
                    for (int j = 0; j < 8; ++j) a[j] = __uint_as_float(U[j].x); }
                else p6a_dot8(a, U, hw);
                __builtin_amdgcn_sched_barrier(0);
                if (!(DRY && P6_DRYMODE == 2)) { p6a_loadh(hw, hbase + (size_t)(dB >> 14) * D); p6a_load8(U, rU, lane * 16, en); }
                __builtin_amdgcn_sched_barrier(0);
                const float w_ = p6a_reduce_gate(a, Eg, Es, dA, jl, b3);
                if (!(DRY && (P6_DRYMODE == 2 || P6_DRYMODE == 4))) p6a_wait_v(V);
                if (DRY && (P6_DRYMODE == 3 || P6_DRYMODE == 4)) { y2[0][0].x += w_ * __uint_as_float(V[0].x ^ V[1].x ^ V[2].x ^ V[3].x ^ V[4].x ^ V[5].x ^ V[6].x ^ V[7].x); } else
                switch (t_) { case 0: p6a_axpy8(V, w_, y2[0]); break; case 1: p6a_axpy8(V, w_, y2[1]); break; case 2: p6a_axpy8(V, w_, y2[2]); break; default: p6a_axpy8(V, w_, y2[3]); break; }
                __builtin_amdgcn_sched_barrier(0);
                if (!(DRY && (P6_DRYMODE == 2 || P6_DRYMODE == 4))) p6a_load8(V, rV, lane * 16, en);
                __builtin_amdgcn_sched_barrier(0);
                dA = dB;
            }
            p6a_drain(hw, U, V);
#pragma unroll
            for (int t = 0; t < 4; ++t) {
                int lane_e = lane; asm volatile("" : "+v"(lane_e));
                const int tok = tokb + sw * 4 + t;
                const int b = (p.tok0 + tok) / SEQ;
                const float* mod = p.MOD + ((size_t)l * BATCH + b) * 6 * D;
                float v[16], gt[16];
                load16c(v, X1 + (size_t)tok * D, lane_e); load16c(gt, mod + 5 * D, lane_e);
                {
                    const float mean1 = p.STATS[2 * (size_t)tok], rstd1 = p.STATS[2 * (size_t)tok + 1];
                    float g1[16], b1[16]; load16c(g1, p.in[17] + l * D, lane_e); load16c(b1, p.in[18] + l * D, lane_e);
#pragma unroll
                    for (int i = 0; i < 16; ++i) v[i] = (v[i] - mean1) * rstd1 * g1[i] + b1[i];
                }
#pragma unroll
                for (int i = 0; i < 8; ++i) { v[2 * i] = DN_ALPHA * v[2 * i] + (1.f + gt[2 * i]) * y2[t][i].x; v[2 * i + 1] = DN_ALPHA * v[2 * i + 1] + (1.f + gt[2 * i + 1]) * y2[t][i].y; }
                ln16c(v, p.in[23] + l * D, p.in[24] + l * D, lane_e);
                if (DRY) {
#pragma unroll
                    for (int i = 0; i < 16; ++i) asm volatile("" :: "v"(v[i]));
                    continue; }
                store16c(xout + (size_t)tok * D, v, lane_e);
                if (l + 1 < DEPTH) { const float* modn = p.MOD + ((size_t)(l + 1) * BATCH + b) * 6 * D; store_mod16c(p.H + (size_t)tok * D, v, modn, modn + D, lane_e); }
                __builtin_amdgcn_sched_barrier(0);
            }
        }
    }
}
#define XB_TMO      128
#define XB_XCNT(j)  (256  + 64 * (j))
#define XB_XSUB(j)  (1280 + 64 * (j))
#define XB_XGEN(j)  (2304 + 64 * (j))
#define XB_TOP      3328
#define XB_TOPGEN   3392
#define XCD_BAR_WORDS 3456
#define XB_SPIN_CAP (1u << 22)
#define LAS __attribute__((address_space(3)))
DI unsigned xb_ld(unsigned* p)              { return __hip_atomic_load(p, __ATOMIC_RELAXED, __HIP_MEMORY_SCOPE_AGENT); }
DI unsigned xb_add(unsigned* p, unsigned v) { return __hip_atomic_fetch_add(p, v, __ATOMIC_RELAXED, __HIP_MEMORY_SCOPE_AGENT); }
DI unsigned xb_xcc_id() { return (unsigned)__builtin_amdgcn_s_getreg((3 << 11) | 20) & 0xFu; }
#define XB_SPIN(cond, bar) do { unsigned _sp = 0; while (cond) { __builtin_amdgcn_s_sleep(1); \
    if ((++_sp & 255u) == 0u) { if (xb_ld(&(bar)[XB_TMO])) break; if (_sp > XB_SPIN_CAP) { atomicAdd(&(bar)[XB_TMO], 1u); break; } } } } while (0)
struct XcdBarrier { unsigned* bar; unsigned x; volatile LAS unsigned* st; };
DI XcdBarrier xcd_barrier_post(unsigned* bar, volatile LAS unsigned* st) {
    XcdBarrier b; b.bar = bar; b.x = xb_xcc_id(); b.st = st;
    if (threadIdx.x == 0) st[2] = xb_add(&bar[XB_XCNT(b.x)], 1u);
    return b;
}
DI void xcd_barrier_complete(unsigned* bar, unsigned x, unsigned& nloc, unsigned& nx) {
    const unsigned G = gridDim.x * gridDim.y * gridDim.z;
    unsigned sum, cnt, mine, sp = 0u;
    for (;;) {
        sum = 0u; cnt = 0u; mine = 0u;
#pragma unroll
        for (unsigned j = 0; j < 16; ++j) { const unsigned c = xb_ld(&bar[XB_XCNT(j)]); sum += c; cnt += (c > 0u) ? 1u : 0u; mine = (j == x) ? c : mine; }
        if (sum == G) break;
        __builtin_amdgcn_s_sleep(1);
        if ((++sp & 255u) == 0u) { if (xb_ld(&bar[XB_TMO])) break; if (sp > XB_SPIN_CAP) { atomicAdd(&bar[XB_TMO], 1u); break; } }
    }
    nloc = mine > 0u ? mine : 1u; nx = cnt > 0u ? cnt : 1u;
}
DI void xcd_barrier(const XcdBarrier& b) {
    asm volatile("s_waitcnt vmcnt(0)" ::: "memory");
    __syncthreads();
    if (threadIdx.x == 0) {
        unsigned* bar = b.bar;
        __builtin_amdgcn_s_waitcnt(0);
        unsigned nloc = b.st[0], nx = b.st[1];
        if (nloc == 0u) { xcd_barrier_complete(bar, b.x, nloc, nx); b.st[0] = nloc; b.st[1] = nx; }
        const unsigned old = xb_add(&bar[XB_XSUB(b.x)], 1u);
        const unsigned gen = old / nloc;
        if (old + 1u == (gen + 1u) * nloc) {
            __builtin_amdgcn_fence(__ATOMIC_RELEASE, "agent");
            asm volatile("s_waitcnt vmcnt(0)" ::: "memory");
            const unsigned og = xb_add(&bar[XB_TOP], 1u);
            const unsigned tg = og / nx;
            if (og + 1u == (tg + 1u) * nx) xb_add(&bar[XB_TOPGEN], 1u);
            else XB_SPIN(xb_ld(&bar[XB_TOPGEN]) == tg, bar);
            __builtin_amdgcn_fence(__ATOMIC_ACQUIRE, "agent");
            xb_add(&bar[XB_XGEN(b.x)], 1u);
            asm volatile("s_waitcnt vmcnt(0)" ::: "memory");
        } else {
            XB_SPIN(xb_ld(&bar[XB_XGEN(b.x)]) == gen, bar);
            __builtin_amdgcn_fence(__ATOMIC_ACQUIRE, "agent");
            asm volatile("s_waitcnt vmcnt(0)" ::: "memory");
        }
    }
    __syncthreads();
}
DI void ada_item(const Params& p, int item, char* lds) {
    int tid_ = threadIdx.x; asm volatile("" : "+v"(tid_)); const int tid = tid_, lane = tid & 63, wv = tid >> 6;
    float* cs = (float*)lds;
    float* part = cs + 4 * D;
    __syncthreads();
    for (int i = tid; i < BATCH * D; i += 256) { const float cv = p.in[1][i]; cs[i] = cv / (1.f + __expf(-cv)); }
    __syncthreads();
    const int col = item * 64 + lane, l = col / (6 * D), j = col % (6 * D);
    const float* w = p.in[2] + (size_t)l * D * 6 * D + j;
    float a0 = 0.f, a1 = 0.f, a2 = 0.f, a3 = 0.f;
#pragma unroll 16
    for (int k = wv * 256; k < wv * 256 + 256; ++k) { const float wk = w[(size_t)k * 6 * D]; a0 += cs[k] * wk; a1 += cs[D + k] * wk; a2 += cs[2 * D + k] * wk; a3 += cs[3 * D + k] * wk; }
    part[(wv * 4 + 0) * 64 + lane] = a0; part[(wv * 4 + 1) * 64 + lane] = a1; part[(wv * 4 + 2) * 64 + lane] = a2; part[(wv * 4 + 3) * 64 + lane] = a3;
    __syncthreads();
    {
        const float s = part[(0 * 4 + wv) * 64 + lane] + part[(1 * 4 + wv) * 64 + lane] + part[(2 * 4 + wv) * 64 + lane] + part[(3 * 4 + wv) * 64 + lane];
        p.MOD[((size_t)l * BATCH + wv) * 6 * D + j] = s + p.in[3][l * 6 * D + j];
    }
}

DI void rope_table_item(const Params& p, int idx) {
    const int pos = idx >> 4, i = idx & 15;
    const float inv = 1.0f / powf(10000.0f, (float)(2 * i) / 32.0f);
    const float ang = (float)pos * inv;
    double fr = (double)ang * 0.15915494309189535;
    fr -= rint(fr);
    const float f = (float)fr;
    p.COS[idx] = __builtin_amdgcn_cosf(f); p.SIN[idx] = __builtin_amdgcn_sinf(f);
}

DI void convert_tables(const Params& p, int l, int bid, int nb) {
    const float* us = p.in[21] + (size_t)l * 16384 * D; const float* vs = p.in[22] + (size_t)l * 16384 * D;
    const size_t n8 = (size_t)16384 * D / 8;
    for (size_t i = (size_t)bid * 256 + threadIdx.x; i < n8; i += (size_t)nb * 256) { cvt8(us, p.Ut, i); cvt8(vs, p.Vt, i); }
}

DI void prologue(const Params& p, char* lds) {
    int tid_ = threadIdx.x; asm volatile("" : "+v"(tid_)); const int tid = tid_, lane = tid & 63, wv = tid >> 6, bid = blockIdx.x, nb = gridDim.x;
    for (int it = bid; it < DEPTH * 6 * D / 64; it += nb) ada_item(p, it, lds);
    __syncthreads();
    float* scr = (float*)(lds + wv * 16384);
    const int n_win = (D / 64) * (WIN_N / 32), n_uq = 4 * 24, n_ukv = 2 * 32, n_wo = 16 * 32, n_pq = 16 * 64, per_l = n_win + n_uq + n_ukv + n_wo + n_pq;
    for (int it = bid * 4 + wv; it < DEPTH * per_l; it += nb * 4) {
        const int l = it / per_l; int r = it % per_l;
        if (r < n_win) { transpose_item(TK_WIN, p.in[4] + (size_t)l * D * D_IN, D_IN, D, WIN_N, p.WinT + (size_t)l * WIN_N * D, nullptr, scr, r, lane); continue; } r -= n_win;
        if (r < n_uq) { transpose_item(TK_WUQ, p.in[6] + (size_t)l * 256 * 768, 768, 256, 768, p.WuqT + (size_t)l * 768 * 256, p.in[5] + l * 256, scr, r, lane); continue; } r -= n_uq;
        if (r < n_ukv) { transpose_item(TK_WUKV, p.in[8] + (size_t)l * 128 * 1024, 1024, 128, 1024, p.WukvT + (size_t)l * 1024 * 128, p.in[7] + l * 128, scr, r, lane); continue; } r -= n_ukv;
        if (r < n_wo) { transpose_item(TK_WO, p.in[16] + (size_t)l * D * D, D, D, D, p.WoT + (size_t)l * D * D, nullptr, scr, r, lane); continue; } r -= n_wo;
        transpose_item(TK_WPQ, p.in[19] + (size_t)l * D * 2048, 2048, D, 2048, p.WpqT + (size_t)l * 2048 * D, nullptr, scr, r, lane);
    }
    for (int it = bid; it < DEPTH * 1028; it += nb) fold_pw_item(p, it / 1028, it % 1028);
    for (size_t i = (size_t)bid * 256 + tid; i < (size_t)DEPTH * 16 * 128 * 128; i += (size_t)nb * 256)
        p.SKp[i] = f2bf(p.in[20][(i & ~(size_t)127) + perm16((int)(i & 127))]);
    for (int i = bid * 256 + tid; i < SEQ * 16; i += nb * 256) rope_table_item(p, i);
    convert_tables_fp8(p, 0, bid, nb);
}

DI void modh_items(const Params& p, int bid, int nb) {
    const size_t n8 = (size_t)p.rows * D / 8;
    for (size_t i = (size_t)bid * 256 + threadIdx.x; i < n8; i += (size_t)nb * 256) {
        const size_t e = i * 8; const int row = (int)(e >> 10), col = (int)(e & 1023), b = row / SEQ;
        const float* mod = p.MOD + (size_t)b * 6 * D;
        const float4 x0 = *(const float4*)(p.in[0] + e), x1 = *(const float4*)(p.in[0] + e + 4);
        const float4 h0 = *(const float4*)(mod + col), h1 = *(const float4*)(mod + col + 4), s0 = *(const float4*)(mod + D + col), s1 = *(const float4*)(mod + D + col + 4);
        u32x4 o;
        o.x = pk2(x0.x * (1.f + s0.x) + h0.x, x0.y * (1.f + s0.y) + h0.y); o.y = pk2(x0.z * (1.f + s0.z) + h0.z, x0.w * (1.f + s0.w) + h0.w);
        o.z = pk2(x1.x * (1.f + s1.x) + h1.x, x1.y * (1.f + s1.y) + h1.y); o.w = pk2(x1.z * (1.f + s1.z) + h1.z, x1.w * (1.f + s1.w) + h1.w);
        *(u32x4*)(p.H + e) = o;
    }
}

#ifndef MLA_UNIT
#define MLA_UNIT mla_unit4
#endif
#ifndef P6_BLOCK
#define P6_BLOCK p6a_block
#endif
#ifndef REP_P1
#define REP_P1 1
#endif
#ifndef REP_P2
#define REP_P2 1
#endif
#ifndef REP_P3
#define REP_P3 1
#endif
#ifndef REP_P4
#define REP_P4 1
#endif
#ifndef REP_P5
#define REP_P5 1
#endif
#ifndef REP_SYNC
#define REP_SYNC 1
#endif
typedef const __attribute__((address_space(4))) Params* kparams_t;
#define LOADP(q) const Params& q = p
#define GSYNC() do { for (int rs_ = 0; rs_ < REP_SYNC; ++rs_) { XcdBarrier xb_; xb_.bar = p.ctr + 4096; xb_.x = xb_xcc_id(); xb_.st = (volatile LAS unsigned*)(lds + LDS_TOTAL - 32); xcd_barrier(xb_); } } while (0)
__global__ void __launch_bounds__(256, 2) mega(Params p) {
    extern __shared__ __attribute__((aligned(16))) char lds[];
    cg::grid_group grid = cg::this_grid();
#define bid ((int)blockIdx.x)
#define nb ((int)gridDim.x)
#define rows NTOK
#define mtiles (NTOK / 128)
    {
        if (threadIdx.x < 4) ((volatile LAS unsigned*)(lds + LDS_TOTAL - 32))[threadIdx.x] = 0u;
        __syncthreads();
    }
    (void)xcd_barrier_post(p.ctr + 4096, (volatile LAS unsigned*)(lds + LDS_TOTAL - 32));
#ifndef REP_PRO
#define REP_PRO 1
#endif
    for (int rep = 0; rep < REP_PRO; ++rep) prologue(p, lds);
    grid.sync();
    {
        volatile LAS unsigned* cw = (volatile LAS unsigned*)(lds + LDS_TOTAL - 32);
        if (threadIdx.x == 0) {
            unsigned pre = 0u, even = 1u; const unsigned myx = xb_xcc_id(); unsigned* bar_ = p.ctr + 4096;
            for (unsigned j = 0; j < 16; ++j) { const unsigned c = xb_ld(&bar_[XB_XCNT(j)]); if (j < myx) pre += c; if (j < 8 ? c * 8u != (unsigned)nb : c != 0u) even = 0u; }
            cw[3] = pre + cw[2]; cw[5] = even;
        }
        __syncthreads();
    }
#define SLOT ((int)((volatile LAS unsigned*)(lds + LDS_TOTAL - 32))[3])
#define XEVEN ((int)((volatile LAS unsigned*)(lds + LDS_TOTAL - 32))[5])
#define FOR_TILES(NT, T) for (int u_ = XEVEN ? (SLOT % (nb / 8)) : bid, T = 0; u_ < (XEVEN ? (mtiles / 8) * (NT) : mtiles * (NT)) && ((T = XEVEN ? ((SLOT / (nb / 8)) * (mtiles / 8) + u_ / (NT)) * (NT) + u_ % (NT) : u_), true); u_ += XEVEN ? nb / 8 : nb)
#ifndef REP_MODH
#define REP_MODH 1
#endif
    for (int rep = 0; rep < REP_MODH; ++rep) modh_items(p, bid, nb);
    GSYNC();
    for (int l = 0; l < DEPTH; ++l) {
        { LOADP(q);
        for (int rep = 0; rep < REP_P1; ++rep) FOR_TILES(12, t) p1_tile(q, l, t, lds);
#ifndef REP_CVT
#define REP_CVT 1
#endif
        if (l > 0) for (int rep = 0; rep < REP_CVT; ++rep) convert_tables_fp8(q, l, bid, nb);
        }
        GSYNC();
        { LOADP(q);
        for (int rep = 0; rep < REP_P2; ++rep) { FOR_TILES(6, t) p2q_tile(q, l, t, lds); FOR_TILES(8, t2) p2kv_tile(q, l, t2, lds); }
        }
        GSYNC();
        { LOADP(q);
        {
            const int nbt = rows / SEQ, nmla = nbt * 8 * 64, nswa = nbt * 4 * 64, nconv = rows / 32, ntot = nmla + nswa + nconv;
            int* su = (int*)(lds + LDS_TOTAL - 16);
            for (int rep = 0; rep < REP_P3; ++rep) { unsigned* ctr = q.ctr + l * 64 + rep * 16;
            for (;;) {
                __syncthreads();
                if (threadIdx.x == 0) *su = (int)atomicAdd(ctr, 1u);
                __syncthreads();
                const int u = *su;
                if (u >= ntot) break;
#ifdef P3_ABL
                if (u < nmla) { if (rep + 1 < REP_P3) MLA_UNIT<P3_ABL>(q, u, lds); else MLA_UNIT<0>(q, u, lds); }
#else
                if (u < nmla) MLA_UNIT<0>(q, u, lds);
#endif
                else if (u < nmla + nswa) swa_unit(q, l, u - nmla, lds);
                else conv_unit(q, l, u - nmla - nswa, lds);
            } }
        }
        }
        GSYNC();
        { LOADP(q);
        for (int rep = 0; rep < REP_P4; ++rep) FOR_TILES(8, t) p4_tile(q, l, t, (l == 0) ? q.in[0] : q.XB, q.out, lds);
        }
        GSYNC();
        { LOADP(q);
        { int t_ = threadIdx.x; asm volatile("" : "+v"(t_)); const int wv = t_ >> 6, lane = t_ & 63; for (int r = bid * 4 + wv; r < rows; r += nb * 4) p4b_row(q, l, r, q.out, lane); }
        }
        GSYNC();
        { LOADP(q);
        for (int rep = 0; rep < REP_P5; ++rep) FOR_TILES(16, t) p5_tile(q, l, t, lds);
        }
        GSYNC();
        { LOADP(q);
        {
            const int slot = SLOT, per = rows / nb;
            if (per * nb == rows && (per & 31) == 0) {
#ifdef REP_P6
                for (int rep = 1; rep < REP_P6; ++rep) P6_BLOCK<true>(q, l, slot * per, per, q.out, (l + 1 < DEPTH) ? q.XB : q.out, lds);
#endif
                P6_BLOCK<false>(q, l, slot * per, per, q.out, (l + 1 < DEPTH) ? q.XB : q.out, lds); }
            else for (int u = bid; u < rows / 32; u += nb) p6f_unit(q, l, u, q.out, (l + 1 < DEPTH) ? q.XB : q.out, lds);
        }
        }
        if (l + 1 < DEPTH) GSYNC();
    }
}

#undef bid
#undef nb
#undef rows
#undef mtiles
extern "C" void kernel_launch(void* const* d_in, const int* in_sizes, int n_in, void* d_out, int out_size, void* d_ws, size_t ws_size, hipStream_t stream) {
    const size_t MiB = 1u << 20;
    char* ws = (char*)d_ws;
    Params P{};
    for (int i = 0; i < 25; ++i) P.in[i] = (const float*)d_in[i];
    P.out = (float*)d_out; P.rows = NTOK; P.tok0 = 0;
    size_t o = 0;
    auto take = [&](size_t mib) { char* r = ws + o; o += mib * MiB; return r; };
    char* ctl = take(1);
    P.ctr = (unsigned*)ctl; P.biasO = (float*)(ctl + 64 * 1024); P.MOD = (float*)(ctl + 128 * 1024);
    P.COS = (float*)take(1); P.SIN = P.COS + SEQ * 16;
    P.WinT = (bf16*)take(6); P.WuqT = (bf16*)take(1); P.WukvT = (bf16*)take(1); P.WoT = (bf16*)take(4); P.WpqT = (bf16*)take(8); P.SKp = (bf16*)take(1);
    P.U8 = (unsigned char*)take(16); P.V8 = (unsigned char*)take(16); P.US = (float*)take(1); P.VS = P.US + DEPTH * 16384;
    P.H = (bf16*)take(64); P.MIXIN = P.H;
    P.PROJ = (bf16*)take(80); P.Q = (bf16*)take(48); P.TOPK = (unsigned*)P.Q;
    P.KN = (bf16*)take(32); P.KR = (bf16*)take(2); P.VT = (bf16*)take(32); P.VsT = (bf16*)take(8);
    P.XB = (float*)take(128); P.STATS = (float*)take(1);
    if (o > ws_size) { fprintf(stderr, "kernel_launch: workspace too small: need %zu, have %zu\n", o, ws_size); return; }
    static int grid_blocks = 0;
    if (!grid_blocks) {
        int dev = 0, cus = 0, per_cu = 0;
        (void)hipGetDevice(&dev);
        (void)hipDeviceGetAttribute(&cus, hipDeviceAttributeMultiprocessorCount, dev);
        (void)hipFuncSetAttribute((const void*)mega, hipFuncAttributeMaxDynamicSharedMemorySize, LDS_TOTAL);
        (void)hipOccupancyMaxActiveBlocksPerMultiprocessor(&per_cu, mega, 256, LDS_TOTAL);
        if (per_cu > 2) per_cu = 2;
        if (per_cu < 1) per_cu = 1;
        grid_blocks = cus * per_cu;
    }
    (void)hipMemsetAsync(ctl, 0, 32768, stream);
    void* args[] = {(void*)&P};
    hipError_t e = hipLaunchCooperativeKernel((void*)mega, dim3(grid_blocks), dim3(256), args, LDS_TOTAL, stream);
    if (e != hipSuccess) fprintf(stderr, "cooperative launch failed: %s (grid %d)\n", hipGetErrorString(e), grid_blocks);
}
```

```cpp
#include <hip/hip_runtime.h>
#include <hip/hip_cooperative_groups.h>
#include <cstdio>
#include <cstdint>
namespace cg = cooperative_groups;

constexpr int D = 1024, BATCH = 4, SEQ = 8192, DEPTH = 2, NTOK = BATCH * SEQ;
constexpr int D_IN = 1440;
constexpr int OFF_CQ = 0, OFF_CKV = 256, OFF_KR = 384, OFF_CONV = 416, OFF_QS = 928, OFF_KS = 1184, OFF_VS = 1312;
constexpr float EPS = 1e-6f;
constexpr float DN_ALPHA = 1.41421356237309515f;

typedef __attribute__((ext_vector_type(8))) short bf16x8;
typedef __attribute__((ext_vector_type(16))) float f32x16;
typedef __attribute__((ext_vector_type(4))) unsigned u32x4;
typedef __attribute__((ext_vector_type(2))) unsigned u32x2;
typedef float f32x2_t __attribute__((ext_vector_type(2)));
typedef __bf16 bf16x2_t __attribute__((ext_vector_type(2)));
typedef unsigned short bf16;
#define DI __device__ __forceinline__
#define MFMA32(a, b, c) __builtin_amdgcn_mfma_f32_32x32x16_bf16((a), (b), (c), 0, 0, 0)

DI unsigned pk2(float lo, float hi) { f32x2_t v = {lo, hi}; bf16x2_t b = __builtin_convertvector(v, bf16x2_t); return __builtin_bit_cast(unsigned, b); }
DI bf16 f2bf(float f) { return (bf16)(pk2(f, 0.f) & 0xffffu); }
DI float bf2f(bf16 b) { return __uint_as_float((unsigned)b << 16); }
typedef float f32x2v __attribute__((ext_vector_type(2)));
DI float bflo(unsigned u) { return __uint_as_float(u << 16); }
DI float bfhi(unsigned u) { return __uint_as_float(u & 0xffff0000u); }
DI int crow(int reg, int hh) { return (reg & 3) + 8 * (reg >> 2) + 4 * hh; }
DI int cperm_lin(int rho) { return 16 * ((rho >> 2) & 1) + (rho & 3) + 4 * (rho >> 3); }
DI int cperm_rope(int rho) { int hh = (rho >> 2) & 1, reg = (rho & 3) + 4 * (rho >> 3); return (reg < 8) ? 8 * hh + reg : 16 + 8 * hh + (reg - 8); }
DI int perm16(int p) { int g = (p >> 2) & 3; g = (g == 1) ? 2 : (g == 2) ? 1 : g; return (p & ~15) | (g << 2) | (p & 3); }

constexpr float LOG2E = 1.4426950408889634f;
constexpr int PROJ_LD = 1280;
constexpr int WIN_N = 1536;
constexpr int TS = 144;
constexpr int TILE_B = 128 * TS;
constexpr int STAGE_B = 2 * TILE_B;
constexpr int LDS_BYTES = 2 * STAGE_B;

struct Params {
    const float* in[25];
    float* out;
    bf16 *WinT, *WuqT, *WukvT, *WoT, *WpqT, *SKp, *Ut, *Vt;
    float* biasO;
    float* MOD;
    float* COS; float* SIN;
    bf16 *H, *PROJ, *Q, *KN, *KR, *VT, *VsT, *MIXIN;
    float* XB;
    unsigned* TOPK;
    float* STATS;
    unsigned char *U8, *V8; float *US, *VS;
    unsigned* ctr;
    int rows;
    int tok0;
};

enum { TK_WIN = 0, TK_WUQ = 1, TK_WUKV = 2, TK_WO = 3, TK_WPQ = 4 };
DI void transpose_item(int kind, const float* W, int ldin, int K, int Nout, bf16* WT, const float* rowscale, float* scr, int item, int lane) {
    const int nblk = Nout / 32, kb = item / nblk, nb = item % nblk, k0 = 64 * kb, n0 = 32 * nb;
    int src0 = n0; float cs = 1.f;
    if (kind == TK_WIN) {
        if (n0 < 384) src0 = n0;
        else if (n0 < 896) src0 = 416 + (n0 - 384);
        else if (n0 < 1152) { src0 = 928 + (n0 - 896); cs = 0.125f * LOG2E; }
        else if (n0 < 1280) src0 = 1184 + (n0 - 1152);
        else if (n0 < 1408) src0 = 1312 + (n0 - 1280);
        else if (n0 < 1440) src0 = 384 + (n0 - 1408);
        else src0 = -1;
    } else if (kind == TK_WUQ) cs = 0.10206207261596577f * LOG2E;
#pragma unroll
    for (int i = 0; i < 32; ++i) {
        const int kk = 2 * i + (lane >> 5);
        float v = (src0 >= 0) ? W[(size_t)(k0 + kk) * ldin + src0 + (lane & 31)] : 0.f;
        if (rowscale) v *= rowscale[k0 + kk];
        scr[kk * 33 + (lane & 31)] = v * cs;
    }
    __builtin_amdgcn_s_waitcnt(0xc07f); asm volatile("" ::: "memory");
    const int c = lane & 7;
#pragma unroll
    for (int j = 0; j < 4; ++j) {
        const int n = (lane >> 3) + 8 * j; const float* s = scr + (8 * c) * 33 + n;
        u32x4 o; o.x = pk2(s[0], s[33]); o.y = pk2(s[66], s[99]); o.z = pk2(s[132], s[165]); o.w = pk2(s[198], s[231]);
        if (!(kind == TK_WO && k0 + 8 * c >= 512 && k0 + 8 * c < 768))
            *(u32x4*)(WT + (size_t)(n0 + n) * K + k0 + 8 * c) = o;
    }
    __builtin_amdgcn_s_waitcnt(0xc07f); asm volatile("" ::: "memory");
}

DI void cvt8(const float* src, bf16* dst, size_t i8) {
    const float4 a = ((const float4*)src)[2 * i8], b = ((const float4*)src)[2 * i8 + 1];
    u32x4 o; o.x = pk2(a.x, a.y); o.y = pk2(a.z, a.w); o.z = pk2(b.x, b.y); o.w = pk2(b.z, b.w);
    ((u32x4*)dst)[i8] = o;
}

struct TileRegs { u32x4 v[4]; };
DI void gload_tile(TileRegs& t, const bf16* base, int ld, int k0, int tid) {
#pragma unroll
    for (int i = 0; i < 4; ++i) { const int q = tid + 256 * i, row = q >> 3, kc = q & 7; t.v[i] = *(const u32x4*)(base + (size_t)row * ld + k0 + kc * 8); }
}
DI void sstore_tile(const TileRegs& t, char* lds, int tid) {
#pragma unroll
    for (int i = 0; i < 4; ++i) { const int q = tid + 256 * i, row = q >> 3, kc = q & 7; *(u32x4*)(lds + row * TS + kc * 16) = t.v[i]; }
}
template <int NF, int NG>
DI void gemm_core2(const bf16* A, int lda, const bf16* W, int ldw, int K, char* lds, f32x16 (&acc)[NF][NG], int fo, const int (&frow)[NF], int go, const int (&grow)[NG]) {
    int tid_ = threadIdx.x; asm volatile("" : "+v"(tid_)); const int tid = tid_, hh = (tid & 63) >> 5;
    const int nk = K / 64;
    TileRegs ta0, tw0, ta1, tw1;
    gload_tile(ta0, A, lda, 0, tid); gload_tile(tw0, W, ldw, 0, tid);
    gload_tile(ta1, A, lda, 64, tid); gload_tile(tw1, W, ldw, 64, tid);
    __syncthreads();
    sstore_tile(ta0, lds, tid); sstore_tile(tw0, lds + TILE_B, tid);
    if (2 < nk) { gload_tile(ta0, A, lda, 128, tid); gload_tile(tw0, W, ldw, 128, tid); }
    __syncthreads();
#define GEMM_STEP(KS, TA, TW, TAN, TWN) do { \
        char* cur = lds + ((KS) & 1) * STAGE_B; \
        _Pragma("unroll") for (int kk = 0; kk < 4; ++kk) { \
            bf16x8 f[NF], g[NG]; \
            _Pragma("unroll") for (int x = 0; x < NF; ++x) f[x] = *(const bf16x8*)(cur + fo + frow[x] * TS + kk * 32 + hh * 16); \
            _Pragma("unroll") for (int y = 0; y < NG; ++y) g[y] = *(const bf16x8*)(cur + go + grow[y] * TS + kk * 32 + hh * 16); \
            _Pragma("unroll") for (int x = 0; x < NF; ++x) _Pragma("unroll") for (int y = 0; y < NG; ++y) acc[x][y] = MFMA32(f[x], g[y], acc[x][y]); } \
        if ((KS) + 1 < nk) { char* nxt = lds + (((KS) + 1) & 1) * STAGE_B; sstore_tile(TAN, nxt, tid); sstore_tile(TWN, nxt + TILE_B, tid); \
            if ((KS) + 3 < nk) { gload_tile(TAN, A, lda, ((KS) + 3) * 64, tid); gload_tile(TWN, W, ldw, ((KS) + 3) * 64, tid); } } \
        __syncthreads(); } while (0)
    for (int ks = 0; ks < nk; ks += 2) { GEMM_STEP(ks, ta0, tw0, ta1, tw1); GEMM_STEP(ks + 1, ta1, tw1, ta0, tw0); }
#undef GEMM_STEP
}

template <int NF, int NG>
DI void gemm_core(const bf16* A, int lda, const bf16* W, int ldw, int K, char* lds, f32x16 (&acc)[NF][NG], int fo, const int (&frow)[NF], int go, const int (&grow)[NG]) {
    int tid_ = threadIdx.x; asm volatile("" : "+v"(tid_)); const int tid = tid_, hh = (tid & 63) >> 5;
    TileRegs ta, tw;
    gload_tile(ta, A, lda, 0, tid); gload_tile(tw, W, ldw, 0, tid);
    __syncthreads();
    sstore_tile(ta, lds, tid); sstore_tile(tw, lds + TILE_B, tid);
    __syncthreads();
    const int nk = K / 64;
    for (int ks = 0; ks < nk; ++ks) {
        char* cur = lds + (ks & 1) * STAGE_B;
        if (ks + 1 < nk) { gload_tile(ta, A, lda, (ks + 1) * 64, tid); gload_tile(tw, W, ldw, (ks + 1) * 64, tid); }
#pragma unroll
        for (int kk = 0; kk < 4; ++kk) {
            bf16x8 f[NF], g[NG];
#pragma unroll
            for (int x = 0; x < NF; ++x) f[x] = *(const bf16x8*)(cur + fo + frow[x] * TS + kk * 32 + hh * 16);
#pragma unroll
            for (int y = 0; y < NG; ++y) g[y] = *(const bf16x8*)(cur + go + grow[y] * TS + kk * 32 + hh * 16);
#pragma unroll
            for (int x = 0; x < NF; ++x)
#pragma unroll
                for (int y = 0; y < NG; ++y) acc[x][y] = MFMA32(f[x], g[y], acc[x][y]);
        }
        if (ks + 1 < nk) { char* nxt = lds + ((ks + 1) & 1) * STAGE_B; sstore_tile(ta, nxt, tid); sstore_tile(tw, nxt + TILE_B, tid); }
        __syncthreads();
    }
}

#define LAS3 __attribute__((address_space(3)))
constexpr int GT = 128 * 128;
DI void glds_tile(const bf16* base, int ld, int k0, char* tile, int wv, int lane) {
#pragma unroll
    for (int i = 0; i < 4; ++i) {
        const int row0 = 32 * wv + 8 * i, rr = lane >> 3;
        const bf16* src = base + (size_t)(row0 + rr) * ld + k0 + (((lane & 7) ^ rr) << 3);
        __builtin_amdgcn_global_load_lds((const void*)src, (LAS3 void*)(tile + row0 * 128), 16, 0, 0);
    }
}
template <int NF, int NG>
DI void gemm_core3(const bf16* A, int lda, const bf16* W, int ldw, int K, char* lds, f32x16 (&acc)[NF][NG], int fo, const int (&frow)[NF], int go, const int (&grow)[NG]) {
    int tid_ = threadIdx.x; asm volatile("" : "+v"(tid_)); const int tid = tid_, lane = tid & 63, hh = lane >> 5;
    const int wv = __builtin_amdgcn_readfirstlane(tid >> 6);
    const int nk = K / 64;
    const int fof = fo ? GT : 0, gof = go ? GT : 0;
    int foff[NF], goff[NG], fsw[NF], gsw[NG];
#pragma unroll
    for (int x = 0; x < NF; ++x) { foff[x] = fof + frow[x] * 128; fsw[x] = frow[x] & 7; }
#pragma unroll
    for (int y = 0; y < NG; ++y) { goff[y] = gof + grow[y] * 128; gsw[y] = grow[y] & 7; }
    __syncthreads();
#ifdef G3_PROBE
    const int dry = __builtin_amdgcn_readfirstlane(*(volatile int*)(lds + LDS_BYTES + 1024 - 64));
#else
    const int dry = 0;
#endif
    glds_tile(A, lda, 0, lds, wv, lane); glds_tile(W, ldw, 0, lds + GT, wv, lane);
    __syncthreads();
    for (int ks = 0; ks < nk; ++ks) {
        char* cur = lds + (ks & 1) * (2 * GT);
        if (ks + 1 < nk && !(dry & 1)) { char* nxt = lds + ((ks + 1) & 1) * (2 * GT); glds_tile(A, lda, (ks + 1) * 64, nxt, wv, lane); glds_tile(W, ldw, (ks + 1) * 64, nxt + GT, wv, lane); }
#pragma unroll
        for (int kk = 0; kk < 4; ++kk) {
            bf16x8 f[NF], g[NG];
#pragma unroll
            for (int x = 0; x < NF; ++x) f[x] = *(const bf16x8*)(cur + foff[x] + ((((kk << 1) | hh) ^ fsw[x]) << 4));
#pragma unroll
            for (int y = 0; y < NG; ++y) g[y] = *(const bf16x8*)(cur + goff[y] + ((((kk << 1) | hh) ^ gsw[y]) << 4));
            if (dry & 2) {
#pragma unroll
                for (int x = 0; x < NF; ++x) asm volatile("" :: "v"(f[x]));
#pragma unroll
                for (int y = 0; y < NG; ++y) asm volatile("" :: "v"(g[y]));
            } else {
#pragma unroll
            for (int x = 0; x < NF; ++x)
#pragma unroll
                for (int y = 0; y < NG; ++y) acc[x][y] = MFMA32(f[x], g[y], acc[x][y]);
            }
        }
        __syncthreads();
    }
}


DI u32x4 g4_rsrc(const void* base, unsigned bytes) {
    const unsigned long long a = (unsigned long long)base;
    u32x4 r; r.x = __builtin_amdgcn_readfirstlane((unsigned)a); r.y = __builtin_amdgcn_readfirstlane((unsigned)(a >> 32) & 0xffffu); r.z = bytes; r.w = 0x00020000u;
    return r;
}
DI void g4_dma(unsigned m0v, int voff, u32x4 rsrc, unsigned soff) {
    asm volatile("s_nop 4\n\ts_mov_b32 m0, %0\n\ts_nop 0\n\tbuffer_load_dwordx4 %1, %2, %3 offen lds" :: "s"(m0v), "v"(voff), "s"(rsrc), "s"(soff) : "m0", "memory");
}
template <int NF, int NG>
DI void gemm_core4(const bf16* A, int lda, const bf16* W, int ldw, int K, char* lds, f32x16 (&acc)[NF][NG], int fo, const int (&frow)[NF], int go, const int (&grow)[NG]) {
    int tid_ = threadIdx.x; asm volatile("" : "+v"(tid_)); const int tid = tid_, lane = tid & 63, hh = lane >> 5;
    const int wv = __builtin_amdgcn_readfirstlane(tid >> 6);
    const int nk = K / 32;
    const int fof = fo ? 8192 : 0, gof = go ? 8192 : 0;
    int foff[NF], goff[NG], fsw[NF], gsw[NG];
#pragma unroll
    for (int x = 0; x < NF; ++x) { foff[x] = fof + frow[x] * 64; fsw[x] = (frow[x] >> 2) & 3; }
#pragma unroll
    for (int y = 0; y < NG; ++y) { goff[y] = gof + grow[y] * 64; gsw[y] = (grow[y] >> 2) & 3; }
    const u32x4 rA = g4_rsrc(A, 128u * (unsigned)lda * 2u), rW = g4_rsrc(W, 128u * (unsigned)ldw * 2u);
    const int lsw = ((lane & 3) ^ ((lane >> 4) & 3)) << 4;
    const int voA = (lane >> 2) * lda * 2 + lsw, voW = (lane >> 2) * ldw * 2 + lsw;
    const unsigned ldsb = (unsigned)(size_t)(LAS3 char*)lds;
    const unsigned mb = __builtin_amdgcn_readfirstlane(ldsb + 2048u * wv);
    const unsigned sA0 = (unsigned)(32 * wv * lda) * 2u, sA1 = sA0 + (unsigned)(16 * lda) * 2u, sW0 = (unsigned)(32 * wv * ldw) * 2u, sW1 = sW0 + (unsigned)(16 * ldw) * 2u;
    auto issue = [&](int ks) {
        const unsigned so = (unsigned)(ks & 3) * 16384u, kb = (unsigned)ks * 64u;
        g4_dma(mb + so, voA, rA, sA0 + kb); g4_dma(mb + so + 1024u, voA, rA, sA1 + kb);
        g4_dma(mb + so + 8192u, voW, rW, sW0 + kb); g4_dma(mb + so + 9216u, voW, rW, sW1 + kb);
    };
    __syncthreads();
    issue(0); if (nk > 1) issue(1); if (nk > 2) issue(2);
    for (int ks = 0; ks < nk; ++ks) {
        if (ks + 2 < nk) asm volatile("s_waitcnt vmcnt(8)" ::: "memory"); else if (ks + 1 < nk) asm volatile("s_waitcnt vmcnt(4)" ::: "memory"); else asm volatile("s_waitcnt vmcnt(0)" ::: "memory");
        __syncthreads();
        if (ks + 3 < nk) issue(ks + 3);
        const char* cur = lds + (ks & 3) * 16384;
#pragma unroll
        for (int kk = 0; kk < 2; ++kk) {
            bf16x8 f[NF], g[NG];
#pragma unroll
            for (int x = 0; x < NF; ++x) f[x] = *(const bf16x8*)(cur + foff[x] + ((((kk << 1) | hh) ^ fsw[x]) << 4));
#pragma unroll
            for (int y = 0; y < NG; ++y) g[y] = *(const bf16x8*)(cur + goff[y] + ((((kk << 1) | hh) ^ gsw[y]) << 4));
#pragma unroll
            for (int x = 0; x < NF; ++x)
#pragma unroll
                for (int y = 0; y < NG; ++y) acc[x][y] = MFMA32(f[x], g[y], acc[x][y]);
        }
    }
    __syncthreads();
}

#ifndef GEMM_CORE
#define GEMM_CORE gemm_core3
#endif
template <int NF, int NG> DI void zero_acc(f32x16 (&acc)[NF][NG]) {
#pragma unroll
    for (int x = 0; x < NF; ++x)
#pragma unroll
        for (int y = 0; y < NG; ++y)
#pragma unroll
            for (int r = 0; r < 16; ++r) acc[x][y][r] = 0.f;
}

DI void store16(bf16* dst, const float* v) {
    u32x4 a, b;
    a.x = pk2(v[0], v[1]); a.y = pk2(v[2], v[3]); a.z = pk2(v[4], v[5]); a.w = pk2(v[6], v[7]);
    b.x = pk2(v[8], v[9]); b.y = pk2(v[10], v[11]); b.z = pk2(v[12], v[13]); b.w = pk2(v[14], v[15]);
    *(u32x4*)dst = a; *(u32x4*)(dst + 8) = b;
}
DI void store8(bf16* dst, const float* v) {
    u32x4 a; a.x = pk2(v[0], v[1]); a.y = pk2(v[2], v[3]); a.z = pk2(v[4], v[5]); a.w = pk2(v[6], v[7]);
    *(u32x4*)dst = a;
}
DI void store_vt(bf16* dst, const f32x16& a, int hh) {
    float v0[8], v1[8];
#pragma unroll
    for (int i = 0; i < 8; ++i) { v0[i] = a[i]; v1[i] = a[8 + i]; }
    store8(dst + 8 * hh, v0); store8(dst + 16 + 8 * hh, v1);
}

DI void p1_tile(const Params& p, int l, int tile, char* lds) {
    int tid_ = threadIdx.x; asm volatile("" : "+v"(tid_)); const int tid = tid_, lane = tid & 63, r = lane & 31, hh = lane >> 5;
    const int wv = __builtin_amdgcn_readfirstlane(tid >> 6), wm = wv >> 1, wn = wv & 1;
    const int mt = tile / 12, nt = tile % 12, m0 = mt * 128, n0 = nt * 128;
    const bf16* A = p.H + (size_t)m0 * D;
    const bf16* W = p.WinT + ((size_t)l * WIN_N + n0) * D;
    f32x16 acc[2][2]; zero_acc(acc);
    int frow[2], grow[2];
    const bool kr = (nt == 11);
    int fo, go;
    if (nt == 10) { fo = 0; go = TILE_B; frow[0] = 64 * wm + r; frow[1] = frow[0] + 32; grow[0] = 64 * wn + r; grow[1] = grow[0] + 32; }
    else { fo = TILE_B; go = 0; frow[0] = 64 * wn + (kr ? cperm_rope(r) : cperm_lin(r)); frow[1] = 64 * wn + 32 + cperm_lin(r); grow[0] = 64 * wm + r; grow[1] = grow[0] + 32; }
    GEMM_CORE<2, 2>(A, D, W, D, D, lds, acc, fo, frow, go, grow);
    if (nt == 10) {
#pragma unroll
        for (int x = 0; x < 2; ++x)
#pragma unroll
            for (int y = 0; y < 2; ++y) {
                const int tok = m0 + 64 * wm + 32 * x, b = tok / SEQ, s0 = tok % SEQ, d = 32 * y + r;
                store_vt(p.VsT + ((size_t)(b * 2 + wn) * 64 + d) * SEQ + s0, acc[x][y], hh);
            }
    } else {
        if (!kr) {
#pragma unroll
            for (int x = 0; x < 2; ++x)
#pragma unroll
                for (int y = 0; y < 2; ++y) {
                    const int tok = m0 + 64 * wm + 32 * y + r, col = n0 + 64 * wn + 32 * x + 16 * hh;
                    float v[16];
#pragma unroll
                    for (int i = 0; i < 16; ++i) v[i] = acc[x][y][i];
                    store16(p.PROJ + (size_t)tok * PROJ_LD + col, v);
                }
        } else if (wn == 0) {
#pragma unroll
            for (int y = 0; y < 2; ++y) {
                const int tok = m0 + 64 * wm + 32 * y + r, pos = tok % SEQ;
                const float4 c0 = *(const float4*)(p.COS + pos * 16 + 8 * hh), c1 = *(const float4*)(p.COS + pos * 16 + 8 * hh + 4);
                const float4 s0 = *(const float4*)(p.SIN + pos * 16 + 8 * hh), s1 = *(const float4*)(p.SIN + pos * 16 + 8 * hh + 4);
                const float cs[8] = {c0.x, c0.y, c0.z, c0.w, c1.x, c1.y, c1.z, c1.w}, sn[8] = {s0.x, s0.y, s0.z, s0.w, s1.x, s1.y, s1.z, s1.w};
                float o1[8], o2[8];
#pragma unroll
                for (int i = 0; i < 8; ++i) { const float t1 = acc[0][y][i], t2 = acc[0][y][8 + i]; o1[i] = t1 * cs[i] - t2 * sn[i]; o2[i] = t1 * sn[i] + t2 * cs[i]; }
                store8(p.KR + (size_t)tok * 32 + 8 * hh, o1); store8(p.KR + (size_t)tok * 32 + 16 + 8 * hh, o2);
            }
        }
    }
}
constexpr int LDS_RS_OFF = LDS_BYTES;
constexpr int LDS_TOTAL = LDS_BYTES + 1024;

template <int W> DI void row_rms(const bf16* A, int lda, float* rs, int tid) {
    const int row = tid >> 1, half = tid & 1;
    const u32x4* p = (const u32x4*)(A + (size_t)row * lda + half * (W / 2));
    float ss = 0.f;
#pragma unroll
    for (int i = 0; i < W / 16; ++i) { const u32x4 v = p[i];
        ss += bflo(v.x) * bflo(v.x) + bfhi(v.x) * bfhi(v.x) + bflo(v.y) * bflo(v.y) + bfhi(v.y) * bfhi(v.y)
            + bflo(v.z) * bflo(v.z) + bfhi(v.z) * bfhi(v.z) + bflo(v.w) * bflo(v.w) + bfhi(v.w) * bfhi(v.w); }
    ss += __shfl_xor(ss, 1);
    if (half == 0) rs[row] = rsqrtf(ss * (1.f / W) + EPS);
}

DI void p2q_tile(const Params& p, int l, int tile, char* lds) {
    int tid_ = threadIdx.x; asm volatile("" : "+v"(tid_)); const int tid = tid_, lane = tid & 63, r = lane & 31, hh = lane >> 5;
    const int wv = __builtin_amdgcn_readfirstlane(tid >> 6), wm = wv >> 1, wn = wv & 1;
    const int mt = tile / 6, nt = tile % 6, m0 = mt * 128, n0 = nt * 128;
    const bf16* A = p.PROJ + (size_t)m0 * PROJ_LD;
    const bf16* W = p.WuqT + ((size_t)l * 768 + n0) * 256;
    float* rs = (float*)(lds + LDS_RS_OFF);
    __syncthreads();
    row_rms<256>(A, PROJ_LD, rs, tid);
    f32x16 acc[2][2]; zero_acc(acc);
    int frow[2], grow[2]; bool rope[2];
#pragma unroll
    for (int x = 0; x < 2; ++x) { rope[x] = (((n0 + 64 * wn + 32 * x) >> 5) % 3) == 2; frow[x] = 64 * wn + 32 * x + (rope[x] ? cperm_rope(r) : cperm_lin(r)); }
    grow[0] = 64 * wm + r; grow[1] = grow[0] + 32;
    GEMM_CORE<2, 2>(A, PROJ_LD, W, 256, 256, lds, acc, TILE_B, frow, 0, grow);
#pragma unroll
    for (int y = 0; y < 2; ++y) {
        const int tl = 64 * wm + 32 * y + r, tok = m0 + tl, pos = tok % SEQ;
        const float sc = rs[tl];
#pragma unroll
        for (int x = 0; x < 2; ++x) {
            bf16* dst = p.Q + (size_t)tok * 768 + n0 + 64 * wn + 32 * x;
            if (rope[x]) {
                const float4 c0 = *(const float4*)(p.COS + pos * 16 + 8 * hh), c1 = *(const float4*)(p.COS + pos * 16 + 8 * hh + 4);
                const float4 s0 = *(const float4*)(p.SIN + pos * 16 + 8 * hh), s1 = *(const float4*)(p.SIN + pos * 16 + 8 * hh + 4);
                const float cs[8] = {c0.x, c0.y, c0.z, c0.w, c1.x, c1.y, c1.z, c1.w}, sn[8] = {s0.x, s0.y, s0.z, s0.w, s1.x, s1.y, s1.z, s1.w};
                float o1[8], o2[8];
#pragma unroll
                for (int i = 0; i < 8; ++i) { const float t1 = acc[x][y][i] * sc, t2 = acc[x][y][8 + i] * sc; o1[i] = t1 * cs[i] - t2 * sn[i]; o2[i] = t1 * sn[i] + t2 * cs[i]; }
                store8(dst + 8 * hh, o1); store8(dst + 16 + 8 * hh, o2);
            } else {
                float v[16];
#pragma unroll
                for (int i = 0; i < 16; ++i) v[i] = acc[x][y][i] * sc;
                store16(dst + 16 * hh, v);
            }
        }
    }
}

DI void p2kv_tile(const Params& p, int l, int tile, char* lds) {
    int tid_ = threadIdx.x; asm volatile("" : "+v"(tid_)); const int tid = tid_, lane = tid & 63, r = lane & 31, hh = lane >> 5;
    const int wv = __builtin_amdgcn_readfirstlane(tid >> 6), wm = wv >> 1, wn = wv & 1;
    const int mt = tile >> 3, h = tile & 7, m0 = mt * 128, n0 = h * 128;
    const bf16* A = p.PROJ + (size_t)m0 * PROJ_LD + 256;
    const bf16* W = p.WukvT + ((size_t)l * 1024 + n0) * 128;
    float* rs = (float*)(lds + LDS_RS_OFF);
    __syncthreads();
    row_rms<128>(A, PROJ_LD, rs, tid);
    f32x16 acc[2][2]; zero_acc(acc);
    int frow[2], grow[2];
    int fo, go;
    if (wn == 0) { fo = TILE_B; go = 0; frow[0] = cperm_lin(r); frow[1] = 32 + cperm_lin(r); grow[0] = 64 * wm + r; grow[1] = grow[0] + 32; }
    else         { fo = 0; go = TILE_B; frow[0] = 64 * wm + r; frow[1] = frow[0] + 32; grow[0] = 64 + r; grow[1] = 96 + r; }
    GEMM_CORE<2, 2>(A, PROJ_LD, W, 128, 128, lds, acc, fo, frow, go, grow);
    if (wn == 0) {
#pragma unroll
        for (int y = 0; y < 2; ++y) {
            const int tl = 64 * wm + 32 * y + r, tok = m0 + tl; const float sc = rs[tl];
#pragma unroll
            for (int x = 0; x < 2; ++x) {
                float v[16];
#pragma unroll
                for (int i = 0; i < 16; ++i) v[i] = acc[x][y][i] * sc;
                store16(p.KN + (size_t)tok * 512 + h * 64 + 32 * x + 16 * hh, v);
            }
        }
    } else {
#pragma unroll
        for (int x = 0; x < 2; ++x) {
            const int tl0 = 64 * wm + 32 * x, tok0 = m0 + tl0, b = tok0 / SEQ, s0 = tok0 % SEQ;
#pragma unroll
            for (int y = 0; y < 2; ++y) {
                f32x16 a = acc[x][y];
#pragma unroll
                for (int i = 0; i < 16; ++i) a[i] *= rs[tl0 + crow(i, hh)];
                store_vt(p.VT + ((size_t)(b * 8 + h) * 64 + 32 * y + r) * SEQ + s0, a, hh);
            }
        }
    }
}
constexpr int VSTR = 144;
template <int KD> struct AttnCfg { static constexpr int KSTR = KD * 2 + 16; static constexpr int BUF = 64 * KSTR + 64 * VSTR; };

template <int KD, int MODE, int ABL = 0>
DI void attn_unit(const bf16* Qp, int qld, const bf16* K1, int k1ld, const bf16* K2, const bf16* VTp, bf16* Op, int b, int qb, float sink_l2, char* lds) {
    constexpr int KSTR = AttnCfg<KD>::KSTR, BUF = AttnCfg<KD>::BUF, NKS = KD / 16;
    int tid_ = threadIdx.x; asm volatile("" : "+v"(tid_)); const int tid = tid_, lane = tid & 63, r = lane & 31, hh = lane >> 5;
    const int wv = __builtin_amdgcn_readfirstlane(tid >> 6);
    const int q0 = qb * 128, qpos = q0 + 32 * wv + r;
    const size_t rowb = (size_t)b * SEQ;
    bf16x8 qf[NKS];
#pragma unroll
    for (int ks = 0; ks < NKS; ++ks) qf[ks] = *(const bf16x8*)(Qp + (rowb + qpos) * qld + ks * 16 + hh * 8);
#pragma unroll
    for (int ks = 0; ks < NKS; ++ks) asm volatile("" : "+v"(qf[ks]));
    const int kstart = (MODE == 0) ? 0 : (q0 >= 128 ? q0 - 128 : 0);
    const int nt = (q0 + 128 - kstart) / 64;
    f32x16 ot[2];
#pragma unroll
    for (int i = 0; i < 16; ++i) { ot[0][i] = 0.f; ot[1][i] = 0.f; }
    float m = (MODE == 0) ? -INFINITY : sink_l2, l = (MODE == 1 && hh == 0) ? 1.f : 0.f;
    u32x4 sk[3], sv[2];
    auto gload = [&](int t) {
        const int key0 = kstart + 64 * t;
#pragma unroll
        for (int i = 0; i < 2; ++i) { const int q = tid + 256 * i, row = q >> 3, c = q & 7;
            sk[i] = *(const u32x4*)(K1 + (rowb + key0 + row) * k1ld + c * 8);
            sv[i] = *(const u32x4*)(VTp + (size_t)row * SEQ + key0 + c * 8); }
        if (KD == 96) { const int row = tid >> 2, c = tid & 3; sk[2] = *(const u32x4*)(K2 + (rowb + key0 + row) * 32 + c * 8); }
    };
    auto sstore = [&](char* buf) {
#pragma unroll
        for (int i = 0; i < 2; ++i) { const int q = tid + 256 * i, row = q >> 3, c = q & 7;
            *(u32x4*)(buf + row * KSTR + c * 16) = sk[i];
            *(u32x4*)(buf + 64 * KSTR + row * VSTR + c * 16) = sv[i]; }
        if (KD == 96) { const int row = tid >> 2, c = tid & 3; *(u32x4*)(buf + row * KSTR + 128 + c * 16) = sk[2]; }
    };
    gload(0);
    __syncthreads();
    sstore(lds);
    __syncthreads();
    for (int t = 0; t < nt; ++t) {
        const char* cur = lds + (t & 1) * BUF;
        if (!(ABL & 8)) if (t + 1 < nt) gload(t + 1);
        const int key0 = kstart + 64 * t;
        f32x16 st[2];
        bf16x8 kf[2][NKS];
#pragma unroll
        for (int mt = 0; mt < 2; ++mt)
#pragma unroll
            for (int ks = 0; ks < NKS; ++ks) kf[mt][ks] = *(const bf16x8*)(cur + (mt * 32 + r) * KSTR + ks * 32 + hh * 16);
        __builtin_amdgcn_sched_barrier(0);
#pragma unroll
        for (int mt = 0; mt < 2; ++mt) {
#pragma unroll
            for (int i = 0; i < 16; ++i) st[mt][i] = 0.f;
#pragma unroll
            for (int ks = 0; ks < NKS; ++ks) { if (ABL & 2) { asm volatile("" :: "v"(kf[mt][ks])); st[mt][ks] += 1.f; } else st[mt] = MFMA32(kf[mt][ks], qf[ks], st[mt]); }
        }
        const char* vt = cur + 64 * KSTR;
        bf16x8 vf[2][4];
#pragma unroll
        for (int mt = 0; mt < 2; ++mt)
#pragma unroll
            for (int s = 0; s < 4; ++s) vf[mt][s] = *(const bf16x8*)(vt + (mt * 32 + r) * VSTR + s * 32 + hh * 16);
        __builtin_amdgcn_sched_barrier(0);
        const bool need_mask = (MODE == 1) || (key0 + 63 > q0 + 32 * wv);
        if (need_mask) {
#pragma unroll
            for (int mt = 0; mt < 2; ++mt)
#pragma unroll
                for (int i = 0; i < 16; ++i) {
                    const int key = key0 + mt * 32 + crow(i, hh);
                    const bool ok = (MODE == 0) ? (key <= qpos) : (key <= qpos && key > qpos - 128);
                    if (!ok) st[mt][i] = -INFINITY;
                }
        }
        float mx = st[0][0];
#pragma unroll
        for (int i = 1; i < 16; ++i) mx = fmaxf(mx, st[0][i]);
#pragma unroll
        for (int i = 0; i < 16; ++i) mx = fmaxf(mx, st[1][i]);
        { auto rr = __builtin_amdgcn_permlane32_swap(__float_as_uint(mx), __float_as_uint(mx), false, false); mx = fmaxf(__uint_as_float(rr[0]), __uint_as_float(rr[1])); }
        const float mn = fmaxf(m, mx);
        const float alpha = __builtin_amdgcn_exp2f(m - mn);
        m = mn;
        float ps = 0.f;
#pragma unroll
        for (int mt = 0; mt < 2; ++mt)
#pragma unroll
            for (int i = 0; i < 16; ++i) { const float pv = (ABL & 1) ? (st[mt][i] - mn) : __builtin_amdgcn_exp2f(st[mt][i] - mn); st[mt][i] = pv; ps += pv; }
        l = l * alpha + ps;
#pragma unroll
        for (int i = 0; i < 16; ++i) { ot[0][i] *= alpha; ot[1][i] *= alpha; }
        bf16x8 pb[4];
#pragma unroll
        for (int s = 0; s < 4; ++s) {
            const int mt = s >> 1, o = 8 * (s & 1);
            u32x4 w; w.x = pk2(st[mt][o], st[mt][o + 1]); w.y = pk2(st[mt][o + 2], st[mt][o + 3]); w.z = pk2(st[mt][o + 4], st[mt][o + 5]); w.w = pk2(st[mt][o + 6], st[mt][o + 7]);
            pb[s] = __builtin_bit_cast(bf16x8, w);
        }
        __builtin_amdgcn_sched_barrier(0);
#pragma unroll
        for (int mt = 0; mt < 2; ++mt)
#pragma unroll
            for (int s = 0; s < 4; ++s) { if (ABL & 4) { asm volatile("" :: "v"(vf[mt][s]), "v"(pb[s])); ot[mt][s] += 1.f; } else ot[mt] = MFMA32(vf[mt][s], pb[s], ot[mt]); }
        if (!(ABL & 8)) if (t + 1 < nt) sstore(lds + ((t + 1) & 1) * BUF);
        __syncthreads();
    }
    { auto rr = __builtin_amdgcn_permlane32_swap(__float_as_uint(l), __float_as_uint(l), false, false); l = __uint_as_float(rr[0]) + __uint_as_float(rr[1]); }
    const float inv = 1.f / l;
    bf16* orow = Op + (rowb + qpos) * 1024;
#pragma unroll
    for (int mt = 0; mt < 2; ++mt)
#pragma unroll
        for (int g = 0; g < 4; ++g) {
            u32x2 w; w.x = pk2(ot[mt][4 * g] * inv, ot[mt][4 * g + 1] * inv); w.y = pk2(ot[mt][4 * g + 2] * inv, ot[mt][4 * g + 3] * inv);
            *(u32x2*)(orow + mt * 32 + 8 * g + 4 * hh) = w;
        }
}

template <int ABL = 0> DI void mla_unit(const Params& p, int u, char* lds) {
    const int nbh = (p.rows / SEQ) * 8, qb = 63 - u / nbh, bh = u % nbh, b = bh >> 3, h = bh & 7;
    attn_unit<96, 0, ABL>(p.Q + h * 96, 768, p.KN + h * 64, 512, p.KR, p.VT + (size_t)bh * 64 * SEQ, p.MIXIN + h * 64, b, qb, 0.f, lds);
}
DI void swa_unit(const Params& p, int l, int u, char* lds) {
    const int qb = u & 63, bh = u >> 6, b = bh >> 2, hq = bh & 3, kvh = hq >> 1;
    attn_unit<64, 1>(p.PROJ + 896 + hq * 64, PROJ_LD, p.PROJ + 1152 + kvh * 64, PROJ_LD, nullptr, p.VsT + (size_t)(b * 2 + kvh) * 64 * SEQ, p.MIXIN + 768 + hq * 64, b, qb,
                     p.in[15][l * 4 + hq] * LOG2E, lds);
}

DI void conv_unit(const Params& p, int l, int u, char* lds) {
    int tid_ = threadIdx.x; asm volatile("" : "+v"(tid_)); const int tid = tid_, lane = tid & 63, wv = tid >> 6;
    const int tok0 = u * 32, pos0 = tok0 % SEQ;
    bf16* glu = (bf16*)lds;
    float* hc = (float*)(lds + 62 * 512);
    __syncthreads();
    for (int it = tid; it < 62 * 32; it += 256) {
        const int row = it >> 5, c8 = (it & 31) * 8, pos = pos0 - 30 + row;
        u32x4 o = {0u, 0u, 0u, 0u};
        if (pos >= 0) {
            const bf16* src = p.PROJ + (size_t)(tok0 - 30 + row) * PROJ_LD + 384 + c8;
            const u32x4 a = *(const u32x4*)src, g = *(const u32x4*)(src + 256);
            const unsigned av[4] = {a.x, a.y, a.z, a.w}, gv[4] = {g.x, g.y, g.z, g.w}; unsigned ov[4];
#pragma unroll
            for (int i = 0; i < 4; ++i) {
                const float g0 = bflo(gv[i]), g1 = bfhi(gv[i]);
                ov[i] = pk2(bflo(av[i]) / (1.f + __expf(-g0)), bfhi(av[i]) / (1.f + __expf(-g1)));
            }
            o.x = ov[0]; o.y = ov[1]; o.z = ov[2]; o.w = ov[3];
        }
        *(u32x4*)(glu + row * 256 + c8) = o;
    }
    __syncthreads();
    {
        const int c = tid;
        float w[31];
        const float* wd = p.in[9] + (size_t)l * 31 * 256 + c;
#pragma unroll
        for (int k = 0; k < 31; ++k) w[k] = wd[k * 256];
        const float bd = p.in[10][l * 256 + c];
#pragma unroll 1
        for (int ch = 0; ch < 4; ++ch) {
            float g[38], acc[8];
#pragma unroll
            for (int i = 0; i < 38; ++i) g[i] = bf2f(glu[(ch * 8 + i) * 256 + c]);
#pragma unroll
            for (int tt = 0; tt < 8; ++tt) { acc[tt] = bd;
#pragma unroll
                for (int k = 0; k < 31; ++k) acc[tt] += w[k] * g[tt + k]; }
#pragma unroll
            for (int tt = 0; tt < 8; ++tt) hc[(ch * 8 + tt) * 256 + c] = acc[tt];
        }
    }
    __syncthreads();
    {
        const float4 gg = *(const float4*)(p.in[11] + l * 256 + lane * 4), bb = *(const float4*)(p.in[12] + l * 256 + lane * 4);
#pragma unroll 1
        for (int i = 0; i < 8; ++i) {
            const int t = wv * 8 + i;
            const float4 v = *(const float4*)(hc + t * 256 + lane * 4);
            float s = v.x + v.y + v.z + v.w;
#pragma unroll
            for (int o = 1; o < 64; o <<= 1) s += __shfl_xor(s, o);
            const float mean = s * (1.f / 256.f);
            const float d0 = v.x - mean, d1 = v.y - mean, d2 = v.z - mean, d3 = v.w - mean;
            float q = d0 * d0 + d1 * d1 + d2 * d2 + d3 * d3;
#pragma unroll
            for (int o = 1; o < 64; o <<= 1) q += __shfl_xor(q, o);
            const float rstd = rsqrtf(q * (1.f / 256.f) + EPS);
            float y0 = d0 * rstd * gg.x + bb.x, y1 = d1 * rstd * gg.y + bb.y, y2 = d2 * rstd * gg.z + bb.z, y3 = d3 * rstd * gg.w + bb.w;
            y0 = y0 / (1.f + __expf(-y0)); y1 = y1 / (1.f + __expf(-y1)); y2 = y2 / (1.f + __expf(-y2)); y3 = y3 / (1.f + __expf(-y3));
            u32x2 w; w.x = pk2(y0, y1); w.y = pk2(y2, y3);
            *(u32x2*)(p.MIXIN + (size_t)(tok0 + t) * 1024 + 512 + lane * 4) = w;
        }
    }
}

constexpr int MSLOT = 20480, MKR = 8192, MVT = 12288;
DI u32x4 mla_rsrc(const void* base, unsigned bytes) {
    const unsigned long long a = (unsigned long long)base;
    u32x4 r; r.x = __builtin_amdgcn_readfirstlane((unsigned)a); r.y = __builtin_amdgcn_readfirstlane((unsigned)(a >> 32) & 0xffffu); r.z = bytes; r.w = 0x00020000u;
    return r;
}
DI void mla_dma(unsigned m0v, int voff, u32x4 rsrc, unsigned soff) {
    asm volatile("s_nop 4\n\ts_mov_b32 m0, %0\n\ts_nop 0\n\tbuffer_load_dwordx4 %1, %2, %3 offen lds" :: "s"(m0v), "v"(voff), "s"(rsrc), "s"(soff) : "m0", "memory");
}
template <int ABL = 0>
DI void mla_attn_dma(const bf16* Qp, const bf16* Kn, const bf16* Kr, const bf16* VTp, bf16* Op, int b, int qb, char* lds) {
    int tid_ = threadIdx.x; asm volatile("" : "+v"(tid_)); const int tid = tid_, lane = tid & 63, r = lane & 31, hh = lane >> 5;
    const int wv = __builtin_amdgcn_readfirstlane(tid >> 6);
    const int q0 = qb * 128, qpos = q0 + 32 * wv + r;
    const size_t rowb = (size_t)b * SEQ;
    const int nt = (q0 + 128) / 64;
    const u32x4 rKn = mla_rsrc(Kn + rowb * 512, (unsigned)SEQ * 1024u), rKr = mla_rsrc(Kr + rowb * 32, (unsigned)SEQ * 64u), rVt = mla_rsrc(VTp, 64u * (unsigned)SEQ * 2u);
    const int l8 = lane >> 3, l4 = lane >> 2;
    const int vkn = l8 * 1024 + (((lane & 7) ^ l8) << 4), vkr = l4 * 64 + (((lane & 3) ^ ((l4 >> 2) & 3)) << 4), vvt = l8 * (SEQ * 2) + (((lane & 7) ^ l8) << 4);
    const unsigned ldsb = (unsigned)(size_t)(LAS3 char*)lds;
    const unsigned mkn = __builtin_amdgcn_readfirstlane(ldsb + 2048u * wv), mkr = __builtin_amdgcn_readfirstlane(ldsb + MKR + 1024u * wv), mvt = __builtin_amdgcn_readfirstlane(ldsb + MVT + 2048u * wv);
    auto dma = [&](int t, unsigned slot) {
        const unsigned key0 = 64u * t, so = slot * MSLOT;
        const unsigned skn = (key0 + 16u * wv) * 1024u, skr = (key0 + 16u * wv) * 64u, svt = (16u * wv * SEQ + key0) * 2u;
        mla_dma(mkn + so, vkn, rKn, skn); mla_dma(mkn + so + 1024u, vkn, rKn, skn + 8u * 1024u);
        mla_dma(mkr + so, vkr, rKr, skr);
        mla_dma(mvt + so, vvt, rVt, svt); mla_dma(mvt + so + 1024u, vvt, rVt, svt + 8u * SEQ * 2u);
    };
    dma(0, 0); if (nt > 1) dma(1, 1);
    bf16x8 qf[6];
#pragma unroll
    for (int ks = 0; ks < 6; ++ks) qf[ks] = *(const bf16x8*)(Qp + (rowb + qpos) * 768 + ks * 16 + hh * 8);
#pragma unroll
    for (int ks = 0; ks < 6; ++ks) asm volatile("" : "+v"(qf[ks]));
    asm volatile("s_waitcnt vmcnt(0)" ::: "memory");
    __syncthreads();
    f32x16 ot[2];
#pragma unroll
    for (int i = 0; i < 16; ++i) { ot[0][i] = 0.f; ot[1][i] = 0.f; }
    float m = -INFINITY, l = 0.f;
    const int sw7 = r & 7, sw3 = (r >> 2) & 3;
    unsigned slot = 0;
    for (int t = 0; t < nt; ++t) {
        const char* cur = lds + slot * MSLOT;
        const unsigned slot2 = (slot >= 1) ? slot - 1 : 2;
        if (!(ABL & 8)) if (t + 2 < nt) dma(t + 2, slot2);
        const int key0 = 64 * t;
        f32x16 st[2];
        bf16x8 kf[2][6];
#pragma unroll
        for (int mt = 0; mt < 2; ++mt) {
#pragma unroll
            for (int ks = 0; ks < 4; ++ks) kf[mt][ks] = *(const bf16x8*)(cur + (mt * 32 + r) * 128 + ((((ks << 1) | hh) ^ sw7) << 4));
#pragma unroll
            for (int ks = 4; ks < 6; ++ks) kf[mt][ks] = *(const bf16x8*)(cur + MKR + (mt * 32 + r) * 64 + ((((((ks - 4) << 1) | hh)) ^ sw3) << 4));
        }
        __builtin_amdgcn_sched_barrier(0);
#pragma unroll
        for (int mt = 0; mt < 2; ++mt) {
#pragma unroll
            for (int i = 0; i < 16; ++i) st[mt][i] = 0.f;
#pragma unroll
            for (int ks = 0; ks < 6; ++ks) { if (ABL & 2) { asm volatile("" :: "v"(kf[mt][ks])); st[mt][ks] += 1.f; } else st[mt] = MFMA32(kf[mt][ks], qf[ks], st[mt]); }
        }
        const char* vt = cur + MVT;
        bf16x8 vf[2][4];
#pragma unroll
        for (int mt = 0; mt < 2; ++mt)
#pragma unroll
            for (int s = 0; s < 4; ++s) vf[mt][s] = *(const bf16x8*)(vt + (mt * 32 + r) * 128 + ((((s << 1) | hh) ^ sw7) << 4));
        __builtin_amdgcn_sched_barrier(0);
        if (key0 + 63 > q0 + 32 * wv) {
#pragma unroll
            for (int mt = 0; mt < 2; ++mt)
#pragma unroll
                for (int i = 0; i < 16; ++i) { const int key = key0 + mt * 32 + crow(i, hh); if (key > qpos) st[mt][i] = -INFINITY; }
        }
        float mx = st[0][0];
#pragma unroll
        for (int i = 1; i < 16; ++i) mx = fmaxf(mx, st[0][i]);
#pragma unroll
        for (int i = 0; i < 16; ++i) mx = fmaxf(mx, st[1][i]);
        { auto rr = __builtin_amdgcn_permlane32_swap(__float_as_uint(mx), __float_as_uint(mx), false, false); mx = fmaxf(__uint_as_float(rr[0]), __uint_as_float(rr[1])); }
        const float mn = fmaxf(m, mx);
        const float alpha = __builtin_amdgcn_exp2f(m - mn);
        m = mn;
        float ps = 0.f;
#pragma unroll
        for (int mt = 0; mt < 2; ++mt)
#pragma unroll
            for (int i = 0; i < 16; ++i) { const float pv = (ABL & 1) ? (st[mt][i] - mn) : __builtin_amdgcn_exp2f(st[mt][i] - mn); st[mt][i] = pv; ps += pv; }
        l = l * alpha + ps;
#pragma unroll
        for (int i = 0; i < 16; ++i) { ot[0][i] *= alpha; ot[1][i] *= alpha; }
        bf16x8 pb[4];
#pragma unroll
        for (int s = 0; s < 4; ++s) {
            const int mt = s >> 1, o = 8 * (s & 1);
            u32x4 w; w.x = pk2(st[mt][o], st[mt][o + 1]); w.y = pk2(st[mt][o + 2], st[mt][o + 3]); w.z = pk2(st[mt][o + 4], st[mt][o + 5]); w.w = pk2(st[mt][o + 6], st[mt][o + 7]);
            pb[s] = __builtin_bit_cast(bf16x8, w);
        }
        __builtin_amdgcn_sched_barrier(0);
#pragma unroll
        for (int mt = 0; mt < 2; ++mt)
#pragma unroll
            for (int s = 0; s < 4; ++s) { if (ABL & 4) { asm volatile("" :: "v"(vf[mt][s]), "v"(pb[s])); ot[mt][s] += 1.f; } else ot[mt] = MFMA32(vf[mt][s], pb[s], ot[mt]); }
        if (t + 2 < nt && !(ABL & 8)) asm volatile("s_waitcnt vmcnt(5)" ::: "memory"); else asm volatile("s_waitcnt vmcnt(0)" ::: "memory");
        __syncthreads();
        slot = (slot == 2) ? 0 : slot + 1;
    }
    { auto rr = __builtin_amdgcn_permlane32_swap(__float_as_uint(l), __float_as_uint(l), false, false); l = __uint_as_float(rr[0]) + __uint_as_float(rr[1]); }
    const float inv = 1.f / l;
    bf16* orow = Op + (rowb + qpos) * 1024;
#pragma unroll
    for (int mt = 0; mt < 2; ++mt)
#pragma unroll
        for (int g = 0; g < 4; ++g) {
            u32x2 w; w.x = pk2(ot[mt][4 * g] * inv, ot[mt][4 * g + 1] * inv); w.y = pk2(ot[mt][4 * g + 2] * inv, ot[mt][4 * g + 3] * inv);
            *(u32x2*)(orow + mt * 32 + 8 * g + 4 * hh) = w;
        }
}
template <int ABL = 0> DI void mla_unit2(const Params& p, int u, char* lds) {
    const int nbh = (p.rows / SEQ) * 8, qb = 63 - u / nbh, bh = u % nbh, b = bh >> 3, h = bh & 7;
    mla_attn_dma<ABL>(p.Q + h * 96, p.KN + h * 64, p.KR, p.VT + (size_t)bh * 64 * SEQ, p.MIXIN + h * 64, b, qb, lds);
}
DI void fold_pw_item(const Params& p, int l, int item) {
    const int tid = threadIdx.x;
    const float* wo = p.in[16] + (size_t)l * D * D + (size_t)512 * D;
    if (item < 1024) {
        const int kp = item >> 2, n = (item & 3) * 256 + tid;
        const float* wp = p.in[13] + (size_t)l * 256 * 256 + (size_t)kp * 256;
        float acc = 0.f;
        for (int j = 0; j < 256; ++j) acc += wp[j] * wo[(size_t)j * D + n];
        p.WoT[((size_t)l * D + n) * D + 512 + kp] = f2bf(acc);
    } else {
        const int n = (item - 1024) * 256 + tid;
        const float* bp = p.in[14] + l * 256;
        float acc = 0.f;
        for (int j = 0; j < 256; ++j) acc += bp[j] * wo[(size_t)j * D + n];
        p.biasO[l * D + n] = acc;
    }
}

DI void p4_tile(const Params& p, int l, int tile, const float* xin, float* X1, char* lds) {
    int tid_ = threadIdx.x; asm volatile("" : "+v"(tid_)); const int tid = tid_, lane = tid & 63, r = lane & 31, hh = lane >> 5;
    const int wv = __builtin_amdgcn_readfirstlane(tid >> 6), wm = wv >> 1, wn = wv & 1;
    const int mt = tile >> 3, nt = tile & 7, m0 = mt * 128, n0 = nt * 128;
    const bf16* A = p.MIXIN + (size_t)m0 * D;
    const bf16* W = p.WoT + ((size_t)l * D + n0) * D;
    f32x16 acc[2][2]; zero_acc(acc);
    int frow[2], grow[2];
    frow[0] = 64 * wm + r; frow[1] = frow[0] + 32; grow[0] = 64 * wn + r; grow[1] = grow[0] + 32;
    GEMM_CORE<2, 2>(A, D, W, D, D, lds, acc, 0, frow, TILE_B, grow);
    const int b = (p.tok0 + m0) / SEQ;
    const float* gt = p.MOD + ((size_t)l * BATCH + b) * 6 * D + 2 * D;
#pragma unroll
    for (int y = 0; y < 2; ++y) {
        const int col = n0 + 64 * wn + 32 * y + r;
        const float g1 = 1.f + gt[col], bo = p.biasO[l * D + col];
#pragma unroll
        for (int x = 0; x < 2; ++x) {
            const size_t base = (size_t)(m0 + 64 * wm + 32 * x + 4 * hh) * D + col;
            float xv[16];
#pragma unroll
            for (int i = 0; i < 16; ++i) xv[i] = xin[base + (size_t)((i & 3) + 8 * (i >> 2)) * D];
#pragma unroll
            for (int i = 0; i < 16; ++i) X1[base + (size_t)((i & 3) + 8 * (i >> 2)) * D] = DN_ALPHA * xv[i] + g1 * (acc[x][y][i] + bo);
        }
    }
}

DI void ln16(float (&v)[16], const float* g, const float* bta, int lane) {
    float s = 0.f;
#pragma unroll
    for (int i = 0; i < 16; ++i) s += v[i];
#pragma unroll
    for (int o = 1; o < 64; o <<= 1) s += __shfl_xor(s, o);
    const float mean = s * (1.f / D); float q = 0.f;
#pragma unroll
    for (int i = 0; i < 16; ++i) { v[i] -= mean; q += v[i] * v[i]; }
#pragma unroll
    for (int o = 1; o < 64; o <<= 1) q += __shfl_xor(q, o);
    const float rstd = rsqrtf(q * (1.f / D) + EPS);
#pragma unroll
    for (int hf = 0; hf < 2; ++hf)
#pragma unroll
        for (int q4 = 0; q4 < 2; ++q4) {
            const int c = hf * 512 + lane * 8 + q4 * 4;
            const float4 gg = *(const float4*)(g + c), bb = *(const float4*)(bta + c);
            const int i = hf * 8 + q4 * 4;
            v[i] = v[i] * rstd * gg.x + bb.x; v[i + 1] = v[i + 1] * rstd * gg.y + bb.y; v[i + 2] = v[i + 2] * rstd * gg.z + bb.z; v[i + 3] = v[i + 3] * rstd * gg.w + bb.w;
        }
}
DI void load16(float (&v)[16], const float* row, int lane) {
#pragma unroll
    for (int hf = 0; hf < 2; ++hf)
#pragma unroll
        for (int q4 = 0; q4 < 2; ++q4) { const float4 t = *(const float4*)(row + hf * 512 + lane * 8 + q4 * 4); const int i = hf * 8 + q4 * 4; v[i] = t.x; v[i + 1] = t.y; v[i + 2] = t.z; v[i + 3] = t.w; }
}
DI void store16f(float* row, const float (&v)[16], int lane) {
#pragma unroll
    for (int hf = 0; hf < 2; ++hf)
#pragma unroll
        for (int q4 = 0; q4 < 2; ++q4) { const int i = hf * 8 + q4 * 4; *(float4*)(row + hf * 512 + lane * 8 + q4 * 4) = make_float4(v[i], v[i + 1], v[i + 2], v[i + 3]); }
}
DI void store_mod16(bf16* hrow, const float (&v)[16], const float* sh, const float* sc, int lane) {
#pragma unroll
    for (int hf = 0; hf < 2; ++hf) {
        float o[8];
#pragma unroll
        for (int q4 = 0; q4 < 2; ++q4) {
            const int c = hf * 512 + lane * 8 + q4 * 4, i = hf * 8 + q4 * 4;
            const float4 s4 = *(const float4*)(sc + c), h4 = *(const float4*)(sh + c);
            o[q4 * 4] = v[i] * (1.f + s4.x) + h4.x; o[q4 * 4 + 1] = v[i + 1] * (1.f + s4.y) + h4.y; o[q4 * 4 + 2] = v[i + 2] * (1.f + s4.z) + h4.z; o[q4 * 4 + 3] = v[i + 3] * (1.f + s4.w) + h4.w;
        }
        store8(hrow + hf * 512 + lane * 8, o);
    }
}
DI void p4b_row(const Params& p, int l, int row, float* X1, int lane) {
    float v[16];
    load16(v, X1 + (size_t)row * D, lane);
    float s = 0.f;
#pragma unroll
    for (int i = 0; i < 16; ++i) s += v[i];
#pragma unroll
    for (int o = 1; o < 64; o <<= 1) s += __shfl_xor(s, o);
    const float mean = s * (1.f / D); float q = 0.f;
#pragma unroll
    for (int i = 0; i < 16; ++i) { v[i] -= mean; q += v[i] * v[i]; }
#pragma unroll
    for (int o = 1; o < 64; o <<= 1) q += __shfl_xor(q, o);
    const float rstd = rsqrtf(q * (1.f / D) + EPS);
    if (lane == 0) { p.STATS[2 * (size_t)row] = mean; p.STATS[2 * (size_t)row + 1] = rstd; }
    const float* g = p.in[17] + l * D; const float* bta = p.in[18] + l * D;
#pragma unroll
    for (int hf = 0; hf < 2; ++hf)
#pragma unroll
        for (int q4 = 0; q4 < 2; ++q4) {
            const int c = hf * 512 + lane * 8 + q4 * 4;
            const float4 gg = *(const float4*)(g + c), bb = *(const float4*)(bta + c);
            const int i = hf * 8 + q4 * 4;
            v[i] = v[i] * rstd * gg.x + bb.x; v[i + 1] = v[i + 1] * rstd * gg.y + bb.y; v[i + 2] = v[i + 2] * rstd * gg.z + bb.z; v[i + 3] = v[i + 3] * rstd * gg.w + bb.w;
        }
    const int b = (p.tok0 + row) / SEQ;
    const float* mod = p.MOD + ((size_t)l * BATCH + b) * 6 * D;
    store_mod16(p.H + (size_t)row * D, v, mod + 3 * D, mod + 4 * D, lane);
}

DI unsigned ford(float f) { const unsigned u = __float_as_uint(f); return u ^ ((u >> 31) ? 0xffffffffu : 0x80000000u); }
DI float funord(unsigned o) { const unsigned u = o ^ ((o >> 31) ? 0x80000000u : 0xffffffffu); return __uint_as_float(u); }
constexpr int SKSTR = 272;

DI void p5_tile(const Params& p, int l, int tile, char* lds) {
    int tid_ = threadIdx.x; asm volatile("" : "+v"(tid_)); const int tid = tid_, lane = tid & 63, r = lane & 31, hh = lane >> 5;
    const int wv = __builtin_amdgcn_readfirstlane(tid >> 6);
    const int mt = tile >> 4, hp = tile & 15, m0 = mt * 128;
    const bf16* A = p.H + (size_t)m0 * D;
    const bf16* W = p.WpqT + ((size_t)l * 2048 + hp * 128) * D;
    f32x16 acc[4][1]; zero_acc(acc);
    int frow[4], grow[1];
#pragma unroll
    for (int x = 0; x < 4; ++x) frow[x] = 32 * x + r;
    grow[0] = 32 * wv + r;
    GEMM_CORE<4, 1>(A, D, W, D, D, lds, acc, TILE_B, frow, 0, grow);
    bf16x8 xb[8];
#pragma unroll
    for (int s = 0; s < 8; ++s) {
        const int x = s >> 1, o = 8 * (s & 1);
        u32x4 w; w.x = pk2(acc[x][0][o], acc[x][0][o + 1]); w.y = pk2(acc[x][0][o + 2], acc[x][0][o + 3]); w.z = pk2(acc[x][0][o + 4], acc[x][0][o + 5]); w.w = pk2(acc[x][0][o + 6], acc[x][0][o + 7]);
        xb[s] = __builtin_bit_cast(bf16x8, w);
    }
    const bf16* sk = p.SKp + ((size_t)l * 16 + hp) * 128 * 128;
#pragma unroll
    for (int i = 0; i < 8; ++i) { const int q = tid + 256 * i, row = q >> 4, c = q & 15; *(u32x4*)(lds + row * SKSTR + c * 16) = *(const u32x4*)(sk + row * 128 + c * 8); }
    __syncthreads();
    unsigned L[16];
#pragma unroll
    for (int m2 = 0; m2 < 4; ++m2) {
        f32x16 st;
#pragma unroll
        for (int i = 0; i < 16; ++i) st[i] = 0.f;
#pragma unroll
        for (int s = 0; s < 8; ++s) {
            const bf16x8 a = *(const bf16x8*)(lds + (32 * m2 + r) * SKSTR + s * 32 + hh * 16);
            st = MFMA32(a, xb[s], st);
        }
        unsigned V[16];
#pragma unroll
        for (int i = 0; i < 16; ++i) V[i] = (ford(st[i]) & ~0x7fu) | (unsigned)(32 * m2 + crow(i, hh));
#pragma unroll
        for (int k = 2; k <= 16; k <<= 1)
#pragma unroll
            for (int j = k >> 1; j >= 1; j >>= 1)
#pragma unroll
                for (int i = 0; i < 16; ++i) { const int o = i ^ j; if (o > i) { const unsigned a = max(V[i], V[o]), b = min(V[i], V[o]); if ((i & k) == 0) { V[i] = a; V[o] = b; } else { V[i] = b; V[o] = a; } } }
        if (m2 == 0) {
#pragma unroll
            for (int k = 0; k < 16; ++k) L[k] = V[k];
        } else {
#pragma unroll
            for (int k = 0; k < 16; ++k) L[k] = max(L[k], V[15 - k]);
#pragma unroll
            for (int d = 8; d >= 1; d >>= 1)
#pragma unroll
                for (int i = 0; i < 16; ++i) if ((i & d) == 0) { const unsigned a = max(L[i], L[i + d]), b = min(L[i], L[i + d]); L[i] = a; L[i + d] = b; }
        }
    }
    unsigned C[16];
#pragma unroll
    for (int k = 0; k < 16; ++k) C[k] = max(L[k], (unsigned)__shfl_xor((int)L[15 - k], 32));
#pragma unroll
    for (int d = 8; d >= 1; d >>= 1)
#pragma unroll
        for (int i = 0; i < 16; ++i) if ((i & d) == 0) { const unsigned a = max(C[i], C[i + d]), b = min(C[i], C[i + d]); C[i] = a; C[i + d] = b; }
    unsigned* dst = p.TOPK + ((size_t)(m0 + 32 * wv + r) * 16 + hp) * 16 + 8 * hh;
    u32x4 o0, o1;
    if (hh == 0) { o0 = (u32x4){C[0], C[1], C[2], C[3]}; o1 = (u32x4){C[4], C[5], C[6], C[7]}; }
    else { o0 = (u32x4){C[8], C[9], C[10], C[11]}; o1 = (u32x4){C[12], C[13], C[14], C[15]}; }
    *(u32x4*)dst = o0; *(u32x4*)(dst + 4) = o1;
}
typedef __bf16 bf16x2v __attribute__((ext_vector_type(2)));
DI float dot2(unsigned a, unsigned b, float c) { return __builtin_amdgcn_fdot2_f32_bf16(__builtin_bit_cast(bf16x2v, a), __builtin_bit_cast(bf16x2v, b), c, false); }
DI float gelu_erf(float a) { return 0.5f * a * (1.f + erff(a * 0.70710678118654752f)); }

DI void p6_unit(const Params& p, int l, int u, const float* X1, float* xout, char* lds) {
    int tid_ = threadIdx.x; asm volatile("" : "+v"(tid_)); const int tid = tid_, lane = tid & 63;
    const int wv = __builtin_amdgcn_readfirstlane(tid >> 6);
    unsigned* LA = (unsigned*)(lds + wv * 16384); unsigned* LB = LA + 1024; unsigned* Ee = LA + 2048; float* Eg = (float*)(LA + 3072);
    const int tokb = u * 32 + wv * 8;
    __syncthreads();
    {
        const int ti = lane >> 3, head = lane & 7;
        const unsigned* src = p.TOPK + ((size_t)(tokb + ti) * 16 + head * 2) * 16;
        unsigned A[16], B[16];
#pragma unroll
        for (int q = 0; q < 4; ++q) { const u32x4 a = *(const u32x4*)(src + 4 * q), b = *(const u32x4*)(src + 16 + 4 * q);
            A[4 * q] = a.x; A[4 * q + 1] = a.y; A[4 * q + 2] = a.z; A[4 * q + 3] = a.w; B[4 * q] = b.x; B[4 * q + 1] = b.y; B[4 * q + 2] = b.z; B[4 * q + 3] = b.w;
            *(u32x4*)(LA + lane * 16 + 4 * q) = a; *(u32x4*)(LB + lane * 16 + 4 * q) = b; }
        float sA[16], sB[16];
#pragma unroll
        for (int k = 0; k < 16; ++k) { sA[k] = funord(A[k] & ~0x7fu); sB[k] = funord(B[k] & ~0x7fu); }
        unsigned T[16];
#pragma unroll
        for (int k = 0; k < 16; ++k) T[k] = 0u;
#pragma unroll
        for (int a = 0; a < 16; ++a)
#pragma unroll
            for (int b = 0; b < 16; ++b)
                if ((a + 1) * (b + 1) <= 16) {
                    unsigned v = (ford(sA[a] + sB[b]) & ~0xffu) | (unsigned)(a * 16 + b);
#pragma unroll
                    for (int k = 0; k < 16; ++k) { const unsigned t = max(T[k], v); v = min(T[k], v); T[k] = t; }
                }
        float ex[16]; float sum = 0.f; const float mx = funord(T[0] & ~0xffu);
#pragma unroll
        for (int k = 0; k < 16; ++k) { ex[k] = __expf(funord(T[k] & ~0xffu) - mx); sum += ex[k]; }
        const float inv = 1.f / sum;
#pragma unroll
        for (int k = 0; k < 16; ++k) {
            const unsigned cid = T[k] & 0xffu, ia = LA[lane * 16 + (cid >> 4)] & 0x7fu, ib = LB[lane * 16 + (cid & 15u)] & 0x7fu;
            Ee[ti * 128 + head * 16 + k] = ia * 128u + ib; Eg[ti * 128 + head * 16 + k] = ex[k] * inv;
        }
    }
    const bf16* Ut = p.Ut; const bf16* Vt = p.Vt;
    const int jl = 4 * (lane >> 5) + 2 * ((lane >> 4) & 1) + ((lane >> 3) & 1);
    const bool b5 = lane & 32, b4 = lane & 16, b3 = lane & 8;
#pragma unroll 1
    for (int ti = 0; ti < 8; ++ti) {
        const int tok = tokb + ti;
        const u32x4 h0 = *(const u32x4*)(p.H + (size_t)tok * D + lane * 8), h1 = *(const u32x4*)(p.H + (size_t)tok * D + 512 + lane * 8);
        float y[16];
#pragma unroll
        for (int i = 0; i < 16; ++i) y[i] = 0.f;
#pragma unroll 1
        for (int bt = 0; bt < 16; ++bt) {
            u32x4 uu[8][2], vv[8][2];
#pragma unroll
            for (int j = 0; j < 8; ++j) {
                const unsigned e = __builtin_amdgcn_readfirstlane(Ee[ti * 128 + bt * 8 + j]);
                const bf16* ur = Ut + (size_t)e * D + lane * 8; const bf16* vr = Vt + (size_t)e * D + lane * 8;
                uu[j][0] = *(const u32x4*)ur; uu[j][1] = *(const u32x4*)(ur + 512);
                vv[j][0] = *(const u32x4*)vr; vv[j][1] = *(const u32x4*)(vr + 512);
            }
            float a[8];
#pragma unroll
            for (int j = 0; j < 8; ++j) {
                float s = dot2(h0.x, uu[j][0].x, 0.f); s = dot2(h0.y, uu[j][0].y, s); s = dot2(h0.z, uu[j][0].z, s); s = dot2(h0.w, uu[j][0].w, s);
                s = dot2(h1.x, uu[j][1].x, s); s = dot2(h1.y, uu[j][1].y, s); s = dot2(h1.z, uu[j][1].z, s); s = dot2(h1.w, uu[j][1].w, s);
                a[j] = s;
            }
            float k1[4], k2[2], k3;
#pragma unroll
            for (int i = 0; i < 4; ++i) { const float snd = b5 ? a[i] : a[4 + i]; const float rcv = __shfl_xor(snd, 32); k1[i] = (b5 ? a[4 + i] : a[i]) + rcv; }
#pragma unroll
            for (int i = 0; i < 2; ++i) { const float snd = b4 ? k1[i] : k1[2 + i]; const float rcv = __shfl_xor(snd, 16); k2[i] = (b4 ? k1[2 + i] : k1[i]) + rcv; }
            { const float snd = b3 ? k2[0] : k2[1]; const float rcv = __shfl_xor(snd, 8); k3 = (b3 ? k2[1] : k2[0]) + rcv; }
            k3 += __shfl_xor(k3, 4); k3 += __shfl_xor(k3, 2); k3 += __shfl_xor(k3, 1);
            const float w = Eg[ti * 128 + bt * 8 + jl] * gelu_erf(k3);
#pragma unroll
            for (int j = 0; j < 8; ++j) {
                const int src = 32 * (j >> 2) + 16 * ((j >> 1) & 1) + 8 * (j & 1);
                const float wj = __uint_as_float(__builtin_amdgcn_readlane(__float_as_uint(w), src));
                const unsigned w0[4] = {vv[j][0].x, vv[j][0].y, vv[j][0].z, vv[j][0].w}, w1[4] = {vv[j][1].x, vv[j][1].y, vv[j][1].z, vv[j][1].w};
#pragma unroll
                for (int i = 0; i < 4; ++i) { y[2 * i] += wj * bflo(w0[i]); y[2 * i + 1] += wj * bfhi(w0[i]); y[8 + 2 * i] += wj * bflo(w1[i]); y[8 + 2 * i + 1] += wj * bfhi(w1[i]); }
            }
        }
        const int b = (p.tok0 + tok) / SEQ;
        const float* mod = p.MOD + ((size_t)l * BATCH + b) * 6 * D;
        float v[16], gt[16];
        load16(v, X1 + (size_t)tok * D, lane); load16(gt, mod + 5 * D, lane);
#pragma unroll
        for (int i = 0; i < 16; ++i) v[i] = DN_ALPHA * v[i] + (1.f + gt[i]) * y[i];
        ln16(v, p.in[23] + l * D, p.in[24] + l * D, lane);
        store16f(xout + (size_t)tok * D, v, lane);
        if (l + 1 < DEPTH) { const float* modn = p.MOD + ((size_t)(l + 1) * BATCH + b) * 6 * D; store_mod16(p.H + (size_t)tok * D, v, modn, modn + D, lane); }
    }
}
DI void table_row_fp8(const float* src, unsigned char* dst, float* inv_scale, int lane) {
    float v[16];
#pragma unroll
    for (int q = 0; q < 4; ++q) { const float4 t = *(const float4*)(src + lane * 16 + q * 4); v[4 * q] = t.x; v[4 * q + 1] = t.y; v[4 * q + 2] = t.z; v[4 * q + 3] = t.w; }
    float mx = 0.f;
#pragma unroll
    for (int i = 0; i < 16; ++i) mx = fmaxf(mx, fabsf(v[i]));
#pragma unroll
    for (int o = 1; o < 64; o <<= 1) mx = fmaxf(mx, __shfl_xor(mx, o));
    const float sc = (mx > 0.f) ? 448.f / mx : 1.f;
    u32x4 o;
    unsigned w[4];
#pragma unroll
    for (int q = 0; q < 4; ++q) { unsigned t = 0u; t = __builtin_amdgcn_cvt_pk_fp8_f32(v[4 * q] * sc, v[4 * q + 1] * sc, t, false); t = __builtin_amdgcn_cvt_pk_fp8_f32(v[4 * q + 2] * sc, v[4 * q + 3] * sc, t, true); w[q] = t; }
    o.x = w[0]; o.y = w[1]; o.z = w[2]; o.w = w[3];
    *(u32x4*)(dst + lane * 16) = o;
    if (lane == 0) *inv_scale = (mx > 0.f) ? mx * (1.f / 448.f) : 1.f;
}
DI void convert_tables_fp8(const Params& p, int l, int bid, int nb) {
    int t_ = threadIdx.x; asm volatile("" : "+v"(t_)); const int wv = t_ >> 6, lane = t_ & 63;
    const float* us = p.in[21] + (size_t)l * 16384 * D; const float* vs = p.in[22] + (size_t)l * 16384 * D;
    for (int row = bid * 4 + wv; row < 2 * 16384; row += nb * 4) {
        if (row < 16384) table_row_fp8(us + (size_t)row * D, p.U8 + (size_t)row * D, p.US + l * 16384 + row, lane);
        else { const int r2 = row - 16384; table_row_fp8(vs + (size_t)r2 * D, p.V8 + (size_t)r2 * D, p.VS + l * 16384 + r2, lane); }
    }
}
DI void load16c(float (&v)[16], const float* row, int lane) {
#pragma unroll
    for (int q = 0; q < 4; ++q) { const float4 t = *(const float4*)(row + lane * 16 + q * 4); v[4 * q] = t.x; v[4 * q + 1] = t.y; v[4 * q + 2] = t.z; v[4 * q + 3] = t.w; }
}
DI void ln16c(float (&v)[16], const float* g, const float* bta, int lane) {
    float s = 0.f;
#pragma unroll
    for (int i = 0; i < 16; ++i) s += v[i];
#pragma unroll
    for (int o = 1; o < 64; o <<= 1) s += __shfl_xor(s, o);
    const float mean = s * (1.f / D); float q = 0.f;
#pragma unroll
    for (int i = 0; i < 16; ++i) { v[i] -= mean; q += v[i] * v[i]; }
#pragma unroll
    for (int o = 1; o < 64; o <<= 1) q += __shfl_xor(q, o);
    const float rstd = rsqrtf(q * (1.f / D) + EPS);
    float gg[16], bb[16]; load16c(gg, g, lane); load16c(bb, bta, lane);
#pragma unroll
    for (int i = 0; i < 16; ++i) v[i] = v[i] * rstd * gg[i] + bb[i];
}
DI void store16c(float* row, const float (&v)[16], int lane) {
#pragma unroll
    for (int q = 0; q < 4; ++q) *(float4*)(row + lane * 16 + q * 4) = make_float4(v[4 * q], v[4 * q + 1], v[4 * q + 2], v[4 * q + 3]);
}
DI void store_mod16c(bf16* hrow, const float (&v)[16], const float* sh, const float* sc, int lane) {
    float s[16], h[16], o[16]; load16c(s, sc, lane); load16c(h, sh, lane);
#pragma unroll
    for (int i = 0; i < 16; ++i) o[i] = v[i] * (1.f + s[i]) + h[i];
    store16(hrow + lane * 16, o);
}

DI void p6f_unit(const Params& p, int l, int u, const float* X1, float* xout, char* lds) {
    int tid_ = threadIdx.x; asm volatile("" : "+v"(tid_)); const int tid = tid_, lane = tid & 63;
    const int wv = __builtin_amdgcn_readfirstlane(tid >> 6);
    unsigned* LA = (unsigned*)(lds + wv * 16384); unsigned* LB = LA + 1024; unsigned* Ee = LA + 2048; float* Eg = (float*)(LA + 3072); float* Es = (float*)LA;
    const int tokb = u * 32 + wv * 8;
    __syncthreads();
    {
        const int ti = lane >> 3, head = lane & 7;
        const unsigned* src = p.TOPK + ((size_t)(tokb + ti) * 16 + head * 2) * 16;
        unsigned A[16], B[16];
#pragma unroll
        for (int q = 0; q < 4; ++q) { const u32x4 a = *(const u32x4*)(src + 4 * q), b = *(const u32x4*)(src + 16 + 4 * q);
            A[4 * q] = a.x; A[4 * q + 1] = a.y; A[4 * q + 2] = a.z; A[4 * q + 3] = a.w; B[4 * q] = b.x; B[4 * q + 1] = b.y; B[4 * q + 2] = b.z; B[4 * q + 3] = b.w;
            *(u32x4*)(LA + lane * 16 + 4 * q) = a; *(u32x4*)(LB + lane * 16 + 4 * q) = b; }
        float sA[16], sB[16];
#pragma unroll
        for (int k = 0; k < 16; ++k) { sA[k] = funord(A[k] & ~0x7fu); sB[k] = funord(B[k] & ~0x7fu); }
        unsigned T[16];
#pragma unroll
        for (int k = 0; k < 16; ++k) T[k] = 0u;
#pragma unroll
        for (int a = 0; a < 16; ++a)
#pragma unroll
            for (int b = 0; b < 16; ++b)
                if ((a + 1) * (b + 1) <= 16) {
                    unsigned v = (ford(sA[a] + sB[b]) & ~0xffu) | (unsigned)(a * 16 + b);
#pragma unroll
                    for (int k = 0; k < 16; ++k) { const unsigned t = max(T[k], v); v = min(T[k], v); T[k] = t; }
                }
        float ex[16]; float sum = 0.f; const float mx = funord(T[0] & ~0xffu);
        unsigned ev[16];
#pragma unroll
        for (int k = 0; k < 16; ++k) { ex[k] = __expf(funord(T[k] & ~0xffu) - mx); sum += ex[k];
            const unsigned cid = T[k] & 0xffu; ev[k] = (LA[lane * 16 + (cid >> 4)] & 0x7fu) * 128u + (LB[lane * 16 + (cid & 15u)] & 0x7fu); }
        const float inv = 1.f / sum;
        const float* US = p.US + l * 16384; const float* VS = p.VS + l * 16384;
#pragma unroll
        for (int k = 0; k < 16; ++k) {
            const float su = US[ev[k]], sv = VS[ev[k]];
            Ee[ti * 128 + head * 16 + k] = ev[k]; Eg[ti * 128 + head * 16 + k] = ex[k] * inv * sv; Es[ti * 128 + head * 16 + k] = su;
        }
    }
    const unsigned char* U8 = p.U8; const unsigned char* V8 = p.V8;
    const int jl = 8 * (lane >> 5) + 4 * ((lane >> 4) & 1) + 2 * ((lane >> 3) & 1) + ((lane >> 2) & 1);
    const bool b5 = lane & 32, b4 = lane & 16, b3 = lane & 8, b2 = lane & 4;
#pragma unroll 1
    for (int ti = 0; ti < 8; ++ti) {
        const int tok = tokb + ti;
        const u32x4 h0 = *(const u32x4*)(p.H + (size_t)tok * D + lane * 16), h1 = *(const u32x4*)(p.H + (size_t)tok * D + lane * 16 + 8);
        const unsigned hw[8] = {h0.x, h0.y, h0.z, h0.w, h1.x, h1.y, h1.z, h1.w};
        f32x2v hf[8], y2[8];
#pragma unroll
        for (int i = 0; i < 8; ++i) { hf[i] = (f32x2v){bflo(hw[i]), bfhi(hw[i])}; y2[i] = (f32x2v){0.f, 0.f}; }
#pragma unroll 1
        for (int bt = 0; bt < 8; ++bt) {
            u32x4 uu[16], vv[16];
#pragma unroll
            for (int j = 0; j < 16; ++j) {
                const unsigned e = __builtin_amdgcn_readfirstlane(Ee[ti * 128 + bt * 16 + j]);
                uu[j] = *(const u32x4*)(U8 + (size_t)e * D + lane * 16);
                vv[j] = *(const u32x4*)(V8 + (size_t)e * D + lane * 16);
            }
            float a[16];
#pragma unroll
            for (int j = 0; j < 16; ++j) {
                const unsigned w[4] = {uu[j].x, uu[j].y, uu[j].z, uu[j].w};
                f32x2v acc = {0.f, 0.f};
#pragma unroll
                for (int q = 0; q < 4; ++q) { acc = __builtin_amdgcn_cvt_pk_f32_fp8(w[q], false) * hf[2 * q] + acc; acc = __builtin_amdgcn_cvt_pk_f32_fp8(w[q], true) * hf[2 * q + 1] + acc; }
                a[j] = acc.x + acc.y;
            }
            float k1[8], k2[4], k3[2], k4;
#pragma unroll
            for (int i = 0; i < 8; ++i) { const float snd = b5 ? a[i] : a[8 + i]; const float rcv = __shfl_xor(snd, 32); k1[i] = (b5 ? a[8 + i] : a[i]) + rcv; }
#pragma unroll
            for (int i = 0; i < 4; ++i) { const float snd = b4 ? k1[i] : k1[4 + i]; const float rcv = __shfl_xor(snd, 16); k2[i] = (b4 ? k1[4 + i] : k1[i]) + rcv; }
#pragma unroll
            for (int i = 0; i < 2; ++i) { const float snd = b3 ? k2[i] : k2[2 + i]; const float rcv = __shfl_xor(snd, 8); k3[i] = (b3 ? k2[2 + i] : k2[i]) + rcv; }
            { const float snd = b2 ? k3[0] : k3[1]; const float rcv = __shfl_xor(snd, 4); k4 = (b2 ? k3[1] : k3[0]) + rcv; }
            k4 += __shfl_xor(k4, 2); k4 += __shfl_xor(k4, 1);
            const int ei = ti * 128 + bt * 16 + jl;
            const float w = Eg[ei] * gelu_erf(k4 * Es[ei]);
#pragma unroll
            for (int j = 0; j < 16; ++j) {
                const int src = 32 * (j >> 3) + 16 * ((j >> 2) & 1) + 8 * ((j >> 1) & 1) + 4 * (j & 1);
                const float wj = __uint_as_float(__builtin_amdgcn_readlane(__float_as_uint(w), src));
                const f32x2v wj2 = {wj, wj};
                const unsigned wd[4] = {vv[j].x, vv[j].y, vv[j].z, vv[j].w};
#pragma unroll
                for (int q = 0; q < 4; ++q) { y2[2 * q] = __builtin_amdgcn_cvt_pk_f32_fp8(wd[q], false) * wj2 + y2[2 * q]; y2[2 * q + 1] = __builtin_amdgcn_cvt_pk_f32_fp8(wd[q], true) * wj2 + y2[2 * q + 1]; }
            }
        }
        const int b = (p.tok0 + tok) / SEQ;
        const float* mod = p.MOD + ((size_t)l * BATCH + b) * 6 * D;
        float v[16], gt[16];
        load16c(v, X1 + (size_t)tok * D, lane); load16c(gt, mod + 5 * D, lane);
        {
            const float mean1 = p.STATS[2 * (size_t)tok], rstd1 = p.STATS[2 * (size_t)tok + 1];
            float g1[16], b1[16]; load16c(g1, p.in[17] + l * D, lane); load16c(b1, p.in[18] + l * D, lane);
#pragma unroll
            for (int i = 0; i < 16; ++i) v[i] = (v[i] - mean1) * rstd1 * g1[i] + b1[i];
        }
#pragma unroll
        for (int i = 0; i < 8; ++i) { v[2 * i] = DN_ALPHA * v[2 * i] + (1.f + gt[2 * i]) * y2[i].x; v[2 * i + 1] = DN_ALPHA * v[2 * i + 1] + (1.f + gt[2 * i + 1]) * y2[i].y; }
        ln16c(v, p.in[23] + l * D, p.in[24] + l * D, lane);
        store16c(xout + (size_t)tok * D, v, lane);
        if (l + 1 < DEPTH) { const float* modn = p.MOD + ((size_t)(l + 1) * BATCH + b) * 6 * D; store_mod16c(p.H + (size_t)tok * D, v, modn, modn + D, lane); }
    }
}
#ifndef P6_NR
#define P6_NR 8
#endif
constexpr int NR = P6_NR, RSH = (NR == 16) ? 10 : (NR == 8) ? 11 : (NR == 4) ? 12 : (NR == 2) ? 13 : 14;

DI void p6x_combine(const Params& p, int l, int tokb, unsigned* LA, unsigned* LB, unsigned* Ee, float* Eg, float* Es, int lane) {
    const int ti = lane >> 3, head = lane & 7;
    const unsigned* src = p.TOPK + ((size_t)(tokb + ti) * 16 + head * 2) * 16;
    unsigned A[16], B[16];
#pragma unroll
    for (int q = 0; q < 4; ++q) { const u32x4 a = *(const u32x4*)(src + 4 * q), b = *(const u32x4*)(src + 16 + 4 * q);
        A[4 * q] = a.x; A[4 * q + 1] = a.y; A[4 * q + 2] = a.z; A[4 * q + 3] = a.w; B[4 * q] = b.x; B[4 * q + 1] = b.y; B[4 * q + 2] = b.z; B[4 * q + 3] = b.w;
        *(u32x4*)(LA + lane * 16 + 4 * q) = a; *(u32x4*)(LB + lane * 16 + 4 * q) = b; }
    float sA[16], sB[16];
#pragma unroll
    for (int k = 0; k < 16; ++k) { sA[k] = funord(A[k] & ~0x7fu); sB[k] = funord(B[k] & ~0x7fu); }
    unsigned T[16];
#pragma unroll
    for (int k = 0; k < 16; ++k) T[k] = 0u;
#pragma unroll
    for (int a = 0; a < 16; ++a)
#pragma unroll
        for (int b = 0; b < 16; ++b)
            if ((a + 1) * (b + 1) <= 16) {
                unsigned v = (ford(sA[a] + sB[b]) & ~0xffu) | (unsigned)(a * 16 + b);
#pragma unroll
                for (int k = 0; k < 16; ++k) { const unsigned t = max(T[k], v); v = min(T[k], v); T[k] = t; }
            }
    float ex[16]; float sum = 0.f; const float mx = funord(T[0] & ~0xffu);
    unsigned ev[16];
#pragma unroll
    for (int k = 0; k < 16; ++k) { ex[k] = __expf(funord(T[k] & ~0xffu) - mx); sum += ex[k];
        const unsigned cid = T[k] & 0xffu; ev[k] = (LA[lane * 16 + (cid >> 4)] & 0x7fu) * 128u + (LB[lane * 16 + (cid & 15u)] & 0x7fu); }
    const float inv = 1.f / sum;
    const float* US = p.US + l * 16384; const float* VS = p.VS + l * 16384;
    float su[16], gv[16];
#pragma unroll
    for (int k = 0; k < 16; ++k) { su[k] = US[ev[k]]; gv[k] = ex[k] * inv * VS[ev[k]]; }
    unsigned* cnt = LB; unsigned* off = LB + 8 * NR; unsigned* cur = LB + 16 * NR;
    for (int i = lane; i < 24 * NR; i += 64) LB[i] = 0u;
#pragma unroll
    for (int k = 0; k < 16; ++k) atomicAdd(&cnt[ti * NR + (ev[k] >> RSH)], 1u);
    {
#pragma unroll
        for (int rb = 0; rb < NR; rb += 8) {
            unsigned s = 0u;
#pragma unroll
            for (int r = 0; r < NR; ++r) { const unsigned c = cnt[ti * NR + r]; if (r < head + rb) s += c; }
            if (head + rb < NR) off[ti * NR + head + rb] = s;
        }
    }
#pragma unroll
    for (int k = 0; k < 16; ++k) {
        const int r = ev[k] >> RSH;
        const unsigned pos = off[ti * NR + r] + atomicAdd(&cur[ti * NR + r], 1u);
        Ee[ti * 128 + pos] = ev[k]; Eg[ti * 128 + pos] = gv[k]; Es[ti * 128 + pos] = su[k];
    }
}

DI float gelu_fast(float v) {
    const float av = fabsf(v), t = __builtin_amdgcn_rcpf(av * 0.2316418882f + 1.0f);
    float q = t * 0.5307027145f + (-0.7265760135f); q = q * t + 0.7107068705f; q = q * t + (-0.142248368f); q = q * t + 0.127414796f; q = q * t;
    const float e = __builtin_amdgcn_exp2f((v * v) * (-0.72134752044f));
    const float m = v * (q * e);
    return v < 0.f ? m : v - m;
}
template <bool DRY> DI void p6x_ids(unsigned (&en)[8], const unsigned* Ee, unsigned desc) {
    const int ebase = desc & 0x3ff, n = (desc >> 10) & 0xf;
#pragma unroll
    for (int j = 0; j < 8; ++j) en[j] = (__builtin_amdgcn_readfirstlane(Ee[ebase + (j < n ? j : 0)]) & (DRY ? 1023u : 0xffffu)) * (unsigned)D;
}
typedef __amdgpu_buffer_rsrc_t rsrc_t;
DI u32x4 rowload(rsrc_t r, int voff, unsigned soff) { return __builtin_amdgcn_raw_buffer_load_b128(r, voff, (int)soff, 0); }
DI void p6x_issue(u32x4 (&buf)[8], rsrc_t T8, const unsigned (&en)[8], int voff) {
#pragma unroll
    for (int j = 0; j < 8; ++j) buf[j] = rowload(T8, voff, en[j]);
}
template <int CTRL> DI float dppf(float v) { return __uint_as_float(__builtin_amdgcn_mov_dpp(__float_as_uint(v), CTRL, 0xf, 0xf, true)); }
DI float pair32(float x, float y) { auto r = __builtin_amdgcn_permlane32_swap(__float_as_uint(x), __float_as_uint(y), false, false); return __uint_as_float(r[0]) + __uint_as_float(r[1]); }
DI float pair16(float x, float y) { auto r = __builtin_amdgcn_permlane16_swap(__float_as_uint(x), __float_as_uint(y), false, false); return __uint_as_float(r[0]) + __uint_as_float(r[1]); }
DI float p6x_dots(u32x4 (&uu)[8], rsrc_t U8, const unsigned (&en)[8], bool refill, u32x4 (&hw)[2], const bf16* hnext, const float* Eg, const float* Es, unsigned desc,
                  int lane, int jl, bool b5, bool b4, bool b3) {
    const int ebase = desc & 0x3ff, n = (desc >> 10) & 0xf;
    float a[8];
    {
        f32x2v hf[8];
#pragma unroll
        for (int i = 0; i < 8; ++i) { const unsigned hwi = (i < 4) ? hw[0][i & 3] : hw[1][i & 3]; hf[i] = (f32x2v){bflo(hwi), bfhi(hwi)}; }
#pragma unroll
        for (int j = 0; j < 8; ++j) {
            f32x2v acc0 = __builtin_amdgcn_cvt_pk_f32_fp8(uu[j].x, false) * hf[0];
            f32x2v acc1 = __builtin_amdgcn_cvt_pk_f32_fp8(uu[j].x, true) * hf[1];
            acc0 = __builtin_amdgcn_cvt_pk_f32_fp8(uu[j].y, false) * hf[2] + acc0;
            acc1 = __builtin_amdgcn_cvt_pk_f32_fp8(uu[j].y, true) * hf[3] + acc1;
            acc0 = __builtin_amdgcn_cvt_pk_f32_fp8(uu[j].z, false) * hf[4] + acc0;
            acc1 = __builtin_amdgcn_cvt_pk_f32_fp8(uu[j].z, true) * hf[5] + acc1;
            acc0 = __builtin_amdgcn_cvt_pk_f32_fp8(uu[j].w, false) * hf[6] + acc0;
            acc1 = __builtin_amdgcn_cvt_pk_f32_fp8(uu[j].w, true) * hf[7] + acc1;
            acc0 += acc1;
            a[j] = acc0.x + acc0.y;
        }
    }
    __builtin_amdgcn_sched_barrier(0);
    hw[0] = *(const u32x4*)hnext; hw[1] = *(const u32x4*)(hnext + 8);
#pragma unroll
    for (int j = 0; j < 8; ++j) uu[j] = rowload(U8, lane * 16, en[j]);
    __builtin_amdgcn_sched_barrier(0);
    float k1[4], k2[2], k3;
#pragma unroll
    for (int i = 0; i < 4; ++i) k1[i] = pair32(a[i], a[4 + i]);
#pragma unroll
    for (int i = 0; i < 2; ++i) k2[i] = pair16(k1[i], k1[2 + i]);
    { const float snd = b3 ? k2[0] : k2[1]; k3 = (b3 ? k2[1] : k2[0]) + dppf<0x128>(snd); }
    k3 += dppf<0x141>(k3);
    k3 += dppf<0xB1>(k3);
    k3 += dppf<0x4E>(k3);
    const int ei = ebase + (jl < n ? jl : 0);
    return (jl < n) ? Eg[ei] * gelu_fast(k3 * Es[ei]) : 0.f;
}
DI void p6x_axpy(u32x4 (&vv)[8], rsrc_t V8, const unsigned (&en)[8], bool refill, float w, f32x2v (&y2)[8], int lane) {
#pragma unroll
    for (int j = 0; j < 8; ++j) {
        const int src = 32 * (j >> 2) + 16 * ((j >> 1) & 1) + 8 * (j & 1);
        const float wj = __uint_as_float(__builtin_amdgcn_readlane(__float_as_uint(w), src));
        const f32x2v wj2 = {wj, wj};
        const unsigned wd[4] = {vv[j].x, vv[j].y, vv[j].z, vv[j].w};
#pragma unroll
        for (int q = 0; q < 4; ++q) { y2[2 * q] = __builtin_amdgcn_cvt_pk_f32_fp8(wd[q], false) * wj2 + y2[2 * q]; y2[2 * q + 1] = __builtin_amdgcn_cvt_pk_f32_fp8(wd[q], true) * wj2 + y2[2 * q + 1]; }
    }
    __builtin_amdgcn_sched_barrier(0);
#pragma unroll
    for (int j = 0; j < 8; ++j) vv[j] = rowload(V8, lane * 16, en[j]);
    __builtin_amdgcn_sched_barrier(0);
}
#define P6X_AXPY(T) p6x_axpy(V, V8, en, more, w_, y2[T], lane)

template <bool DRY> DI void p6x_block(const Params& p, int l, int tok_first, int ntok, const float* X1, float* xout, char* lds) {
    int tid_ = threadIdx.x; asm volatile("" : "+v"(tid_)); const int tid = tid_, lane = tid & 63;
    const int wv = __builtin_amdgcn_readfirstlane(tid >> 6);
    unsigned* LA = (unsigned*)(lds + wv * 16384); unsigned* LB = LA + 1024; unsigned* Ee = LA + 2048; float* Eg = (float*)(LA + 3072); float* Es = (float*)LA;
    const unsigned* cnt = LB; const unsigned* off = LB + 8 * NR; unsigned* dl = LB + 24 * NR;
    const rsrc_t U8 = __builtin_amdgcn_make_buffer_rsrc((void*)p.U8, 0, 16384 * D, 0x00020000), V8 = __builtin_amdgcn_make_buffer_rsrc((void*)p.V8, 0, 16384 * D, 0x00020000);
    const int jl = 4 * (lane >> 5) + 2 * ((lane >> 4) & 1) + ((lane >> 3) & 1);
    const bool b5 = lane & 32, b4 = lane & 16, b3 = lane & 8;
    const int per_wave = ntok >> 2;
    __syncthreads();
#pragma unroll 1
    for (int g8 = 0; g8 < per_wave; g8 += 8) {
        const int tokb = tok_first + wv * per_wave + g8;
        { int lc = lane; asm volatile("" : "+v"(lc)); p6x_combine(p, l, tokb, LA, LB, Ee, Eg, Es, lc); }
#pragma unroll 1
        for (int sw = 0; sw < 2; ++sw) {
            int nd;
            {
                int lane_d = lane; asm volatile("" : "+v"(lane_d));
                const bool rev = ((g8 >> 3) * 2 + sw) & 1;
                const int rr = (lane_d >> 2) & (NR - 1), t = lane_d & 3, r = rev ? (NR - 1 - rr) : rr, ti = sw * 4 + t;
                const int n = (lane_d < 4 * NR) ? (int)cnt[ti * NR + r] : 0, base = (int)off[ti * NR + r];
                const int nbat = (n + 7) >> 3;
                int incl = nbat;
#pragma unroll
                for (int o = 1; o < 64; o <<= 1) { const int up = __shfl_up(incl, o); if (lane_d >= o) incl += up; }
                const int start = incl - nbat;
                for (int k = 0; k < nbat; ++k) { const int rem = n - 8 * k; dl[start + k] = ((unsigned)t << 14) | ((unsigned)(rem < 8 ? rem : 8) << 10) | (unsigned)(ti * 128 + base + 8 * k); }
                nd = __builtin_amdgcn_readlane(incl, 63);
            }
            f32x2v y2[4][8];
#pragma unroll
            for (int t = 0; t < 4; ++t)
#pragma unroll
                for (int i = 0; i < 8; ++i) y2[t][i] = (f32x2v){0.f, 0.f};
            const bf16* hbase = p.H + (size_t)(tokb + sw * 4) * D + lane * 16;
            u32x4 U[8], V[8]; unsigned en[8];
            unsigned dA = __builtin_amdgcn_readfirstlane(dl[0]);
            u32x4 hw[2];
            if (nd > 0) { p6x_ids<DRY>(en, Ee, dA); p6x_issue(U, U8, en, lane * 16); p6x_issue(V, V8, en, lane * 16); const bf16* hr = hbase + (size_t)(dA >> 14) * D; hw[0] = *(const u32x4*)hr; hw[1] = *(const u32x4*)(hr + 8); }
#pragma unroll 1
            for (int i = 0; i < nd; ++i) {
                const bool more = i + 1 < nd;
                const unsigned dB = __builtin_amdgcn_readfirstlane(dl[more ? i + 1 : i]);
                p6x_ids<DRY>(en, Ee, dB);
                const int t_ = (int)(dA >> 14);
                const float w_ = p6x_dots(U, U8, en, more, hw, hbase + (size_t)(dB >> 14) * D, Eg, Es, dA, lane, jl, b5, b4, b3);
                switch (t_) { case 0: P6X_AXPY(0); break; case 1: P6X_AXPY(1); break; case 2: P6X_AXPY(2); break; default: P6X_AXPY(3); break; }
                dA = dB;
            }
#pragma unroll
            for (int t = 0; t < 4; ++t) {
                int lane_e = lane; asm volatile("" : "+v"(lane_e));
                const int tok = tokb + sw * 4 + t;
                const int b = (p.tok0 + tok) / SEQ;
                const float* mod = p.MOD + ((size_t)l * BATCH + b) * 6 * D;
                float v[16], gt[16];
                load16c(v, X1 + (size_t)tok * D, lane_e); load16c(gt, mod + 5 * D, lane_e);
#pragma unroll
                for (int i = 0; i < 8; ++i) { v[2 * i] = DN_ALPHA * v[2 * i] + (1.f + gt[2 * i]) * y2[t][i].x; v[2 * i + 1] = DN_ALPHA * v[2 * i + 1] + (1.f + gt[2 * i + 1]) * y2[t][i].y; }
                ln16c(v, p.in[23] + l * D, p.in[24] + l * D, lane_e);
                if (DRY) {
#pragma unroll
                    for (int i = 0; i < 16; ++i) asm volatile("" :: "v"(v[i]));
                    continue; }
                store16c(xout + (size_t)tok * D, v, lane_e);
                if (l + 1 < DEPTH) { const float* modn = p.MOD + ((size_t)(l + 1) * BATCH + b) * 6 * D; store_mod16c(p.H + (size_t)tok * D, v, modn, modn + D, lane_e); }
                __builtin_amdgcn_sched_barrier(0);
            }
        }
    }
}
#ifdef P6_NOPTAIL
#define P6_TAILNOP "\n\ts_nop 7\n\ts_nop 7\n\ts_nop 7\n\ts_nop 7\n\ts_nop 7\n\ts_nop 7\n\ts_nop 7\n\ts_nop 7"
#else
#define P6_TAILNOP
#endif
#ifdef P6C_SAFE
#define P6C_W10 "s_waitcnt vmcnt(0)"
#else
#define P6C_W10 "s_waitcnt vmcnt(10)"
#endif

DI u32x4 p6a_rsrc(const unsigned char* base) {
    const unsigned long long a = (unsigned long long)base;
    u32x4 r; r.x = __builtin_amdgcn_readfirstlane((unsigned)a); r.y = __builtin_amdgcn_readfirstlane((unsigned)(a >> 32) & 0xffffu); r.z = 16384u * (unsigned)D; r.w = 0x00020000u;
    return r;
}
#ifndef P6_DRYMODE
#define P6_DRYMODE 0
#endif
#ifndef P6_FULLBATCH
#define P6_FULLBATCH 0
#endif
#ifndef P6_LDMOD
#define P6_LDMOD ""
#endif
#ifndef P6_SWEEPSYNC
#define P6_SWEEPSYNC 0
#endif
#ifndef P6_DRYMASK
#define P6_DRYMASK 0
#endif
template <bool DRY> DI void p6a_ids(unsigned (&en)[8], const unsigned* Ee, unsigned desc, int lane) {
    const int ebase = desc & 0x3ff, n = (desc >> 10) & 0xf, j = lane & 7;
    const unsigned ev = (Ee[ebase + (j < n ? j : 0)] & ((DRY && (P6_DRYMODE == 1 || P6_DRYMASK)) ? 1023u : 0xffffu)) * (unsigned)D;
#pragma unroll
    for (int k = 0; k < 8; ++k) en[k] = __builtin_amdgcn_readlane(ev, k);
}
DI void p6a_load8(u32x4 (&b)[8], u32x4 rsrc, int voff, const unsigned (&so)[8]) {
    asm volatile("s_nop 4\n\t"
        "buffer_load_dwordx4 %0, %8, %9, %10 offen" P6_LDMOD "\n\t" "buffer_load_dwordx4 %1, %8, %9, %11 offen" P6_LDMOD "\n\t" "buffer_load_dwordx4 %2, %8, %9, %12 offen" P6_LDMOD "\n\t" "buffer_load_dwordx4 %3, %8, %9, %13 offen" P6_LDMOD "\n\t"
        "buffer_load_dwordx4 %4, %8, %9, %14 offen" P6_LDMOD "\n\t" "buffer_load_dwordx4 %5, %8, %9, %15 offen" P6_LDMOD "\n\t" "buffer_load_dwordx4 %6, %8, %9, %16 offen" P6_LDMOD "\n\t" "buffer_load_dwordx4 %7, %8, %9, %17 offen" P6_LDMOD P6_TAILNOP
        : "=&v"(b[0]), "=&v"(b[1]), "=&v"(b[2]), "=&v"(b[3]), "=&v"(b[4]), "=&v"(b[5]), "=&v"(b[6]), "=&v"(b[7])
        : "v"(voff), "s"(rsrc), "s"(so[0]), "s"(so[1]), "s"(so[2]), "s"(so[3]), "s"(so[4]), "s"(so[5]), "s"(so[6]), "s"(so[7])
        : "memory");
}
DI void p6a_loadh(u32x4 (&h)[2], const bf16* src) {
    asm volatile("global_load_dwordx4 %0, %2, off\n\tglobal_load_dwordx4 %1, %2, off offset:16" : "=&v"(h[0]), "=&v"(h[1]) : "v"(src) : "memory");
}
DI void p6a_wait_hu(u32x4 (&h)[2], u32x4 (&b)[8]) {
    asm volatile("s_waitcnt vmcnt(8)" : "+v"(h[0]), "+v"(h[1]), "+v"(b[0]), "+v"(b[1]), "+v"(b[2]), "+v"(b[3]), "+v"(b[4]), "+v"(b[5]), "+v"(b[6]), "+v"(b[7]) :: "memory");
}
DI void p6a_wait_v(u32x4 (&b)[8]) {
    asm volatile(P6C_W10  : "+v"(b[0]), "+v"(b[1]), "+v"(b[2]), "+v"(b[3]), "+v"(b[4]), "+v"(b[5]), "+v"(b[6]), "+v"(b[7]) :: "memory");
}
DI void p6a_drain(u32x4 (&h)[2], u32x4 (&u)[8], u32x4 (&v)[8]) {
    asm volatile("s_waitcnt vmcnt(0)" : "+v"(h[0]), "+v"(h[1]), "+v"(u[0]), "+v"(u[1]), "+v"(u[2]), "+v"(u[3]), "+v"(u[4]), "+v"(u[5]), "+v"(u[6]), "+v"(u[7]),
                                        "+v"(v[0]), "+v"(v[1]), "+v"(v[2]), "+v"(v[3]), "+v"(v[4]), "+v"(v[5]), "+v"(v[6]), "+v"(v[7]) :: "memory");
}
DI void p6a_dot8(float (&a)[8], const u32x4 (&uu)[8], const u32x4 (&hw)[2]) {
    f32x2v hf[8];
#pragma unroll
    for (int i = 0; i < 8; ++i) { const unsigned hwi = (i < 4) ? hw[0][i & 3] : hw[1][i & 3]; hf[i] = (f32x2v){bflo(hwi), bfhi(hwi)}; }
#pragma unroll
    for (int j = 0; j < 8; ++j) {
        f32x2v acc0 = __builtin_amdgcn_cvt_pk_f32_fp8(uu[j].x, false) * hf[0];
        f32x2v acc1 = __builtin_amdgcn_cvt_pk_f32_fp8(uu[j].x, true) * hf[1];
        acc0 = __builtin_amdgcn_cvt_pk_f32_fp8(uu[j].y, false) * hf[2] + acc0;
        acc1 = __builtin_amdgcn_cvt_pk_f32_fp8(uu[j].y, true) * hf[3] + acc1;
        acc0 = __builtin_amdgcn_cvt_pk_f32_fp8(uu[j].z, false) * hf[4] + acc0;
        acc1 = __builtin_amdgcn_cvt_pk_f32_fp8(uu[j].z, true) * hf[5] + acc1;
        acc0 = __builtin_amdgcn_cvt_pk_f32_fp8(uu[j].w, false) * hf[6] + acc0;
        acc1 = __builtin_amdgcn_cvt_pk_f32_fp8(uu[j].w, true) * hf[7] + acc1;
        acc0 += acc1;
        a[j] = acc0.x + acc0.y;
    }
}
DI float p6a_reduce_gate(const float (&a)[8], const float* Eg, const float* Es, unsigned desc, int jl, bool b3) {
    const int ebase = desc & 0x3ff, n = (desc >> 10) & 0xf;
    float k1[4], k2[2], k3;
#pragma unroll
    for (int i = 0; i < 4; ++i) k1[i] = pair32(a[i], a[4 + i]);
#pragma unroll
    for (int i = 0; i < 2; ++i) k2[i] = pair16(k1[i], k1[2 + i]);
    { const float snd = b3 ? k2[0] : k2[1]; k3 = (b3 ? k2[1] : k2[0]) + dppf<0x128>(snd); }
    k3 += dppf<0x141>(k3); k3 += dppf<0xB1>(k3); k3 += dppf<0x4E>(k3);
    const int ei = ebase + (jl < n ? jl : 0);
    return (jl < n) ? Eg[ei] * gelu_fast(k3 * Es[ei]) : 0.f;
}
DI void p6a_axpy8(const u32x4 (&vv)[8], float w, f32x2v (&y2)[8]) {
#pragma unroll
    for (int j = 0; j < 8; ++j) {
        const int src = 32 * (j >> 2) + 16 * ((j >> 1) & 1) + 8 * (j & 1);
        const float wj = __uint_as_float(__builtin_amdgcn_readlane(__float_as_uint(w), src));
        const f32x2v wj2 = {wj, wj};
        const unsigned wd[4] = {vv[j].x, vv[j].y, vv[j].z, vv[j].w};
#pragma unroll
        for (int q = 0; q < 4; ++q) { y2[2 * q] = __builtin_amdgcn_cvt_pk_f32_fp8(wd[q], false) * wj2 + y2[2 * q]; y2[2 * q + 1] = __builtin_amdgcn_cvt_pk_f32_fp8(wd[q], true) * wj2 + y2[2 * q + 1]; }
    }
}
template <bool DRY> DI void p6a_block(const Params& p, int l, int tok_first, int ntok, const float* X1, float* xout, char* lds) {
    int tid_ = threadIdx.x; asm volatile("" : "+v"(tid_)); const int tid = tid_, lane = tid & 63;
    const int wv = __builtin_amdgcn_readfirstlane(tid >> 6);
    unsigned* LA = (unsigned*)(lds + wv * 16384); unsigned* LB = LA + 1024; unsigned* Ee = LA + 2048; float* Eg = (float*)(LA + 3072); float* Es = (float*)LA;
    const unsigned* cnt = LB; const unsigned* off = LB + 8 * NR; unsigned* dl = LB + 24 * NR;
    const u32x4 rU = p6a_rsrc(p.U8), rV = p6a_rsrc(p.V8);
    const int jl = 4 * (lane >> 5) + 2 * ((lane >> 4) & 1) + ((lane >> 3) & 1);
    const bool b5 = lane & 32, b4 = lane & 16, b3 = lane & 8;
    const int per_wave = ntok >> 2;
    __syncthreads();
#pragma unroll 1
    for (int g8 = 0; g8 < per_wave; g8 += 8) {
        const int tokb = tok_first + wv * per_wave + g8;
        { int lc = lane; asm volatile("" : "+v"(lc)); p6x_combine(p, l, tokb, LA, LB, Ee, Eg, Es, lc); }
#pragma unroll 1
        for (int sw = 0; sw < 2; ++sw) {
            int nd;
#if P6_FULLBATCH
            {
                int lane_d = lane; asm volatile("" : "+v"(lane_d));
                const bool rev = ((g8 >> 3) * 2 + sw) & 1;
                const int kk = lane_d >> 2, t = lane_d & 3, k = rev ? (15 - kk) : kk, ti = sw * 4 + t;
                dl[lane_d] = ((unsigned)t << 14) | (8u << 10) | (unsigned)(ti * 128 + 8 * k);
                nd = 64; asm volatile("" : "+s"(nd));
            }
#else
            {
                int lane_d = lane; asm volatile("" : "+v"(lane_d));
                const bool rev = ((g8 >> 3) * 2 + sw) & 1;
                const int rr = (lane_d >> 2) & (NR - 1), t = lane_d & 3, r = rev ? (NR - 1 - rr) : rr, ti = sw * 4 + t;
                const int n = (lane_d < 4 * NR) ? (int)cnt[ti * NR + r] : 0, base = (int)off[ti * NR + r];
                const int nbat = (n + 7) >> 3;
                int incl = nbat;
#pragma unroll
                for (int o = 1; o < 64; o <<= 1) { const int up = __shfl_up(incl, o); if (lane_d >= o) incl += up; }
                const int start = incl - nbat;
                for (int k = 0; k < nbat; ++k) { const int rem = n - 8 * k; dl[start + k] = ((unsigned)t << 14) | ((unsigned)(rem < 8 ? rem : 8) << 10) | (unsigned)(ti * 128 + base + 8 * k); }
                nd = __builtin_amdgcn_readlane(incl, 63);
            }
#endif
#if P6_SWEEPSYNC
            { XcdBarrier xb_; xb_.bar = p.ctr + 4096; xb_.x = xb_xcc_id(); xb_.st = (volatile LAS unsigned*)(lds + LDS_TOTAL - 32); xcd_barrier(xb_); }
#endif
            f32x2v y2[4][8];
#pragma unroll
            for (int t = 0; t < 4; ++t)
#pragma unroll
                for (int i = 0; i < 8; ++i) y2[t][i] = (f32x2v){0.f, 0.f};
            const bf16* hbase = p.H + (size_t)(tokb + sw * 4) * D + lane * 16;
            u32x4 U[8], V[8], hw[2]; unsigned en[8];
            asm volatile("s_waitcnt vmcnt(0)" ::: "memory");
            unsigned dA = __builtin_amdgcn_readfirstlane(dl[0]);
            { p6a_ids<DRY>(en, Ee, dA, lane); p6a_loadh(hw, hbase + (size_t)(dA >> 14) * D); p6a_load8(U, rU, lane * 16, en); p6a_load8(V, rV, lane * 16, en); }
#pragma unroll 1
            for (int i = 0; i < nd; ++i) {
                const unsigned dB = __builtin_amdgcn_readfirstlane(dl[i + 1 < nd ? i + 1 : i]);
                p6a_ids<DRY>(en, Ee, dB, lane);
                const int t_ = (int)(dA >> 14);
                if (DRY && P6_DRYMODE == 4) p6a_drain(hw, U, V); else if (!(DRY && P6_DRYMODE == 2)) p6a_wait_hu(hw, U);
                float a[8];
                if (DRY && (P6_DRYMODE == 3 || P6_DRYMODE == 4)) {
#pragma unroll
                    for (int j = 0; j < 8; ++j) a[j] = __uint_as_float(U[j].x); }
                else p6a_dot8(a, U, hw);
                __builtin_amdgcn_sched_barrier(0);
                if (!(DRY && P6_DRYMODE == 2)) { p6a_loadh(hw, hbase + (size_t)(dB >> 14) * D); p6a_load8(U, rU, lane * 16, en); }
                __builtin_amdgcn_sched_barrier(0);
                const float w_ = p6a_reduce_gate(a, Eg, Es, dA, jl, b3);
                if (!(DRY && (P6_DRYMODE == 2 || P6_DRYMODE == 4))) p6a_wait_v(V);
                if (DRY && (P6_DRYMODE == 3 || P6_DRYMODE == 4)) { y2[0][0].x += w_ * __uint_as_float(V[0].x ^ V[1].x ^ V[2].x ^ V[3].x ^ V[4].x ^ V[5].x ^ V[6].x ^ V[7].x); } else
                switch (t_) { case 0: p6a_axpy8(V, w_, y2[0]); break; case 1: p6a_axpy8(V, w_, y2[1]); break; case 2: p6a_axpy8(V, w_, y2[2]); break; default: p6a_axpy8(V, w_, y2[3]); break; }
                __builtin_amdgcn_sched_barrier(0);
                if (!(DRY && (P6_DRYMODE == 2 || P6_DRYMODE == 4))) p6a_load8(V, rV, lane * 16, en);
                __builtin_amdgcn_sched_barrier(0);
                dA = dB;
            }
            p6a_drain(hw, U, V);
#pragma unroll
            for (int t = 0; t < 4; ++t) {
                int lane_e = lane; asm volatile("" : "+v"(lane_e));
                const int tok = tokb + sw * 4 + t;
                const int b = (p.tok0 + tok) / SEQ;
                const float* mod = p.MOD + ((size_t)l * BATCH + b) * 6 * D;
                float v[16], gt[16];
                load16c(v, X1 + (size_t)tok * D, lane_e); load16c(gt, mod + 5 * D, lane_e);
                {
                    const float mean1 = p.STATS[2 * (size_t)tok], rstd1 = p.STATS[2 * (size_t)tok + 1];
                    float g1[16], b1[16]; load16c(g1, p.in[17] + l * D, lane_e); load16c(b1, p.in[18] + l * D, lane_e);
#pragma unroll
                    for (int i = 0; i < 16; ++i) v[i] = (v[i] - mean1) * rstd1 * g1[i] + b1[i];
                }
#pragma unroll
                for (int i = 0; i < 8; ++i) { v[2 * i] = DN_ALPHA * v[2 * i] + (1.f + gt[2 * i]) * y2[t][i].x; v[2 * i + 1] = DN_ALPHA * v[2 * i + 1] + (1.f + gt[2 * i + 1]) * y2[t][i].y; }
                ln16c(v, p.in[23] + l * D, p.in[24] + l * D, lane_e);
                if (DRY) {
#pragma unroll
                    for (int i = 0; i < 16; ++i) asm volatile("" :: "v"(v[i]));
                    continue; }
                store16c(xout + (size_t)tok * D, v, lane_e);
                if (l + 1 < DEPTH) { const float* modn = p.MOD + ((size_t)(l + 1) * BATCH + b) * 6 * D; store_mod16c(p.H + (size_t)tok * D, v, modn, modn + D, lane_e); }
                __builtin_amdgcn_sched_barrier(0);
            }
        }
    }
}
#define XB_TMO      128
#define XB_XCNT(j)  (256  + 64 * (j))
#define XB_XSUB(j)  (1280 + 64 * (j))
#define XB_XGEN(j)  (2304 + 64 * (j))
#define XB_TOP      3328
#define XB_TOPGEN   3392
#define XCD_BAR_WORDS 3456
#define XB_SPIN_CAP (1u << 22)
#define LAS __attribute__((address_space(3)))
DI unsigned xb_ld(unsigned* p)              { return __hip_atomic_load(p, __ATOMIC_RELAXED, __HIP_MEMORY_SCOPE_AGENT); }
DI unsigned xb_add(unsigned* p, unsigned v) { return __hip_atomic_fetch_add(p, v, __ATOMIC_RELAXED, __HIP_MEMORY_SCOPE_AGENT); }
DI unsigned xb_xcc_id() { return (unsigned)__builtin_amdgcn_s_getreg((3 << 11) | 20) & 0xFu; }
#define XB_SPIN(cond, bar) do { unsigned _sp = 0; while (cond) { __builtin_amdgcn_s_sleep(1); \
    if ((++_sp & 255u) == 0u) { if (xb_ld(&(bar)[XB_TMO])) break; if (_sp > XB_SPIN_CAP) { atomicAdd(&(bar)[XB_TMO], 1u); break; } } } } while (0)
struct XcdBarrier { unsigned* bar; unsigned x; volatile LAS unsigned* st; };
DI XcdBarrier xcd_barrier_post(unsigned* bar, volatile LAS unsigned* st) {
    XcdBarrier b; b.bar = bar; b.x = xb_xcc_id(); b.st = st;
    if (threadIdx.x == 0) st[2] = xb_add(&bar[XB_XCNT(b.x)], 1u);
    return b;
}
DI void xcd_barrier_complete(unsigned* bar, unsigned x, unsigned& nloc, unsigned& nx) {
    const unsigned G = gridDim.x * gridDim.y * gridDim.z;
    unsigned sum, cnt, mine, sp = 0u;
    for (;;) {
        sum = 0u; cnt = 0u; mine = 0u;
#pragma unroll
        for (unsigned j = 0; j < 16; ++j) { const unsigned c = xb_ld(&bar[XB_XCNT(j)]); sum += c; cnt += (c > 0u) ? 1u : 0u; mine = (j == x) ? c : mine; }
        if (sum == G) break;
        __builtin_amdgcn_s_sleep(1);
        if ((++sp & 255u) == 0u) { if (xb_ld(&bar[XB_TMO])) break; if (sp > XB_SPIN_CAP) { atomicAdd(&bar[XB_TMO], 1u); break; } }
    }
    nloc = mine > 0u ? mine : 1u; nx = cnt > 0u ? cnt : 1u;
}
DI void xcd_barrier(const XcdBarrier& b) {
    asm volatile("s_waitcnt vmcnt(0)" ::: "memory");
    __syncthreads();
    if (threadIdx.x == 0) {
        unsigned* bar = b.bar;
        __builtin_amdgcn_s_waitcnt(0);
        unsigned nloc = b.st[0], nx = b.st[1];
        if (nloc == 0u) { xcd_barrier_complete(bar, b.x, nloc, nx); b.st[0] = nloc; b.st[1] = nx; }
        const unsigned old = xb_add(&bar[XB_XSUB(b.x)], 1u);
        const unsigned gen = old / nloc;
        if (old + 1u == (gen + 1u) * nloc) {
            __builtin_amdgcn_fence(__ATOMIC_RELEASE, "agent");
            asm volatile("s_waitcnt vmcnt(0)" ::: "memory");
            const unsigned og = xb_add(&bar[XB_TOP], 1u);
            const unsigned tg = og / nx;
            if (og + 1u == (tg + 1u) * nx) xb_add(&bar[XB_TOPGEN], 1u);
            else XB_SPIN(xb_ld(&bar[XB_TOPGEN]) == tg, bar);
            __builtin_amdgcn_fence(__ATOMIC_ACQUIRE, "agent");
            xb_add(&bar[XB_XGEN(b.x)], 1u);
            asm volatile("s_waitcnt vmcnt(0)" ::: "memory");
        } else {
            XB_SPIN(xb_ld(&bar[XB_XGEN(b.x)]) == gen, bar);
            __builtin_amdgcn_fence(__ATOMIC_ACQUIRE, "agent");
            asm volatile("s_waitcnt vmcnt(0)" ::: "memory");
        }
    }
    __syncthreads();
}
DI void ada_item(const Params& p, int item, char* lds) {
    int tid_ = threadIdx.x; asm volatile("" : "+v"(tid_)); const int tid = tid_, lane = tid & 63, wv = tid >> 6;
    float* cs = (float*)lds;
    float* part = cs + 4 * D;
    __syncthreads();
    for (int i = tid; i < BATCH * D; i += 256) { const float cv = p.in[1][i]; cs[i] = cv / (1.f + __expf(-cv)); }
    __syncthreads();
    const int col = item * 64 + lane, l = col / (6 * D), j = col % (6 * D);
    const float* w = p.in[2] + (size_t)l * D * 6 * D + j;
    float a0 = 0.f, a1 = 0.f, a2 = 0.f, a3 = 0.f;
#pragma unroll 16
    for (int k = wv * 256; k < wv * 256 + 256; ++k) { const float wk = w[(size_t)k * 6 * D]; a0 += cs[k] * wk; a1 += cs[D + k] * wk; a2 += cs[2 * D + k] * wk; a3 += cs[3 * D + k] * wk; }
    part[(wv * 4 + 0) * 64 + lane] = a0; part[(wv * 4 + 1) * 64 + lane] = a1; part[(wv * 4 + 2) * 64 + lane] = a2; part[(wv * 4 + 3) * 64 + lane] = a3;
    __syncthreads();
    {
        const float s = part[(0 * 4 + wv) * 64 + lane] + part[(1 * 4 + wv) * 64 + lane] + part[(2 * 4 + wv) * 64 + lane] + part[(3 * 4 + wv) * 64 + lane];
        p.MOD[((size_t)l * BATCH + wv) * 6 * D + j] = s + p.in[3][l * 6 * D + j];
    }
}

DI void rope_table_item(const Params& p, int idx) {
    const int pos = idx >> 4, i = idx & 15;
    const float inv = 1.0f / powf(10000.0f, (float)(2 * i) / 32.0f);
    const float ang = (float)pos * inv;
    double fr = (double)ang * 0.15915494309189535;
    fr -= rint(fr);
    const float f = (float)fr;
    p.COS[idx] = __builtin_amdgcn_cosf(f); p.SIN[idx] = __builtin_amdgcn_sinf(f);
}

DI void convert_tables(const Params& p, int l, int bid, int nb) {
    const float* us = p.in[21] + (size_t)l * 16384 * D; const float* vs = p.in[22] + (size_t)l * 16384 * D;
    const size_t n8 = (size_t)16384 * D / 8;
    for (size_t i = (size_t)bid * 256 + threadIdx.x; i < n8; i += (size_t)nb * 256) { cvt8(us, p.Ut, i); cvt8(vs, p.Vt, i); }
}

DI void prologue(const Params& p, char* lds) {
    int tid_ = threadIdx.x; asm volatile("" : "+v"(tid_)); const int tid = tid_, lane = tid & 63, wv = tid >> 6, bid = blockIdx.x, nb = gridDim.x;
    for (int it = bid; it < DEPTH * 6 * D / 64; it += nb) ada_item(p, it, lds);
    __syncthreads();
    float* scr = (float*)(lds + wv * 16384);
    const int n_win = (D / 64) * (WIN_N / 32), n_uq = 4 * 24, n_ukv = 2 * 32, n_wo = 16 * 32, n_pq = 16 * 64, per_l = n_win + n_uq + n_ukv + n_wo + n_pq;
    for (int it = bid * 4 + wv; it < DEPTH * per_l; it += nb * 4) {
        const int l = it / per_l; int r = it % per_l;
        if (r < n_win) { transpose_item(TK_WIN, p.in[4] + (size_t)l * D * D_IN, D_IN, D, WIN_N, p.WinT + (size_t)l * WIN_N * D, nullptr, scr, r, lane); continue; } r -= n_win;
        if (r < n_uq) { transpose_item(TK_WUQ, p.in[6] + (size_t)l * 256 * 768, 768, 256, 768, p.WuqT + (size_t)l * 768 * 256, p.in[5] + l * 256, scr, r, lane); continue; } r -= n_uq;
        if (r < n_ukv) { transpose_item(TK_WUKV, p.in[8] + (size_t)l * 128 * 1024, 1024, 128, 1024, p.WukvT + (size_t)l * 1024 * 128, p.in[7] + l * 128, scr, r, lane); continue; } r -= n_ukv;
        if (r < n_wo) { transpose_item(TK_WO, p.in[16] + (size_t)l * D * D, D, D, D, p.WoT + (size_t)l * D * D, nullptr, scr, r, lane); continue; } r -= n_wo;
        transpose_item(TK_WPQ, p.in[19] + (size_t)l * D * 2048, 2048, D, 2048, p.WpqT + (size_t)l * 2048 * D, nullptr, scr, r, lane);
    }
    for (int it = bid; it < DEPTH * 1028; it += nb) fold_pw_item(p, it / 1028, it % 1028);
    for (size_t i = (size_t)bid * 256 + tid; i < (size_t)DEPTH * 16 * 128 * 128; i += (size_t)nb * 256)
        p.SKp[i] = f2bf(p.in[20][(i & ~(size_t)127) + perm16((int)(i & 127))]);
    for (int i = bid * 256 + tid; i < SEQ * 16; i += nb * 256) rope_table_item(p, i);
    convert_tables_fp8(p, 0, bid, nb);
}

DI void modh_items(const Params& p, int bid, int nb) {
    const size_t n8 = (size_t)p.rows * D / 8;
    for (size_t i = (size_t)bid * 256 + threadIdx.x; i < n8; i += (size_t)nb * 256) {
        const size_t e = i * 8; const int row = (int)(e >> 10), col = (int)(e & 1023), b = row / SEQ;
        const float* mod = p.MOD + (size_t)b * 6 * D;
        const float4 x0 = *(const float4*)(p.in[0] + e), x1 = *(const float4*)(p.in[0] + e + 4);
        const float4 h0 = *(const float4*)(mod + col), h1 = *(const float4*)(mod + col + 4), s0 = *(const float4*)(mod + D + col), s1 = *(const float4*)(mod + D + col + 4);
        u32x4 o;
        o.x = pk2(x0.x * (1.f + s0.x) + h0.x, x0.y * (1.f + s0.y) + h0.y); o.y = pk2(x0.z * (1.f + s0.z) + h0.z, x0.w * (1.f + s0.w) + h0.w);
        o.z = pk2(x1.x * (1.f + s1.x) + h1.x, x1.y * (1.f + s1.y) + h1.y); o.w = pk2(x1.z * (1.f + s1.z) + h1.z, x1.w * (1.f + s1.w) + h1.w);
        *(u32x4*)(p.H + e) = o;
    }
}

#ifndef MLA_UNIT
#define MLA_UNIT mla_unit2
#endif
#ifndef P6_BLOCK
#define P6_BLOCK p6a_block
#endif
#ifndef REP_P1
#define REP_P1 1
#endif
#ifndef REP_P2
#define REP_P2 1
#endif
#ifndef REP_P3
#define REP_P3 1
#endif
#ifndef REP_P4
#define REP_P4 1
#endif
#ifndef REP_P5
#define REP_P5 1
#endif
#ifndef REP_SYNC
#define REP_SYNC 1
#endif
typedef const __attribute__((address_space(4))) Params* kparams_t;
#define LOADP(q) const Params& q = p
#define GSYNC() do { for (int rs_ = 0; rs_ < REP_SYNC; ++rs_) { XcdBarrier xb_; xb_.bar = p.ctr + 4096; xb_.x = xb_xcc_id(); xb_.st = (volatile LAS unsigned*)(lds + LDS_TOTAL - 32); xcd_barrier(xb_); } } while (0)
__global__ void __launch_bounds__(256, 2) mega(Params p) {
    extern __shared__ __attribute__((aligned(16))) char lds[];
    cg::grid_group grid = cg::this_grid();
#define bid ((int)blockIdx.x)
#define nb ((int)gridDim.x)
#define rows NTOK
#define mtiles (NTOK / 128)
    {
        if (threadIdx.x < 4) ((volatile LAS unsigned*)(lds + LDS_TOTAL - 32))[threadIdx.x] = 0u;
        __syncthreads();
    }
    (void)xcd_barrier_post(p.ctr + 4096, (volatile LAS unsigned*)(lds + LDS_TOTAL - 32));
#ifndef REP_PRO
#define REP_PRO 1
#endif
    for (int rep = 0; rep < REP_PRO; ++rep) prologue(p, lds);
    grid.sync();
    {
        volatile LAS unsigned* cw = (volatile LAS unsigned*)(lds + LDS_TOTAL - 32);
        if (threadIdx.x == 0) {
            unsigned pre = 0u, even = 1u; const unsigned myx = xb_xcc_id(); unsigned* bar_ = p.ctr + 4096;
            for (unsigned j = 0; j < 16; ++j) { const unsigned c = xb_ld(&bar_[XB_XCNT(j)]); if (j < myx) pre += c; if (j < 8 ? c * 8u != (unsigned)nb : c != 0u) even = 0u; }
            cw[3] = pre + cw[2]; cw[5] = even;
        }
        __syncthreads();
    }
#define SLOT ((int)((volatile LAS unsigned*)(lds + LDS_TOTAL - 32))[3])
#define XEVEN ((int)((volatile LAS unsigned*)(lds + LDS_TOTAL - 32))[5])
#define FOR_TILES(NT, T) for (int u_ = XEVEN ? (SLOT % (nb / 8)) : bid, T = 0; u_ < (XEVEN ? (mtiles / 8) * (NT) : mtiles * (NT)) && ((T = XEVEN ? ((SLOT / (nb / 8)) * (mtiles / 8) + u_ / (NT)) * (NT) + u_ % (NT) : u_), true); u_ += XEVEN ? nb / 8 : nb)
#ifndef REP_MODH
#define REP_MODH 1
#endif
    for (int rep = 0; rep < REP_MODH; ++rep) modh_items(p, bid, nb);
    GSYNC();
    for (int l = 0; l < DEPTH; ++l) {
        { LOADP(q);
#ifdef G3_PROBE
        for (int rep = 0; rep < REP_P1; ++rep) { __syncthreads(); if (threadIdx.x == 0) *(volatile int*)(lds + LDS_TOTAL - 64) = (rep + 1 < REP_P1) ? G3_PROBE : 0; __syncthreads(); FOR_TILES(12, t) p1_tile(q, l, t, lds); }
#else
        for (int rep = 0; rep < REP_P1; ++rep) FOR_TILES(12, t) p1_tile(q, l, t, lds);
#endif
#ifndef REP_CVT
#define REP_CVT 1
#endif
        if (l > 0) for (int rep = 0; rep < REP_CVT; ++rep) convert_tables_fp8(q, l, bid, nb);
        }
        GSYNC();
        { LOADP(q);
        for (int rep = 0; rep < REP_P2; ++rep) { FOR_TILES(6, t) p2q_tile(q, l, t, lds); FOR_TILES(8, t2) p2kv_tile(q, l, t2, lds); }
        }
        GSYNC();
        { LOADP(q);
        {
            const int nbt = rows / SEQ, nmla = nbt * 8 * 64, nswa = nbt * 4 * 64, nconv = rows / 32, ntot = nmla + nswa + nconv;
            int* su = (int*)(lds + LDS_TOTAL - 16);
            for (int rep = 0; rep < REP_P3; ++rep) { unsigned* ctr = q.ctr + l * 64 + rep * 16;
            for (;;) {
                __syncthreads();
                if (threadIdx.x == 0) *su = (int)atomicAdd(ctr, 1u);
                __syncthreads();
                const int u = *su;
                if (u >= ntot) break;
#ifdef P3_ABL
                if (u < nmla) { if (rep + 1 < REP_P3) MLA_UNIT<P3_ABL>(q, u, lds); else MLA_UNIT<0>(q, u, lds); }
#else
                if (u < nmla) MLA_UNIT<0>(q, u, lds);
#endif
                else if (u < nmla + nswa) swa_unit(q, l, u - nmla, lds);
                else conv_unit(q, l, u - nmla - nswa, lds);
            } }
        }
        }
        GSYNC();
        { LOADP(q);
        for (int rep = 0; rep < REP_P4; ++rep) FOR_TILES(8, t) p4_tile(q, l, t, (l == 0) ? q.in[0] : q.XB, q.out, lds);
        }
        GSYNC();
        { LOADP(q);
        { int t_ = threadIdx.x; asm volatile("" : "+v"(t_)); const int wv = t_ >> 6, lane = t_ & 63; for (int r = bid * 4 + wv; r < rows; r += nb * 4) p4b_row(q, l, r, q.out, lane); }
        }
        GSYNC();
        { LOADP(q);
#ifdef G3_PROBE
        for (int rep = 0; rep < REP_P5; ++rep) { __syncthreads(); if (threadIdx.x == 0) *(volatile int*)(lds + LDS_TOTAL - 64) = (rep + 1 < REP_P5) ? G3_PROBE : 0; __syncthreads(); FOR_TILES(16, t) p5_tile(q, l, t, lds); }
#else
        for (int rep = 0; rep < REP_P5; ++rep) FOR_TILES(16, t) p5_tile(q, l, t, lds);
#endif
        }
        GSYNC();
        { LOADP(q);
        {
            const int slot = SLOT, per = rows / nb;
            if (per * nb == rows && (per & 31) == 0) {
#ifdef REP_P6
                for (int rep = 1; rep < REP_P6; ++rep) P6_BLOCK<true>(q, l, slot * per, per, q.out, (l + 1 < DEPTH) ? q.XB : q.out, lds);
#endif
                P6_BLOCK<false>(q, l, slot * per, per, q.out, (l + 1 < DEPTH) ? q.XB : q.out, lds); }
            else for (int u = bid; u < rows / 32; u += nb) p6f_unit(q, l, u, q.out, (l + 1 < DEPTH) ? q.XB : q.out, lds);
        }
        }
        if (l + 1 < DEPTH) GSYNC();
    }
}

#undef bid
#undef nb
#undef rows
#undef mtiles
extern "C" void kernel_launch(void* const* d_in, const int* in_sizes, int n_in, void* d_out, int out_size, void* d_ws, size_t ws_size, hipStream_t stream) {
    const size_t MiB = 1u << 20;
    char* ws = (char*)d_ws;
    Params P{};
    for (int i = 0; i < 25; ++i) P.in[i] = (const float*)d_in[i];
    P.out = (float*)d_out; P.rows = NTOK; P.tok0 = 0;
    size_t o = 0;
    auto take = [&](size_t mib) { char* r = ws + o; o += mib * MiB; return r; };
    char* ctl = take(1);
    P.ctr = (unsigned*)ctl; P.biasO = (float*)(ctl + 64 * 1024); P.MOD = (float*)(ctl + 128 * 1024);
    P.COS = (float*)take(1); P.SIN = P.COS + SEQ * 16;
    P.WinT = (bf16*)take(6); P.WuqT = (bf16*)take(1); P.WukvT = (bf16*)take(1); P.WoT = (bf16*)take(4); P.WpqT = (bf16*)take(8); P.SKp = (bf16*)take(1);
    P.U8 = (unsigned char*)take(16); P.V8 = (unsigned char*)take(16); P.US = (float*)take(1); P.VS = P.US + DEPTH * 16384;
    P.H = (bf16*)take(64); P.MIXIN = P.H;
    P.PROJ = (bf16*)take(80); P.Q = (bf16*)take(48); P.TOPK = (unsigned*)P.Q;
    P.KN = (bf16*)take(32); P.KR = (bf16*)take(2); P.VT = (bf16*)take(32); P.VsT = (bf16*)take(8);
    P.XB = (float*)take(128); P.STATS = (float*)take(1);
    if (o > ws_size) { fprintf(stderr, "kernel_launch: workspace too small: need %zu, have %zu\n", o, ws_size); return; }
    static int grid_blocks = 0;
    if (!grid_blocks) {
        int dev = 0, cus = 0, per_cu = 0;
        (void)hipGetDevice(&dev);
        (void)hipDeviceGetAttribute(&cus, hipDeviceAttributeMultiprocessorCount, dev);
        (void)hipFuncSetAttribute((const void*)mega, hipFuncAttributeMaxDynamicSharedMemorySize, LDS_TOTAL);
        (void)hipOccupancyMaxActiveBlocksPerMultiprocessor(&per_cu, mega, 256, LDS_TOTAL);
        if (per_cu > 2) per_cu = 2;
        if (per_cu < 1) per_cu = 1;
        grid_blocks = cus * per_cu;
    }
    (void)hipMemsetAsync(ctl, 0, 32768, stream);
    void* args[] = {(void*)&P};
    hipError_t e = hipLaunchCooperativeKernel((void*)mega, dim3(grid_blocks), dim3(256), args, LDS_TOTAL, stream);
    if (e != hipSuccess) fprintf(stderr, "cooperative launch failed: %s (grid %d)\n", hipGetErrorString(e), grid_blocks);
}
```

```cpp
#include <hip/hip_runtime.h>
#include <hip/hip_cooperative_groups.h>
#include <cstdio>
#include <cstdint>
namespace cg = cooperative_groups;

constexpr int D = 1024, BATCH = 4, SEQ = 8192, DEPTH = 2, NTOK = BATCH * SEQ;
constexpr int D_IN = 1440;
constexpr int OFF_CQ = 0, OFF_CKV = 256, OFF_KR = 384, OFF_CONV = 416, OFF_QS = 928, OFF_KS = 1184, OFF_VS = 1312;
constexpr float EPS = 1e-6f;
constexpr float DN_ALPHA = 1.41421356237309515f;

typedef __attribute__((ext_vector_type(8))) short bf16x8;
typedef __attribute__((ext_vector_type(16))) float f32x16;
typedef __attribute__((ext_vector_type(4))) unsigned u32x4;
typedef __attribute__((ext_vector_type(2))) unsigned u32x2;
typedef float f32x2_t __attribute__((ext_vector_type(2)));
typedef __bf16 bf16x2_t __attribute__((ext_vector_type(2)));
typedef unsigned short bf16;
#define DI __device__ __forceinline__
#define MFMA32(a, b, c) __builtin_amdgcn_mfma_f32_32x32x16_bf16((a), (b), (c), 0, 0, 0)

DI unsigned pk2(float lo, float hi) { f32x2_t v = {lo, hi}; bf16x2_t b = __builtin_convertvector(v, bf16x2_t); return __builtin_bit_cast(unsigned, b); }
DI bf16 f2bf(float f) { return (bf16)(pk2(f, 0.f) & 0xffffu); }
DI float bf2f(bf16 b) { return __uint_as_float((unsigned)b << 16); }
typedef float f32x2v __attribute__((ext_vector_type(2)));
DI float bflo(unsigned u) { return __uint_as_float(u << 16); }
DI float bfhi(unsigned u) { return __uint_as_float(u & 0xffff0000u); }
DI int crow(int reg, int hh) { return (reg & 3) + 8 * (reg >> 2) + 4 * hh; }
DI int cperm_lin(int rho) { return 16 * ((rho >> 2) & 1) + (rho & 3) + 4 * (rho >> 3); }
DI int cperm_rope(int rho) { int hh = (rho >> 2) & 1, reg = (rho & 3) + 4 * (rho >> 3); return (reg < 8) ? 8 * hh + reg : 16 + 8 * hh + (reg - 8); }
DI int perm16(int p) { int g = (p >> 2) & 3; g = (g == 1) ? 2 : (g == 2) ? 1 : g; return (p & ~15) | (g << 2) | (p & 3); }

constexpr float LOG2E = 1.4426950408889634f;
constexpr int PROJ_LD = 1280;
constexpr int WIN_N = 1536;
constexpr int TS = 144;
constexpr int TILE_B = 128 * TS;
constexpr int STAGE_B = 2 * TILE_B;
constexpr int LDS_BYTES = 2 * STAGE_B;

struct Params {
    const float* in[25];
    float* out;
    bf16 *WinT, *WuqT, *WukvT, *WoT, *WpqT, *SKp, *Ut, *Vt;
    float* biasO;
    float* MOD;
    float* COS; float* SIN;
    bf16 *H, *PROJ, *Q, *KN, *KR, *VT, *VsT, *MIXIN;
    float* XB;
    unsigned* TOPK;
    float* STATS;
    unsigned char *U8, *V8; float *US, *VS;
    unsigned* ctr;
    int rows;
    int tok0;
};

enum { TK_WIN = 0, TK_WUQ = 1, TK_WUKV = 2, TK_WO = 3, TK_WPQ = 4 };
DI void transpose_item(int kind, const float* W, int ldin, int K, int Nout, bf16* WT, const float* rowscale, float* scr, int item, int lane) {
    const int nblk = Nout / 32, kb = item / nblk, nb = item % nblk, k0 = 64 * kb, n0 = 32 * nb;
    int src0 = n0; float cs = 1.f;
    if (kind == TK_WIN) {
        if (n0 < 384) src0 = n0;
        else if (n0 < 896) src0 = 416 + (n0 - 384);
        else if (n0 < 1152) { src0 = 928 + (n0 - 896); cs = 0.125f * LOG2E; }
        else if (n0 < 1280) src0 = 1184 + (n0 - 1152);
        else if (n0 < 1408) src0 = 1312 + (n0 - 1280);
        else if (n0 < 1440) src0 = 384 + (n0 - 1408);
        else src0 = -1;
    } else if (kind == TK_WUQ) cs = 0.10206207261596577f * LOG2E;
#pragma unroll
    for (int i = 0; i < 32; ++i) {
        const int kk = 2 * i + (lane >> 5);
        float v = (src0 >= 0) ? W[(size_t)(k0 + kk) * ldin + src0 + (lane & 31)] : 0.f;
        if (rowscale) v *= rowscale[k0 + kk];
        scr[kk * 33 + (lane & 31)] = v * cs;
    }
    __builtin_amdgcn_s_waitcnt(0xc07f); asm volatile("" ::: "memory");
    const int c = lane & 7;
#pragma unroll
    for (int j = 0; j < 4; ++j) {
        const int n = (lane >> 3) + 8 * j; const float* s = scr + (8 * c) * 33 + n;
        u32x4 o; o.x = pk2(s[0], s[33]); o.y = pk2(s[66], s[99]); o.z = pk2(s[132], s[165]); o.w = pk2(s[198], s[231]);
        if (!(kind == TK_WO && k0 + 8 * c >= 512 && k0 + 8 * c < 768))
            *(u32x4*)(WT + (size_t)(n0 + n) * K + k0 + 8 * c) = o;
    }
    __builtin_amdgcn_s_waitcnt(0xc07f); asm volatile("" ::: "memory");
}

DI void cvt8(const float* src, bf16* dst, size_t i8) {
    const float4 a = ((const float4*)src)[2 * i8], b = ((const float4*)src)[2 * i8 + 1];
    u32x4 o; o.x = pk2(a.x, a.y); o.y = pk2(a.z, a.w); o.z = pk2(b.x, b.y); o.w = pk2(b.z, b.w);
    ((u32x4*)dst)[i8] = o;
}

struct TileRegs { u32x4 v[4]; };
DI void gload_tile(TileRegs& t, const bf16* base, int ld, int k0, int tid) {
#pragma unroll
    for (int i = 0; i < 4; ++i) { const int q = tid + 256 * i, row = q >> 3, kc = q & 7; t.v[i] = *(const u32x4*)(base + (size_t)row * ld + k0 + kc * 8); }
}
DI void sstore_tile(const TileRegs& t, char* lds, int tid) {
#pragma unroll
    for (int i = 0; i < 4; ++i) { const int q = tid + 256 * i, row = q >> 3, kc = q & 7; *(u32x4*)(lds + row * TS + kc * 16) = t.v[i]; }
}
template <int NF, int NG>
DI void gemm_core2(const bf16* A, int lda, const bf16* W, int ldw, int K, char* lds, f32x16 (&acc)[NF][NG], int fo, const int (&frow)[NF], int go, const int (&grow)[NG]) {
    int tid_ = threadIdx.x; asm volatile("" : "+v"(tid_)); const int tid = tid_, hh = (tid & 63) >> 5;
    const int nk = K / 64;
    TileRegs ta0, tw0, ta1, tw1;
    gload_tile(ta0, A, lda, 0, tid); gload_tile(tw0, W, ldw, 0, tid);
    gload_tile(ta1, A, lda, 64, tid); gload_tile(tw1, W, ldw, 64, tid);
    __syncthreads();
    sstore_tile(ta0, lds, tid); sstore_tile(tw0, lds + TILE_B, tid);
    if (2 < nk) { gload_tile(ta0, A, lda, 128, tid); gload_tile(tw0, W, ldw, 128, tid); }
    __syncthreads();
#define GEMM_STEP(KS, TA, TW, TAN, TWN) do { \
        char* cur = lds + ((KS) & 1) * STAGE_B; \
        _Pragma("unroll") for (int kk = 0; kk < 4; ++kk) { \
            bf16x8 f[NF], g[NG]; \
            _Pragma("unroll") for (int x = 0; x < NF; ++x) f[x] = *(const bf16x8*)(cur + fo + frow[x] * TS + kk * 32 + hh * 16); \
            _Pragma("unroll") for (int y = 0; y < NG; ++y) g[y] = *(const bf16x8*)(cur + go + grow[y] * TS + kk * 32 + hh * 16); \
            _Pragma("unroll") for (int x = 0; x < NF; ++x) _Pragma("unroll") for (int y = 0; y < NG; ++y) acc[x][y] = MFMA32(f[x], g[y], acc[x][y]); } \
        if ((KS) + 1 < nk) { char* nxt = lds + (((KS) + 1) & 1) * STAGE_B; sstore_tile(TAN, nxt, tid); sstore_tile(TWN, nxt + TILE_B, tid); \
            if ((KS) + 3 < nk) { gload_tile(TAN, A, lda, ((KS) + 3) * 64, tid); gload_tile(TWN, W, ldw, ((KS) + 3) * 64, tid); } } \
        __syncthreads(); } while (0)
    for (int ks = 0; ks < nk; ks += 2) { GEMM_STEP(ks, ta0, tw0, ta1, tw1); GEMM_STEP(ks + 1, ta1, tw1, ta0, tw0); }
#undef GEMM_STEP
}

template <int NF, int NG>
DI void gemm_core(const bf16* A, int lda, const bf16* W, int ldw, int K, char* lds, f32x16 (&acc)[NF][NG], int fo, const int (&frow)[NF], int go, const int (&grow)[NG]) {
    int tid_ = threadIdx.x; asm volatile("" : "+v"(tid_)); const int tid = tid_, hh = (tid & 63) >> 5;
    TileRegs ta, tw;
    gload_tile(ta, A, lda, 0, tid); gload_tile(tw, W, ldw, 0, tid);
    __syncthreads();
    sstore_tile(ta, lds, tid); sstore_tile(tw, lds + TILE_B, tid);
    __syncthreads();
    const int nk = K / 64;
    for (int ks = 0; ks < nk; ++ks) {
        char* cur = lds + (ks & 1) * STAGE_B;
        if (ks + 1 < nk) { gload_tile(ta, A, lda, (ks + 1) * 64, tid); gload_tile(tw, W, ldw, (ks + 1) * 64, tid); }
#pragma unroll
        for (int kk = 0; kk < 4; ++kk) {
            bf16x8 f[NF], g[NG];
#pragma unroll
            for (int x = 0; x < NF; ++x) f[x] = *(const bf16x8*)(cur + fo + frow[x] * TS + kk * 32 + hh * 16);
#pragma unroll
            for (int y = 0; y < NG; ++y) g[y] = *(const bf16x8*)(cur + go + grow[y] * TS + kk * 32 + hh * 16);
#pragma unroll
            for (int x = 0; x < NF; ++x)
#pragma unroll
                for (int y = 0; y < NG; ++y) acc[x][y] = MFMA32(f[x], g[y], acc[x][y]);
        }
        if (ks + 1 < nk) { char* nxt = lds + ((ks + 1) & 1) * STAGE_B; sstore_tile(ta, nxt, tid); sstore_tile(tw, nxt + TILE_B, tid); }
        __syncthreads();
    }
}

#define LAS3 __attribute__((address_space(3)))
constexpr int GT = 128 * 128;
DI void glds_tile(const bf16* base, int ld, int k0, char* tile, int wv, int lane) {
#pragma unroll
    for (int i = 0; i < 4; ++i) {
        const int row0 = 32 * wv + 8 * i, rr = lane >> 3;
        const bf16* src = base + (size_t)(row0 + rr) * ld + k0 + (((lane & 7) ^ (((row0 + rr) >> 1) & 7)) << 3);
        __builtin_amdgcn_global_load_lds((const void*)src, (LAS3 void*)(tile + row0 * 128), 16, 0, 0);
    }
}
template <int NF, int NG>
DI void gemm_core3(const bf16* A, int lda, const bf16* W, int ldw, int K, char* lds, f32x16 (&acc)[NF][NG], int fo, const int (&frow)[NF], int go, const int (&grow)[NG]) {
    int tid_ = threadIdx.x; asm volatile("" : "+v"(tid_)); const int tid = tid_, lane = tid & 63, hh = lane >> 5;
    const int wv = __builtin_amdgcn_readfirstlane(tid >> 6);
    const int nk = K / 64;
    const int fof = fo ? GT : 0, gof = go ? GT : 0;
    int foff[NF], goff[NG], fsw[NF], gsw[NG];
#pragma unroll
    for (int x = 0; x < NF; ++x) { foff[x] = fof + frow[x] * 128; fsw[x] = (frow[x] >> 1) & 7; }
#pragma unroll
    for (int y = 0; y < NG; ++y) { goff[y] = gof + grow[y] * 128; gsw[y] = (grow[y] >> 1) & 7; }
    __syncthreads();
#ifdef G3_PROBE
    const int dry = __builtin_amdgcn_readfirstlane(*(volatile int*)(lds + LDS_BYTES + 1024 - 64));
#else
    const int dry = 0;
#endif
    glds_tile(A, lda, 0, lds, wv, lane); glds_tile(W, ldw, 0, lds + GT, wv, lane);
    __syncthreads();
    for (int ks = 0; ks < nk; ++ks) {
        char* cur = lds + (ks & 1) * (2 * GT);
        if (ks + 1 < nk && !(dry & 1)) { char* nxt = lds + ((ks + 1) & 1) * (2 * GT); glds_tile(A, lda, (ks + 1) * 64, nxt, wv, lane); glds_tile(W, ldw, (ks + 1) * 64, nxt + GT, wv, lane); }
#pragma unroll
        for (int kk = 0; kk < 4; ++kk) {
            bf16x8 f[NF], g[NG];
#pragma unroll
            for (int x = 0; x < NF; ++x) f[x] = *(const bf16x8*)(cur + foff[x] + ((((kk << 1) | hh) ^ fsw[x]) << 4));
#pragma unroll
            for (int y = 0; y < NG; ++y) g[y] = *(const bf16x8*)(cur + goff[y] + ((((kk << 1) | hh) ^ gsw[y]) << 4));
            if (dry & 2) {
#pragma unroll
                for (int x = 0; x < NF; ++x) asm volatile("" :: "v"(f[x]));
#pragma unroll
                for (int y = 0; y < NG; ++y) asm volatile("" :: "v"(g[y]));
            } else {
#pragma unroll
            for (int x = 0; x < NF; ++x)
#pragma unroll
                for (int y = 0; y < NG; ++y) acc[x][y] = MFMA32(f[x], g[y], acc[x][y]);
            }
        }
        __syncthreads();
    }
}


template <int NF, int NG>
DI void gemm_core5(const bf16* A, int lda, const bf16* W, int ldw, int K, char* lds, f32x16 (&acc)[NF][NG], int fo, const int (&frow)[NF], int go, const int (&grow)[NG]) {
    int tid_ = threadIdx.x; asm volatile("" : "+v"(tid_)); const int tid = tid_, lane = tid & 63, hh = lane >> 5;
    const int wv = __builtin_amdgcn_readfirstlane(tid >> 6);
    const int nk = K / 64;
    const int fof = fo ? GT : 0, gof = go ? GT : 0;
    int foff[NF], goff[NG], fsw[NF], gsw[NG];
#pragma unroll
    for (int x = 0; x < NF; ++x) { foff[x] = fof + frow[x] * 128; fsw[x] = (frow[x] >> 1) & 7; }
#pragma unroll
    for (int y = 0; y < NG; ++y) { goff[y] = gof + grow[y] * 128; gsw[y] = (grow[y] >> 1) & 7; }
    __syncthreads();
#ifdef G3_PROBE
    const int dry = __builtin_amdgcn_readfirstlane(*(volatile int*)(lds + LDS_BYTES + 1024 - 64));
#else
    const int dry = 0;
#endif
    glds_tile(A, lda, 0, lds, wv, lane); glds_tile(W, ldw, 0, lds + GT, wv, lane);
    __syncthreads();
    for (int ks = 0; ks < nk; ++ks) {
        char* cur = lds + (ks & 1) * (2 * GT);
        if (ks + 1 < nk && !(dry & 1)) { char* nxt = lds + ((ks + 1) & 1) * (2 * GT); glds_tile(A, lda, (ks + 1) * 64, nxt, wv, lane); glds_tile(W, ldw, (ks + 1) * 64, nxt + GT, wv, lane); }
        bf16x8 f[4][NF], g[4][NG];
#pragma unroll
        for (int kk = 0; kk < 4; ++kk) {
#pragma unroll
            for (int x = 0; x < NF; ++x) f[kk][x] = *(const bf16x8*)(cur + foff[x] + ((((kk << 1) | hh) ^ fsw[x]) << 4));
#pragma unroll
            for (int y = 0; y < NG; ++y) g[kk][y] = *(const bf16x8*)(cur + goff[y] + ((((kk << 1) | hh) ^ gsw[y]) << 4));
        }
        __builtin_amdgcn_sched_barrier(0);
#pragma unroll
        for (int kk = 0; kk < 4; ++kk)
#pragma unroll
            for (int x = 0; x < NF; ++x)
#pragma unroll
                for (int y = 0; y < NG; ++y) acc[x][y] = MFMA32(f[kk][x], g[kk][y], acc[x][y]);
        __builtin_amdgcn_sched_barrier(0);
        __syncthreads();
    }
}


DI u32x4 g4_rsrc(const void* base, unsigned bytes) {
    const unsigned long long a = (unsigned long long)base;
    u32x4 r; r.x = __builtin_amdgcn_readfirstlane((unsigned)a); r.y = __builtin_amdgcn_readfirstlane((unsigned)(a >> 32) & 0xffffu); r.z = bytes; r.w = 0x00020000u;
    return r;
}
DI void g4_dma(unsigned m0v, int voff, u32x4 rsrc, unsigned soff) {
    asm volatile("s_nop 4\n\ts_mov_b32 m0, %0\n\ts_nop 0\n\tbuffer_load_dwordx4 %1, %2, %3 offen lds" :: "s"(m0v), "v"(voff), "s"(rsrc), "s"(soff) : "m0", "memory");
}
template <int NF, int NG>
DI void gemm_core4(const bf16* A, int lda, const bf16* W, int ldw, int K, char* lds, f32x16 (&acc)[NF][NG], int fo, const int (&frow)[NF], int go, const int (&grow)[NG]) {
    int tid_ = threadIdx.x; asm volatile("" : "+v"(tid_)); const int tid = tid_, lane = tid & 63, hh = lane >> 5;
    const int wv = __builtin_amdgcn_readfirstlane(tid >> 6);
    const int nk = K / 32;
    const int fof = fo ? 8192 : 0, gof = go ? 8192 : 0;
    int foff[NF], goff[NG], fsw[NF], gsw[NG];
#pragma unroll
    for (int x = 0; x < NF; ++x) { foff[x] = fof + frow[x] * 64; fsw[x] = (frow[x] >> 2) & 3; }
#pragma unroll
    for (int y = 0; y < NG; ++y) { goff[y] = gof + grow[y] * 64; gsw[y] = (grow[y] >> 2) & 3; }
    const u32x4 rA = g4_rsrc(A, 128u * (unsigned)lda * 2u), rW = g4_rsrc(W, 128u * (unsigned)ldw * 2u);
    const int lsw = ((lane & 3) ^ ((lane >> 4) & 3)) << 4;
    const int voA = (lane >> 2) * lda * 2 + lsw, voW = (lane >> 2) * ldw * 2 + lsw;
    const unsigned ldsb = (unsigned)(size_t)(LAS3 char*)lds;
    const unsigned mb = __builtin_amdgcn_readfirstlane(ldsb + 2048u * wv);
    const unsigned sA0 = (unsigned)(32 * wv * lda) * 2u, sA1 = sA0 + (unsigned)(16 * lda) * 2u, sW0 = (unsigned)(32 * wv * ldw) * 2u, sW1 = sW0 + (unsigned)(16 * ldw) * 2u;
    auto issue = [&](int ks) {
        const unsigned so = (unsigned)(ks & 3) * 16384u, kb = (unsigned)ks * 64u;
        g4_dma(mb + so, voA, rA, sA0 + kb); g4_dma(mb + so + 1024u, voA, rA, sA1 + kb);
        g4_dma(mb + so + 8192u, voW, rW, sW0 + kb); g4_dma(mb + so + 9216u, voW, rW, sW1 + kb);
    };
    __syncthreads();
    issue(0); if (nk > 1) issue(1); if (nk > 2) issue(2);
    for (int ks = 0; ks < nk; ++ks) {
        if (ks + 2 < nk) asm volatile("s_waitcnt vmcnt(8)" ::: "memory"); else if (ks + 1 < nk) asm volatile("s_waitcnt vmcnt(4)" ::: "memory"); else asm volatile("s_waitcnt vmcnt(0)" ::: "memory");
        __syncthreads();
        if (ks + 3 < nk) issue(ks + 3);
        const char* cur = lds + (ks & 3) * 16384;
#pragma unroll
        for (int kk = 0; kk < 2; ++kk) {
            bf16x8 f[NF], g[NG];
#pragma unroll
            for (int x = 0; x < NF; ++x) f[x] = *(const bf16x8*)(cur + foff[x] + ((((kk << 1) | hh) ^ fsw[x]) << 4));
#pragma unroll
            for (int y = 0; y < NG; ++y) g[y] = *(const bf16x8*)(cur + goff[y] + ((((kk << 1) | hh) ^ gsw[y]) << 4));
#pragma unroll
            for (int x = 0; x < NF; ++x)
#pragma unroll
                for (int y = 0; y < NG; ++y) acc[x][y] = MFMA32(f[x], g[y], acc[x][y]);
        }
    }
    __syncthreads();
}

#ifndef GEMM_CORE
#define GEMM_CORE gemm_core3
#endif
template <int NF, int NG> DI void zero_acc(f32x16 (&acc)[NF][NG]) {
#pragma unroll
    for (int x = 0; x < NF; ++x)
#pragma unroll
        for (int y = 0; y < NG; ++y)
#pragma unroll
            for (int r = 0; r < 16; ++r) acc[x][y][r] = 0.f;
}

DI void store16(bf16* dst, const float* v) {
    u32x4 a, b;
    a.x = pk2(v[0], v[1]); a.y = pk2(v[2], v[3]); a.z = pk2(v[4], v[5]); a.w = pk2(v[6], v[7]);
    b.x = pk2(v[8], v[9]); b.y = pk2(v[10], v[11]); b.z = pk2(v[12], v[13]); b.w = pk2(v[14], v[15]);
    *(u32x4*)dst = a; *(u32x4*)(dst + 8) = b;
}
DI void store8(bf16* dst, const float* v) {
    u32x4 a; a.x = pk2(v[0], v[1]); a.y = pk2(v[2], v[3]); a.z = pk2(v[4], v[5]); a.w = pk2(v[6], v[7]);
    *(u32x4*)dst = a;
}
DI void store_vt(bf16* dst, const f32x16& a, int hh) {
    float v0[8], v1[8];
#pragma unroll
    for (int i = 0; i < 8; ++i) { v0[i] = a[i]; v1[i] = a[8 + i]; }
    store8(dst + 8 * hh, v0); store8(dst + 16 + 8 * hh, v1);
}

DI void p1_tile(const Params& p, int l, int tile, char* lds) {
    int tid_ = threadIdx.x; asm volatile("" : "+v"(tid_)); const int tid = tid_, lane = tid & 63, r = lane & 31, hh = lane >> 5;
    const int wv = __builtin_amdgcn_readfirstlane(tid >> 6), wm = wv >> 1, wn = wv & 1;
    const int mt = tile / 12, nt = tile % 12, m0 = mt * 128, n0 = nt * 128;
    const bf16* A = p.H + (size_t)m0 * D;
    const bf16* W = p.WinT + ((size_t)l * WIN_N + n0) * D;
    f32x16 acc[2][2]; zero_acc(acc);
    int frow[2], grow[2];
    const bool kr = (nt == 11);
    int fo, go;
    if (nt == 10) { fo = 0; go = TILE_B; frow[0] = 64 * wm + r; frow[1] = frow[0] + 32; grow[0] = 64 * wn + r; grow[1] = grow[0] + 32; }
    else { fo = TILE_B; go = 0; frow[0] = 64 * wn + (kr ? cperm_rope(r) : cperm_lin(r)); frow[1] = 64 * wn + 32 + cperm_lin(r); grow[0] = 64 * wm + r; grow[1] = grow[0] + 32; }
    GEMM_CORE<2, 2>(A, D, W, D, D, lds, acc, fo, frow, go, grow);
    if (nt == 10) {
#pragma unroll
        for (int x = 0; x < 2; ++x)
#pragma unroll
            for (int y = 0; y < 2; ++y) {
                const int tok = m0 + 64 * wm + 32 * x, b = tok / SEQ, s0 = tok % SEQ, d = 32 * y + r;
                store_vt(p.VsT + ((size_t)(b * 2 + wn) * 64 + d) * SEQ + s0, acc[x][y], hh);
            }
    } else {
        if (!kr) {
#pragma unroll
            for (int x = 0; x < 2; ++x)
#pragma unroll
                for (int y = 0; y < 2; ++y) {
                    const int tok = m0 + 64 * wm + 32 * y + r, col = n0 + 64 * wn + 32 * x + 16 * hh;
                    float v[16];
#pragma unroll
                    for (int i = 0; i < 16; ++i) v[i] = acc[x][y][i];
                    store16(p.PROJ + (size_t)tok * PROJ_LD + col, v);
                }
        } else if (wn == 0) {
#pragma unroll
            for (int y = 0; y < 2; ++y) {
                const int tok = m0 + 64 * wm + 32 * y + r, pos = tok % SEQ;
                const float4 c0 = *(const float4*)(p.COS + pos * 16 + 8 * hh), c1 = *(const float4*)(p.COS + pos * 16 + 8 * hh + 4);
                const float4 s0 = *(const float4*)(p.SIN + pos * 16 + 8 * hh), s1 = *(const float4*)(p.SIN + pos * 16 + 8 * hh + 4);
                const float cs[8] = {c0.x, c0.y, c0.z, c0.w, c1.x, c1.y, c1.z, c1.w}, sn[8] = {s0.x, s0.y, s0.z, s0.w, s1.x, s1.y, s1.z, s1.w};
                float o1[8], o2[8];
#pragma unroll
                for (int i = 0; i < 8; ++i) { const float t1 = acc[0][y][i], t2 = acc[0][y][8 + i]; o1[i] = t1 * cs[i] - t2 * sn[i]; o2[i] = t1 * sn[i] + t2 * cs[i]; }
                store8(p.KR + (size_t)tok * 32 + 8 * hh, o1); store8(p.KR + (size_t)tok * 32 + 16 + 8 * hh, o2);
            }
        }
    }
}
constexpr int LDS_RS_OFF = LDS_BYTES;
constexpr int LDS_TOTAL = LDS_BYTES + 1024;

template <int W> DI void row_rms(const bf16* A, int lda, float* rs, int tid) {
    const int row = tid >> 1, half = tid & 1;
    const u32x4* p = (const u32x4*)(A + (size_t)row * lda + half * (W / 2));
    float ss = 0.f;
#pragma unroll
    for (int i = 0; i < W / 16; ++i) { const u32x4 v = p[i];
        ss += bflo(v.x) * bflo(v.x) + bfhi(v.x) * bfhi(v.x) + bflo(v.y) * bflo(v.y) + bfhi(v.y) * bfhi(v.y)
            + bflo(v.z) * bflo(v.z) + bfhi(v.z) * bfhi(v.z) + bflo(v.w) * bflo(v.w) + bfhi(v.w) * bfhi(v.w); }
    ss += __shfl_xor(ss, 1);
    if (half == 0) rs[row] = rsqrtf(ss * (1.f / W) + EPS);
}

DI void p2q_tile(const Params& p, int l, int tile, char* lds) {
    int tid_ = threadIdx.x; asm volatile("" : "+v"(tid_)); const int tid = tid_, lane = tid & 63, r = lane & 31, hh = lane >> 5;
    const int wv = __builtin_amdgcn_readfirstlane(tid >> 6), wm = wv >> 1, wn = wv & 1;
    const int mt = tile / 6, nt = tile % 6, m0 = mt * 128, n0 = nt * 128;
    const bf16* A = p.PROJ + (size_t)m0 * PROJ_LD;
    const bf16* W = p.WuqT + ((size_t)l * 768 + n0) * 256;
    float* rs = (float*)(lds + LDS_RS_OFF);
    __syncthreads();
    row_rms<256>(A, PROJ_LD, rs, tid);
    f32x16 acc[2][2]; zero_acc(acc);
    int frow[2], grow[2]; bool rope[2];
#pragma unroll
    for (int x = 0; x < 2; ++x) { rope[x] = (((n0 + 64 * wn + 32 * x) >> 5) % 3) == 2; frow[x] = 64 * wn + 32 * x + (rope[x] ? cperm_rope(r) : cperm_lin(r)); }
    grow[0] = 64 * wm + r; grow[1] = grow[0] + 32;
    GEMM_CORE<2, 2>(A, PROJ_LD, W, 256, 256, lds, acc, TILE_B, frow, 0, grow);
#pragma unroll
    for (int y = 0; y < 2; ++y) {
        const int tl = 64 * wm + 32 * y + r, tok = m0 + tl, pos = tok % SEQ;
        const float sc = rs[tl];
#pragma unroll
        for (int x = 0; x < 2; ++x) {
            bf16* dst = p.Q + (size_t)tok * 768 + n0 + 64 * wn + 32 * x;
            if (rope[x]) {
                const float4 c0 = *(const float4*)(p.COS + pos * 16 + 8 * hh), c1 = *(const float4*)(p.COS + pos * 16 + 8 * hh + 4);
                const float4 s0 = *(const float4*)(p.SIN + pos * 16 + 8 * hh), s1 = *(const float4*)(p.SIN + pos * 16 + 8 * hh + 4);
                const float cs[8] = {c0.x, c0.y, c0.z, c0.w, c1.x, c1.y, c1.z, c1.w}, sn[8] = {s0.x, s0.y, s0.z, s0.w, s1.x, s1.y, s1.z, s1.w};
                float o1[8], o2[8];
#pragma unroll
                for (int i = 0; i < 8; ++i) { const float t1 = acc[x][y][i] * sc, t2 = acc[x][y][8 + i] * sc; o1[i] = t1 * cs[i] - t2 * sn[i]; o2[i] = t1 * sn[i] + t2 * cs[i]; }
                store8(dst + 8 * hh, o1); store8(dst + 16 + 8 * hh, o2);
            } else {
                float v[16];
#pragma unroll
                for (int i = 0; i < 16; ++i) v[i] = acc[x][y][i] * sc;
                store16(dst + 16 * hh, v);
            }
        }
    }
}

DI void p2kv_tile(const Params& p, int l, int tile, char* lds) {
    int tid_ = threadIdx.x; asm volatile("" : "+v"(tid_)); const int tid = tid_, lane = tid & 63, r = lane & 31, hh = lane >> 5;
    const int wv = __builtin_amdgcn_readfirstlane(tid >> 6), wm = wv >> 1, wn = wv & 1;
    const int mt = tile >> 3, h = tile & 7, m0 = mt * 128, n0 = h * 128;
    const bf16* A = p.PROJ + (size_t)m0 * PROJ_LD + 256;
    const bf16* W = p.WukvT + ((size_t)l * 1024 + n0) * 128;
    float* rs = (float*)(lds + LDS_RS_OFF);
    __syncthreads();
    row_rms<128>(A, PROJ_LD, rs, tid);
    f32x16 acc[2][2]; zero_acc(acc);
    int frow[2], grow[2];
    int fo, go;
    if (wn == 0) { fo = TILE_B; go = 0; frow[0] = cperm_lin(r); frow[1] = 32 + cperm_lin(r); grow[0] = 64 * wm + r; grow[1] = grow[0] + 32; }
    else         { fo = 0; go = TILE_B; frow[0] = 64 * wm + r; frow[1] = frow[0] + 32; grow[0] = 64 + r; grow[1] = 96 + r; }
    GEMM_CORE<2, 2>(A, PROJ_LD, W, 128, 128, lds, acc, fo, frow, go, grow);
    if (wn == 0) {
#pragma unroll
        for (int y = 0; y < 2; ++y) {
            const int tl = 64 * wm + 32 * y + r, tok = m0 + tl; const float sc = rs[tl];
#pragma unroll
            for (int x = 0; x < 2; ++x) {
                float v[16];
#pragma unroll
                for (int i = 0; i < 16; ++i) v[i] = acc[x][y][i] * sc;
                store16(p.KN + (size_t)tok * 512 + h * 64 + 32 * x + 16 * hh, v);
            }
        }
    } else {
#pragma unroll
        for (int x = 0; x < 2; ++x) {
            const int tl0 = 64 * wm + 32 * x, tok0 = m0 + tl0, b = tok0 / SEQ, s0 = tok0 % SEQ;
#pragma unroll
            for (int y = 0; y < 2; ++y) {
                f32x16 a = acc[x][y];
#pragma unroll
                for (int i = 0; i < 16; ++i) a[i] *= rs[tl0 + crow(i, hh)];
                store_vt(p.VT + ((size_t)(b * 8 + h) * 64 + 32 * y + r) * SEQ + s0, a, hh);
            }
        }
    }
}
constexpr int VSTR = 144;
template <int KD> struct AttnCfg { static constexpr int KSTR = KD * 2 + 16; static constexpr int BUF = 64 * KSTR + 64 * VSTR; };

template <int KD, int MODE, int ABL = 0>
DI void attn_unit(const bf16* Qp, int qld, const bf16* K1, int k1ld, const bf16* K2, const bf16* VTp, bf16* Op, int b, int qb, float sink_l2, char* lds) {
    constexpr int KSTR = AttnCfg<KD>::KSTR, BUF = AttnCfg<KD>::BUF, NKS = KD / 16;
    int tid_ = threadIdx.x; asm volatile("" : "+v"(tid_)); const int tid = tid_, lane = tid & 63, r = lane & 31, hh = lane >> 5;
    const int wv = __builtin_amdgcn_readfirstlane(tid >> 6);
    const int q0 = qb * 128, qpos = q0 + 32 * wv + r;
    const size_t rowb = (size_t)b * SEQ;
    bf16x8 qf[NKS];
#pragma unroll
    for (int ks = 0; ks < NKS; ++ks) qf[ks] = *(const bf16x8*)(Qp + (rowb + qpos) * qld + ks * 16 + hh * 8);
#pragma unroll
    for (int ks = 0; ks < NKS; ++ks) asm volatile("" : "+v"(qf[ks]));
    const int kstart = (MODE == 0) ? 0 : (q0 >= 128 ? q0 - 128 : 0);
    const int nt = (q0 + 128 - kstart) / 64;
    f32x16 ot[2];
#pragma unroll
    for (int i = 0; i < 16; ++i) { ot[0][i] = 0.f; ot[1][i] = 0.f; }
    float m = (MODE == 0) ? -INFINITY : sink_l2, l = (MODE == 1 && hh == 0) ? 1.f : 0.f;
    u32x4 sk[3], sv[2];
    auto gload = [&](int t) {
        const int key0 = kstart + 64 * t;
#pragma unroll
        for (int i = 0; i < 2; ++i) { const int q = tid + 256 * i, row = q >> 3, c = q & 7;
            sk[i] = *(const u32x4*)(K1 + (rowb + key0 + row) * k1ld + c * 8);
            sv[i] = *(const u32x4*)(VTp + (size_t)row * SEQ + key0 + c * 8); }
        if (KD == 96) { const int row = tid >> 2, c = tid & 3; sk[2] = *(const u32x4*)(K2 + (rowb + key0 + row) * 32 + c * 8); }
    };
    auto sstore = [&](char* buf) {
#pragma unroll
        for (int i = 0; i < 2; ++i) { const int q = tid + 256 * i, row = q >> 3, c = q & 7;
            *(u32x4*)(buf + row * KSTR + c * 16) = sk[i];
            *(u32x4*)(buf + 64 * KSTR + row * VSTR + c * 16) = sv[i]; }
        if (KD == 96) { const int row = tid >> 2, c = tid & 3; *(u32x4*)(buf + row * KSTR + 128 + c * 16) = sk[2]; }
    };
    gload(0);
    __syncthreads();
    sstore(lds);
    __syncthreads();
    for (int t = 0; t < nt; ++t) {
        const char* cur = lds + (t & 1) * BUF;
        if (!(ABL & 8)) if (t + 1 < nt) gload(t + 1);
        const int key0 = kstart + 64 * t;
        f32x16 st[2];
        bf16x8 kf[2][NKS];
#pragma unroll
        for (int mt = 0; mt < 2; ++mt)
#pragma unroll
            for (int ks = 0; ks < NKS; ++ks) kf[mt][ks] = *(const bf16x8*)(cur + (mt * 32 + r) * KSTR + ks * 32 + hh * 16);
        __builtin_amdgcn_sched_barrier(0);
#pragma unroll
        for (int mt = 0; mt < 2; ++mt) {
#pragma unroll
            for (int i = 0; i < 16; ++i) st[mt][i] = 0.f;
#pragma unroll
            for (int ks = 0; ks < NKS; ++ks) { if (ABL & 2) { asm volatile("" :: "v"(kf[mt][ks])); st[mt][ks] += 1.f; } else st[mt] = MFMA32(kf[mt][ks], qf[ks], st[mt]); }
        }
        const char* vt = cur + 64 * KSTR;
        bf16x8 vf[2][4];
#pragma unroll
        for (int mt = 0; mt < 2; ++mt)
#pragma unroll
            for (int s = 0; s < 4; ++s) vf[mt][s] = *(const bf16x8*)(vt + (mt * 32 + r) * VSTR + s * 32 + hh * 16);
        __builtin_amdgcn_sched_barrier(0);
        const bool need_mask = (MODE == 1) || (key0 + 63 > q0 + 32 * wv);
        if (need_mask) {
#pragma unroll
            for (int mt = 0; mt < 2; ++mt)
#pragma unroll
                for (int i = 0; i < 16; ++i) {
                    const int key = key0 + mt * 32 + crow(i, hh);
                    const bool ok = (MODE == 0) ? (key <= qpos) : (key <= qpos && key > qpos - 128);
                    if (!ok) st[mt][i] = -INFINITY;
                }
        }
        float mx = st[0][0];
#pragma unroll
        for (int i = 1; i < 16; ++i) mx = fmaxf(mx, st[0][i]);
#pragma unroll
        for (int i = 0; i < 16; ++i) mx = fmaxf(mx, st[1][i]);
        { auto rr = __builtin_amdgcn_permlane32_swap(__float_as_uint(mx), __float_as_uint(mx), false, false); mx = fmaxf(__uint_as_float(rr[0]), __uint_as_float(rr[1])); }
        const float mn = fmaxf(m, mx);
        const float alpha = __builtin_amdgcn_exp2f(m - mn);
        m = mn;
        float ps = 0.f;
#pragma unroll
        for (int mt = 0; mt < 2; ++mt)
#pragma unroll
            for (int i = 0; i < 16; ++i) { const float pv = (ABL & 1) ? (st[mt][i] - mn) : __builtin_amdgcn_exp2f(st[mt][i] - mn); st[mt][i] = pv; ps += pv; }
        l = l * alpha + ps;
#pragma unroll
        for (int i = 0; i < 16; ++i) { ot[0][i] *= alpha; ot[1][i] *= alpha; }
        bf16x8 pb[4];
#pragma unroll
        for (int s = 0; s < 4; ++s) {
            const int mt = s >> 1, o = 8 * (s & 1);
            u32x4 w; w.x = pk2(st[mt][o], st[mt][o + 1]); w.y = pk2(st[mt][o + 2], st[mt][o + 3]); w.z = pk2(st[mt][o + 4], st[mt][o + 5]); w.w = pk2(st[mt][o + 6], st[mt][o + 7]);
            pb[s] = __builtin_bit_cast(bf16x8, w);
        }
        __builtin_amdgcn_sched_barrier(0);
#pragma unroll
        for (int mt = 0; mt < 2; ++mt)
#pragma unroll
            for (int s = 0; s < 4; ++s) { if (ABL & 4) { asm volatile("" :: "v"(vf[mt][s]), "v"(pb[s])); ot[mt][s] += 1.f; } else ot[mt] = MFMA32(vf[mt][s], pb[s], ot[mt]); }
        if (!(ABL & 8)) if (t + 1 < nt) sstore(lds + ((t + 1) & 1) * BUF);
        __syncthreads();
    }
    { auto rr = __builtin_amdgcn_permlane32_swap(__float_as_uint(l), __float_as_uint(l), false, false); l = __uint_as_float(rr[0]) + __uint_as_float(rr[1]); }
    const float inv = 1.f / l;
    bf16* orow = Op + (rowb + qpos) * 1024;
#pragma unroll
    for (int mt = 0; mt < 2; ++mt)
#pragma unroll
        for (int g = 0; g < 4; ++g) {
            u32x2 w; w.x = pk2(ot[mt][4 * g] * inv, ot[mt][4 * g + 1] * inv); w.y = pk2(ot[mt][4 * g + 2] * inv, ot[mt][4 * g + 3] * inv);
            *(u32x2*)(orow + mt * 32 + 8 * g + 4 * hh) = w;
        }
}

template <int ABL = 0> DI void mla_unit(const Params& p, int u, char* lds) {
    const int nbh = (p.rows / SEQ) * 8, qb = 63 - u / nbh, bh = u % nbh, b = bh >> 3, h = bh & 7;
    attn_unit<96, 0, ABL>(p.Q + h * 96, 768, p.KN + h * 64, 512, p.KR, p.VT + (size_t)bh * 64 * SEQ, p.MIXIN + h * 64, b, qb, 0.f, lds);
}
DI void swa_unit(const Params& p, int l, int u, char* lds) {
    const int qb = u & 63, bh = u >> 6, b = bh >> 2, hq = bh & 3, kvh = hq >> 1;
    attn_unit<64, 1>(p.PROJ + 896 + hq * 64, PROJ_LD, p.PROJ + 1152 + kvh * 64, PROJ_LD, nullptr, p.VsT + (size_t)(b * 2 + kvh) * 64 * SEQ, p.MIXIN + 768 + hq * 64, b, qb,
                     p.in[15][l * 4 + hq] * LOG2E, lds);
}

DI void conv_unit(const Params& p, int l, int u, char* lds) {
    int tid_ = threadIdx.x; asm volatile("" : "+v"(tid_)); const int tid = tid_, lane = tid & 63, wv = tid >> 6;
    const int tok0 = u * 32, pos0 = tok0 % SEQ;
    bf16* glu = (bf16*)lds;
    float* hc = (float*)(lds + 62 * 512);
    __syncthreads();
    for (int it = tid; it < 62 * 32; it += 256) {
        const int row = it >> 5, c8 = (it & 31) * 8, pos = pos0 - 30 + row;
        u32x4 o = {0u, 0u, 0u, 0u};
        if (pos >= 0) {
            const bf16* src = p.PROJ + (size_t)(tok0 - 30 + row) * PROJ_LD + 384 + c8;
            const u32x4 a = *(const u32x4*)src, g = *(const u32x4*)(src + 256);
            const unsigned av[4] = {a.x, a.y, a.z, a.w}, gv[4] = {g.x, g.y, g.z, g.w}; unsigned ov[4];
#pragma unroll
            for (int i = 0; i < 4; ++i) {
                const float g0 = bflo(gv[i]), g1 = bfhi(gv[i]);
                ov[i] = pk2(bflo(av[i]) / (1.f + __expf(-g0)), bfhi(av[i]) / (1.f + __expf(-g1)));
            }
            o.x = ov[0]; o.y = ov[1]; o.z = ov[2]; o.w = ov[3];
        }
        *(u32x4*)(glu + row * 256 + c8) = o;
    }
    __syncthreads();
    {
        const int c = tid;
        float w[31];
        const float* wd = p.in[9] + (size_t)l * 31 * 256 + c;
#pragma unroll
        for (int k = 0; k < 31; ++k) w[k] = wd[k * 256];
        const float bd = p.in[10][l * 256 + c];
#pragma unroll 1
        for (int ch = 0; ch < 4; ++ch) {
            float g[38], acc[8];
#pragma unroll
            for (int i = 0; i < 38; ++i) g[i] = bf2f(glu[(ch * 8 + i) * 256 + c]);
#pragma unroll
            for (int tt = 0; tt < 8; ++tt) { acc[tt] = bd;
#pragma unroll
                for (int k = 0; k < 31; ++k) acc[tt] += w[k] * g[tt + k]; }
#pragma unroll
            for (int tt = 0; tt < 8; ++tt) hc[(ch * 8 + tt) * 256 + c] = acc[tt];
        }
    }
    __syncthreads();
    {
        const float4 gg = *(const float4*)(p.in[11] + l * 256 + lane * 4), bb = *(const float4*)(p.in[12] + l * 256 + lane * 4);
#pragma unroll 1
        for (int i = 0; i < 8; ++i) {
            const int t = wv * 8 + i;
            const float4 v = *(const float4*)(hc + t * 256 + lane * 4);
            float s = v.x + v.y + v.z + v.w;
#pragma unroll
            for (int o = 1; o < 64; o <<= 1) s += __shfl_xor(s, o);
            const float mean = s * (1.f / 256.f);
            const float d0 = v.x - mean, d1 = v.y - mean, d2 = v.z - mean, d3 = v.w - mean;
            float q = d0 * d0 + d1 * d1 + d2 * d2 + d3 * d3;
#pragma unroll
            for (int o = 1; o < 64; o <<= 1) q += __shfl_xor(q, o);
            const float rstd = rsqrtf(q * (1.f / 256.f) + EPS);
            float y0 = d0 * rstd * gg.x + bb.x, y1 = d1 * rstd * gg.y + bb.y, y2 = d2 * rstd * gg.z + bb.z, y3 = d3 * rstd * gg.w + bb.w;
            y0 = y0 / (1.f + __expf(-y0)); y1 = y1 / (1.f + __expf(-y1)); y2 = y2 / (1.f + __expf(-y2)); y3 = y3 / (1.f + __expf(-y3));
            u32x2 w; w.x = pk2(y0, y1); w.y = pk2(y2, y3);
            *(u32x2*)(p.MIXIN + (size_t)(tok0 + t) * 1024 + 512 + lane * 4) = w;
        }
    }
}

constexpr int MSLOT = 20480, MKR = 8192, MVT = 12288;
DI u32x4 mla_rsrc(const void* base, unsigned bytes) {
    const unsigned long long a = (unsigned long long)base;
    u32x4 r; r.x = __builtin_amdgcn_readfirstlane((unsigned)a); r.y = __builtin_amdgcn_readfirstlane((unsigned)(a >> 32) & 0xffffu); r.z = bytes; r.w = 0x00020000u;
    return r;
}
DI void mla_dma(unsigned m0v, int voff, u32x4 rsrc, unsigned soff) {
    asm volatile("s_nop 4\n\ts_mov_b32 m0, %0\n\ts_nop 0\n\tbuffer_load_dwordx4 %1, %2, %3 offen lds" :: "s"(m0v), "v"(voff), "s"(rsrc), "s"(soff) : "m0", "memory");
}
template <int ABL = 0>
DI void mla_attn_dma(const bf16* Qp, const bf16* Kn, const bf16* Kr, const bf16* VTp, bf16* Op, int b, int qb, char* lds) {
    int tid_ = threadIdx.x; asm volatile("" : "+v"(tid_)); const int tid = tid_, lane = tid & 63, r = lane & 31, hh = lane >> 5;
    const int wv = __builtin_amdgcn_readfirstlane(tid >> 6);
    const int q0 = qb * 128, qpos = q0 + 32 * wv + r;
    const size_t rowb = (size_t)b * SEQ;
    const int nt = (q0 + 128) / 64;
    const u32x4 rKn = mla_rsrc(Kn + rowb * 512, (unsigned)SEQ * 1024u), rKr = mla_rsrc(Kr + rowb * 32, (unsigned)SEQ * 64u), rVt = mla_rsrc(VTp, 64u * (unsigned)SEQ * 2u);
    const int l8 = lane >> 3, l4 = lane >> 2;
    const int f0 = l8 >> 1, f1 = f0 ^ 4;
    const int vkn = l8 * 1024 + (((lane & 7) ^ f0) << 4), vkn1 = l8 * 1024 + (((lane & 7) ^ f1) << 4), vkr = l4 * 64 + (((lane & 3) ^ ((l4 >> 2) & 3)) << 4), vvt = l8 * (SEQ * 2) + (((lane & 7) ^ f0) << 4), vvt1 = l8 * (SEQ * 2) + (((lane & 7) ^ f1) << 4);
    const unsigned ldsb = (unsigned)(size_t)(LAS3 char*)lds;
    const unsigned mkn = __builtin_amdgcn_readfirstlane(ldsb + 2048u * wv), mkr = __builtin_amdgcn_readfirstlane(ldsb + MKR + 1024u * wv), mvt = __builtin_amdgcn_readfirstlane(ldsb + MVT + 2048u * wv);
    auto dma = [&](int t, unsigned slot) {
        const unsigned key0 = 64u * t, so = slot * MSLOT;
        const unsigned skn = (key0 + 16u * wv) * 1024u, skr = (key0 + 16u * wv) * 64u, svt = (16u * wv * SEQ + key0) * 2u;
        mla_dma(mkn + so, vkn, rKn, skn); mla_dma(mkn + so + 1024u, vkn1, rKn, skn + 8u * 1024u);
        mla_dma(mkr + so, vkr, rKr, skr);
        mla_dma(mvt + so, vvt, rVt, svt); mla_dma(mvt + so + 1024u, vvt1, rVt, svt + 8u * SEQ * 2u);
    };
    dma(0, 0); if (nt > 1) dma(1, 1);
    bf16x8 qf[6];
#pragma unroll
    for (int ks = 0; ks < 6; ++ks) qf[ks] = *(const bf16x8*)(Qp + (rowb + qpos) * 768 + ks * 16 + hh * 8);
#pragma unroll
    for (int ks = 0; ks < 6; ++ks) asm volatile("" : "+v"(qf[ks]));
    asm volatile("s_waitcnt vmcnt(0)" ::: "memory");
    __syncthreads();
    f32x16 ot[2];
#pragma unroll
    for (int i = 0; i < 16; ++i) { ot[0][i] = 0.f; ot[1][i] = 0.f; }
    float m = -INFINITY, l = 0.f;
    const int sw7 = (r >> 1) & 7, sw3 = (r >> 2) & 3;
    unsigned slot = 0;
    for (int t = 0; t < nt; ++t) {
        const char* cur = lds + slot * MSLOT;
        const unsigned slot2 = (slot >= 1) ? slot - 1 : 2;
        if (!(ABL & 8)) if (t + 2 < nt) dma(t + 2, slot2);
        const int key0 = 64 * t;
        f32x16 st[2];
        bf16x8 kf[2][6];
#pragma unroll
        for (int mt = 0; mt < 2; ++mt) {
#pragma unroll
            for (int ks = 0; ks < 4; ++ks) kf[mt][ks] = *(const bf16x8*)(cur + (mt * 32 + r) * 128 + ((((ks << 1) | hh) ^ sw7) << 4));
#pragma unroll
            for (int ks = 4; ks < 6; ++ks) kf[mt][ks] = *(const bf16x8*)(cur + MKR + (mt * 32 + r) * 64 + ((((((ks - 4) << 1) | hh)) ^ sw3) << 4));
        }
        __builtin_amdgcn_sched_barrier(0);
#pragma unroll
        for (int mt = 0; mt < 2; ++mt) {
#pragma unroll
            for (int i = 0; i < 16; ++i) st[mt][i] = 0.f;
#pragma unroll
            for (int ks = 0; ks < 6; ++ks) { if (ABL & 2) { asm volatile("" :: "v"(kf[mt][ks])); st[mt][ks] += 1.f; } else st[mt] = MFMA32(kf[mt][ks], qf[ks], st[mt]); }
        }
        const char* vt = cur + MVT;
        bf16x8 vf[2][4];
#pragma unroll
        for (int mt = 0; mt < 2; ++mt)
#pragma unroll
            for (int s = 0; s < 4; ++s) vf[mt][s] = *(const bf16x8*)(vt + (mt * 32 + r) * 128 + ((((s << 1) | hh) ^ sw7) << 4));
        __builtin_amdgcn_sched_barrier(0);
        if (key0 + 63 > q0 + 32 * wv) {
#pragma unroll
            for (int mt = 0; mt < 2; ++mt)
#pragma unroll
                for (int i = 0; i < 16; ++i) { const int key = key0 + mt * 32 + crow(i, hh); if (key > qpos) st[mt][i] = -INFINITY; }
        }
        float mx = st[0][0];
#pragma unroll
        for (int i = 1; i < 16; ++i) mx = fmaxf(mx, st[0][i]);
#pragma unroll
        for (int i = 0; i < 16; ++i) mx = fmaxf(mx, st[1][i]);
        { auto rr = __builtin_amdgcn_permlane32_swap(__float_as_uint(mx), __float_as_uint(mx), false, false); mx = fmaxf(__uint_as_float(rr[0]), __uint_as_float(rr[1])); }
        const float mn = fmaxf(m, mx);
        const float alpha = __builtin_amdgcn_exp2f(m - mn);
        m = mn;
        float ps = 0.f;
#pragma unroll
        for (int mt = 0; mt < 2; ++mt)
#pragma unroll
            for (int i = 0; i < 16; ++i) { const float pv = (ABL & 1) ? (st[mt][i] - mn) : __builtin_amdgcn_exp2f(st[mt][i] - mn); st[mt][i] = pv; ps += pv; }
        l = l * alpha + ps;
#pragma unroll
        for (int i = 0; i < 16; ++i) { ot[0][i] *= alpha; ot[1][i] *= alpha; }
        bf16x8 pb[4];
#pragma unroll
        for (int s = 0; s < 4; ++s) {
            const int mt = s >> 1, o = 8 * (s & 1);
            u32x4 w; w.x = pk2(st[mt][o], st[mt][o + 1]); w.y = pk2(st[mt][o + 2], st[mt][o + 3]); w.z = pk2(st[mt][o + 4], st[mt][o + 5]); w.w = pk2(st[mt][o + 6], st[mt][o + 7]);
            pb[s] = __builtin_bit_cast(bf16x8, w);
        }
        __builtin_amdgcn_sched_barrier(0);
#pragma unroll
        for (int mt = 0; mt < 2; ++mt)
#pragma unroll
            for (int s = 0; s < 4; ++s) { if (ABL & 4) { asm volatile("" :: "v"(vf[mt][s]), "v"(pb[s])); ot[mt][s] += 1.f; } else ot[mt] = MFMA32(vf[mt][s], pb[s], ot[mt]); }
        if (t + 2 < nt && !(ABL & 8)) asm volatile("s_waitcnt vmcnt(5)" ::: "memory"); else asm volatile("s_waitcnt vmcnt(0)" ::: "memory");
        __syncthreads();
        slot = (slot == 2) ? 0 : slot + 1;
    }
    { auto rr = __builtin_amdgcn_permlane32_swap(__float_as_uint(l), __float_as_uint(l), false, false); l = __uint_as_float(rr[0]) + __uint_as_float(rr[1]); }
    const float inv = 1.f / l;
    bf16* orow = Op + (rowb + qpos) * 1024;
#pragma unroll
    for (int mt = 0; mt < 2; ++mt)
#pragma unroll
        for (int g = 0; g < 4; ++g) {
            u32x2 w; w.x = pk2(ot[mt][4 * g] * inv, ot[mt][4 * g + 1] * inv); w.y = pk2(ot[mt][4 * g + 2] * inv, ot[mt][4 * g + 3] * inv);
            *(u32x2*)(orow + mt * 32 + 8 * g + 4 * hh) = w;
        }
}
template <int ABL = 0> DI void mla_unit2(const Params& p, int u, char* lds) {
    const int nbh = (p.rows / SEQ) * 8, qb = 63 - u / nbh, bh = u % nbh, b = bh >> 3, h = bh & 7;
    mla_attn_dma<ABL>(p.Q + h * 96, p.KN + h * 64, p.KR, p.VT + (size_t)bh * 64 * SEQ, p.MIXIN + h * 64, b, qb, lds);
}
DI void fold_pw_item(const Params& p, int l, int item) {
    const int tid = threadIdx.x;
    const float* wo = p.in[16] + (size_t)l * D * D + (size_t)512 * D;
    if (item < 1024) {
        const int kp = item >> 2, n = (item & 3) * 256 + tid;
        const float* wp = p.in[13] + (size_t)l * 256 * 256 + (size_t)kp * 256;
        float acc = 0.f;
        for (int j = 0; j < 256; ++j) acc += wp[j] * wo[(size_t)j * D + n];
        p.WoT[((size_t)l * D + n) * D + 512 + kp] = f2bf(acc);
    } else {
        const int n = (item - 1024) * 256 + tid;
        const float* bp = p.in[14] + l * 256;
        float acc = 0.f;
        for (int j = 0; j < 256; ++j) acc += bp[j] * wo[(size_t)j * D + n];
        p.biasO[l * D + n] = acc;
    }
}

DI void p4_tile(const Params& p, int l, int tile, const float* xin, float* X1, char* lds) {
    int tid_ = threadIdx.x; asm volatile("" : "+v"(tid_)); const int tid = tid_, lane = tid & 63, r = lane & 31, hh = lane >> 5;
    const int wv = __builtin_amdgcn_readfirstlane(tid >> 6), wm = wv >> 1, wn = wv & 1;
    const int mt = tile >> 3, nt = tile & 7, m0 = mt * 128, n0 = nt * 128;
    const bf16* A = p.MIXIN + (size_t)m0 * D;
    const bf16* W = p.WoT + ((size_t)l * D + n0) * D;
    f32x16 acc[2][2]; zero_acc(acc);
    int frow[2], grow[2];
    frow[0] = 64 * wm + r; frow[1] = frow[0] + 32; grow[0] = 64 * wn + r; grow[1] = grow[0] + 32;
    GEMM_CORE<2, 2>(A, D, W, D, D, lds, acc, 0, frow, TILE_B, grow);
    const int b = (p.tok0 + m0) / SEQ;
    const float* gt = p.MOD + ((size_t)l * BATCH + b) * 6 * D + 2 * D;
#pragma unroll
    for (int y = 0; y < 2; ++y) {
        const int col = n0 + 64 * wn + 32 * y + r;
        const float g1 = 1.f + gt[col], bo = p.biasO[l * D + col];
#pragma unroll
        for (int x = 0; x < 2; ++x) {
            const size_t base = (size_t)(m0 + 64 * wm + 32 * x + 4 * hh) * D + col;
            float xv[16];
#pragma unroll
            for (int i = 0; i < 16; ++i) xv[i] = xin[base + (size_t)((i & 3) + 8 * (i >> 2)) * D];
#pragma unroll
            for (int i = 0; i < 16; ++i) X1[base + (size_t)((i & 3) + 8 * (i >> 2)) * D] = DN_ALPHA * xv[i] + g1 * (acc[x][y][i] + bo);
        }
    }
}

DI void ln16(float (&v)[16], const float* g, const float* bta, int lane) {
    float s = 0.f;
#pragma unroll
    for (int i = 0; i < 16; ++i) s += v[i];
#pragma unroll
    for (int o = 1; o < 64; o <<= 1) s += __shfl_xor(s, o);
    const float mean = s * (1.f / D); float q = 0.f;
#pragma unroll
    for (int i = 0; i < 16; ++i) { v[i] -= mean; q += v[i] * v[i]; }
#pragma unroll
    for (int o = 1; o < 64; o <<= 1) q += __shfl_xor(q, o);
    const float rstd = rsqrtf(q * (1.f / D) + EPS);
#pragma unroll
    for (int hf = 0; hf < 2; ++hf)
#pragma unroll
        for (int q4 = 0; q4 < 2; ++q4) {
            const int c = hf * 512 + lane * 8 + q4 * 4;
            const float4 gg = *(const float4*)(g + c), bb = *(const float4*)(bta + c);
            const int i = hf * 8 + q4 * 4;
            v[i] = v[i] * rstd * gg.x + bb.x; v[i + 1] = v[i + 1] * rstd * gg.y + bb.y; v[i + 2] = v[i + 2] * rstd * gg.z + bb.z; v[i + 3] = v[i + 3] * rstd * gg.w + bb.w;
        }
}
DI void load16(float (&v)[16], const float* row, int lane) {
#pragma unroll
    for (int hf = 0; hf < 2; ++hf)
#pragma unroll
        for (int q4 = 0; q4 < 2; ++q4) { const float4 t = *(const float4*)(row + hf * 512 + lane * 8 + q4 * 4); const int i = hf * 8 + q4 * 4; v[i] = t.x; v[i + 1] = t.y; v[i + 2] = t.z; v[i + 3] = t.w; }
}
DI void store16f(float* row, const float (&v)[16], int lane) {
#pragma unroll
    for (int hf = 0; hf < 2; ++hf)
#pragma unroll
        for (int q4 = 0; q4 < 2; ++q4) { const int i = hf * 8 + q4 * 4; *(float4*)(row + hf * 512 + lane * 8 + q4 * 4) = make_float4(v[i], v[i + 1], v[i + 2], v[i + 3]); }
}
DI void store_mod16(bf16* hrow, const float (&v)[16], const float* sh, const float* sc, int lane) {
#pragma unroll
    for (int hf = 0; hf < 2; ++hf) {
        float o[8];
#pragma unroll
        for (int q4 = 0; q4 < 2; ++q4) {
            const int c = hf * 512 + lane * 8 + q4 * 4, i = hf * 8 + q4 * 4;
            const float4 s4 = *(const float4*)(sc + c), h4 = *(const float4*)(sh + c);
            o[q4 * 4] = v[i] * (1.f + s4.x) + h4.x; o[q4 * 4 + 1] = v[i + 1] * (1.f + s4.y) + h4.y; o[q4 * 4 + 2] = v[i + 2] * (1.f + s4.z) + h4.z; o[q4 * 4 + 3] = v[i + 3] * (1.f + s4.w) + h4.w;
        }
        store8(hrow + hf * 512 + lane * 8, o);
    }
}
DI void p4b_row(const Params& p, int l, int row, float* X1, int lane) {
    float v[16];
    load16(v, X1 + (size_t)row * D, lane);
    float s = 0.f;
#pragma unroll
    for (int i = 0; i < 16; ++i) s += v[i];
#pragma unroll
    for (int o = 1; o < 64; o <<= 1) s += __shfl_xor(s, o);
    const float mean = s * (1.f / D); float q = 0.f;
#pragma unroll
    for (int i = 0; i < 16; ++i) { v[i] -= mean; q += v[i] * v[i]; }
#pragma unroll
    for (int o = 1; o < 64; o <<= 1) q += __shfl_xor(q, o);
    const float rstd = rsqrtf(q * (1.f / D) + EPS);
    if (lane == 0) { p.STATS[2 * (size_t)row] = mean; p.STATS[2 * (size_t)row + 1] = rstd; }
    const float* g = p.in[17] + l * D; const float* bta = p.in[18] + l * D;
#pragma unroll
    for (int hf = 0; hf < 2; ++hf)
#pragma unroll
        for (int q4 = 0; q4 < 2; ++q4) {
            const int c = hf * 512 + lane * 8 + q4 * 4;
            const float4 gg = *(const float4*)(g + c), bb = *(const float4*)(bta + c);
            const int i = hf * 8 + q4 * 4;
            v[i] = v[i] * rstd * gg.x + bb.x; v[i + 1] = v[i + 1] * rstd * gg.y + bb.y; v[i + 2] = v[i + 2] * rstd * gg.z + bb.z; v[i + 3] = v[i + 3] * rstd * gg.w + bb.w;
        }
    const int b = (p.tok0 + row) / SEQ;
    const float* mod = p.MOD + ((size_t)l * BATCH + b) * 6 * D;
    store_mod16(p.H + (size_t)row * D, v, mod + 3 * D, mod + 4 * D, lane);
}

DI unsigned ford(float f) { const unsigned u = __float_as_uint(f); return u ^ ((u >> 31) ? 0xffffffffu : 0x80000000u); }
DI float funord(unsigned o) { const unsigned u = o ^ ((o >> 31) ? 0x80000000u : 0xffffffffu); return __uint_as_float(u); }
constexpr int SKSTR = 272;

DI void p5_tile(const Params& p, int l, int tile, char* lds) {
    int tid_ = threadIdx.x; asm volatile("" : "+v"(tid_)); const int tid = tid_, lane = tid & 63, r = lane & 31, hh = lane >> 5;
    const int wv = __builtin_amdgcn_readfirstlane(tid >> 6);
    const int mt = tile >> 4, hp = tile & 15, m0 = mt * 128;
    const bf16* A = p.H + (size_t)m0 * D;
    const bf16* W = p.WpqT + ((size_t)l * 2048 + hp * 128) * D;
    f32x16 acc[4][1]; zero_acc(acc);
    int frow[4], grow[1];
#pragma unroll
    for (int x = 0; x < 4; ++x) frow[x] = 32 * x + r;
    grow[0] = 32 * wv + r;
    GEMM_CORE<4, 1>(A, D, W, D, D, lds, acc, TILE_B, frow, 0, grow);
#ifdef G3_PROBE
    const int dry5 = __builtin_amdgcn_readfirstlane(*(volatile int*)(lds + LDS_BYTES + 1024 - 64));
    if (dry5 & 4) return;
#endif
    bf16x8 xb[8];
#pragma unroll
    for (int s = 0; s < 8; ++s) {
        const int x = s >> 1, o = 8 * (s & 1);
        u32x4 w; w.x = pk2(acc[x][0][o], acc[x][0][o + 1]); w.y = pk2(acc[x][0][o + 2], acc[x][0][o + 3]); w.z = pk2(acc[x][0][o + 4], acc[x][0][o + 5]); w.w = pk2(acc[x][0][o + 6], acc[x][0][o + 7]);
        xb[s] = __builtin_bit_cast(bf16x8, w);
    }
    const bf16* sk = p.SKp + ((size_t)l * 16 + hp) * 128 * 128;
#pragma unroll
    for (int i = 0; i < 8; ++i) { const int q = tid + 256 * i, row = q >> 4, c = q & 15; *(u32x4*)(lds + row * SKSTR + c * 16) = *(const u32x4*)(sk + row * 128 + c * 8); }
    __syncthreads();
    unsigned L[16];
#pragma unroll
    for (int m2 = 0; m2 < 4; ++m2) {
        f32x16 st;
#pragma unroll
        for (int i = 0; i < 16; ++i) st[i] = 0.f;
#pragma unroll
        for (int s = 0; s < 8; ++s) {
            const bf16x8 a = *(const bf16x8*)(lds + (32 * m2 + r) * SKSTR + s * 32 + hh * 16);
            st = MFMA32(a, xb[s], st);
        }
        unsigned V[16];
#pragma unroll
        for (int i = 0; i < 16; ++i) V[i] = (ford(st[i]) & ~0x7fu) | (unsigned)(32 * m2 + crow(i, hh));
#pragma unroll
        for (int k = 2; k <= 16; k <<= 1)
#pragma unroll
            for (int j = k >> 1; j >= 1; j >>= 1)
#pragma unroll
                for (int i = 0; i < 16; ++i) { const int o = i ^ j; if (o > i) { const unsigned a = max(V[i], V[o]), b = min(V[i], V[o]); if ((i & k) == 0) { V[i] = a; V[o] = b; } else { V[i] = b; V[o] = a; } } }
        if (m2 == 0) {
#pragma unroll
            for (int k = 0; k < 16; ++k) L[k] = V[k];
        } else {
#pragma unroll
            for (int k = 0; k < 16; ++k) L[k] = max(L[k], V[15 - k]);
#pragma unroll
            for (int d = 8; d >= 1; d >>= 1)
#pragma unroll
                for (int i = 0; i < 16; ++i) if ((i & d) == 0) { const unsigned a = max(L[i], L[i + d]), b = min(L[i], L[i + d]); L[i] = a; L[i + d] = b; }
        }
    }
    unsigned C[16];
#pragma unroll
    for (int k = 0; k < 16; ++k) C[k] = max(L[k], (unsigned)__shfl_xor((int)L[15 - k], 32));
#pragma unroll
    for (int d = 8; d >= 1; d >>= 1)
#pragma unroll
        for (int i = 0; i < 16; ++i) if ((i & d) == 0) { const unsigned a = max(C[i], C[i + d]), b = min(C[i], C[i + d]); C[i] = a; C[i + d] = b; }
    unsigned* dst = p.TOPK + ((size_t)(m0 + 32 * wv + r) * 16 + hp) * 16 + 8 * hh;
    u32x4 o0, o1;
    if (hh == 0) { o0 = (u32x4){C[0], C[1], C[2], C[3]}; o1 = (u32x4){C[4], C[5], C[6], C[7]}; }
    else { o0 = (u32x4){C[8], C[9], C[10], C[11]}; o1 = (u32x4){C[12], C[13], C[14], C[15]}; }
    *(u32x4*)dst = o0; *(u32x4*)(dst + 4) = o1;
}
typedef __bf16 bf16x2v __attribute__((ext_vector_type(2)));
DI float dot2(unsigned a, unsigned b, float c) { return __builtin_amdgcn_fdot2_f32_bf16(__builtin_bit_cast(bf16x2v, a), __builtin_bit_cast(bf16x2v, b), c, false); }
DI float gelu_erf(float a) { return 0.5f * a * (1.f + erff(a * 0.70710678118654752f)); }

DI void p6_unit(const Params& p, int l, int u, const float* X1, float* xout, char* lds) {
    int tid_ = threadIdx.x; asm volatile("" : "+v"(tid_)); const int tid = tid_, lane = tid & 63;
    const int wv = __builtin_amdgcn_readfirstlane(tid >> 6);
    unsigned* LA = (unsigned*)(lds + wv * 16384); unsigned* LB = LA + 1024; unsigned* Ee = LA + 2048; float* Eg = (float*)(LA + 3072);
    const int tokb = u * 32 + wv * 8;
    __syncthreads();
    {
        const int ti = lane >> 3, head = lane & 7;
        const unsigned* src = p.TOPK + ((size_t)(tokb + ti) * 16 + head * 2) * 16;
        unsigned A[16], B[16];
#pragma unroll
        for (int q = 0; q < 4; ++q) { const u32x4 a = *(const u32x4*)(src + 4 * q), b = *(const u32x4*)(src + 16 + 4 * q);
            A[4 * q] = a.x; A[4 * q + 1] = a.y; A[4 * q + 2] = a.z; A[4 * q + 3] = a.w; B[4 * q] = b.x; B[4 * q + 1] = b.y; B[4 * q + 2] = b.z; B[4 * q + 3] = b.w;
            *(u32x4*)(LA + lane * 16 + 4 * q) = a; *(u32x4*)(LB + lane * 16 + 4 * q) = b; }
        float sA[16], sB[16];
#pragma unroll
        for (int k = 0; k < 16; ++k) { sA[k] = funord(A[k] & ~0x7fu); sB[k] = funord(B[k] & ~0x7fu); }
        unsigned T[16];
#pragma unroll
        for (int k = 0; k < 16; ++k) T[k] = 0u;
#pragma unroll
        for (int a = 0; a < 16; ++a)
#pragma unroll
            for (int b = 0; b < 16; ++b)
                if ((a + 1) * (b + 1) <= 16) {
                    unsigned v = (ford(sA[a] + sB[b]) & ~0xffu) | (unsigned)(a * 16 + b);
#pragma unroll
                    for (int k = 0; k < 16; ++k) { const unsigned t = max(T[k], v); v = min(T[k], v); T[k] = t; }
                }
        float ex[16]; float sum = 0.f; const float mx = funord(T[0] & ~0xffu);
#pragma unroll
        for (int k = 0; k < 16; ++k) { ex[k] = __expf(funord(T[k] & ~0xffu) - mx); sum += ex[k]; }
        const float inv = 1.f / sum;
#pragma unroll
        for (int k = 0; k < 16; ++k) {
            const unsigned cid = T[k] & 0xffu, ia = LA[lane * 16 + (cid >> 4)] & 0x7fu, ib = LB[lane * 16 + (cid & 15u)] & 0x7fu;
            Ee[ti * 128 + head * 16 + k] = ia * 128u + ib; Eg[ti * 128 + head * 16 + k] = ex[k] * inv;
        }
    }
    const bf16* Ut = p.Ut; const bf16* Vt = p.Vt;
    const int jl = 4 * (lane >> 5) + 2 * ((lane >> 4) & 1) + ((lane >> 3) & 1);
    const bool b5 = lane & 32, b4 = lane & 16, b3 = lane & 8;
#pragma unroll 1
    for (int ti = 0; ti < 8; ++ti) {
        const int tok = tokb + ti;
        const u32x4 h0 = *(const u32x4*)(p.H + (size_t)tok * D + lane * 8), h1 = *(const u32x4*)(p.H + (size_t)tok * D + 512 + lane * 8);
        float y[16];
#pragma unroll
        for (int i = 0; i < 16; ++i) y[i] = 0.f;
#pragma unroll 1
        for (int bt = 0; bt < 16; ++bt) {
            u32x4 uu[8][2], vv[8][2];
#pragma unroll
            for (int j = 0; j < 8; ++j) {
                const unsigned e = __builtin_amdgcn_readfirstlane(Ee[ti * 128 + bt * 8 + j]);
                const bf16* ur = Ut + (size_t)e * D + lane * 8; const bf16* vr = Vt + (size_t)e * D + lane * 8;
                uu[j][0] = *(const u32x4*)ur; uu[j][1] = *(const u32x4*)(ur + 512);
                vv[j][0] = *(const u32x4*)vr; vv[j][1] = *(const u32x4*)(vr + 512);
            }
            float a[8];
#pragma unroll
            for (int j = 0; j < 8; ++j) {
                float s = dot2(h0.x, uu[j][0].x, 0.f); s = dot2(h0.y, uu[j][0].y, s); s = dot2(h0.z, uu[j][0].z, s); s = dot2(h0.w, uu[j][0].w, s);
                s = dot2(h1.x, uu[j][1].x, s); s = dot2(h1.y, uu[j][1].y, s); s = dot2(h1.z, uu[j][1].z, s); s = dot2(h1.w, uu[j][1].w, s);
                a[j] = s;
            }
            float k1[4], k2[2], k3;
#pragma unroll
            for (int i = 0; i < 4; ++i) { const float snd = b5 ? a[i] : a[4 + i]; const float rcv = __shfl_xor(snd, 32); k1[i] = (b5 ? a[4 + i] : a[i]) + rcv; }
#pragma unroll
            for (int i = 0; i < 2; ++i) { const float snd = b4 ? k1[i] : k1[2 + i]; const float rcv = __shfl_xor(snd, 16); k2[i] = (b4 ? k1[2 + i] : k1[i]) + rcv; }
            { const float snd = b3 ? k2[0] : k2[1]; const float rcv = __shfl_xor(snd, 8); k3 = (b3 ? k2[1] : k2[0]) + rcv; }
            k3 += __shfl_xor(k3, 4); k3 += __shfl_xor(k3, 2); k3 += __shfl_xor(k3, 1);
            const float w = Eg[ti * 128 + bt * 8 + jl] * gelu_erf(k3);
#pragma unroll
            for (int j = 0; j < 8; ++j) {
                const int src = 32 * (j >> 2) + 16 * ((j >> 1) & 1) + 8 * (j & 1);
                const float wj = __uint_as_float(__builtin_amdgcn_readlane(__float_as_uint(w), src));
                const unsigned w0[4] = {vv[j][0].x, vv[j][0].y, vv[j][0].z, vv[j][0].w}, w1[4] = {vv[j][1].x, vv[j][1].y, vv[j][1].z, vv[j][1].w};
#pragma unroll
                for (int i = 0; i < 4; ++i) { y[2 * i] += wj * bflo(w0[i]); y[2 * i + 1] += wj * bfhi(w0[i]); y[8 + 2 * i] += wj * bflo(w1[i]); y[8 + 2 * i + 1] += wj * bfhi(w1[i]); }
            }
        }
        const int b = (p.tok0 + tok) / SEQ;
        const float* mod = p.MOD + ((size_t)l * BATCH + b) * 6 * D;
        float v[16], gt[16];
        load16(v, X1 + (size_t)tok * D, lane); load16(gt, mod + 5 * D, lane);
#pragma unroll
        for (int i = 0; i < 16; ++i) v[i] = DN_ALPHA * v[i] + (1.f + gt[i]) * y[i];
        ln16(v, p.in[23] + l * D, p.in[24] + l * D, lane);
        store16f(xout + (size_t)tok * D, v, lane);
        if (l + 1 < DEPTH) { const float* modn = p.MOD + ((size_t)(l + 1) * BATCH + b) * 6 * D; store_mod16(p.H + (size_t)tok * D, v, modn, modn + D, lane); }
    }
}
DI void table_row_fp8(const float* src, unsigned char* dst, float* inv_scale, int lane) {
    float v[16];
#pragma unroll
    for (int q = 0; q < 4; ++q) { const float4 t = *(const float4*)(src + lane * 16 + q * 4); v[4 * q] = t.x; v[4 * q + 1] = t.y; v[4 * q + 2] = t.z; v[4 * q + 3] = t.w; }
    float mx = 0.f;
#pragma unroll
    for (int i = 0; i < 16; ++i) mx = fmaxf(mx, fabsf(v[i]));
#pragma unroll
    for (int o = 1; o < 64; o <<= 1) mx = fmaxf(mx, __shfl_xor(mx, o));
    const float sc = (mx > 0.f) ? 448.f / mx : 1.f;
    u32x4 o;
    unsigned w[4];
#pragma unroll
    for (int q = 0; q < 4; ++q) { unsigned t = 0u; t = __builtin_amdgcn_cvt_pk_fp8_f32(v[4 * q] * sc, v[4 * q + 1] * sc, t, false); t = __builtin_amdgcn_cvt_pk_fp8_f32(v[4 * q + 2] * sc, v[4 * q + 3] * sc, t, true); w[q] = t; }
    o.x = w[0]; o.y = w[1]; o.z = w[2]; o.w = w[3];
    *(u32x4*)(dst + lane * 16) = o;
    if (lane == 0) *inv_scale = (mx > 0.f) ? mx * (1.f / 448.f) : 1.f;
}
DI void convert_tables_fp8(const Params& p, int l, int bid, int nb) {
    int t_ = threadIdx.x; asm volatile("" : "+v"(t_)); const int wv = t_ >> 6, lane = t_ & 63;
    const float* us = p.in[21] + (size_t)l * 16384 * D; const float* vs = p.in[22] + (size_t)l * 16384 * D;
    for (int row = bid * 4 + wv; row < 2 * 16384; row += nb * 4) {
        if (row < 16384) table_row_fp8(us + (size_t)row * D, p.U8 + (size_t)row * D, p.US + l * 16384 + row, lane);
        else { const int r2 = row - 16384; table_row_fp8(vs + (size_t)r2 * D, p.V8 + (size_t)r2 * D, p.VS + l * 16384 + r2, lane); }
    }
}
DI void load16c(float (&v)[16], const float* row, int lane) {
#pragma unroll
    for (int q = 0; q < 4; ++q) { const float4 t = *(const float4*)(row + lane * 16 + q * 4); v[4 * q] = t.x; v[4 * q + 1] = t.y; v[4 * q + 2] = t.z; v[4 * q + 3] = t.w; }
}
DI void ln16c(float (&v)[16], const float* g, const float* bta, int lane) {
    float s = 0.f;
#pragma unroll
    for (int i = 0; i < 16; ++i) s += v[i];
#pragma unroll
    for (int o = 1; o < 64; o <<= 1) s += __shfl_xor(s, o);
    const float mean = s * (1.f / D); float q = 0.f;
#pragma unroll
    for (int i = 0; i < 16; ++i) { v[i] -= mean; q += v[i] * v[i]; }
#pragma unroll
    for (int o = 1; o < 64; o <<= 1) q += __shfl_xor(q, o);
    const float rstd = rsqrtf(q * (1.f / D) + EPS);
    float gg[16], bb[16]; load16c(gg, g, lane); load16c(bb, bta, lane);
#pragma unroll
    for (int i = 0; i < 16; ++i) v[i] = v[i] * rstd * gg[i] + bb[i];
}
DI void store16c(float* row, const float (&v)[16], int lane) {
#pragma unroll
    for (int q = 0; q < 4; ++q) *(float4*)(row + lane * 16 + q * 4) = make_float4(v[4 * q], v[4 * q + 1], v[4 * q + 2], v[4 * q + 3]);
}
DI void store_mod16c(bf16* hrow, const float (&v)[16], const float* sh, const float* sc, int lane) {
    float s[16], h[16], o[16]; load16c(s, sc, lane); load16c(h, sh, lane);
#pragma unroll
    for (int i = 0; i < 16; ++i) o[i] = v[i] * (1.f + s[i]) + h[i];
    store16(hrow + lane * 16, o);
}

DI void p6f_unit(const Params& p, int l, int u, const float* X1, float* xout, char* lds) {
    int tid_ = threadIdx.x; asm volatile("" : "+v"(tid_)); const int tid = tid_, lane = tid & 63;
    const int wv = __builtin_amdgcn_readfirstlane(tid >> 6);
    unsigned* LA = (unsigned*)(lds + wv * 16384); unsigned* LB = LA + 1024; unsigned* Ee = LA + 2048; float* Eg = (float*)(LA + 3072); float* Es = (float*)LA;
    const int tokb = u * 32 + wv * 8;
    __syncthreads();
    {
        const int ti = lane >> 3, head = lane & 7;
        const unsigned* src = p.TOPK + ((size_t)(tokb + ti) * 16 + head * 2) * 16;
        unsigned A[16], B[16];
#pragma unroll
        for (int q = 0; q < 4; ++q) { const u32x4 a = *(const u32x4*)(src + 4 * q), b = *(const u32x4*)(src + 16 + 4 * q);
            A[4 * q] = a.x; A[4 * q + 1] = a.y; A[4 * q + 2] = a.z; A[4 * q + 3] = a.w; B[4 * q] = b.x; B[4 * q + 1] = b.y; B[4 * q + 2] = b.z; B[4 * q + 3] = b.w;
            *(u32x4*)(LA + lane * 16 + 4 * q) = a; *(u32x4*)(LB + lane * 16 + 4 * q) = b; }
        float sA[16], sB[16];
#pragma unroll
        for (int k = 0; k < 16; ++k) { sA[k] = funord(A[k] & ~0x7fu); sB[k] = funord(B[k] & ~0x7fu); }
        unsigned T[16];
#pragma unroll
        for (int k = 0; k < 16; ++k) T[k] = 0u;
#pragma unroll
        for (int a = 0; a < 16; ++a)
#pragma unroll
            for (int b = 0; b < 16; ++b)
                if ((a + 1) * (b + 1) <= 16) {
                    unsigned v = (ford(sA[a] + sB[b]) & ~0xffu) | (unsigned)(a * 16 + b);
#pragma unroll
                    for (int k = 0; k < 16; ++k) { const unsigned t = max(T[k], v); v = min(T[k], v); T[k] = t; }
                }
        float ex[16]; float sum = 0.f; const float mx = funord(T[0] & ~0xffu);
        unsigned ev[16];
#pragma unroll
        for (int k = 0; k < 16; ++k) { ex[k] = __expf(funord(T[k] & ~0xffu) - mx); sum += ex[k];
            const unsigned cid = T[k] & 0xffu; ev[k] = (LA[lane * 16 + (cid >> 4)] & 0x7fu) * 128u + (LB[lane * 16 + (cid & 15u)] & 0x7fu); }
        const float inv = 1.f / sum;
        const float* US = p.US + l * 16384; const float* VS = p.VS + l * 16384;
#pragma unroll
        for (int k = 0; k < 16; ++k) {
            const float su = US[ev[k]], sv = VS[ev[k]];
            Ee[ti * 128 + head * 16 + k] = ev[k]; Eg[ti * 128 + head * 16 + k] = ex[k] * inv * sv; Es[ti * 128 + head * 16 + k] = su;
        }
    }
    const unsigned char* U8 = p.U8; const unsigned char* V8 = p.V8;
    const int jl = 8 * (lane >> 5) + 4 * ((lane >> 4) & 1) + 2 * ((lane >> 3) & 1) + ((lane >> 2) & 1);
    const bool b5 = lane & 32, b4 = lane & 16, b3 = lane & 8, b2 = lane & 4;
#pragma unroll 1
    for (int ti = 0; ti < 8; ++ti) {
        const int tok = tokb + ti;
        const u32x4 h0 = *(const u32x4*)(p.H + (size_t)tok * D + lane * 16), h1 = *(const u32x4*)(p.H + (size_t)tok * D + lane * 16 + 8);
        const unsigned hw[8] = {h0.x, h0.y, h0.z, h0.w, h1.x, h1.y, h1.z, h1.w};
        f32x2v hf[8], y2[8];
#pragma unroll
        for (int i = 0; i < 8; ++i) { hf[i] = (f32x2v){bflo(hw[i]), bfhi(hw[i])}; y2[i] = (f32x2v){0.f, 0.f}; }
#pragma unroll 1
        for (int bt = 0; bt < 8; ++bt) {
            u32x4 uu[16], vv[16];
#pragma unroll
            for (int j = 0; j < 16; ++j) {
                const unsigned e = __builtin_amdgcn_readfirstlane(Ee[ti * 128 + bt * 16 + j]);
                uu[j] = *(const u32x4*)(U8 + (size_t)e * D + lane * 16);
                vv[j] = *(const u32x4*)(V8 + (size_t)e * D + lane * 16);
            }
            float a[16];
#pragma unroll
            for (int j = 0; j < 16; ++j) {
                const unsigned w[4] = {uu[j].x, uu[j].y, uu[j].z, uu[j].w};
                f32x2v acc = {0.f, 0.f};
#pragma unroll
                for (int q = 0; q < 4; ++q) { acc = __builtin_amdgcn_cvt_pk_f32_fp8(w[q], false) * hf[2 * q] + acc; acc = __builtin_amdgcn_cvt_pk_f32_fp8(w[q], true) * hf[2 * q + 1] + acc; }
                a[j] = acc.x + acc.y;
            }
            float k1[8], k2[4], k3[2], k4;
#pragma unroll
            for (int i = 0; i < 8; ++i) { const float snd = b5 ? a[i] : a[8 + i]; const float rcv = __shfl_xor(snd, 32); k1[i] = (b5 ? a[8 + i] : a[i]) + rcv; }
#pragma unroll
            for (int i = 0; i < 4; ++i) { const float snd = b4 ? k1[i] : k1[4 + i]; const float rcv = __shfl_xor(snd, 16); k2[i] = (b4 ? k1[4 + i] : k1[i]) + rcv; }
#pragma unroll
            for (int i = 0; i < 2; ++i) { const float snd = b3 ? k2[i] : k2[2 + i]; const float rcv = __shfl_xor(snd, 8); k3[i] = (b3 ? k2[2 + i] : k2[i]) + rcv; }
            { const float snd = b2 ? k3[0] : k3[1]; const float rcv = __shfl_xor(snd, 4); k4 = (b2 ? k3[1] : k3[0]) + rcv; }
            k4 += __shfl_xor(k4, 2); k4 += __shfl_xor(k4, 1);
            const int ei = ti * 128 + bt * 16 + jl;
            const float w = Eg[ei] * gelu_erf(k4 * Es[ei]);
#pragma unroll
            for (int j = 0; j < 16; ++j) {
                const int src = 32 * (j >> 3) + 16 * ((j >> 2) & 1) + 8 * ((j >> 1) & 1) + 4 * (j & 1);
                const float wj = __uint_as_float(__builtin_amdgcn_readlane(__float_as_uint(w), src));
                const f32x2v wj2 = {wj, wj};
                const unsigned wd[4] = {vv[j].x, vv[j].y, vv[j].z, vv[j].w};
#pragma unroll
                for (int q = 0; q < 4; ++q) { y2[2 * q] = __builtin_amdgcn_cvt_pk_f32_fp8(wd[q], false) * wj2 + y2[2 * q]; y2[2 * q + 1] = __builtin_amdgcn_cvt_pk_f32_fp8(wd[q], true) * wj2 + y2[2 * q + 1]; }
            }
        }
        const int b = (p.tok0 + tok) / SEQ;
        const float* mod = p.MOD + ((size_t)l * BATCH + b) * 6 * D;
        float v[16], gt[16];
        load16c(v, X1 + (size_t)tok * D, lane); load16c(gt, mod + 5 * D, lane);
        {
            const float mean1 = p.STATS[2 * (size_t)tok], rstd1 = p.STATS[2 * (size_t)tok + 1];
            float g1[16], b1[16]; load16c(g1, p.in[17] + l * D, lane); load16c(b1, p.in[18] + l * D, lane);
#pragma unroll
            for (int i = 0; i < 16; ++i) v[i] = (v[i] - mean1) * rstd1 * g1[i] + b1[i];
        }
#pragma unroll
        for (int i = 0; i < 8; ++i) { v[2 * i] = DN_ALPHA * v[2 * i] + (1.f + gt[2 * i]) * y2[i].x; v[2 * i + 1] = DN_ALPHA * v[2 * i + 1] + (1.f + gt[2 * i + 1]) * y2[i].y; }
        ln16c(v, p.in[23] + l * D, p.in[24] + l * D, lane);
        store16c(xout + (size_t)tok * D, v, lane);
        if (l + 1 < DEPTH) { const float* modn = p.MOD + ((size_t)(l + 1) * BATCH + b) * 6 * D; store_mod16c(p.H + (size_t)tok * D, v, modn, modn + D, lane); }
    }
}
#ifndef P6_NR
#define P6_NR 8
#endif
constexpr int NR = P6_NR, RSH = (NR == 16) ? 10 : (NR == 8) ? 11 : (NR == 4) ? 12 : (NR == 2) ? 13 : 14;

DI void p6x_combine(const Params& p, int l, int tokb, unsigned* LA, unsigned* LB, unsigned* Ee, float* Eg, float* Es, int lane) {
    const int ti = lane >> 3, head = lane & 7;
    const unsigned* src = p.TOPK + ((size_t)(tokb + ti) * 16 + head * 2) * 16;
    unsigned A[16], B[16];
#pragma unroll
    for (int q = 0; q < 4; ++q) { const u32x4 a = *(const u32x4*)(src + 4 * q), b = *(const u32x4*)(src + 16 + 4 * q);
        A[4 * q] = a.x; A[4 * q + 1] = a.y; A[4 * q + 2] = a.z; A[4 * q + 3] = a.w; B[4 * q] = b.x; B[4 * q + 1] = b.y; B[4 * q + 2] = b.z; B[4 * q + 3] = b.w;
        *(u32x4*)(LA + lane * 16 + 4 * q) = a; *(u32x4*)(LB + lane * 16 + 4 * q) = b; }
    float sA[16], sB[16];
#pragma unroll
    for (int k = 0; k < 16; ++k) { sA[k] = funord(A[k] & ~0x7fu); sB[k] = funord(B[k] & ~0x7fu); }
    unsigned T[16];
#pragma unroll
    for (int k = 0; k < 16; ++k) T[k] = 0u;
#pragma unroll
    for (int a = 0; a < 16; ++a)
#pragma unroll
        for (int b = 0; b < 16; ++b)
            if ((a + 1) * (b + 1) <= 16) {
                unsigned v = (ford(sA[a] + sB[b]) & ~0xffu) | (unsigned)(a * 16 + b);
#pragma unroll
                for (int k = 0; k < 16; ++k) { const unsigned t = max(T[k], v); v = min(T[k], v); T[k] = t; }
            }
    float ex[16]; float sum = 0.f; const float mx = funord(T[0] & ~0xffu);
    unsigned ev[16];
#pragma unroll
    for (int k = 0; k < 16; ++k) { ex[k] = __expf(funord(T[k] & ~0xffu) - mx); sum += ex[k];
        const unsigned cid = T[k] & 0xffu; ev[k] = (LA[lane * 16 + (cid >> 4)] & 0x7fu) * 128u + (LB[lane * 16 + (cid & 15u)] & 0x7fu); }
    const float inv = 1.f / sum;
    const float* US = p.US + l * 16384; const float* VS = p.VS + l * 16384;
    float su[16], gv[16];
#pragma unroll
    for (int k = 0; k < 16; ++k) { su[k] = US[ev[k]]; gv[k] = ex[k] * inv * VS[ev[k]]; }
    unsigned* cnt = LB; unsigned* off = LB + 8 * NR; unsigned* cur = LB + 16 * NR;
    for (int i = lane; i < 24 * NR; i += 64) LB[i] = 0u;
#pragma unroll
    for (int k = 0; k < 16; ++k) atomicAdd(&cnt[ti * NR + (ev[k] >> RSH)], 1u);
    {
#pragma unroll
        for (int rb = 0; rb < NR; rb += 8) {
            unsigned s = 0u;
#pragma unroll
            for (int r = 0; r < NR; ++r) { const unsigned c = cnt[ti * NR + r]; if (r < head + rb) s += c; }
            if (head + rb < NR) off[ti * NR + head + rb] = s;
        }
    }
#pragma unroll
    for (int k = 0; k < 16; ++k) {
        const int r = ev[k] >> RSH;
        const unsigned pos = off[ti * NR + r] + atomicAdd(&cur[ti * NR + r], 1u);
        Ee[ti * 128 + pos] = ev[k]; Eg[ti * 128 + pos] = gv[k]; Es[ti * 128 + pos] = su[k];
    }
}

DI float gelu_fast(float v) {
    const float av = fabsf(v), t = __builtin_amdgcn_rcpf(av * 0.2316418882f + 1.0f);
    float q = t * 0.5307027145f + (-0.7265760135f); q = q * t + 0.7107068705f; q = q * t + (-0.142248368f); q = q * t + 0.127414796f; q = q * t;
    const float e = __builtin_amdgcn_exp2f((v * v) * (-0.72134752044f));
    const float m = v * (q * e);
    return v < 0.f ? m : v - m;
}
template <bool DRY> DI void p6x_ids(unsigned (&en)[8], const unsigned* Ee, unsigned desc) {
    const int ebase = desc & 0x3ff, n = (desc >> 10) & 0xf;
#pragma unroll
    for (int j = 0; j < 8; ++j) en[j] = (__builtin_amdgcn_readfirstlane(Ee[ebase + (j < n ? j : 0)]) & (DRY ? 1023u : 0xffffu)) * (unsigned)D;
}
typedef __amdgpu_buffer_rsrc_t rsrc_t;
DI u32x4 rowload(rsrc_t r, int voff, unsigned soff) { return __builtin_amdgcn_raw_buffer_load_b128(r, voff, (int)soff, 0); }
DI void p6x_issue(u32x4 (&buf)[8], rsrc_t T8, const unsigned (&en)[8], int voff) {
#pragma unroll
    for (int j = 0; j < 8; ++j) buf[j] = rowload(T8, voff, en[j]);
}
template <int CTRL> DI float dppf(float v) { return __uint_as_float(__builtin_amdgcn_mov_dpp(__float_as_uint(v), CTRL, 0xf, 0xf, true)); }
DI float pair32(float x, float y) { auto r = __builtin_amdgcn_permlane32_swap(__float_as_uint(x), __float_as_uint(y), false, false); return __uint_as_float(r[0]) + __uint_as_float(r[1]); }
DI float pair16(float x, float y) { auto r = __builtin_amdgcn_permlane16_swap(__float_as_uint(x), __float_as_uint(y), false, false); return __uint_as_float(r[0]) + __uint_as_float(r[1]); }
DI float p6x_dots(u32x4 (&uu)[8], rsrc_t U8, const unsigned (&en)[8], bool refill, u32x4 (&hw)[2], const bf16* hnext, const float* Eg, const float* Es, unsigned desc,
                  int lane, int jl, bool b5, bool b4, bool b3) {
    const int ebase = desc & 0x3ff, n = (desc >> 10) & 0xf;
    float a[8];
    {
        f32x2v hf[8];
#pragma unroll
        for (int i = 0; i < 8; ++i) { const unsigned hwi = (i < 4) ? hw[0][i & 3] : hw[1][i & 3]; hf[i] = (f32x2v){bflo(hwi), bfhi(hwi)}; }
#pragma unroll
        for (int j = 0; j < 8; ++j) {
            f32x2v acc0 = __builtin_amdgcn_cvt_pk_f32_fp8(uu[j].x, false) * hf[0];
            f32x2v acc1 = __builtin_amdgcn_cvt_pk_f32_fp8(uu[j].x, true) * hf[1];
            acc0 = __builtin_amdgcn_cvt_pk_f32_fp8(uu[j].y, false) * hf[2] + acc0;
            acc1 = __builtin_amdgcn_cvt_pk_f32_fp8(uu[j].y, true) * hf[3] + acc1;
            acc0 = __builtin_amdgcn_cvt_pk_f32_fp8(uu[j].z, false) * hf[4] + acc0;
            acc1 = __builtin_amdgcn_cvt_pk_f32_fp8(uu[j].z, true) * hf[5] + acc1;
            acc0 = __builtin_amdgcn_cvt_pk_f32_fp8(uu[j].w, false) * hf[6] + acc0;
            acc1 = __builtin_amdgcn_cvt_pk_f32_fp8(uu[j].w, true) * hf[7] + acc1;
            acc0 += acc1;
            a[j] = acc0.x + acc0.y;
        }
    }
    __builtin_amdgcn_sched_barrier(0);
    hw[0] = *(const u32x4*)hnext; hw[1] = *(const u32x4*)(hnext + 8);
#pragma unroll
    for (int j = 0; j < 8; ++j) uu[j] = rowload(U8, lane * 16, en[j]);
    __builtin_amdgcn_sched_barrier(0);
    float k1[4], k2[2], k3;
#pragma unroll
    for (int i = 0; i < 4; ++i) k1[i] = pair32(a[i], a[4 + i]);
#pragma unroll
    for (int i = 0; i < 2; ++i) k2[i] = pair16(k1[i], k1[2 + i]);
    { const float snd = b3 ? k2[0] : k2[1]; k3 = (b3 ? k2[1] : k2[0]) + dppf<0x128>(snd); }
    k3 += dppf<0x141>(k3);
    k3 += dppf<0xB1>(k3);
    k3 += dppf<0x4E>(k3);
    const int ei = ebase + (jl < n ? jl : 0);
    return (jl < n) ? Eg[ei] * gelu_fast(k3 * Es[ei]) : 0.f;
}
DI void p6x_axpy(u32x4 (&vv)[8], rsrc_t V8, const unsigned (&en)[8], bool refill, float w, f32x2v (&y2)[8], int lane) {
#pragma unroll
    for (int j = 0; j < 8; ++j) {
        const int src = 32 * (j >> 2) + 16 * ((j >> 1) & 1) + 8 * (j & 1);
        const float wj = __uint_as_float(__builtin_amdgcn_readlane(__float_as_uint(w), src));
        const f32x2v wj2 = {wj, wj};
        const unsigned wd[4] = {vv[j].x, vv[j].y, vv[j].z, vv[j].w};
#pragma unroll
        for (int q = 0; q < 4; ++q) { y2[2 * q] = __builtin_amdgcn_cvt_pk_f32_fp8(wd[q], false) * wj2 + y2[2 * q]; y2[2 * q + 1] = __builtin_amdgcn_cvt_pk_f32_fp8(wd[q], true) * wj2 + y2[2 * q + 1]; }
    }
    __builtin_amdgcn_sched_barrier(0);
#pragma unroll
    for (int j = 0; j < 8; ++j) vv[j] = rowload(V8, lane * 16, en[j]);
    __builtin_amdgcn_sched_barrier(0);
}
#define P6X_AXPY(T) p6x_axpy(V, V8, en, more, w_, y2[T], lane)

template <bool DRY> DI void p6x_block(const Params& p, int l, int tok_first, int ntok, const float* X1, float* xout, char* lds) {
    int tid_ = threadIdx.x; asm volatile("" : "+v"(tid_)); const int tid = tid_, lane = tid & 63;
    const int wv = __builtin_amdgcn_readfirstlane(tid >> 6);
    unsigned* LA = (unsigned*)(lds + wv * 16384); unsigned* LB = LA + 1024; unsigned* Ee = LA + 2048; float* Eg = (float*)(LA + 3072); float* Es = (float*)LA;
    const unsigned* cnt = LB; const unsigned* off = LB + 8 * NR; unsigned* dl = LB + 24 * NR;
    const rsrc_t U8 = __builtin_amdgcn_make_buffer_rsrc((void*)p.U8, 0, 16384 * D, 0x00020000), V8 = __builtin_amdgcn_make_buffer_rsrc((void*)p.V8, 0, 16384 * D, 0x00020000);
    const int jl = 4 * (lane >> 5) + 2 * ((lane >> 4) & 1) + ((lane >> 3) & 1);
    const bool b5 = lane & 32, b4 = lane & 16, b3 = lane & 8;
    const int per_wave = ntok >> 2;
    __syncthreads();
#pragma unroll 1
    for (int g8 = 0; g8 < per_wave; g8 += 8) {
        const int tokb = tok_first + wv * per_wave + g8;
        { int lc = lane; asm volatile("" : "+v"(lc)); p6x_combine(p, l, tokb, LA, LB, Ee, Eg, Es, lc); }
#pragma unroll 1
        for (int sw = 0; sw < 2; ++sw) {
            int nd;
            {
                int lane_d = lane; asm volatile("" : "+v"(lane_d));
                const bool rev = ((g8 >> 3) * 2 + sw) & 1;
                const int rr = (lane_d >> 2) & (NR - 1), t = lane_d & 3, r = rev ? (NR - 1 - rr) : rr, ti = sw * 4 + t;
                const int n = (lane_d < 4 * NR) ? (int)cnt[ti * NR + r] : 0, base = (int)off[ti * NR + r];
                const int nbat = (n + 7) >> 3;
                int incl = nbat;
#pragma unroll
                for (int o = 1; o < 64; o <<= 1) { const int up = __shfl_up(incl, o); if (lane_d >= o) incl += up; }
                const int start = incl - nbat;
                for (int k = 0; k < nbat; ++k) { const int rem = n - 8 * k; dl[start + k] = ((unsigned)t << 14) | ((unsigned)(rem < 8 ? rem : 8) << 10) | (unsigned)(ti * 128 + base + 8 * k); }
                nd = __builtin_amdgcn_readlane(incl, 63);
            }
            f32x2v y2[4][8];
#pragma unroll
            for (int t = 0; t < 4; ++t)
#pragma unroll
                for (int i = 0; i < 8; ++i) y2[t][i] = (f32x2v){0.f, 0.f};
            const bf16* hbase = p.H + (size_t)(tokb + sw * 4) * D + lane * 16;
            u32x4 U[8], V[8]; unsigned en[8];
            unsigned dA = __builtin_amdgcn_readfirstlane(dl[0]);
            u32x4 hw[2];
            if (nd > 0) { p6x_ids<DRY>(en, Ee, dA); p6x_issue(U, U8, en, lane * 16); p6x_issue(V, V8, en, lane * 16); const bf16* hr = hbase + (size_t)(dA >> 14) * D; hw[0] = *(const u32x4*)hr; hw[1] = *(const u32x4*)(hr + 8); }
#pragma unroll 1
            for (int i = 0; i < nd; ++i) {
                const bool more = i + 1 < nd;
                const unsigned dB = __builtin_amdgcn_readfirstlane(dl[more ? i + 1 : i]);
                p6x_ids<DRY>(en, Ee, dB);
                const int t_ = (int)(dA >> 14);
                const float w_ = p6x_dots(U, U8, en, more, hw, hbase + (size_t)(dB >> 14) * D, Eg, Es, dA, lane, jl, b5, b4, b3);
                switch (t_) { case 0: P6X_AXPY(0); break; case 1: P6X_AXPY(1); break; case 2: P6X_AXPY(2); break; default: P6X_AXPY(3); break; }
                dA = dB;
            }
#pragma unroll
            for (int t = 0; t < 4; ++t) {
                int lane_e = lane; asm volatile("" : "+v"(lane_e));
                const int tok = tokb + sw * 4 + t;
                const int b = (p.tok0 + tok) / SEQ;
                const float* mod = p.MOD + ((size_t)l * BATCH + b) * 6 * D;
                float v[16], gt[16];
                load16c(v, X1 + (size_t)tok * D, lane_e); load16c(gt, mod + 5 * D, lane_e);
#pragma unroll
                for (int i = 0; i < 8; ++i) { v[2 * i] = DN_ALPHA * v[2 * i] + (1.f + gt[2 * i]) * y2[t][i].x; v[2 * i + 1] = DN_ALPHA * v[2 * i + 1] + (1.f + gt[2 * i + 1]) * y2[t][i].y; }
                ln16c(v, p.in[23] + l * D, p.in[24] + l * D, lane_e);
                if (DRY) {
#pragma unroll
                    for (int i = 0; i < 16; ++i) asm volatile("" :: "v"(v[i]));
                    continue; }
                store16c(xout + (size_t)tok * D, v, lane_e);
                if (l + 1 < DEPTH) { const float* modn = p.MOD + ((size_t)(l + 1) * BATCH + b) * 6 * D; store_mod16c(p.H + (size_t)tok * D, v, modn, modn + D, lane_e); }
                __builtin_amdgcn_sched_barrier(0);
            }
        }
    }
}
#ifdef P6_NOPTAIL
#define P6_TAILNOP "\n\ts_nop 7\n\ts_nop 7\n\ts_nop 7\n\ts_nop 7\n\ts_nop 7\n\ts_nop 7\n\ts_nop 7\n\ts_nop 7"
#else
#define P6_TAILNOP
#endif
#ifdef P6C_SAFE
#define P6C_W10 "s_waitcnt vmcnt(0)"
#else
#define P6C_W10 "s_waitcnt vmcnt(10)"
#endif

DI u32x4 p6a_rsrc(const unsigned char* base) {
    const unsigned long long a = (unsigned long long)base;
    u32x4 r; r.x = __builtin_amdgcn_readfirstlane((unsigned)a); r.y = __builtin_amdgcn_readfirstlane((unsigned)(a >> 32) & 0xffffu); r.z = 16384u * (unsigned)D; r.w = 0x00020000u;
    return r;
}
#ifndef P6_DRYMODE
#define P6_DRYMODE 0
#endif
#ifndef P6_FULLBATCH
#define P6_FULLBATCH 0
#endif
#ifndef P6_LDMOD
#define P6_LDMOD ""
#endif
#ifndef P6_SWEEPSYNC
#define P6_SWEEPSYNC 0
#endif
#ifndef P6_DRYMASK
#define P6_DRYMASK 0
#endif
template <bool DRY> DI void p6a_ids(unsigned (&en)[8], const unsigned* Ee, unsigned desc, int lane) {
    const int ebase = desc & 0x3ff, n = (desc >> 10) & 0xf, j = lane & 7;
    const unsigned ev = (Ee[ebase + (j < n ? j : 0)] & ((DRY && (P6_DRYMODE == 1 || P6_DRYMASK)) ? 1023u : 0xffffu)) * (unsigned)D;
#pragma unroll
    for (int k = 0; k < 8; ++k) en[k] = __builtin_amdgcn_readlane(ev, k);
}
DI void p6a_load8(u32x4 (&b)[8], u32x4 rsrc, int voff, const unsigned (&so)[8]) {
    asm volatile("s_nop 4\n\t"
        "buffer_load_dwordx4 %0, %8, %9, %10 offen" P6_LDMOD "\n\t" "buffer_load_dwordx4 %1, %8, %9, %11 offen" P6_LDMOD "\n\t" "buffer_load_dwordx4 %2, %8, %9, %12 offen" P6_LDMOD "\n\t" "buffer_load_dwordx4 %3, %8, %9, %13 offen" P6_LDMOD "\n\t"
        "buffer_load_dwordx4 %4, %8, %9, %14 offen" P6_LDMOD "\n\t" "buffer_load_dwordx4 %5, %8, %9, %15 offen" P6_LDMOD "\n\t" "buffer_load_dwordx4 %6, %8, %9, %16 offen" P6_LDMOD "\n\t" "buffer_load_dwordx4 %7, %8, %9, %17 offen" P6_LDMOD P6_TAILNOP
        : "=&v"(b[0]), "=&v"(b[1]), "=&v"(b[2]), "=&v"(b[3]), "=&v"(b[4]), "=&v"(b[5]), "=&v"(b[6]), "=&v"(b[7])
        : "v"(voff), "s"(rsrc), "s"(so[0]), "s"(so[1]), "s"(so[2]), "s"(so[3]), "s"(so[4]), "s"(so[5]), "s"(so[6]), "s"(so[7])
        : "memory");
}
DI void p6a_loadh(u32x4 (&h)[2], const bf16* src) {
    asm volatile("global_load_dwordx4 %0, %2, off\n\tglobal_load_dwordx4 %1, %2, off offset:16" : "=&v"(h[0]), "=&v"(h[1]) : "v"(src) : "memory");
}
DI void p6a_wait_hu(u32x4 (&h)[2], u32x4 (&b)[8]) {
    asm volatile("s_waitcnt vmcnt(8)" : "+v"(h[0]), "+v"(h[1]), "+v"(b[0]), "+v"(b[1]), "+v"(b[2]), "+v"(b[3]), "+v"(b[4]), "+v"(b[5]), "+v"(b[6]), "+v"(b[7]) :: "memory");
}
DI void p6a_wait_v(u32x4 (&b)[8]) {
    asm volatile(P6C_W10  : "+v"(b[0]), "+v"(b[1]), "+v"(b[2]), "+v"(b[3]), "+v"(b[4]), "+v"(b[5]), "+v"(b[6]), "+v"(b[7]) :: "memory");
}
DI void p6a_drain(u32x4 (&h)[2], u32x4 (&u)[8], u32x4 (&v)[8]) {
    asm volatile("s_waitcnt vmcnt(0)" : "+v"(h[0]), "+v"(h[1]), "+v"(u[0]), "+v"(u[1]), "+v"(u[2]), "+v"(u[3]), "+v"(u[4]), "+v"(u[5]), "+v"(u[6]), "+v"(u[7]),
                                        "+v"(v[0]), "+v"(v[1]), "+v"(v[2]), "+v"(v[3]), "+v"(v[4]), "+v"(v[5]), "+v"(v[6]), "+v"(v[7]) :: "memory");
}
DI void p6a_dot8(float (&a)[8], const u32x4 (&uu)[8], const u32x4 (&hw)[2]) {
    f32x2v hf[8];
#pragma unroll
    for (int i = 0; i < 8; ++i) { const unsigned hwi = (i < 4) ? hw[0][i & 3] : hw[1][i & 3]; hf[i] = (f32x2v){bflo(hwi), bfhi(hwi)}; }
#pragma unroll
    for (int j = 0; j < 8; ++j) {
        f32x2v acc0 = __builtin_amdgcn_cvt_pk_f32_fp8(uu[j].x, false) * hf[0];
        f32x2v acc1 = __builtin_amdgcn_cvt_pk_f32_fp8(uu[j].x, true) * hf[1];
        acc0 = __builtin_amdgcn_cvt_pk_f32_fp8(uu[j].y, false) * hf[2] + acc0;
        acc1 = __builtin_amdgcn_cvt_pk_f32_fp8(uu[j].y, true) * hf[3] + acc1;
        acc0 = __builtin_amdgcn_cvt_pk_f32_fp8(uu[j].z, false) * hf[4] + acc0;
        acc1 = __builtin_amdgcn_cvt_pk_f32_fp8(uu[j].z, true) * hf[5] + acc1;
        acc0 = __builtin_amdgcn_cvt_pk_f32_fp8(uu[j].w, false) * hf[6] + acc0;
        acc1 = __builtin_amdgcn_cvt_pk_f32_fp8(uu[j].w, true) * hf[7] + acc1;
        acc0 += acc1;
        a[j] = acc0.x + acc0.y;
    }
}
DI float p6a_reduce_gate(const float (&a)[8], const float* Eg, const float* Es, unsigned desc, int jl, bool b3) {
    const int ebase = desc & 0x3ff, n = (desc >> 10) & 0xf;
    float k1[4], k2[2], k3;
#pragma unroll
    for (int i = 0; i < 4; ++i) k1[i] = pair32(a[i], a[4 + i]);
#pragma unroll
    for (int i = 0; i < 2; ++i) k2[i] = pair16(k1[i], k1[2 + i]);
    { const float snd = b3 ? k2[0] : k2[1]; k3 = (b3 ? k2[1] : k2[0]) + dppf<0x128>(snd); }
    k3 += dppf<0x141>(k3); k3 += dppf<0xB1>(k3); k3 += dppf<0x4E>(k3);
    const int ei = ebase + (jl < n ? jl : 0);
    return (jl < n) ? Eg[ei] * gelu_fast(k3 * Es[ei]) : 0.f;
}
DI void p6a_axpy8(const u32x4 (&vv)[8], float w, f32x2v (&y2)[8]) {
#pragma unroll
    for (int j = 0; j < 8; ++j) {
        const int src = 32 * (j >> 2) + 16 * ((j >> 1) & 1) + 8 * (j & 1);
        const float wj = __uint_as_float(__builtin_amdgcn_readlane(__float_as_uint(w), src));
        const f32x2v wj2 = {wj, wj};
        const unsigned wd[4] = {vv[j].x, vv[j].y, vv[j].z, vv[j].w};
#pragma unroll
        for (int q = 0; q < 4; ++q) { y2[2 * q] = __builtin_amdgcn_cvt_pk_f32_fp8(wd[q], false) * wj2 + y2[2 * q]; y2[2 * q + 1] = __builtin_amdgcn_cvt_pk_f32_fp8(wd[q], true) * wj2 + y2[2 * q + 1]; }
    }
}
template <bool DRY> DI void p6a_block(const Params& p, int l, int tok_first, int ntok, const float* X1, float* xout, char* lds) {
    int tid_ = threadIdx.x; asm volatile("" : "+v"(tid_)); const int tid = tid_, lane = tid & 63;
    const int wv = __builtin_amdgcn_readfirstlane(tid >> 6);
    unsigned* LA = (unsigned*)(lds + wv * 16384); unsigned* LB = LA + 1024; unsigned* Ee = LA + 2048; float* Eg = (float*)(LA + 3072); float* Es = (float*)LA;
    const unsigned* cnt = LB; const unsigned* off = LB + 8 * NR; unsigned* dl = LB + 24 * NR;
    const u32x4 rU = p6a_rsrc(p.U8), rV = p6a_rsrc(p.V8);
    const int jl = 4 * (lane >> 5) + 2 * ((lane >> 4) & 1) + ((lane >> 3) & 1);
    const bool b5 = lane & 32, b4 = lane & 16, b3 = lane & 8;
    const int per_wave = ntok >> 2;
    __syncthreads();
#pragma unroll 1
    for (int g8 = 0; g8 < per_wave; g8 += 8) {
        const int tokb = tok_first + wv * per_wave + g8;
        { int lc = lane; asm volatile("" : "+v"(lc)); p6x_combine(p, l, tokb, LA, LB, Ee, Eg, Es, lc); }
#pragma unroll 1
        for (int sw = 0; sw < 2; ++sw) {
            int nd;
#if P6_FULLBATCH
            {
                int lane_d = lane; asm volatile("" : "+v"(lane_d));
                const bool rev = ((g8 >> 3) * 2 + sw) & 1;
                const int kk = lane_d >> 2, t = lane_d & 3, k = rev ? (15 - kk) : kk, ti = sw * 4 + t;
                dl[lane_d] = ((unsigned)t << 14) | (8u << 10) | (unsigned)(ti * 128 + 8 * k);
                nd = 64; asm volatile("" : "+s"(nd));
            }
#else
            {
                int lane_d = lane; asm volatile("" : "+v"(lane_d));
                const bool rev = ((g8 >> 3) * 2 + sw) & 1;
                const int rr = (lane_d >> 2) & (NR - 1), t = lane_d & 3, r = rev ? (NR - 1 - rr) : rr, ti = sw * 4 + t;
                const int n = (lane_d < 4 * NR) ? (int)cnt[ti * NR + r] : 0, base = (int)off[ti * NR + r];
                const int nbat = (n + 7) >> 3;
                int incl = nbat;
#pragma unroll
                for (int o = 1; o < 64; o <<= 1) { const int up = __shfl_up(incl, o); if (lane_d >= o) incl += up; }
                const int start = incl - nbat;
                for (int k = 0; k < nbat; ++k) { const int rem = n - 8 * k; dl[start + k] = ((unsigned)t << 14) | ((unsigned)(rem < 8 ? rem : 8) << 10) | (unsigned)(ti * 128 + base + 8 * k); }
                nd = __builtin_amdgcn_readlane(incl, 63);
            }
#endif
#if P6_SWEEPSYNC
            { XcdBarrier xb_; xb_.bar = p.ctr + 4096; xb_.x = xb_xcc_id(); xb_.st = (volatile LAS unsigned*)(lds + LDS_TOTAL - 32); xcd_barrier(xb_); }
#endif
            f32x2v y2[4][8];
#pragma unroll
            for (int t = 0; t < 4; ++t)
#pragma unroll
                for (int i = 0; i < 8; ++i) y2[t][i] = (f32x2v){0.f, 0.f};
            const bf16* hbase = p.H + (size_t)(tokb + sw * 4) * D + lane * 16;
            u32x4 U[8], V[8], hw[2]; unsigned en[8];
            asm volatile("s_waitcnt vmcnt(0)" ::: "memory");
            unsigned dA = __builtin_amdgcn_readfirstlane(dl[0]);
            { p6a_ids<DRY>(en, Ee, dA, lane); p6a_loadh(hw, hbase + (size_t)(dA >> 14) * D); p6a_load8(U, rU, lane * 16, en); p6a_load8(V, rV, lane * 16, en); }
#pragma unroll 1
            for (int i = 0; i < nd; ++i) {
                const unsigned dB = __builtin_amdgcn_readfirstlane(dl[i + 1 < nd ? i + 1 : i]);
                p6a_ids<DRY>(en, Ee, dB, lane);
                const int t_ = (int)(dA >> 14);
                if (DRY && P6_DRYMODE == 4) p6a_drain(hw, U, V); else if (!(DRY && P6_DRYMODE == 2)) p6a_wait_hu(hw, U);
                float a[8];
                if (DRY && (P6_DRYMODE == 3 || P6_DRYMODE == 4)) {
#pragma unroll
                    for (int j = 0; j < 8; ++j) a[j] = __uint_as_float(U[j].x); }
                else p6a_dot8(a, U, hw);
                __builtin_amdgcn_sched_barrier(0);
                if (!(DRY && P6_DRYMODE == 2)) { p6a_loadh(hw, hbase + (size_t)(dB >> 14) * D); p6a_load8(U, rU, lane * 16, en); }
                __builtin_amdgcn_sched_barrier(0);
                const float w_ = p6a_reduce_gate(a, Eg, Es, dA, jl, b3);
                if (!(DRY && (P6_DRYMODE == 2 || P6_DRYMODE == 4))) p6a_wait_v(V);
                if (DRY && (P6_DRYMODE == 3 || P6_DRYMODE == 4)) { y2[0][0].x += w_ * __uint_as_float(V[0].x ^ V[1].x ^ V[2].x ^ V[3].x ^ V[4].x ^ V[5].x ^ V[6].x ^ V[7].x); } else
                switch (t_) { case 0: p6a_axpy8(V, w_, y2[0]); break; case 1: p6a_axpy8(V, w_, y2[1]); break; case 2: p6a_axpy8(V, w_, y2[2]); break; default: p6a_axpy8(V, w_, y2[3]); break; }
                __builtin_amdgcn_sched_barrier(0);
                if (!(DRY && (P6_DRYMODE == 2 || P6_DRYMODE == 4))) p6a_load8(V, rV, lane * 16, en);
                __builtin_amdgcn_sched_barrier(0);
                dA = dB;
            }
            p6a_drain(hw, U, V);
#pragma unroll
            for (int t = 0; t < 4; ++t) {
                int lane_e = lane; asm volatile("" : "+v"(lane_e));
                const int tok = tokb + sw * 4 + t;
                const int b = (p.tok0 + tok) / SEQ;
                const float* mod = p.MOD + ((size_t)l * BATCH + b) * 6 * D;
                float v[16], gt[16];
                load16c(v, X1 + (size_t)tok * D, lane_e); load16c(gt, mod + 5 * D, lane_e);
                {
                    const float mean1 = p.STATS[2 * (size_t)tok], rstd1 = p.STATS[2 * (size_t)tok + 1];
                    float g1[16], b1[16]; load16c(g1, p.in[17] + l * D, lane_e); load16c(b1, p.in[18] + l * D, lane_e);
#pragma unroll
                    for (int i = 0; i < 16; ++i) v[i] = (v[i] - mean1) * rstd1 * g1[i] + b1[i];
                }
#pragma unroll
                for (int i = 0; i < 8; ++i) { v[2 * i] = DN_ALPHA * v[2 * i] + (1.f + gt[2 * i]) * y2[t][i].x; v[2 * i + 1] = DN_ALPHA * v[2 * i + 1] + (1.f + gt[2 * i + 1]) * y2[t][i].y; }
                ln16c(v, p.in[23] + l * D, p.in[24] + l * D, lane_e);
                if (DRY) {
#pragma unroll
                    for (int i = 0; i < 16; ++i) asm volatile("" :: "v"(v[i]));
                    continue; }
                store16c(xout + (size_t)tok * D, v, lane_e);
                if (l + 1 < DEPTH) { const float* modn = p.MOD + ((size_t)(l + 1) * BATCH + b) * 6 * D; store_mod16c(p.H + (size_t)tok * D, v, modn, modn + D, lane_e); }
                __builtin_amdgcn_sched_barrier(0);
            }
        }
    }
}
#define XB_TMO      128
#define XB_XCNT(j)  (256  + 64 * (j))
#define XB_XSUB(j)  (1280 + 64 * (j))
#define XB_XGEN(j)  (2304 + 64 * (j))
#define XB_TOP      3328
#define XB_TOPGEN   3392
#define XCD_BAR_WORDS 3456
#define XB_SPIN_CAP (1u << 22)
#define LAS __attribute__((address_space(3)))
DI unsigned xb_ld(unsigned* p)              { return __hip_atomic_load(p, __ATOMIC_RELAXED, __HIP_MEMORY_SCOPE_AGENT); }
DI unsigned xb_add(unsigned* p, unsigned v) { return __hip_atomic_fetch_add(p, v, __ATOMIC_RELAXED, __HIP_MEMORY_SCOPE_AGENT); }
DI unsigned xb_xcc_id() { return (unsigned)__builtin_amdgcn_s_getreg((3 << 11) | 20) & 0xFu; }
#define XB_SPIN(cond, bar) do { unsigned _sp = 0; while (cond) { __builtin_amdgcn_s_sleep(1); \
    if ((++_sp & 255u) == 0u) { if (xb_ld(&(bar)[XB_TMO])) break; if (_sp > XB_SPIN_CAP) { atomicAdd(&(bar)[XB_TMO], 1u); break; } } } } while (0)
struct XcdBarrier { unsigned* bar; unsigned x; volatile LAS unsigned* st; };
DI XcdBarrier xcd_barrier_post(unsigned* bar, volatile LAS unsigned* st) {
    XcdBarrier b; b.bar = bar; b.x = xb_xcc_id(); b.st = st;
    if (threadIdx.x == 0) st[2] = xb_add(&bar[XB_XCNT(b.x)], 1u);
    return b;
}
DI void xcd_barrier_complete(unsigned* bar, unsigned x, unsigned& nloc, unsigned& nx) {
    const unsigned G = gridDim.x * gridDim.y * gridDim.z;
    unsigned sum, cnt, mine, sp = 0u;
    for (;;) {
        sum = 0u; cnt = 0u; mine = 0u;
#pragma unroll
        for (unsigned j = 0; j < 16; ++j) { const unsigned c = xb_ld(&bar[XB_XCNT(j)]); sum += c; cnt += (c > 0u) ? 1u : 0u; mine = (j == x) ? c : mine; }
        if (sum == G) break;
        __builtin_amdgcn_s_sleep(1);
        if ((++sp & 255u) == 0u) { if (xb_ld(&bar[XB_TMO])) break; if (sp > XB_SPIN_CAP) { atomicAdd(&bar[XB_TMO], 1u); break; } }
    }
    nloc = mine > 0u ? mine : 1u; nx = cnt > 0u ? cnt : 1u;
}
DI void xcd_barrier(const XcdBarrier& b) {
    asm volatile("s_waitcnt vmcnt(0)" ::: "memory");
    __syncthreads();
    if (threadIdx.x == 0) {
        unsigned* bar = b.bar;
        __builtin_amdgcn_s_waitcnt(0);
        unsigned nloc = b.st[0], nx = b.st[1];
        if (nloc == 0u) { xcd_barrier_complete(bar, b.x, nloc, nx); b.st[0] = nloc; b.st[1] = nx; }
        const unsigned old = xb_add(&bar[XB_XSUB(b.x)], 1u);
        const unsigned gen = old / nloc;
        if (old + 1u == (gen + 1u) * nloc) {
            __builtin_amdgcn_fence(__ATOMIC_RELEASE, "agent");
            asm volatile("s_waitcnt vmcnt(0)" ::: "memory");
            const unsigned og = xb_add(&bar[XB_TOP], 1u);
            const unsigned tg = og / nx;
            if (og + 1u == (tg + 1u) * nx) xb_add(&bar[XB_TOPGEN], 1u);
            else XB_SPIN(xb_ld(&bar[XB_TOPGEN]) == tg, bar);
            __builtin_amdgcn_fence(__ATOMIC_ACQUIRE, "agent");
            xb_add(&bar[XB_XGEN(b.x)], 1u);
            asm volatile("s_waitcnt vmcnt(0)" ::: "memory");
        } else {
            XB_SPIN(xb_ld(&bar[XB_XGEN(b.x)]) == gen, bar);
            __builtin_amdgcn_fence(__ATOMIC_ACQUIRE, "agent");
            asm volatile("s_waitcnt vmcnt(0)" ::: "memory");
        }
    }
    __syncthreads();
}
DI void ada_item(const Params& p, int item, char* lds) {
    int tid_ = threadIdx.x; asm volatile("" : "+v"(tid_)); const int tid = tid_, lane = tid & 63, wv = tid >> 6;
    float* cs = (float*)lds;
    float* part = cs + 4 * D;
    __syncthreads();
    for (int i = tid; i < BATCH * D; i += 256) { const float cv = p.in[1][i]; cs[i] = cv / (1.f + __expf(-cv)); }
    __syncthreads();
    const int col = item * 64 + lane, l = col / (6 * D), j = col % (6 * D);
    const float* w = p.in[2] + (size_t)l * D * 6 * D + j;
    float a0 = 0.f, a1 = 0.f, a2 = 0.f, a3 = 0.f;
#pragma unroll 16
    for (int k = wv * 256; k < wv * 256 + 256; ++k) { const float wk = w[(size_t)k * 6 * D]; a0 += cs[k] * wk; a1 += cs[D + k] * wk; a2 += cs[2 * D + k] * wk; a3 += cs[3 * D + k] * wk; }
    part[(wv * 4 + 0) * 64 + lane] = a0; part[(wv * 4 + 1) * 64 + lane] = a1; part[(wv * 4 + 2) * 64 + lane] = a2; part[(wv * 4 + 3) * 64 + lane] = a3;
    __syncthreads();
    {
        const float s = part[(0 * 4 + wv) * 64 + lane] + part[(1 * 4 + wv) * 64 + lane] + part[(2 * 4 + wv) * 64 + lane] + part[(3 * 4 + wv) * 64 + lane];
        p.MOD[((size_t)l * BATCH + wv) * 6 * D + j] = s + p.in[3][l * 6 * D + j];
    }
}

DI void rope_table_item(const Params& p, int idx) {
    const int pos = idx >> 4, i = idx & 15;
    const float inv = 1.0f / powf(10000.0f, (float)(2 * i) / 32.0f);
    const float ang = (float)pos * inv;
    double fr = (double)ang * 0.15915494309189535;
    fr -= rint(fr);
    const float f = (float)fr;
    p.COS[idx] = __builtin_amdgcn_cosf(f); p.SIN[idx] = __builtin_amdgcn_sinf(f);
}

DI void convert_tables(const Params& p, int l, int bid, int nb) {
    const float* us = p.in[21] + (size_t)l * 16384 * D; const float* vs = p.in[22] + (size_t)l * 16384 * D;
    const size_t n8 = (size_t)16384 * D / 8;
    for (size_t i = (size_t)bid * 256 + threadIdx.x; i < n8; i += (size_t)nb * 256) { cvt8(us, p.Ut, i); cvt8(vs, p.Vt, i); }
}

DI void prologue(const Params& p, char* lds) {
    int tid_ = threadIdx.x; asm volatile("" : "+v"(tid_)); const int tid = tid_, lane = tid & 63, wv = tid >> 6, bid = blockIdx.x, nb = gridDim.x;
    for (int it = bid; it < DEPTH * 6 * D / 64; it += nb) ada_item(p, it, lds);
    __syncthreads();
    float* scr = (float*)(lds + wv * 16384);
    const int n_win = (D / 64) * (WIN_N / 32), n_uq = 4 * 24, n_ukv = 2 * 32, n_wo = 16 * 32, n_pq = 16 * 64, per_l = n_win + n_uq + n_ukv + n_wo + n_pq;
    for (int it = bid * 4 + wv; it < DEPTH * per_l; it += nb * 4) {
        const int l = it / per_l; int r = it % per_l;
        if (r < n_win) { transpose_item(TK_WIN, p.in[4] + (size_t)l * D * D_IN, D_IN, D, WIN_N, p.WinT + (size_t)l * WIN_N * D, nullptr, scr, r, lane); continue; } r -= n_win;
        if (r < n_uq) { transpose_item(TK_WUQ, p.in[6] + (size_t)l * 256 * 768, 768, 256, 768, p.WuqT + (size_t)l * 768 * 256, p.in[5] + l * 256, scr, r, lane); continue; } r -= n_uq;
        if (r < n_ukv) { transpose_item(TK_WUKV, p.in[8] + (size_t)l * 128 * 1024, 1024, 128, 1024, p.WukvT + (size_t)l * 1024 * 128, p.in[7] + l * 128, scr, r, lane); continue; } r -= n_ukv;
        if (r < n_wo) { transpose_item(TK_WO, p.in[16] + (size_t)l * D * D, D, D, D, p.WoT + (size_t)l * D * D, nullptr, scr, r, lane); continue; } r -= n_wo;
        transpose_item(TK_WPQ, p.in[19] + (size_t)l * D * 2048, 2048, D, 2048, p.WpqT + (size_t)l * 2048 * D, nullptr, scr, r, lane);
    }
    for (int it = bid; it < DEPTH * 1028; it += nb) fold_pw_item(p, it / 1028, it % 1028);
    for (size_t i = (size_t)bid * 256 + tid; i < (size_t)DEPTH * 16 * 128 * 128; i += (size_t)nb * 256)
        p.SKp[i] = f2bf(p.in[20][(i & ~(size_t)127) + perm16((int)(i & 127))]);
    for (int i = bid * 256 + tid; i < SEQ * 16; i += nb * 256) rope_table_item(p, i);
    convert_tables_fp8(p, 0, bid, nb);
}

DI void modh_items(const Params& p, int bid, int nb) {
    const size_t n8 = (size_t)p.rows * D / 8;
    for (size_t i = (size_t)bid * 256 + threadIdx.x; i < n8; i += (size_t)nb * 256) {
        const size_t e = i * 8; const int row = (int)(e >> 10), col = (int)(e & 1023), b = row / SEQ;
        const float* mod = p.MOD + (size_t)b * 6 * D;
        const float4 x0 = *(const float4*)(p.in[0] + e), x1 = *(const float4*)(p.in[0] + e + 4);
        const float4 h0 = *(const float4*)(mod + col), h1 = *(const float4*)(mod + col + 4), s0 = *(const float4*)(mod + D + col), s1 = *(const float4*)(mod + D + col + 4);
        u32x4 o;
        o.x = pk2(x0.x * (1.f + s0.x) + h0.x, x0.y * (1.f + s0.y) + h0.y); o.y = pk2(x0.z * (1.f + s0.z) + h0.z, x0.w * (1.f + s0.w) + h0.w);
        o.z = pk2(x1.x * (1.f + s1.x) + h1.x, x1.y * (1.f + s1.y) + h1.y); o.w = pk2(x1.z * (1.f + s1.z) + h1.z, x1.w * (1.f + s1.w) + h1.w);
        *(u32x4*)(p.H + e) = o;
    }
}

#ifndef MLA_UNIT
#define MLA_UNIT mla_unit2
#endif
#ifndef P6_BLOCK
#define P6_BLOCK p6a_block
#endif
#ifndef REP_P1
#define REP_P1 1
#endif
#ifndef REP_P2
#define REP_P2 1
#endif
#ifndef REP_P3
#define REP_P3 1
#endif
#ifndef REP_P4
#define REP_P4 1
#endif
#ifndef REP_P5
#define REP_P5 1
#endif
#ifndef REP_SYNC
#define REP_SYNC 1
#endif
typedef const __attribute__((address_space(4))) Params* kparams_t;
#define LOADP(q) const Params& q = p
#define GSYNC() do { for (int rs_ = 0; rs_ < REP_SYNC; ++rs_) { XcdBarrier xb_; xb_.bar = p.ctr + 4096; xb_.x = xb_xcc_id(); xb_.st = (volatile LAS unsigned*)(lds + LDS_TOTAL - 32); xcd_barrier(xb_); } } while (0)
__global__ void __launch_bounds__(256, 2) mega(Params p) {
    extern __shared__ __attribute__((aligned(16))) char lds[];
    cg::grid_group grid = cg::this_grid();
#define bid ((int)blockIdx.x)
#define nb ((int)gridDim.x)
#define rows NTOK
#define mtiles (NTOK / 128)
    {
        if (threadIdx.x < 4) ((volatile LAS unsigned*)(lds + LDS_TOTAL - 32))[threadIdx.x] = 0u;
        __syncthreads();
    }
    (void)xcd_barrier_post(p.ctr + 4096, (volatile LAS unsigned*)(lds + LDS_TOTAL - 32));
#ifndef REP_PRO
#define REP_PRO 1
#endif
    for (int rep = 0; rep < REP_PRO; ++rep) prologue(p, lds);
    grid.sync();
    {
        volatile LAS unsigned* cw = (volatile LAS unsigned*)(lds + LDS_TOTAL - 32);
        if (threadIdx.x == 0) {
            unsigned pre = 0u, even = 1u; const unsigned myx = xb_xcc_id(); unsigned* bar_ = p.ctr + 4096;
            for (unsigned j = 0; j < 16; ++j) { const unsigned c = xb_ld(&bar_[XB_XCNT(j)]); if (j < myx) pre += c; if (j < 8 ? c * 8u != (unsigned)nb : c != 0u) even = 0u; }
            cw[3] = pre + cw[2]; cw[5] = even;
        }
        __syncthreads();
    }
#define SLOT ((int)((volatile LAS unsigned*)(lds + LDS_TOTAL - 32))[3])
#define XEVEN ((int)((volatile LAS unsigned*)(lds + LDS_TOTAL - 32))[5])
#define FOR_TILES(NT, T) for (int u_ = XEVEN ? (SLOT % (nb / 8)) : bid, T = 0; u_ < (XEVEN ? (mtiles / 8) * (NT) : mtiles * (NT)) && ((T = XEVEN ? ((SLOT / (nb / 8)) * (mtiles / 8) + u_ / (NT)) * (NT) + u_ % (NT) : u_), true); u_ += XEVEN ? nb / 8 : nb)
#ifndef REP_MODH
#define REP_MODH 1
#endif
    for (int rep = 0; rep < REP_MODH; ++rep) modh_items(p, bid, nb);
    GSYNC();
    for (int l = 0; l < DEPTH; ++l) {
        { LOADP(q);
#ifdef G3_PROBE
        for (int rep = 0; rep < REP_P1; ++rep) { __syncthreads(); if (threadIdx.x == 0) *(volatile int*)(lds + LDS_TOTAL - 64) = (rep + 1 < REP_P1) ? G3_PROBE : 0; __syncthreads(); FOR_TILES(12, t) p1_tile(q, l, t, lds); }
#else
        for (int rep = 0; rep < REP_P1; ++rep) FOR_TILES(12, t) p1_tile(q, l, t, lds);
#endif
#ifndef REP_CVT
#define REP_CVT 1
#endif
        if (l > 0) for (int rep = 0; rep < REP_CVT; ++rep) convert_tables_fp8(q, l, bid, nb);
        }
        GSYNC();
        { LOADP(q);
        for (int rep = 0; rep < REP_P2; ++rep) { FOR_TILES(6, t) p2q_tile(q, l, t, lds); FOR_TILES(8, t2) p2kv_tile(q, l, t2, lds); }
        }
        GSYNC();
        { LOADP(q);
        {
            const int nbt = rows / SEQ, nmla = nbt * 8 * 64, nswa = nbt * 4 * 64, nconv = rows / 32, ntot = nmla + nswa + nconv;
            int* su = (int*)(lds + LDS_TOTAL - 16);
            for (int rep = 0; rep < REP_P3; ++rep) { unsigned* ctr = q.ctr + l * 64 + rep * 16;
            for (;;) {
                __syncthreads();
                if (threadIdx.x == 0) *su = (int)atomicAdd(ctr, 1u);
                __syncthreads();
                const int u = *su;
                if (u >= ntot) break;
#ifdef P3_ABL
                if (u < nmla) { if (rep + 1 < REP_P3) MLA_UNIT<P3_ABL>(q, u, lds); else MLA_UNIT<0>(q, u, lds); }
#else
                if (u < nmla) MLA_UNIT<0>(q, u, lds);
#endif
                else if (u < nmla + nswa) swa_unit(q, l, u - nmla, lds);
                else conv_unit(q, l, u - nmla - nswa, lds);
            } }
        }
        }
        GSYNC();
        { LOADP(q);
        for (int rep = 0; rep < REP_P4; ++rep) FOR_TILES(8, t) p4_tile(q, l, t, (l == 0) ? q.in[0] : q.XB, q.out, lds);
        }
        GSYNC();
        { LOADP(q);
        { int t_ = threadIdx.x; asm volatile("" : "+v"(t_)); const int wv = t_ >> 6, lane = t_ & 63; for (int r = bid * 4 + wv; r < rows; r += nb * 4) p4b_row(q, l, r, q.out, lane); }
        }
        GSYNC();
        { LOADP(q);
#ifdef G3_PROBE
        for (int rep = 0; rep < REP_P5; ++rep) { __syncthreads(); if (threadIdx.x == 0) *(volatile int*)(lds + LDS_TOTAL - 64) = (rep + 1 < REP_P5) ? G3_PROBE : 0; __syncthreads(); FOR_TILES(16, t) p5_tile(q, l, t, lds); }
#else
        for (int rep = 0; rep < REP_P5; ++rep) FOR_TILES(16, t) p5_tile(q, l, t, lds);
#endif
        }
        GSYNC();
        { LOADP(q);
        {
            const int slot = SLOT, per = rows / nb;
            if (per * nb == rows && (per & 31) == 0) {
#ifdef REP_P6
                for (int rep = 1; rep < REP_P6; ++rep) P6_BLOCK<true>(q, l, slot * per, per, q.out, (l + 1 < DEPTH) ? q.XB : q.out, lds);
#endif
                P6_BLOCK<false>(q, l, slot * per, per, q.out, (l + 1 < DEPTH) ? q.XB : q.out, lds); }
            else for (int u = bid; u < rows / 32; u += nb) p6f_unit(q, l, u, q.out, (l + 1 < DEPTH) ? q.XB : q.out, lds);
        }
        }
        if (l + 1 < DEPTH) GSYNC();
    }
}

#undef bid
#undef nb
#undef rows
#undef mtiles
extern "C" void kernel_launch(void* const* d_in, const int* in_sizes, int n_in, void* d_out, int out_size, void* d_ws, size_t ws_size, hipStream_t stream) {
    const size_t MiB = 1u << 20;
    char* ws = (char*)d_ws;
    Params P{};
    for (int i = 0; i < 25; ++i) P.in[i] = (const float*)d_in[i];
    P.out = (float*)d_out; P.rows = NTOK; P.tok0 = 0;
    size_t o = 0;
    auto take = [&](size_t mib) { char* r = ws + o; o += mib * MiB; return r; };
    char* ctl = take(1);
    P.ctr = (unsigned*)ctl; P.biasO = (float*)(ctl + 64 * 1024); P.MOD = (float*)(ctl + 128 * 1024);
    P.COS = (float*)take(1); P.SIN = P.COS + SEQ * 16;
    P.WinT = (bf16*)take(6); P.WuqT = (bf16*)take(1); P.WukvT = (bf16*)take(1); P.WoT = (bf16*)take(4); P.WpqT = (bf16*)take(8); P.SKp = (bf16*)take(1);
    P.U8 = (unsigned char*)take(16); P.V8 = (unsigned char*)take(16); P.US = (float*)take(1); P.VS = P.US + DEPTH * 16384;
    P.H = (bf16*)take(64); P.MIXIN = P.H;
    P.PROJ = (bf16*)take(80); P.Q = (bf16*)take(48); P.TOPK = (unsigned*)P.Q;
    P.KN = (bf16*)take(32); P.KR = (bf16*)take(2); P.VT = (bf16*)take(32); P.VsT = (bf16*)take(8);
    P.XB = (float*)take(128); P.STATS = (float*)take(1);
    if (o > ws_size) { fprintf(stderr, "kernel_launch: workspace too small: need %zu, have %zu\n", o, ws_size); return; }
    static int grid_blocks = 0;
    if (!grid_blocks) {
        int dev = 0, cus = 0, per_cu = 0;
        (void)hipGetDevice(&dev);
        (void)hipDeviceGetAttribute(&cus, hipDeviceAttributeMultiprocessorCount, dev);
        (void)hipFuncSetAttribute((const void*)mega, hipFuncAttributeMaxDynamicSharedMemorySize, LDS_TOTAL);
        (void)hipOccupancyMaxActiveBlocksPerMultiprocessor(&per_cu, mega, 256, LDS_TOTAL);
        if (per_cu > 2) per_cu = 2;
        if (per_cu < 1) per_cu = 1;
        grid_blocks = cus * per_cu;
    }
    (void)hipMemsetAsync(ctl, 0, 32768, stream);
    void* args[] = {(void*)&P};
    hipError_t e = hipLaunchCooperativeKernel((void*)mega, dim3(grid_blocks), dim3(256), args, LDS_TOTAL, stream);
    if (e != hipSuccess) fprintf(stderr, "cooperative launch failed: %s (grid %d)\n", hipGetErrorString(e), grid_blocks);
}
```

```cpp
#include <hip/hip_runtime.h>
#include <hip/hip_cooperative_groups.h>
#include <cstdio>
#include <cstdint>
namespace cg = cooperative_groups;

constexpr int D = 1024, BATCH = 4, SEQ = 8192, DEPTH = 2, NTOK = BATCH * SEQ;
constexpr int D_IN = 1440;
constexpr int OFF_CQ = 0, OFF_CKV = 256, OFF_KR = 384, OFF_CONV = 416, OFF_QS = 928, OFF_KS = 1184, OFF_VS = 1312;
constexpr float EPS = 1e-6f;
constexpr float DN_ALPHA = 1.41421356237309515f;

typedef __attribute__((ext_vector_type(8))) short bf16x8;
typedef __attribute__((ext_vector_type(16))) float f32x16;
typedef __attribute__((ext_vector_type(4))) unsigned u32x4;
typedef __attribute__((ext_vector_type(2))) unsigned u32x2;
typedef float f32x2_t __attribute__((ext_vector_type(2)));
typedef __bf16 bf16x2_t __attribute__((ext_vector_type(2)));
typedef unsigned short bf16;
#define DI __device__ __forceinline__
#define MFMA32(a, b, c) __builtin_amdgcn_mfma_f32_32x32x16_bf16((a), (b), (c), 0, 0, 0)

DI unsigned pk2(float lo, float hi) { f32x2_t v = {lo, hi}; bf16x2_t b = __builtin_convertvector(v, bf16x2_t); return __builtin_bit_cast(unsigned, b); }
DI bf16 f2bf(float f) { return (bf16)(pk2(f, 0.f) & 0xffffu); }
DI float bf2f(bf16 b) { return __uint_as_float((unsigned)b << 16); }
typedef float f32x2v __attribute__((ext_vector_type(2)));
DI float bflo(unsigned u) { return __uint_as_float(u << 16); }
DI float bfhi(unsigned u) { return __uint_as_float(u & 0xffff0000u); }
DI int crow(int reg, int hh) { return (reg & 3) + 8 * (reg >> 2) + 4 * hh; }
DI int cperm_lin(int rho) { return 16 * ((rho >> 2) & 1) + (rho & 3) + 4 * (rho >> 3); }
DI int cperm_rope(int rho) { int hh = (rho >> 2) & 1, reg = (rho & 3) + 4 * (rho >> 3); return (reg < 8) ? 8 * hh + reg : 16 + 8 * hh + (reg - 8); }
DI int perm16(int p) { int g = (p >> 2) & 3; g = (g == 1) ? 2 : (g == 2) ? 1 : g; return (p & ~15) | (g << 2) | (p & 3); }

constexpr float LOG2E = 1.4426950408889634f;
constexpr int PROJ_LD = 1280;
constexpr int WIN_N = 1536;
constexpr int TS = 144;
constexpr int TILE_B = 128 * TS;
constexpr int STAGE_B = 2 * TILE_B;
constexpr int LDS_BYTES = 2 * STAGE_B;

struct Params {
    const float* in[25];
    float* out;
    bf16 *WinT, *WuqT, *WukvT, *WoT, *WpqT, *SKp, *Ut, *Vt;
    float* biasO;
    float* MOD;
    float* COS; float* SIN;
    bf16 *H, *PROJ, *Q, *KN, *KR, *VT, *VsT, *MIXIN;
    float* XB;
    unsigned* TOPK;
    float* STATS;
    unsigned char *U8, *V8; float *US, *VS;
    unsigned* ctr;
    int rows;
    int tok0;
};

enum { TK_WIN = 0, TK_WUQ = 1, TK_WUKV = 2, TK_WO = 3, TK_WPQ = 4 };
DI void transpose_item(int kind, const float* W, int ldin, int K, int Nout, bf16* WT, const float* rowscale, float* scr, int item, int lane) {
    const int nblk = Nout / 32, kb = item / nblk, nb = item % nblk, k0 = 64 * kb, n0 = 32 * nb;
    int src0 = n0; float cs = 1.f;
    if (kind == TK_WIN) {
        if (n0 < 384) src0 = n0;
        else if (n0 < 896) src0 = 416 + (n0 - 384);
        else if (n0 < 1152) { src0 = 928 + (n0 - 896); cs = 0.125f * LOG2E; }
        else if (n0 < 1280) src0 = 1184 + (n0 - 1152);
        else if (n0 < 1408) src0 = 1312 + (n0 - 1280);
        else if (n0 < 1440) src0 = 384 + (n0 - 1408);
        else src0 = -1;
    } else if (kind == TK_WUQ) cs = 0.10206207261596577f * LOG2E;
#pragma unroll
    for (int i = 0; i < 32; ++i) {
        const int kk = 2 * i + (lane >> 5);
        float v = (src0 >= 0) ? W[(size_t)(k0 + kk) * ldin + src0 + (lane & 31)] : 0.f;
        if (rowscale) v *= rowscale[k0 + kk];
        scr[kk * 33 + (lane & 31)] = v * cs;
    }
    __builtin_amdgcn_s_waitcnt(0xc07f); asm volatile("" ::: "memory");
    const int c = lane & 7;
#pragma unroll
    for (int j = 0; j < 4; ++j) {
        const int n = (lane >> 3) + 8 * j; const float* s = scr + (8 * c) * 33 + n;
        u32x4 o; o.x = pk2(s[0], s[33]); o.y = pk2(s[66], s[99]); o.z = pk2(s[132], s[165]); o.w = pk2(s[198], s[231]);
        if (!(kind == TK_WO && k0 + 8 * c >= 512 && k0 + 8 * c < 768))
            *(u32x4*)(WT + (size_t)(n0 + n) * K + k0 + 8 * c) = o;
    }
    __builtin_amdgcn_s_waitcnt(0xc07f); asm volatile("" ::: "memory");
}

DI void cvt8(const float* src, bf16* dst, size_t i8) {
    const float4 a = ((const float4*)src)[2 * i8], b = ((const float4*)src)[2 * i8 + 1];
    u32x4 o; o.x = pk2(a.x, a.y); o.y = pk2(a.z, a.w); o.z = pk2(b.x, b.y); o.w = pk2(b.z, b.w);
    ((u32x4*)dst)[i8] = o;
}

struct TileRegs { u32x4 v[4]; };
DI void gload_tile(TileRegs& t, const bf16* base, int ld, int k0, int tid) {
#pragma unroll
    for (int i = 0; i < 4; ++i) { const int q = tid + 256 * i, row = q >> 3, kc = q & 7; t.v[i] = *(const u32x4*)(base + (size_t)row * ld + k0 + kc * 8); }
}
DI void sstore_tile(const TileRegs& t, char* lds, int tid) {
#pragma unroll
    for (int i = 0; i < 4; ++i) { const int q = tid + 256 * i, row = q >> 3, kc = q & 7; *(u32x4*)(lds + row * TS + kc * 16) = t.v[i]; }
}
template <int NF, int NG>
DI void gemm_core2(const bf16* A, int lda, const bf16* W, int ldw, int K, char* lds, f32x16 (&acc)[NF][NG], int fo, const int (&frow)[NF], int go, const int (&grow)[NG]) {
    int tid_ = threadIdx.x; asm volatile("" : "+v"(tid_)); const int tid = tid_, hh = (tid & 63) >> 5;
    const int nk = K / 64;
    TileRegs ta0, tw0, ta1, tw1;
    gload_tile(ta0, A, lda, 0, tid); gload_tile(tw0, W, ldw, 0, tid);
    gload_tile(ta1, A, lda, 64, tid); gload_tile(tw1, W, ldw, 64, tid);
    __syncthreads();
    sstore_tile(ta0, lds, tid); sstore_tile(tw0, lds + TILE_B, tid);
    if (2 < nk) { gload_tile(ta0, A, lda, 128, tid); gload_tile(tw0, W, ldw, 128, tid); }
    __syncthreads();
#define GEMM_STEP(KS, TA, TW, TAN, TWN) do { \
        char* cur = lds + ((KS) & 1) * STAGE_B; \
        _Pragma("unroll") for (int kk = 0; kk < 4; ++kk) { \
            bf16x8 f[NF], g[NG]; \
            _Pragma("unroll") for (int x = 0; x < NF; ++x) f[x] = *(const bf16x8*)(cur + fo + frow[x] * TS + kk * 32 + hh * 16); \
            _Pragma("unroll") for (int y = 0; y < NG; ++y) g[y] = *(const bf16x8*)(cur + go + grow[y] * TS + kk * 32 + hh * 16); \
            _Pragma("unroll") for (int x = 0; x < NF; ++x) _Pragma("unroll") for (int y = 0; y < NG; ++y) acc[x][y] = MFMA32(f[x], g[y], acc[x][y]); } \
        if ((KS) + 1 < nk) { char* nxt = lds + (((KS) + 1) & 1) * STAGE_B; sstore_tile(TAN, nxt, tid); sstore_tile(TWN, nxt + TILE_B, tid); \
            if ((KS) + 3 < nk) { gload_tile(TAN, A, lda, ((KS) + 3) * 64, tid); gload_tile(TWN, W, ldw, ((KS) + 3) * 64, tid); } } \
        __syncthreads(); } while (0)
    for (int ks = 0; ks < nk; ks += 2) { GEMM_STEP(ks, ta0, tw0, ta1, tw1); GEMM_STEP(ks + 1, ta1, tw1, ta0, tw0); }
#undef GEMM_STEP
}

template <int NF, int NG>
DI void gemm_core(const bf16* A, int lda, const bf16* W, int ldw, int K, char* lds, f32x16 (&acc)[NF][NG], int fo, const int (&frow)[NF], int go, const int (&grow)[NG]) {
    int tid_ = threadIdx.x; asm volatile("" : "+v"(tid_)); const int tid = tid_, hh = (tid & 63) >> 5;
    TileRegs ta, tw;
    gload_tile(ta, A, lda, 0, tid); gload_tile(tw, W, ldw, 0, tid);
    __syncthreads();
    sstore_tile(ta, lds, tid); sstore_tile(tw, lds + TILE_B, tid);
    __syncthreads();
    const int nk = K / 64;
    for (int ks = 0; ks < nk; ++ks) {
        char* cur = lds + (ks & 1) * STAGE_B;
        if (ks + 1 < nk) { gload_tile(ta, A, lda, (ks + 1) * 64, tid); gload_tile(tw, W, ldw, (ks + 1) * 64, tid); }
#pragma unroll
        for (int kk = 0; kk < 4; ++kk) {
            bf16x8 f[NF], g[NG];
#pragma unroll
            for (int x = 0; x < NF; ++x) f[x] = *(const bf16x8*)(cur + fo + frow[x] * TS + kk * 32 + hh * 16);
#pragma unroll
            for (int y = 0; y < NG; ++y) g[y] = *(const bf16x8*)(cur + go + grow[y] * TS + kk * 32 + hh * 16);
#pragma unroll
            for (int x = 0; x < NF; ++x)
#pragma unroll
                for (int y = 0; y < NG; ++y) acc[x][y] = MFMA32(f[x], g[y], acc[x][y]);
        }
        if (ks + 1 < nk) { char* nxt = lds + ((ks + 1) & 1) * STAGE_B; sstore_tile(ta, nxt, tid); sstore_tile(tw, nxt + TILE_B, tid); }
        __syncthreads();
    }
}

#define LAS3 __attribute__((address_space(3)))
constexpr int GT = 128 * 128;
DI void glds_tile(const bf16* base, int ld, int k0, char* tile, int wv, int lane) {
#pragma unroll
    for (int i = 0; i < 4; ++i) {
        const int row0 = 32 * wv + 8 * i, rr = lane >> 3;
        const bf16* src = base + (size_t)(row0 + rr) * ld + k0 + (((lane & 7) ^ (((row0 + rr) >> 1) & 7)) << 3);
        __builtin_amdgcn_global_load_lds((const void*)src, (LAS3 void*)(tile + row0 * 128), 16, 0, 0);
    }
}
template <int NF, int NG>
DI void gemm_core3(const bf16* A, int lda, const bf16* W, int ldw, int K, char* lds, f32x16 (&acc)[NF][NG], int fo, const int (&frow)[NF], int go, const int (&grow)[NG]) {
    int tid_ = threadIdx.x; asm volatile("" : "+v"(tid_)); const int tid = tid_, lane = tid & 63, hh = lane >> 5;
    const int wv = __builtin_amdgcn_readfirstlane(tid >> 6);
    const int nk = K / 64;
    const int fof = fo ? GT : 0, gof = go ? GT : 0;
    int foff[NF], goff[NG], fsw[NF], gsw[NG];
#pragma unroll
    for (int x = 0; x < NF; ++x) { foff[x] = fof + frow[x] * 128; fsw[x] = (frow[x] >> 1) & 7; }
#pragma unroll
    for (int y = 0; y < NG; ++y) { goff[y] = gof + grow[y] * 128; gsw[y] = (grow[y] >> 1) & 7; }
    __syncthreads();
#ifdef G3_PROBE
    const int dry = __builtin_amdgcn_readfirstlane(*(volatile int*)(lds + LDS_BYTES + 1024 - 64));
#else
    const int dry = 0;
#endif
    glds_tile(A, lda, 0, lds, wv, lane); glds_tile(W, ldw, 0, lds + GT, wv, lane);
    __syncthreads();
    for (int ks = 0; ks < nk; ++ks) {
        char* cur = lds + (ks & 1) * (2 * GT);
        if (ks + 1 < nk && !(dry & 1)) { char* nxt = lds + ((ks + 1) & 1) * (2 * GT); glds_tile(A, lda, (ks + 1) * 64, nxt, wv, lane); glds_tile(W, ldw, (ks + 1) * 64, nxt + GT, wv, lane); }
#pragma unroll
        for (int kk = 0; kk < 4; ++kk) {
            bf16x8 f[NF], g[NG];
#pragma unroll
            for (int x = 0; x < NF; ++x) f[x] = *(const bf16x8*)(cur + foff[x] + ((((kk << 1) | hh) ^ fsw[x]) << 4));
#pragma unroll
            for (int y = 0; y < NG; ++y) g[y] = *(const bf16x8*)(cur + goff[y] + ((((kk << 1) | hh) ^ gsw[y]) << 4));
            if (dry & 2) {
#pragma unroll
                for (int x = 0; x < NF; ++x) asm volatile("" :: "v"(f[x]));
#pragma unroll
                for (int y = 0; y < NG; ++y) asm volatile("" :: "v"(g[y]));
            } else {
#pragma unroll
            for (int x = 0; x < NF; ++x)
#pragma unroll
                for (int y = 0; y < NG; ++y) acc[x][y] = MFMA32(f[x], g[y], acc[x][y]);
            }
        }
        __syncthreads();
    }
}


template <int NF, int NG>
DI void gemm_core5(const bf16* A, int lda, const bf16* W, int ldw, int K, char* lds, f32x16 (&acc)[NF][NG], int fo, const int (&frow)[NF], int go, const int (&grow)[NG]) {
    int tid_ = threadIdx.x; asm volatile("" : "+v"(tid_)); const int tid = tid_, lane = tid & 63, hh = lane >> 5;
    const int wv = __builtin_amdgcn_readfirstlane(tid >> 6);
    const int nk = K / 64;
    const int fof = fo ? GT : 0, gof = go ? GT : 0;
    int foff[NF], goff[NG], fsw[NF], gsw[NG];
#pragma unroll
    for (int x = 0; x < NF; ++x) { foff[x] = fof + frow[x] * 128; fsw[x] = (frow[x] >> 1) & 7; }
#pragma unroll
    for (int y = 0; y < NG; ++y) { goff[y] = gof + grow[y] * 128; gsw[y] = (grow[y] >> 1) & 7; }
    __syncthreads();
#ifdef G3_PROBE
    const int dry = __builtin_amdgcn_readfirstlane(*(volatile int*)(lds + LDS_BYTES + 1024 - 64));
#else
    const int dry = 0;
#endif
    glds_tile(A, lda, 0, lds, wv, lane); glds_tile(W, ldw, 0, lds + GT, wv, lane);
    __syncthreads();
    for (int ks = 0; ks < nk; ++ks) {
        char* cur = lds + (ks & 1) * (2 * GT);
        if (ks + 1 < nk && !(dry & 1)) { char* nxt = lds + ((ks + 1) & 1) * (2 * GT); glds_tile(A, lda, (ks + 1) * 64, nxt, wv, lane); glds_tile(W, ldw, (ks + 1) * 64, nxt + GT, wv, lane); }
        bf16x8 f[4][NF], g[4][NG];
#pragma unroll
        for (int kk = 0; kk < 4; ++kk) {
#pragma unroll
            for (int x = 0; x < NF; ++x) f[kk][x] = *(const bf16x8*)(cur + foff[x] + ((((kk << 1) | hh) ^ fsw[x]) << 4));
#pragma unroll
            for (int y = 0; y < NG; ++y) g[kk][y] = *(const bf16x8*)(cur + goff[y] + ((((kk << 1) | hh) ^ gsw[y]) << 4));
        }
        __builtin_amdgcn_sched_barrier(0);
#pragma unroll
        for (int kk = 0; kk < 4; ++kk)
#pragma unroll
            for (int x = 0; x < NF; ++x)
#pragma unroll
                for (int y = 0; y < NG; ++y) acc[x][y] = MFMA32(f[kk][x], g[kk][y], acc[x][y]);
        __builtin_amdgcn_sched_barrier(0);
        __syncthreads();
    }
}


DI u32x4 g4_rsrc(const void* base, unsigned bytes) {
    const unsigned long long a = (unsigned long long)base;
    u32x4 r; r.x = __builtin_amdgcn_readfirstlane((unsigned)a); r.y = __builtin_amdgcn_readfirstlane((unsigned)(a >> 32) & 0xffffu); r.z = bytes; r.w = 0x00020000u;
    return r;
}
DI void g4_dma(unsigned m0v, int voff, u32x4 rsrc, unsigned soff) {
    asm volatile("s_nop 4\n\ts_mov_b32 m0, %0\n\ts_nop 0\n\tbuffer_load_dwordx4 %1, %2, %3 offen lds" :: "s"(m0v), "v"(voff), "s"(rsrc), "s"(soff) : "m0", "memory");
}
template <int NF, int NG>
DI void gemm_core4(const bf16* A, int lda, const bf16* W, int ldw, int K, char* lds, f32x16 (&acc)[NF][NG], int fo, const int (&frow)[NF], int go, const int (&grow)[NG]) {
    int tid_ = threadIdx.x; asm volatile("" : "+v"(tid_)); const int tid = tid_, lane = tid & 63, hh = lane >> 5;
    const int wv = __builtin_amdgcn_readfirstlane(tid >> 6);
    const int nk = K / 32;
    const int fof = fo ? 8192 : 0, gof = go ? 8192 : 0;
    int foff[NF], goff[NG], fsw[NF], gsw[NG];
#pragma unroll
    for (int x = 0; x < NF; ++x) { foff[x] = fof + frow[x] * 64; fsw[x] = (frow[x] >> 2) & 3; }
#pragma unroll
    for (int y = 0; y < NG; ++y) { goff[y] = gof + grow[y] * 64; gsw[y] = (grow[y] >> 2) & 3; }
    const u32x4 rA = g4_rsrc(A, 128u * (unsigned)lda * 2u), rW = g4_rsrc(W, 128u * (unsigned)ldw * 2u);
    const int lsw = ((lane & 3) ^ ((lane >> 4) & 3)) << 4;
    const int voA = (lane >> 2) * lda * 2 + lsw, voW = (lane >> 2) * ldw * 2 + lsw;
    const unsigned ldsb = (unsigned)(size_t)(LAS3 char*)lds;
    const unsigned mb = __builtin_amdgcn_readfirstlane(ldsb + 2048u * wv);
    const unsigned sA0 = (unsigned)(32 * wv * lda) * 2u, sA1 = sA0 + (unsigned)(16 * lda) * 2u, sW0 = (unsigned)(32 * wv * ldw) * 2u, sW1 = sW0 + (unsigned)(16 * ldw) * 2u;
    auto issue = [&](int ks) {
        const unsigned so = (unsigned)(ks & 3) * 16384u, kb = (unsigned)ks * 64u;
        g4_dma(mb + so, voA, rA, sA0 + kb); g4_dma(mb + so + 1024u, voA, rA, sA1 + kb);
        g4_dma(mb + so + 8192u, voW, rW, sW0 + kb); g4_dma(mb + so + 9216u, voW, rW, sW1 + kb);
    };
    __syncthreads();
    issue(0); if (nk > 1) issue(1); if (nk > 2) issue(2);
    for (int ks = 0; ks < nk; ++ks) {
        if (ks + 2 < nk) asm volatile("s_waitcnt vmcnt(8)" ::: "memory"); else if (ks + 1 < nk) asm volatile("s_waitcnt vmcnt(4)" ::: "memory"); else asm volatile("s_waitcnt vmcnt(0)" ::: "memory");
        __syncthreads();
        if (ks + 3 < nk) issue(ks + 3);
        const char* cur = lds + (ks & 3) * 16384;
#pragma unroll
        for (int kk = 0; kk < 2; ++kk) {
            bf16x8 f[NF], g[NG];
#pragma unroll
            for (int x = 0; x < NF; ++x) f[x] = *(const bf16x8*)(cur + foff[x] + ((((kk << 1) | hh) ^ fsw[x]) << 4));
#pragma unroll
            for (int y = 0; y < NG; ++y) g[y] = *(const bf16x8*)(cur + goff[y] + ((((kk << 1) | hh) ^ gsw[y]) << 4));
#pragma unroll
            for (int x = 0; x < NF; ++x)
#pragma unroll
                for (int y = 0; y < NG; ++y) acc[x][y] = MFMA32(f[x], g[y], acc[x][y]);
        }
    }
    __syncthreads();
}

#ifndef GEMM_CORE
#define GEMM_CORE gemm_core3
#endif
template <int NF, int NG> DI void zero_acc(f32x16 (&acc)[NF][NG]) {
#pragma unroll
    for (int x = 0; x < NF; ++x)
#pragma unroll
        for (int y = 0; y < NG; ++y)
#pragma unroll
            for (int r = 0; r < 16; ++r) acc[x][y][r] = 0.f;
}

DI void store16(bf16* dst, const float* v) {
    u32x4 a, b;
    a.x = pk2(v[0], v[1]); a.y = pk2(v[2], v[3]); a.z = pk2(v[4], v[5]); a.w = pk2(v[6], v[7]);
    b.x = pk2(v[8], v[9]); b.y = pk2(v[10], v[11]); b.z = pk2(v[12], v[13]); b.w = pk2(v[14], v[15]);
    *(u32x4*)dst = a; *(u32x4*)(dst + 8) = b;
}
DI void store8(bf16* dst, const float* v) {
    u32x4 a; a.x = pk2(v[0], v[1]); a.y = pk2(v[2], v[3]); a.z = pk2(v[4], v[5]); a.w = pk2(v[6], v[7]);
    *(u32x4*)dst = a;
}
DI void store_vt(bf16* dst, const f32x16& a, int hh) {
    float v0[8], v1[8];
#pragma unroll
    for (int i = 0; i < 8; ++i) { v0[i] = a[i]; v1[i] = a[8 + i]; }
    store8(dst + 8 * hh, v0); store8(dst + 16 + 8 * hh, v1);
}

DI void p1_tile(const Params& p, int l, int tile, char* lds) {
    int tid_ = threadIdx.x; asm volatile("" : "+v"(tid_)); const int tid = tid_, lane = tid & 63, r = lane & 31, hh = lane >> 5;
    const int wv = __builtin_amdgcn_readfirstlane(tid >> 6), wm = wv >> 1, wn = wv & 1;
    const int mt = tile / 12, nt = tile % 12, m0 = mt * 128, n0 = nt * 128;
    const bf16* A = p.H + (size_t)m0 * D;
    const bf16* W = p.WinT + ((size_t)l * WIN_N + n0) * D;
    f32x16 acc[2][2]; zero_acc(acc);
    int frow[2], grow[2];
    const bool kr = (nt == 11);
    int fo, go;
    if (nt == 10) { fo = 0; go = TILE_B; frow[0] = 64 * wm + r; frow[1] = frow[0] + 32; grow[0] = 64 * wn + r; grow[1] = grow[0] + 32; }
    else { fo = TILE_B; go = 0; frow[0] = 64 * wn + (kr ? cperm_rope(r) : cperm_lin(r)); frow[1] = 64 * wn + 32 + cperm_lin(r); grow[0] = 64 * wm + r; grow[1] = grow[0] + 32; }
    GEMM_CORE<2, 2>(A, D, W, D, D, lds, acc, fo, frow, go, grow);
    if (nt == 10) {
#pragma unroll
        for (int x = 0; x < 2; ++x)
#pragma unroll
            for (int y = 0; y < 2; ++y) {
                const int tok = m0 + 64 * wm + 32 * x, b = tok / SEQ, s0 = tok % SEQ, d = 32 * y + r;
                store_vt(p.VsT + ((size_t)(b * 2 + wn) * 64 + d) * SEQ + s0, acc[x][y], hh);
            }
    } else {
        if (!kr) {
#pragma unroll
            for (int x = 0; x < 2; ++x)
#pragma unroll
                for (int y = 0; y < 2; ++y) {
                    const int tok = m0 + 64 * wm + 32 * y + r, col = n0 + 64 * wn + 32 * x + 16 * hh;
                    float v[16];
#pragma unroll
                    for (int i = 0; i < 16; ++i) v[i] = acc[x][y][i];
                    store16(p.PROJ + (size_t)tok * PROJ_LD + col, v);
                }
        } else if (wn == 0) {
#pragma unroll
            for (int y = 0; y < 2; ++y) {
                const int tok = m0 + 64 * wm + 32 * y + r, pos = tok % SEQ;
                const float4 c0 = *(const float4*)(p.COS + pos * 16 + 8 * hh), c1 = *(const float4*)(p.COS + pos * 16 + 8 * hh + 4);
                const float4 s0 = *(const float4*)(p.SIN + pos * 16 + 8 * hh), s1 = *(const float4*)(p.SIN + pos * 16 + 8 * hh + 4);
                const float cs[8] = {c0.x, c0.y, c0.z, c0.w, c1.x, c1.y, c1.z, c1.w}, sn[8] = {s0.x, s0.y, s0.z, s0.w, s1.x, s1.y, s1.z, s1.w};
                float o1[8], o2[8];
#pragma unroll
                for (int i = 0; i < 8; ++i) { const float t1 = acc[0][y][i], t2 = acc[0][y][8 + i]; o1[i] = t1 * cs[i] - t2 * sn[i]; o2[i] = t1 * sn[i] + t2 * cs[i]; }
                store8(p.KR + (size_t)tok * 32 + 8 * hh, o1); store8(p.KR + (size_t)tok * 32 + 16 + 8 * hh, o2);
            }
        }
    }
}
constexpr int LDS_RS_OFF = LDS_BYTES;
constexpr int LDS_TOTAL = LDS_BYTES + 1024;

template <int W> DI void row_rms(const bf16* A, int lda, float* rs, int tid) {
    const int row = tid >> 1, half = tid & 1;
    const u32x4* p = (const u32x4*)(A + (size_t)row * lda + half * (W / 2));
    float ss = 0.f;
#pragma unroll
    for (int i = 0; i < W / 16; ++i) { const u32x4 v = p[i];
        ss += bflo(v.x) * bflo(v.x) + bfhi(v.x) * bfhi(v.x) + bflo(v.y) * bflo(v.y) + bfhi(v.y) * bfhi(v.y)
            + bflo(v.z) * bflo(v.z) + bfhi(v.z) * bfhi(v.z) + bflo(v.w) * bflo(v.w) + bfhi(v.w) * bfhi(v.w); }
    ss += __shfl_xor(ss, 1);
    if (half == 0) rs[row] = rsqrtf(ss * (1.f / W) + EPS);
}

DI void p2q_tile(const Params& p, int l, int tile, char* lds) {
    int tid_ = threadIdx.x; asm volatile("" : "+v"(tid_)); const int tid = tid_, lane = tid & 63, r = lane & 31, hh = lane >> 5;
    const int wv = __builtin_amdgcn_readfirstlane(tid >> 6), wm = wv >> 1, wn = wv & 1;
    const int mt = tile / 6, nt = tile % 6, m0 = mt * 128, n0 = nt * 128;
    const bf16* A = p.PROJ + (size_t)m0 * PROJ_LD;
    const bf16* W = p.WuqT + ((size_t)l * 768 + n0) * 256;
    float* rs = (float*)(lds + LDS_RS_OFF);
    __syncthreads();
    row_rms<256>(A, PROJ_LD, rs, tid);
    f32x16 acc[2][2]; zero_acc(acc);
    int frow[2], grow[2]; bool rope[2];
#pragma unroll
    for (int x = 0; x < 2; ++x) { rope[x] = (((n0 + 64 * wn + 32 * x) >> 5) % 3) == 2; frow[x] = 64 * wn + 32 * x + (rope[x] ? cperm_rope(r) : cperm_lin(r)); }
    grow[0] = 64 * wm + r; grow[1] = grow[0] + 32;
    GEMM_CORE<2, 2>(A, PROJ_LD, W, 256, 256, lds, acc, TILE_B, frow, 0, grow);
#pragma unroll
    for (int y = 0; y < 2; ++y) {
        const int tl = 64 * wm + 32 * y + r, tok = m0 + tl, pos = tok % SEQ;
        const float sc = rs[tl];
#pragma unroll
        for (int x = 0; x < 2; ++x) {
            bf16* dst = p.Q + (size_t)tok * 768 + n0 + 64 * wn + 32 * x;
            if (rope[x]) {
                const float4 c0 = *(const float4*)(p.COS + pos * 16 + 8 * hh), c1 = *(const float4*)(p.COS + pos * 16 + 8 * hh + 4);
                const float4 s0 = *(const float4*)(p.SIN + pos * 16 + 8 * hh), s1 = *(const float4*)(p.SIN + pos * 16 + 8 * hh + 4);
                const float cs[8] = {c0.x, c0.y, c0.z, c0.w, c1.x, c1.y, c1.z, c1.w}, sn[8] = {s0.x, s0.y, s0.z, s0.w, s1.x, s1.y, s1.z, s1.w};
                float o1[8], o2[8];
#pragma unroll
                for (int i = 0; i < 8; ++i) { const float t1 = acc[x][y][i] * sc, t2 = acc[x][y][8 + i] * sc; o1[i] = t1 * cs[i] - t2 * sn[i]; o2[i] = t1 * sn[i] + t2 * cs[i]; }
                store8(dst + 8 * hh, o1); store8(dst + 16 + 8 * hh, o2);
            } else {
                float v[16];
#pragma unroll
                for (int i = 0; i < 16; ++i) v[i] = acc[x][y][i] * sc;
                store16(dst + 16 * hh, v);
            }
        }
    }
}

DI void p2kv_tile(const Params& p, int l, int tile, char* lds) {
    int tid_ = threadIdx.x; asm volatile("" : "+v"(tid_)); const int tid = tid_, lane = tid & 63, r = lane & 31, hh = lane >> 5;
    const int wv = __builtin_amdgcn_readfirstlane(tid >> 6), wm = wv >> 1, wn = wv & 1;
    const int mt = tile >> 3, h = tile & 7, m0 = mt * 128, n0 = h * 128;
    const bf16* A = p.PROJ + (size_t)m0 * PROJ_LD + 256;
    const bf16* W = p.WukvT + ((size_t)l * 1024 + n0) * 128;
    float* rs = (float*)(lds + LDS_RS_OFF);
    __syncthreads();
    row_rms<128>(A, PROJ_LD, rs, tid);
    f32x16 acc[2][2]; zero_acc(acc);
    int frow[2], grow[2];
    int fo, go;
    if (wn == 0) { fo = TILE_B; go = 0; frow[0] = cperm_lin(r); frow[1] = 32 + cperm_lin(r); grow[0] = 64 * wm + r; grow[1] = grow[0] + 32; }
    else         { fo = 0; go = TILE_B; frow[0] = 64 * wm + r; frow[1] = frow[0] + 32; grow[0] = 64 + r; grow[1] = 96 + r; }
    GEMM_CORE<2, 2>(A, PROJ_LD, W, 128, 128, lds, acc, fo, frow, go, grow);
    if (wn == 0) {
#pragma unroll
        for (int y = 0; y < 2; ++y) {
            const int tl = 64 * wm + 32 * y + r, tok = m0 + tl; const float sc = rs[tl];
#pragma unroll
            for (int x = 0; x < 2; ++x) {
                float v[16];
#pragma unroll
                for (int i = 0; i < 16; ++i) v[i] = acc[x][y][i] * sc;
                store16(p.KN + (size_t)tok * 512 + h * 64 + 32 * x + 16 * hh, v);
            }
        }
    } else {
#pragma unroll
        for (int x = 0; x < 2; ++x) {
            const int tl0 = 64 * wm + 32 * x, tok0 = m0 + tl0, b = tok0 / SEQ, s0 = tok0 % SEQ;
#pragma unroll
            for (int y = 0; y < 2; ++y) {
                f32x16 a = acc[x][y];
#pragma unroll
                for (int i = 0; i < 16; ++i) a[i] *= rs[tl0 + crow(i, hh)];
                store_vt(p.VT + ((size_t)(b * 8 + h) * 64 + 32 * y + r) * SEQ + s0, a, hh);
            }
        }
    }
}
constexpr int VSTR = 144;
template <int KD> struct AttnCfg { static constexpr int KSTR = KD * 2 + 16; static constexpr int BUF = 64 * KSTR + 64 * VSTR; };

template <int KD, int MODE, int ABL = 0>
DI void attn_unit(const bf16* Qp, int qld, const bf16* K1, int k1ld, const bf16* K2, const bf16* VTp, bf16* Op, int b, int qb, float sink_l2, char* lds) {
    constexpr int KSTR = AttnCfg<KD>::KSTR, BUF = AttnCfg<KD>::BUF, NKS = KD / 16;
    int tid_ = threadIdx.x; asm volatile("" : "+v"(tid_)); const int tid = tid_, lane = tid & 63, r = lane & 31, hh = lane >> 5;
    const int wv = __builtin_amdgcn_readfirstlane(tid >> 6);
    const int q0 = qb * 128, qpos = q0 + 32 * wv + r;
    const size_t rowb = (size_t)b * SEQ;
    bf16x8 qf[NKS];
#pragma unroll
    for (int ks = 0; ks < NKS; ++ks) qf[ks] = *(const bf16x8*)(Qp + (rowb + qpos) * qld + ks * 16 + hh * 8);
#pragma unroll
    for (int ks = 0; ks < NKS; ++ks) asm volatile("" : "+v"(qf[ks]));
    const int kstart = (MODE == 0) ? 0 : (q0 >= 128 ? q0 - 128 : 0);
    const int nt = (q0 + 128 - kstart) / 64;
    f32x16 ot[2];
#pragma unroll
    for (int i = 0; i < 16; ++i) { ot[0][i] = 0.f; ot[1][i] = 0.f; }
    float m = (MODE == 0) ? -INFINITY : sink_l2, l = (MODE == 1 && hh == 0) ? 1.f : 0.f;
    u32x4 sk[3], sv[2];
    auto gload = [&](int t) {
        const int key0 = kstart + 64 * t;
#pragma unroll
        for (int i = 0; i < 2; ++i) { const int q = tid + 256 * i, row = q >> 3, c = q & 7;
            sk[i] = *(const u32x4*)(K1 + (rowb + key0 + row) * k1ld + c * 8);
            sv[i] = *(const u32x4*)(VTp + (size_t)row * SEQ + key0 + c * 8); }
        if (KD == 96) { const int row = tid >> 2, c = tid & 3; sk[2] = *(const u32x4*)(K2 + (rowb + key0 + row) * 32 + c * 8); }
    };
    auto sstore = [&](char* buf) {
#pragma unroll
        for (int i = 0; i < 2; ++i) { const int q = tid + 256 * i, row = q >> 3, c = q & 7;
            *(u32x4*)(buf + row * KSTR + c * 16) = sk[i];
            *(u32x4*)(buf + 64 * KSTR + row * VSTR + c * 16) = sv[i]; }
        if (KD == 96) { const int row = tid >> 2, c = tid & 3; *(u32x4*)(buf + row * KSTR + 128 + c * 16) = sk[2]; }
    };
    gload(0);
    __syncthreads();
    sstore(lds);
    __syncthreads();
    for (int t = 0; t < nt; ++t) {
        const char* cur = lds + (t & 1) * BUF;
        if (!(ABL & 8)) if (t + 1 < nt) gload(t + 1);
        const int key0 = kstart + 64 * t;
        f32x16 st[2];
        bf16x8 kf[2][NKS];
#pragma unroll
        for (int mt = 0; mt < 2; ++mt)
#pragma unroll
            for (int ks = 0; ks < NKS; ++ks) kf[mt][ks] = *(const bf16x8*)(cur + (mt * 32 + r) * KSTR + ks * 32 + hh * 16);
        __builtin_amdgcn_sched_barrier(0);
#pragma unroll
        for (int mt = 0; mt < 2; ++mt) {
#pragma unroll
            for (int i = 0; i < 16; ++i) st[mt][i] = 0.f;
#pragma unroll
            for (int ks = 0; ks < NKS; ++ks) { if (ABL & 2) { asm volatile("" :: "v"(kf[mt][ks])); st[mt][ks] += 1.f; } else st[mt] = MFMA32(kf[mt][ks], qf[ks], st[mt]); }
        }
        const char* vt = cur + 64 * KSTR;
        bf16x8 vf[2][4];
#pragma unroll
        for (int mt = 0; mt < 2; ++mt)
#pragma unroll
            for (int s = 0; s < 4; ++s) vf[mt][s] = *(const bf16x8*)(vt + (mt * 32 + r) * VSTR + s * 32 + hh * 16);
        __builtin_amdgcn_sched_barrier(0);
        const bool need_mask = (MODE == 1) || (key0 + 63 > q0 + 32 * wv);
        if (need_mask) {
#pragma unroll
            for (int mt = 0; mt < 2; ++mt)
#pragma unroll
                for (int i = 0; i < 16; ++i) {
                    const int key = key0 + mt * 32 + crow(i, hh);
                    const bool ok = (MODE == 0) ? (key <= qpos) : (key <= qpos && key > qpos - 128);
                    if (!ok) st[mt][i] = -INFINITY;
                }
        }
        float mx = st[0][0];
#pragma unroll
        for (int i = 1; i < 16; ++i) mx = fmaxf(mx, st[0][i]);
#pragma unroll
        for (int i = 0; i < 16; ++i) mx = fmaxf(mx, st[1][i]);
        { auto rr = __builtin_amdgcn_permlane32_swap(__float_as_uint(mx), __float_as_uint(mx), false, false); mx = fmaxf(__uint_as_float(rr[0]), __uint_as_float(rr[1])); }
        const float mn = fmaxf(m, mx);
        const float alpha = __builtin_amdgcn_exp2f(m - mn);
        m = mn;
        float ps = 0.f;
#pragma unroll
        for (int mt = 0; mt < 2; ++mt)
#pragma unroll
            for (int i = 0; i < 16; ++i) { const float pv = (ABL & 1) ? (st[mt][i] - mn) : __builtin_amdgcn_exp2f(st[mt][i] - mn); st[mt][i] = pv; ps += pv; }
        l = l * alpha + ps;
#pragma unroll
        for (int i = 0; i < 16; ++i) { ot[0][i] *= alpha; ot[1][i] *= alpha; }
        bf16x8 pb[4];
#pragma unroll
        for (int s = 0; s < 4; ++s) {
            const int mt = s >> 1, o = 8 * (s & 1);
            u32x4 w; w.x = pk2(st[mt][o], st[mt][o + 1]); w.y = pk2(st[mt][o + 2], st[mt][o + 3]); w.z = pk2(st[mt][o + 4], st[mt][o + 5]); w.w = pk2(st[mt][o + 6], st[mt][o + 7]);
            pb[s] = __builtin_bit_cast(bf16x8, w);
        }
        __builtin_amdgcn_sched_barrier(0);
#pragma unroll
        for (int mt = 0; mt < 2; ++mt)
#pragma unroll
            for (int s = 0; s < 4; ++s) { if (ABL & 4) { asm volatile("" :: "v"(vf[mt][s]), "v"(pb[s])); ot[mt][s] += 1.f; } else ot[mt] = MFMA32(vf[mt][s], pb[s], ot[mt]); }
        if (!(ABL & 8)) if (t + 1 < nt) sstore(lds + ((t + 1) & 1) * BUF);
        __syncthreads();
    }
    { auto rr = __builtin_amdgcn_permlane32_swap(__float_as_uint(l), __float_as_uint(l), false, false); l = __uint_as_float(rr[0]) + __uint_as_float(rr[1]); }
    const float inv = 1.f / l;
    bf16* orow = Op + (rowb + qpos) * 1024;
#pragma unroll
    for (int mt = 0; mt < 2; ++mt)
#pragma unroll
        for (int g = 0; g < 4; ++g) {
            u32x2 w; w.x = pk2(ot[mt][4 * g] * inv, ot[mt][4 * g + 1] * inv); w.y = pk2(ot[mt][4 * g + 2] * inv, ot[mt][4 * g + 3] * inv);
            *(u32x2*)(orow + mt * 32 + 8 * g + 4 * hh) = w;
        }
}

template <int ABL = 0> DI void mla_unit(const Params& p, int u, char* lds) {
    const int nbh = (p.rows / SEQ) * 8, qb = 63 - u / nbh, bh = u % nbh, b = bh >> 3, h = bh & 7;
    attn_unit<96, 0, ABL>(p.Q + h * 96, 768, p.KN + h * 64, 512, p.KR, p.VT + (size_t)bh * 64 * SEQ, p.MIXIN + h * 64, b, qb, 0.f, lds);
}
DI void swa_unit(const Params& p, int l, int u, char* lds) {
    const int qb = u & 63, bh = u >> 6, b = bh >> 2, hq = bh & 3, kvh = hq >> 1;
    attn_unit<64, 1>(p.PROJ + 896 + hq * 64, PROJ_LD, p.PROJ + 1152 + kvh * 64, PROJ_LD, nullptr, p.VsT + (size_t)(b * 2 + kvh) * 64 * SEQ, p.MIXIN + 768 + hq * 64, b, qb,
                     p.in[15][l * 4 + hq] * LOG2E, lds);
}

DI void conv_unit(const Params& p, int l, int u, char* lds) {
    int tid_ = threadIdx.x; asm volatile("" : "+v"(tid_)); const int tid = tid_, lane = tid & 63, wv = tid >> 6;
    const int tok0 = u * 32, pos0 = tok0 % SEQ;
    bf16* glu = (bf16*)lds;
    float* hc = (float*)(lds + 62 * 512);
    __syncthreads();
    for (int it = tid; it < 62 * 32; it += 256) {
        const int row = it >> 5, c8 = (it & 31) * 8, pos = pos0 - 30 + row;
        u32x4 o = {0u, 0u, 0u, 0u};
        if (pos >= 0) {
            const bf16* src = p.PROJ + (size_t)(tok0 - 30 + row) * PROJ_LD + 384 + c8;
            const u32x4 a = *(const u32x4*)src, g = *(const u32x4*)(src + 256);
            const unsigned av[4] = {a.x, a.y, a.z, a.w}, gv[4] = {g.x, g.y, g.z, g.w}; unsigned ov[4];
#pragma unroll
            for (int i = 0; i < 4; ++i) {
                const float g0 = bflo(gv[i]), g1 = bfhi(gv[i]);
                ov[i] = pk2(bflo(av[i]) / (1.f + __expf(-g0)), bfhi(av[i]) / (1.f + __expf(-g1)));
            }
            o.x = ov[0]; o.y = ov[1]; o.z = ov[2]; o.w = ov[3];
        }
        *(u32x4*)(glu + row * 256 + c8) = o;
    }
    __syncthreads();
    {
        const int c = tid;
        float w[31];
        const float* wd = p.in[9] + (size_t)l * 31 * 256 + c;
#pragma unroll
        for (int k = 0; k < 31; ++k) w[k] = wd[k * 256];
        const float bd = p.in[10][l * 256 + c];
#pragma unroll 1
        for (int ch = 0; ch < 4; ++ch) {
            float g[38], acc[8];
#pragma unroll
            for (int i = 0; i < 38; ++i) g[i] = bf2f(glu[(ch * 8 + i) * 256 + c]);
#pragma unroll
            for (int tt = 0; tt < 8; ++tt) { acc[tt] = bd;
#pragma unroll
                for (int k = 0; k < 31; ++k) acc[tt] += w[k] * g[tt + k]; }
#pragma unroll
            for (int tt = 0; tt < 8; ++tt) hc[(ch * 8 + tt) * 256 + c] = acc[tt];
        }
    }
    __syncthreads();
    {
        const float4 gg = *(const float4*)(p.in[11] + l * 256 + lane * 4), bb = *(const float4*)(p.in[12] + l * 256 + lane * 4);
#pragma unroll 1
        for (int i = 0; i < 8; ++i) {
            const int t = wv * 8 + i;
            const float4 v = *(const float4*)(hc + t * 256 + lane * 4);
            float s = v.x + v.y + v.z + v.w;
#pragma unroll
            for (int o = 1; o < 64; o <<= 1) s += __shfl_xor(s, o);
            const float mean = s * (1.f / 256.f);
            const float d0 = v.x - mean, d1 = v.y - mean, d2 = v.z - mean, d3 = v.w - mean;
            float q = d0 * d0 + d1 * d1 + d2 * d2 + d3 * d3;
#pragma unroll
            for (int o = 1; o < 64; o <<= 1) q += __shfl_xor(q, o);
            const float rstd = rsqrtf(q * (1.f / 256.f) + EPS);
            float y0 = d0 * rstd * gg.x + bb.x, y1 = d1 * rstd * gg.y + bb.y, y2 = d2 * rstd * gg.z + bb.z, y3 = d3 * rstd * gg.w + bb.w;
            y0 = y0 / (1.f + __expf(-y0)); y1 = y1 / (1.f + __expf(-y1)); y2 = y2 / (1.f + __expf(-y2)); y3 = y3 / (1.f + __expf(-y3));
            u32x2 w; w.x = pk2(y0, y1); w.y = pk2(y2, y3);
            *(u32x2*)(p.MIXIN + (size_t)(tok0 + t) * 1024 + 512 + lane * 4) = w;
        }
    }
}

constexpr int MSLOT = 20480, MKR = 8192, MVT = 12288;
DI u32x4 mla_rsrc(const void* base, unsigned bytes) {
    const unsigned long long a = (unsigned long long)base;
    u32x4 r; r.x = __builtin_amdgcn_readfirstlane((unsigned)a); r.y = __builtin_amdgcn_readfirstlane((unsigned)(a >> 32) & 0xffffu); r.z = bytes; r.w = 0x00020000u;
    return r;
}
DI void mla_dma(unsigned m0v, int voff, u32x4 rsrc, unsigned soff) {
    asm volatile("s_nop 4\n\ts_mov_b32 m0, %0\n\ts_nop 0\n\tbuffer_load_dwordx4 %1, %2, %3 offen lds" :: "s"(m0v), "v"(voff), "s"(rsrc), "s"(soff) : "m0", "memory");
}
template <int ABL = 0>
DI void mla_attn_dma(const bf16* Qp, const bf16* Kn, const bf16* Kr, const bf16* VTp, bf16* Op, int b, int qb, char* lds) {
    int tid_ = threadIdx.x; asm volatile("" : "+v"(tid_)); const int tid = tid_, lane = tid & 63, r = lane & 31, hh = lane >> 5;
    const int wv = __builtin_amdgcn_readfirstlane(tid >> 6);
    const int q0 = qb * 128, qpos = q0 + 32 * wv + r;
    const size_t rowb = (size_t)b * SEQ;
    const int nt = (q0 + 128) / 64;
    const u32x4 rKn = mla_rsrc(Kn + rowb * 512, (unsigned)SEQ * 1024u), rKr = mla_rsrc(Kr + rowb * 32, (unsigned)SEQ * 64u), rVt = mla_rsrc(VTp, 64u * (unsigned)SEQ * 2u);
    const int l8 = lane >> 3, l4 = lane >> 2;
    const int f0 = l8 >> 1, f1 = f0 ^ 4;
    const int vkn = l8 * 1024 + (((lane & 7) ^ f0) << 4), vkn1 = l8 * 1024 + (((lane & 7) ^ f1) << 4), vkr = l4 * 64 + (((lane & 3) ^ ((l4 >> 2) & 3)) << 4), vvt = l8 * (SEQ * 2) + (((lane & 7) ^ f0) << 4), vvt1 = l8 * (SEQ * 2) + (((lane & 7) ^ f1) << 4);
    const unsigned ldsb = (unsigned)(size_t)(LAS3 char*)lds;
    const unsigned mkn = __builtin_amdgcn_readfirstlane(ldsb + 2048u * wv), mkr = __builtin_amdgcn_readfirstlane(ldsb + MKR + 1024u * wv), mvt = __builtin_amdgcn_readfirstlane(ldsb + MVT + 2048u * wv);
    auto dma = [&](int t, unsigned slot) {
        const unsigned key0 = 64u * t, so = slot * MSLOT;
        const unsigned skn = (key0 + 16u * wv) * 1024u, skr = (key0 + 16u * wv) * 64u, svt = (16u * wv * SEQ + key0) * 2u;
        mla_dma(mkn + so, vkn, rKn, skn); mla_dma(mkn + so + 1024u, vkn1, rKn, skn + 8u * 1024u);
        mla_dma(mkr + so, vkr, rKr, skr);
        mla_dma(mvt + so, vvt, rVt, svt); mla_dma(mvt + so + 1024u, vvt1, rVt, svt + 8u * SEQ * 2u);
    };
    dma(0, 0); if (nt > 1) dma(1, 1);
    bf16x8 qf[6];
#pragma unroll
    for (int ks = 0; ks < 6; ++ks) qf[ks] = *(const bf16x8*)(Qp + (rowb + qpos) * 768 + ks * 16 + hh * 8);
#pragma unroll
    for (int ks = 0; ks < 6; ++ks) asm volatile("" : "+v"(qf[ks]));
    asm volatile("s_waitcnt vmcnt(0)" ::: "memory");
    __syncthreads();
    f32x16 ot[2];
#pragma unroll
    for (int i = 0; i < 16; ++i) { ot[0][i] = 0.f; ot[1][i] = 0.f; }
    float m = -INFINITY, l = 0.f;
    const int sw7 = (r >> 1) & 7, sw3 = (r >> 2) & 3;
    unsigned slot = 0;
    for (int t = 0; t < nt; ++t) {
        const char* cur = lds + slot * MSLOT;
        const unsigned slot2 = (slot >= 1) ? slot - 1 : 2;
        if (!(ABL & 8)) if (t + 2 < nt) dma(t + 2, slot2);
        const int key0 = 64 * t;
        f32x16 st[2];
        bf16x8 kf[2][6];
#pragma unroll
        for (int mt = 0; mt < 2; ++mt) {
#pragma unroll
            for (int ks = 0; ks < 4; ++ks) kf[mt][ks] = *(const bf16x8*)(cur + (mt * 32 + r) * 128 + ((((ks << 1) | hh) ^ sw7) << 4));
#pragma unroll
            for (int ks = 4; ks < 6; ++ks) kf[mt][ks] = *(const bf16x8*)(cur + MKR + (mt * 32 + r) * 64 + ((((((ks - 4) << 1) | hh)) ^ sw3) << 4));
        }
        __builtin_amdgcn_sched_barrier(0);
#pragma unroll
        for (int mt = 0; mt < 2; ++mt) {
#pragma unroll
            for (int i = 0; i < 16; ++i) st[mt][i] = 0.f;
#pragma unroll
            for (int ks = 0; ks < 6; ++ks) { if (ABL & 2) { asm volatile("" :: "v"(kf[mt][ks])); st[mt][ks] += 1.f; } else st[mt] = MFMA32(kf[mt][ks], qf[ks], st[mt]); }
        }
        const char* vt = cur + MVT;
        bf16x8 vf[2][4];
#pragma unroll
        for (int mt = 0; mt < 2; ++mt)
#pragma unroll
            for (int s = 0; s < 4; ++s) vf[mt][s] = *(const bf16x8*)(vt + (mt * 32 + r) * 128 + ((((s << 1) | hh) ^ sw7) << 4));
        __builtin_amdgcn_sched_barrier(0);
        if (key0 + 63 > q0 + 32 * wv) {
#pragma unroll
            for (int mt = 0; mt < 2; ++mt)
#pragma unroll
                for (int i = 0; i < 16; ++i) { const int key = key0 + mt * 32 + crow(i, hh); if (key > qpos) st[mt][i] = -INFINITY; }
        }
        float mx = st[0][0];
#pragma unroll
        for (int i = 1; i < 16; ++i) mx = fmaxf(mx, st[0][i]);
#pragma unroll
        for (int i = 0; i < 16; ++i) mx = fmaxf(mx, st[1][i]);
        { auto rr = __builtin_amdgcn_permlane32_swap(__float_as_uint(mx), __float_as_uint(mx), false, false); mx = fmaxf(__uint_as_float(rr[0]), __uint_as_float(rr[1])); }
        const float mn = fmaxf(m, mx);
        const float alpha = __builtin_amdgcn_exp2f(m - mn);
        m = mn;
        float ps = 0.f;
#pragma unroll
        for (int mt = 0; mt < 2; ++mt)
#pragma unroll
            for (int i = 0; i < 16; ++i) { const float pv = (ABL & 1) ? (st[mt][i] - mn) : __builtin_amdgcn_exp2f(st[mt][i] - mn); st[mt][i] = pv; ps += pv; }
        l = l * alpha + ps;
#pragma unroll
        for (int i = 0; i < 16; ++i) { ot[0][i] *= alpha; ot[1][i] *= alpha; }
        bf16x8 pb[4];
#pragma unroll
        for (int s = 0; s < 4; ++s) {
            const int mt = s >> 1, o = 8 * (s & 1);
            u32x4 w; w.x = pk2(st[mt][o], st[mt][o + 1]); w.y = pk2(st[mt][o + 2], st[mt][o + 3]); w.z = pk2(st[mt][o + 4], st[mt][o + 5]); w.w = pk2(st[mt][o + 6], st[mt][o + 7]);
            pb[s] = __builtin_bit_cast(bf16x8, w);
        }
        __builtin_amdgcn_sched_barrier(0);
#pragma unroll
        for (int mt = 0; mt < 2; ++mt)
#pragma unroll
            for (int s = 0; s < 4; ++s) { if (ABL & 4) { asm volatile("" :: "v"(vf[mt][s]), "v"(pb[s])); ot[mt][s] += 1.f; } else ot[mt] = MFMA32(vf[mt][s], pb[s], ot[mt]); }
        if (t + 2 < nt && !(ABL & 8)) asm volatile("s_waitcnt vmcnt(5)" ::: "memory"); else asm volatile("s_waitcnt vmcnt(0)" ::: "memory");
        __syncthreads();
        slot = (slot == 2) ? 0 : slot + 1;
    }
    { auto rr = __builtin_amdgcn_permlane32_swap(__float_as_uint(l), __float_as_uint(l), false, false); l = __uint_as_float(rr[0]) + __uint_as_float(rr[1]); }
    const float inv = 1.f / l;
    bf16* orow = Op + (rowb + qpos) * 1024;
#pragma unroll
    for (int mt = 0; mt < 2; ++mt)
#pragma unroll
        for (int g = 0; g < 4; ++g) {
            u32x2 w; w.x = pk2(ot[mt][4 * g] * inv, ot[mt][4 * g + 1] * inv); w.y = pk2(ot[mt][4 * g + 2] * inv, ot[mt][4 * g + 3] * inv);
            *(u32x2*)(orow + mt * 32 + 8 * g + 4 * hh) = w;
        }
}
template <int ABL = 0> DI void mla_unit2(const Params& p, int u, char* lds) {
    const int nbh = (p.rows / SEQ) * 8, qb = 63 - u / nbh, bh = u % nbh, b = bh >> 3, h = bh & 7;
    mla_attn_dma<ABL>(p.Q + h * 96, p.KN + h * 64, p.KR, p.VT + (size_t)bh * 64 * SEQ, p.MIXIN + h * 64, b, qb, lds);
}

DI void swa_attn_dma(const bf16* Qp, const bf16* Kp, const bf16* VTp, bf16* Op, int b, int qb, float sink_l2, char* lds) {
    int tid_ = threadIdx.x; asm volatile("" : "+v"(tid_)); const int tid = tid_, lane = tid & 63, r = lane & 31, hh = lane >> 5;
    const int wv = __builtin_amdgcn_readfirstlane(tid >> 6);
    const int q0 = qb * 128, qpos = q0 + 32 * wv + r;
    const size_t rowb = (size_t)b * SEQ;
    const int kstart = q0 >= 128 ? q0 - 128 : 0, nt = (q0 + 128 - kstart) / 64;
    const u32x4 rK = mla_rsrc(Kp + rowb * PROJ_LD, (unsigned)SEQ * (unsigned)(PROJ_LD * 2)), rVt = mla_rsrc(VTp, 64u * (unsigned)SEQ * 2u);
    const int l8 = lane >> 3, f0 = l8 >> 1, f1 = f0 ^ 4;
    const int vk0 = l8 * (PROJ_LD * 2) + (((lane & 7) ^ f0) << 4), vk1 = l8 * (PROJ_LD * 2) + (((lane & 7) ^ f1) << 4);
    const int vv0 = l8 * (SEQ * 2) + (((lane & 7) ^ f0) << 4), vv1 = l8 * (SEQ * 2) + (((lane & 7) ^ f1) << 4);
    const unsigned ldsb = (unsigned)(size_t)(LAS3 char*)lds;
    const unsigned mk = __builtin_amdgcn_readfirstlane(ldsb + 2048u * wv), mv = __builtin_amdgcn_readfirstlane(ldsb + 8192u + 2048u * wv);
    for (int t = 0; t < nt; ++t) {
        const unsigned key0 = (unsigned)(kstart + 64 * t), so = (unsigned)t * 16384u;
        const unsigned sk = (key0 + 16u * wv) * (unsigned)(PROJ_LD * 2), sv = (16u * wv * SEQ + key0) * 2u;
        mla_dma(mk + so, vk0, rK, sk); mla_dma(mk + so + 1024u, vk1, rK, sk + 8u * (unsigned)(PROJ_LD * 2));
        mla_dma(mv + so, vv0, rVt, sv); mla_dma(mv + so + 1024u, vv1, rVt, sv + 8u * SEQ * 2u);
    }
    bf16x8 qf[4];
#pragma unroll
    for (int ks = 0; ks < 4; ++ks) qf[ks] = *(const bf16x8*)(Qp + (rowb + qpos) * PROJ_LD + ks * 16 + hh * 8);
#pragma unroll
    for (int ks = 0; ks < 4; ++ks) asm volatile("" : "+v"(qf[ks]));
    asm volatile("s_waitcnt vmcnt(0)" ::: "memory");
    __syncthreads();
    f32x16 ot[2];
#pragma unroll
    for (int i = 0; i < 16; ++i) { ot[0][i] = 0.f; ot[1][i] = 0.f; }
    float m = sink_l2, l = (hh == 0) ? 1.f : 0.f;
    const int sw7 = (r >> 1) & 7;
    for (int t = 0; t < nt; ++t) {
        const char* cur = lds + t * 16384;
        const int key0 = kstart + 64 * t;
        f32x16 st[2];
        bf16x8 kf[2][4];
#pragma unroll
        for (int mt = 0; mt < 2; ++mt)
#pragma unroll
            for (int ks = 0; ks < 4; ++ks) kf[mt][ks] = *(const bf16x8*)(cur + (mt * 32 + r) * 128 + ((((ks << 1) | hh) ^ sw7) << 4));
        __builtin_amdgcn_sched_barrier(0);
#pragma unroll
        for (int mt = 0; mt < 2; ++mt) {
#pragma unroll
            for (int i = 0; i < 16; ++i) st[mt][i] = 0.f;
#pragma unroll
            for (int ks = 0; ks < 4; ++ks) st[mt] = MFMA32(kf[mt][ks], qf[ks], st[mt]);
        }
        const char* vt = cur + 8192;
        bf16x8 vf[2][4];
#pragma unroll
        for (int mt = 0; mt < 2; ++mt)
#pragma unroll
            for (int s = 0; s < 4; ++s) vf[mt][s] = *(const bf16x8*)(vt + (mt * 32 + r) * 128 + ((((s << 1) | hh) ^ sw7) << 4));
        __builtin_amdgcn_sched_barrier(0);
#pragma unroll
        for (int mt = 0; mt < 2; ++mt)
#pragma unroll
            for (int i = 0; i < 16; ++i) { const int key = key0 + mt * 32 + crow(i, hh); if (!(key <= qpos && key > qpos - 128)) st[mt][i] = -INFINITY; }
        float mx = st[0][0];
#pragma unroll
        for (int i = 1; i < 16; ++i) mx = fmaxf(mx, st[0][i]);
#pragma unroll
        for (int i = 0; i < 16; ++i) mx = fmaxf(mx, st[1][i]);
        { auto rr = __builtin_amdgcn_permlane32_swap(__float_as_uint(mx), __float_as_uint(mx), false, false); mx = fmaxf(__uint_as_float(rr[0]), __uint_as_float(rr[1])); }
        const float mn = fmaxf(m, mx);
        const float alpha = __builtin_amdgcn_exp2f(m - mn);
        m = mn;
        float ps = 0.f;
#pragma unroll
        for (int mt = 0; mt < 2; ++mt)
#pragma unroll
            for (int i = 0; i < 16; ++i) { const float pv = __builtin_amdgcn_exp2f(st[mt][i] - mn); st[mt][i] = pv; ps += pv; }
        l = l * alpha + ps;
#pragma unroll
        for (int i = 0; i < 16; ++i) { ot[0][i] *= alpha; ot[1][i] *= alpha; }
        bf16x8 pb[4];
#pragma unroll
        for (int s = 0; s < 4; ++s) {
            const int mt = s >> 1, o = 8 * (s & 1);
            u32x4 w; w.x = pk2(st[mt][o], st[mt][o + 1]); w.y = pk2(st[mt][o + 2], st[mt][o + 3]); w.z = pk2(st[mt][o + 4], st[mt][o + 5]); w.w = pk2(st[mt][o + 6], st[mt][o + 7]);
            pb[s] = __builtin_bit_cast(bf16x8, w);
        }
        __builtin_amdgcn_sched_barrier(0);
#pragma unroll
        for (int mt = 0; mt < 2; ++mt)
#pragma unroll
            for (int s = 0; s < 4; ++s) ot[mt] = MFMA32(vf[mt][s], pb[s], ot[mt]);
    }
    { auto rr = __builtin_amdgcn_permlane32_swap(__float_as_uint(l), __float_as_uint(l), false, false); l = __uint_as_float(rr[0]) + __uint_as_float(rr[1]); }
    const float inv = 1.f / l;
    bf16* orow = Op + (rowb + qpos) * 1024;
#pragma unroll
    for (int mt = 0; mt < 2; ++mt)
#pragma unroll
        for (int g = 0; g < 4; ++g) {
            u32x2 w; w.x = pk2(ot[mt][4 * g] * inv, ot[mt][4 * g + 1] * inv); w.y = pk2(ot[mt][4 * g + 2] * inv, ot[mt][4 * g + 3] * inv);
            *(u32x2*)(orow + mt * 32 + 8 * g + 4 * hh) = w;
        }
}
DI void swa_unit2(const Params& p, int l, int u, char* lds) {
    const int qb = u & 63, bh = u >> 6, b = bh >> 2, hq = bh & 3, kvh = hq >> 1;
    swa_attn_dma(p.PROJ + 896 + hq * 64, p.PROJ + 1152 + kvh * 64, p.VsT + (size_t)(b * 2 + kvh) * 64 * SEQ, p.MIXIN + 768 + hq * 64, b, qb, p.in[15][l * 4 + hq] * LOG2E, lds);
}
DI void fold_pw_item(const Params& p, int l, int item) {
    const int tid = threadIdx.x;
    const float* wo = p.in[16] + (size_t)l * D * D + (size_t)512 * D;
    if (item < 1024) {
        const int kp = item >> 2, n = (item & 3) * 256 + tid;
        const float* wp = p.in[13] + (size_t)l * 256 * 256 + (size_t)kp * 256;
        float acc = 0.f;
        for (int j = 0; j < 256; ++j) acc += wp[j] * wo[(size_t)j * D + n];
        p.WoT[((size_t)l * D + n) * D + 512 + kp] = f2bf(acc);
    } else {
        const int n = (item - 1024) * 256 + tid;
        const float* bp = p.in[14] + l * 256;
        float acc = 0.f;
        for (int j = 0; j < 256; ++j) acc += bp[j] * wo[(size_t)j * D + n];
        p.biasO[l * D + n] = acc;
    }
}

DI void p4_tile(const Params& p, int l, int tile, const float* xin, float* X1, char* lds) {
    int tid_ = threadIdx.x; asm volatile("" : "+v"(tid_)); const int tid = tid_, lane = tid & 63, r = lane & 31, hh = lane >> 5;
    const int wv = __builtin_amdgcn_readfirstlane(tid >> 6), wm = wv >> 1, wn = wv & 1;
    const int mt = tile >> 3, nt = tile & 7, m0 = mt * 128, n0 = nt * 128;
    const bf16* A = p.MIXIN + (size_t)m0 * D;
    const bf16* W = p.WoT + ((size_t)l * D + n0) * D;
    f32x16 acc[2][2]; zero_acc(acc);
    int frow[2], grow[2];
    frow[0] = 64 * wm + r; frow[1] = frow[0] + 32; grow[0] = 64 * wn + r; grow[1] = grow[0] + 32;
    GEMM_CORE<2, 2>(A, D, W, D, D, lds, acc, 0, frow, TILE_B, grow);
    const int b = (p.tok0 + m0) / SEQ;
    const float* gt = p.MOD + ((size_t)l * BATCH + b) * 6 * D + 2 * D;
#pragma unroll
    for (int y = 0; y < 2; ++y) {
        const int col = n0 + 64 * wn + 32 * y + r;
        const float g1 = 1.f + gt[col], bo = p.biasO[l * D + col];
#pragma unroll
        for (int x = 0; x < 2; ++x) {
            const size_t base = (size_t)(m0 + 64 * wm + 32 * x + 4 * hh) * D + col;
            float xv[16];
#pragma unroll
            for (int i = 0; i < 16; ++i) xv[i] = xin[base + (size_t)((i & 3) + 8 * (i >> 2)) * D];
#pragma unroll
            for (int i = 0; i < 16; ++i) X1[base + (size_t)((i & 3) + 8 * (i >> 2)) * D] = DN_ALPHA * xv[i] + g1 * (acc[x][y][i] + bo);
        }
    }
}

DI void ln16(float (&v)[16], const float* g, const float* bta, int lane) {
    float s = 0.f;
#pragma unroll
    for (int i = 0; i < 16; ++i) s += v[i];
#pragma unroll
    for (int o = 1; o < 64; o <<= 1) s += __shfl_xor(s, o);
    const float mean = s * (1.f / D); float q = 0.f;
#pragma unroll
    for (int i = 0; i < 16; ++i) { v[i] -= mean; q += v[i] * v[i]; }
#pragma unroll
    for (int o = 1; o < 64; o <<= 1) q += __shfl_xor(q, o);
    const float rstd = rsqrtf(q * (1.f / D) + EPS);
#pragma unroll
    for (int hf = 0; hf < 2; ++hf)
#pragma unroll
        for (int q4 = 0; q4 < 2; ++q4) {
            const int c = hf * 512 + lane * 8 + q4 * 4;
            const float4 gg = *(const float4*)(g + c), bb = *(const float4*)(bta + c);
            const int i = hf * 8 + q4 * 4;
            v[i] = v[i] * rstd * gg.x + bb.x; v[i + 1] = v[i + 1] * rstd * gg.y + bb.y; v[i + 2] = v[i + 2] * rstd * gg.z + bb.z; v[i + 3] = v[i + 3] * rstd * gg.w + bb.w;
        }
}
DI void load16(float (&v)[16], const float* row, int lane) {
#pragma unroll
    for (int hf = 0; hf < 2; ++hf)
#pragma unroll
        for (int q4 = 0; q4 < 2; ++q4) { const float4 t = *(const float4*)(row + hf * 512 + lane * 8 + q4 * 4); const int i = hf * 8 + q4 * 4; v[i] = t.x; v[i + 1] = t.y; v[i + 2] = t.z; v[i + 3] = t.w; }
}
DI void store16f(float* row, const float (&v)[16], int lane) {
#pragma unroll
    for (int hf = 0; hf < 2; ++hf)
#pragma unroll
        for (int q4 = 0; q4 < 2; ++q4) { const int i = hf * 8 + q4 * 4; *(float4*)(row + hf * 512 + lane * 8 + q4 * 4) = make_float4(v[i], v[i + 1], v[i + 2], v[i + 3]); }
}
DI void store_mod16(bf16* hrow, const float (&v)[16], const float* sh, const float* sc, int lane) {
#pragma unroll
    for (int hf = 0; hf < 2; ++hf) {
        float o[8];
#pragma unroll
        for (int q4 = 0; q4 < 2; ++q4) {
            const int c = hf * 512 + lane * 8 + q4 * 4, i = hf * 8 + q4 * 4;
            const float4 s4 = *(const float4*)(sc + c), h4 = *(const float4*)(sh + c);
            o[q4 * 4] = v[i] * (1.f + s4.x) + h4.x; o[q4 * 4 + 1] = v[i + 1] * (1.f + s4.y) + h4.y; o[q4 * 4 + 2] = v[i + 2] * (1.f + s4.z) + h4.z; o[q4 * 4 + 3] = v[i + 3] * (1.f + s4.w) + h4.w;
        }
        store8(hrow + hf * 512 + lane * 8, o);
    }
}
DI void p4b_row(const Params& p, int l, int row, float* X1, int lane) {
    float v[16];
    load16(v, X1 + (size_t)row * D, lane);
    float s = 0.f;
#pragma unroll
    for (int i = 0; i < 16; ++i) s += v[i];
#pragma unroll
    for (int o = 1; o < 64; o <<= 1) s += __shfl_xor(s, o);
    const float mean = s * (1.f / D); float q = 0.f;
#pragma unroll
    for (int i = 0; i < 16; ++i) { v[i] -= mean; q += v[i] * v[i]; }
#pragma unroll
    for (int o = 1; o < 64; o <<= 1) q += __shfl_xor(q, o);
    const float rstd = rsqrtf(q * (1.f / D) + EPS);
    if (lane == 0) { p.STATS[2 * (size_t)row] = mean; p.STATS[2 * (size_t)row + 1] = rstd; }
    const float* g = p.in[17] + l * D; const float* bta = p.in[18] + l * D;
#pragma unroll
    for (int hf = 0; hf < 2; ++hf)
#pragma unroll
        for (int q4 = 0; q4 < 2; ++q4) {
            const int c = hf * 512 + lane * 8 + q4 * 4;
            const float4 gg = *(const float4*)(g + c), bb = *(const float4*)(bta + c);
            const int i = hf * 8 + q4 * 4;
            v[i] = v[i] * rstd * gg.x + bb.x; v[i + 1] = v[i + 1] * rstd * gg.y + bb.y; v[i + 2] = v[i + 2] * rstd * gg.z + bb.z; v[i + 3] = v[i + 3] * rstd * gg.w + bb.w;
        }
    const int b = (p.tok0 + row) / SEQ;
    const float* mod = p.MOD + ((size_t)l * BATCH + b) * 6 * D;
    store_mod16(p.H + (size_t)row * D, v, mod + 3 * D, mod + 4 * D, lane);
}

DI unsigned ford(float f) { const unsigned u = __float_as_uint(f); return u ^ ((u >> 31) ? 0xffffffffu : 0x80000000u); }
DI float funord(unsigned o) { const unsigned u = o ^ ((o >> 31) ? 0x80000000u : 0xffffffffu); return __uint_as_float(u); }
constexpr int SKSTR = 272;

DI void p5_tile(const Params& p, int l, int tile, char* lds) {
    int tid_ = threadIdx.x; asm volatile("" : "+v"(tid_)); const int tid = tid_, lane = tid & 63, r = lane & 31, hh = lane >> 5;
    const int wv = __builtin_amdgcn_readfirstlane(tid >> 6);
    const int mt = tile >> 4, hp = tile & 15, m0 = mt * 128;
    const bf16* A = p.H + (size_t)m0 * D;
    const bf16* W = p.WpqT + ((size_t)l * 2048 + hp * 128) * D;
    f32x16 acc[4][1]; zero_acc(acc);
    int frow[4], grow[1];
#pragma unroll
    for (int x = 0; x < 4; ++x) frow[x] = 32 * x + r;
    grow[0] = 32 * wv + r;
    GEMM_CORE<4, 1>(A, D, W, D, D, lds, acc, TILE_B, frow, 0, grow);
#ifdef G3_PROBE
    const int dry5 = __builtin_amdgcn_readfirstlane(*(volatile int*)(lds + LDS_BYTES + 1024 - 64));
    if (dry5 & 4) return;
#endif
    bf16x8 xb[8];
#pragma unroll
    for (int s = 0; s < 8; ++s) {
        const int x = s >> 1, o = 8 * (s & 1);
        u32x4 w; w.x = pk2(acc[x][0][o], acc[x][0][o + 1]); w.y = pk2(acc[x][0][o + 2], acc[x][0][o + 3]); w.z = pk2(acc[x][0][o + 4], acc[x][0][o + 5]); w.w = pk2(acc[x][0][o + 6], acc[x][0][o + 7]);
        xb[s] = __builtin_bit_cast(bf16x8, w);
    }
    const bf16* sk = p.SKp + ((size_t)l * 16 + hp) * 128 * 128;
#pragma unroll
    for (int i = 0; i < 8; ++i) { const int q = tid + 256 * i, row = q >> 4, c = q & 15; *(u32x4*)(lds + row * SKSTR + c * 16) = *(const u32x4*)(sk + row * 128 + c * 8); }
    __syncthreads();
    unsigned L[16];
#pragma unroll
    for (int m2 = 0; m2 < 4; ++m2) {
        f32x16 st;
#pragma unroll
        for (int i = 0; i < 16; ++i) st[i] = 0.f;
#pragma unroll
        for (int s = 0; s < 8; ++s) {
            const bf16x8 a = *(const bf16x8*)(lds + (32 * m2 + r) * SKSTR + s * 32 + hh * 16);
            st = MFMA32(a, xb[s], st);
        }
        unsigned V[16];
#pragma unroll
        for (int i = 0; i < 16; ++i) V[i] = (ford(st[i]) & ~0x7fu) | (unsigned)(32 * m2 + crow(i, hh));
#pragma unroll
        for (int k = 2; k <= 16; k <<= 1)
#pragma unroll
            for (int j = k >> 1; j >= 1; j >>= 1)
#pragma unroll
                for (int i = 0; i < 16; ++i) { const int o = i ^ j; if (o > i) { const unsigned a = max(V[i], V[o]), b = min(V[i], V[o]); if ((i & k) == 0) { V[i] = a; V[o] = b; } else { V[i] = b; V[o] = a; } } }
        if (m2 == 0) {
#pragma unroll
            for (int k = 0; k < 16; ++k) L[k] = V[k];
        } else {
#pragma unroll
            for (int k = 0; k < 16; ++k) L[k] = max(L[k], V[15 - k]);
#pragma unroll
            for (int d = 8; d >= 1; d >>= 1)
#pragma unroll
                for (int i = 0; i < 16; ++i) if ((i & d) == 0) { const unsigned a = max(L[i], L[i + d]), b = min(L[i], L[i + d]); L[i] = a; L[i + d] = b; }
        }
    }
    unsigned C[16];
#pragma unroll
    for (int k = 0; k < 16; ++k) C[k] = max(L[k], (unsigned)__shfl_xor((int)L[15 - k], 32));
#pragma unroll
    for (int d = 8; d >= 1; d >>= 1)
#pragma unroll
        for (int i = 0; i < 16; ++i) if ((i & d) == 0) { const unsigned a = max(C[i], C[i + d]), b = min(C[i], C[i + d]); C[i] = a; C[i + d] = b; }
    unsigned* dst = p.TOPK + ((size_t)(m0 + 32 * wv + r) * 16 + hp) * 16 + 8 * hh;
    u32x4 o0, o1;
    if (hh == 0) { o0 = (u32x4){C[0], C[1], C[2], C[3]}; o1 = (u32x4){C[4], C[5], C[6], C[7]}; }
    else { o0 = (u32x4){C[8], C[9], C[10], C[11]}; o1 = (u32x4){C[12], C[13], C[14], C[15]}; }
    *(u32x4*)dst = o0; *(u32x4*)(dst + 4) = o1;
}
typedef __bf16 bf16x2v __attribute__((ext_vector_type(2)));
DI float dot2(unsigned a, unsigned b, float c) { return __builtin_amdgcn_fdot2_f32_bf16(__builtin_bit_cast(bf16x2v, a), __builtin_bit_cast(bf16x2v, b), c, false); }
DI float gelu_erf(float a) { return 0.5f * a * (1.f + erff(a * 0.70710678118654752f)); }

DI void p6_unit(const Params& p, int l, int u, const float* X1, float* xout, char* lds) {
    int tid_ = threadIdx.x; asm volatile("" : "+v"(tid_)); const int tid = tid_, lane = tid & 63;
    const int wv = __builtin_amdgcn_readfirstlane(tid >> 6);
    unsigned* LA = (unsigned*)(lds + wv * 16384); unsigned* LB = LA + 1024; unsigned* Ee = LA + 2048; float* Eg = (float*)(LA + 3072);
    const int tokb = u * 32 + wv * 8;
    __syncthreads();
    {
        const int ti = lane >> 3, head = lane & 7;
        const unsigned* src = p.TOPK + ((size_t)(tokb + ti) * 16 + head * 2) * 16;
        unsigned A[16], B[16];
#pragma unroll
        for (int q = 0; q < 4; ++q) { const u32x4 a = *(const u32x4*)(src + 4 * q), b = *(const u32x4*)(src + 16 + 4 * q);
            A[4 * q] = a.x; A[4 * q + 1] = a.y; A[4 * q + 2] = a.z; A[4 * q + 3] = a.w; B[4 * q] = b.x; B[4 * q + 1] = b.y; B[4 * q + 2] = b.z; B[4 * q + 3] = b.w;
            *(u32x4*)(LA + lane * 16 + 4 * q) = a; *(u32x4*)(LB + lane * 16 + 4 * q) = b; }
        float sA[16], sB[16];
#pragma unroll
        for (int k = 0; k < 16; ++k) { sA[k] = funord(A[k] & ~0x7fu); sB[k] = funord(B[k] & ~0x7fu); }
        unsigned T[16];
#pragma unroll
        for (int k = 0; k < 16; ++k) T[k] = 0u;
#pragma unroll
        for (int a = 0; a < 16; ++a)
#pragma unroll
            for (int b = 0; b < 16; ++b)
                if ((a + 1) * (b + 1) <= 16) {
                    unsigned v = (ford(sA[a] + sB[b]) & ~0xffu) | (unsigned)(a * 16 + b);
#pragma unroll
                    for (int k = 0; k < 16; ++k) { const unsigned t = max(T[k], v); v = min(T[k], v); T[k] = t; }
                }
        float ex[16]; float sum = 0.f; const float mx = funord(T[0] & ~0xffu);
#pragma unroll
        for (int k = 0; k < 16; ++k) { ex[k] = __expf(funord(T[k] & ~0xffu) - mx); sum += ex[k]; }
        const float inv = 1.f / sum;
#pragma unroll
        for (int k = 0; k < 16; ++k) {
            const unsigned cid = T[k] & 0xffu, ia = LA[lane * 16 + (cid >> 4)] & 0x7fu, ib = LB[lane * 16 + (cid & 15u)] & 0x7fu;
            Ee[ti * 128 + head * 16 + k] = ia * 128u + ib; Eg[ti * 128 + head * 16 + k] = ex[k] * inv;
        }
    }
    const bf16* Ut = p.Ut; const bf16* Vt = p.Vt;
    const int jl = 4 * (lane >> 5) + 2 * ((lane >> 4) & 1) + ((lane >> 3) & 1);
    const bool b5 = lane & 32, b4 = lane & 16, b3 = lane & 8;
#pragma unroll 1
    for (int ti = 0; ti < 8; ++ti) {
        const int tok = tokb + ti;
        const u32x4 h0 = *(const u32x4*)(p.H + (size_t)tok * D + lane * 8), h1 = *(const u32x4*)(p.H + (size_t)tok * D + 512 + lane * 8);
        float y[16];
#pragma unroll
        for (int i = 0; i < 16; ++i) y[i] = 0.f;
#pragma unroll 1
        for (int bt = 0; bt < 16; ++bt) {
            u32x4 uu[8][2], vv[8][2];
#pragma unroll
            for (int j = 0; j < 8; ++j) {
                const unsigned e = __builtin_amdgcn_readfirstlane(Ee[ti * 128 + bt * 8 + j]);
                const bf16* ur = Ut + (size_t)e * D + lane * 8; const bf16* vr = Vt + (size_t)e * D + lane * 8;
                uu[j][0] = *(const u32x4*)ur; uu[j][1] = *(const u32x4*)(ur + 512);
                vv[j][0] = *(const u32x4*)vr; vv[j][1] = *(const u32x4*)(vr + 512);
            }
            float a[8];
#pragma unroll
            for (int j = 0; j < 8; ++j) {
                float s = dot2(h0.x, uu[j][0].x, 0.f); s = dot2(h0.y, uu[j][0].y, s); s = dot2(h0.z, uu[j][0].z, s); s = dot2(h0.w, uu[j][0].w, s);
                s = dot2(h1.x, uu[j][1].x, s); s = dot2(h1.y, uu[j][1].y, s); s = dot2(h1.z, uu[j][1].z, s); s = dot2(h1.w, uu[j][1].w, s);
                a[j] = s;
            }
            float k1[4], k2[2], k3;
#pragma unroll
            for (int i = 0; i < 4; ++i) { const float snd = b5 ? a[i] : a[4 + i]; const float rcv = __shfl_xor(snd, 32); k1[i] = (b5 ? a[4 + i] : a[i]) + rcv; }
#pragma unroll
            for (int i = 0; i < 2; ++i) { const float snd = b4 ? k1[i] : k1[2 + i]; const float rcv = __shfl_xor(snd, 16); k2[i] = (b4 ? k1[2 + i] : k1[i]) + rcv; }
            { const float snd = b3 ? k2[0] : k2[1]; const float rcv = __shfl_xor(snd, 8); k3 = (b3 ? k2[1] : k2[0]) + rcv; }
            k3 += __shfl_xor(k3, 4); k3 += __shfl_xor(k3, 2); k3 += __shfl_xor(k3, 1);
            const float w = Eg[ti * 128 + bt * 8 + jl] * gelu_erf(k3);
#pragma unroll
            for (int j = 0; j < 8; ++j) {
                const int src = 32 * (j >> 2) + 16 * ((j >> 1) & 1) + 8 * (j & 1);
                const float wj = __uint_as_float(__builtin_amdgcn_readlane(__float_as_uint(w), src));
                const unsigned w0[4] = {vv[j][0].x, vv[j][0].y, vv[j][0].z, vv[j][0].w}, w1[4] = {vv[j][1].x, vv[j][1].y, vv[j][1].z, vv[j][1].w};
#pragma unroll
                for (int i = 0; i < 4; ++i) { y[2 * i] += wj * bflo(w0[i]); y[2 * i + 1] += wj * bfhi(w0[i]); y[8 + 2 * i] += wj * bflo(w1[i]); y[8 + 2 * i + 1] += wj * bfhi(w1[i]); }
            }
        }
        const int b = (p.tok0 + tok) / SEQ;
        const float* mod = p.MOD + ((size_t)l * BATCH + b) * 6 * D;
        float v[16], gt[16];
        load16(v, X1 + (size_t)tok * D, lane); load16(gt, mod + 5 * D, lane);
#pragma unroll
        for (int i = 0; i < 16; ++i) v[i] = DN_ALPHA * v[i] + (1.f + gt[i]) * y[i];
        ln16(v, p.in[23] + l * D, p.in[24] + l * D, lane);
        store16f(xout + (size_t)tok * D, v, lane);
        if (l + 1 < DEPTH) { const float* modn = p.MOD + ((size_t)(l + 1) * BATCH + b) * 6 * D; store_mod16(p.H + (size_t)tok * D, v, modn, modn + D, lane); }
    }
}
DI void table_row_fp8(const float* src, unsigned char* dst, float* inv_scale, int lane) {
    float v[16];
#pragma unroll
    for (int q = 0; q < 4; ++q) { const float4 t = *(const float4*)(src + lane * 16 + q * 4); v[4 * q] = t.x; v[4 * q + 1] = t.y; v[4 * q + 2] = t.z; v[4 * q + 3] = t.w; }
    float mx = 0.f;
#pragma unroll
    for (int i = 0; i < 16; ++i) mx = fmaxf(mx, fabsf(v[i]));
#pragma unroll
    for (int o = 1; o < 64; o <<= 1) mx = fmaxf(mx, __shfl_xor(mx, o));
    const float sc = (mx > 0.f) ? 448.f / mx : 1.f;
    u32x4 o;
    unsigned w[4];
#pragma unroll
    for (int q = 0; q < 4; ++q) { unsigned t = 0u; t = __builtin_amdgcn_cvt_pk_fp8_f32(v[4 * q] * sc, v[4 * q + 1] * sc, t, false); t = __builtin_amdgcn_cvt_pk_fp8_f32(v[4 * q + 2] * sc, v[4 * q + 3] * sc, t, true); w[q] = t; }
    o.x = w[0]; o.y = w[1]; o.z = w[2]; o.w = w[3];
    *(u32x4*)(dst + lane * 16) = o;
    if (lane == 0) *inv_scale = (mx > 0.f) ? mx * (1.f / 448.f) : 1.f;
}
DI void convert_tables_fp8(const Params& p, int l, int bid, int nb) {
    int t_ = threadIdx.x; asm volatile("" : "+v"(t_)); const int wv = t_ >> 6, lane = t_ & 63;
    const float* us = p.in[21] + (size_t)l * 16384 * D; const float* vs = p.in[22] + (size_t)l * 16384 * D;
    for (int row = bid * 4 + wv; row < 2 * 16384; row += nb * 4) {
        if (row < 16384) table_row_fp8(us + (size_t)row * D, p.U8 + (size_t)row * D, p.US + l * 16384 + row, lane);
        else { const int r2 = row - 16384; table_row_fp8(vs + (size_t)r2 * D, p.V8 + (size_t)r2 * D, p.VS + l * 16384 + r2, lane); }
    }
}
DI void load16c(float (&v)[16], const float* row, int lane) {
#pragma unroll
    for (int q = 0; q < 4; ++q) { const float4 t = *(const float4*)(row + lane * 16 + q * 4); v[4 * q] = t.x; v[4 * q + 1] = t.y; v[4 * q + 2] = t.z; v[4 * q + 3] = t.w; }
}
DI void ln16c(float (&v)[16], const float* g, const float* bta, int lane) {
    float s = 0.f;
#pragma unroll
    for (int i = 0; i < 16; ++i) s += v[i];
#pragma unroll
    for (int o = 1; o < 64; o <<= 1) s += __shfl_xor(s, o);
    const float mean = s * (1.f / D); float q = 0.f;
#pragma unroll
    for (int i = 0; i < 16; ++i) { v[i] -= mean; q += v[i] * v[i]; }
#pragma unroll
    for (int o = 1; o < 64; o <<= 1) q += __shfl_xor(q, o);
    const float rstd = rsqrtf(q * (1.f / D) + EPS);
    float gg[16], bb[16]; load16c(gg, g, lane); load16c(bb, bta, lane);
#pragma unroll
    for (int i = 0; i < 16; ++i) v[i] = v[i] * rstd * gg[i] + bb[i];
}
DI void store16c(float* row, const float (&v)[16], int lane) {
#pragma unroll
    for (int q = 0; q < 4; ++q) *(float4*)(row + lane * 16 + q * 4) = make_float4(v[4 * q], v[4 * q + 1], v[4 * q + 2], v[4 * q + 3]);
}
DI void store_mod16c(bf16* hrow, const float (&v)[16], const float* sh, const float* sc, int lane) {
    float s[16], h[16], o[16]; load16c(s, sc, lane); load16c(h, sh, lane);
#pragma unroll
    for (int i = 0; i < 16; ++i) o[i] = v[i] * (1.f + s[i]) + h[i];
    store16(hrow + lane * 16, o);
}

DI void p6f_unit(const Params& p, int l, int u, const float* X1, float* xout, char* lds) {
    int tid_ = threadIdx.x; asm volatile("" : "+v"(tid_)); const int tid = tid_, lane = tid & 63;
    const int wv = __builtin_amdgcn_readfirstlane(tid >> 6);
    unsigned* LA = (unsigned*)(lds + wv * 16384); unsigned* LB = LA + 1024; unsigned* Ee = LA + 2048; float* Eg = (float*)(LA + 3072); float* Es = (float*)LA;
    const int tokb = u * 32 + wv * 8;
    __syncthreads();
    {
        const int ti = lane >> 3, head = lane & 7;
        const unsigned* src = p.TOPK + ((size_t)(tokb + ti) * 16 + head * 2) * 16;
        unsigned A[16], B[16];
#pragma unroll
        for (int q = 0; q < 4; ++q) { const u32x4 a = *(const u32x4*)(src + 4 * q), b = *(const u32x4*)(src + 16 + 4 * q);
            A[4 * q] = a.x; A[4 * q + 1] = a.y; A[4 * q + 2] = a.z; A[4 * q + 3] = a.w; B[4 * q] = b.x; B[4 * q + 1] = b.y; B[4 * q + 2] = b.z; B[4 * q + 3] = b.w;
            *(u32x4*)(LA + lane * 16 + 4 * q) = a; *(u32x4*)(LB + lane * 16 + 4 * q) = b; }
        float sA[16], sB[16];
#pragma unroll
        for (int k = 0; k < 16; ++k) { sA[k] = funord(A[k] & ~0x7fu); sB[k] = funord(B[k] & ~0x7fu); }
        unsigned T[16];
#pragma unroll
        for (int k = 0; k < 16; ++k) T[k] = 0u;
#pragma unroll
        for (int a = 0; a < 16; ++a)
#pragma unroll
            for (int b = 0; b < 16; ++b)
                if ((a + 1) * (b + 1) <= 16) {
                    unsigned v = (ford(sA[a] + sB[b]) & ~0xffu) | (unsigned)(a * 16 + b);
#pragma unroll
                    for (int k = 0; k < 16; ++k) { const unsigned t = max(T[k], v); v = min(T[k], v); T[k] = t; }
                }
        float ex[16]; float sum = 0.f; const float mx = funord(T[0] & ~0xffu);
        unsigned ev[16];
#pragma unroll
        for (int k = 0; k < 16; ++k) { ex[k] = __expf(funord(T[k] & ~0xffu) - mx); sum += ex[k];
            const unsigned cid = T[k] & 0xffu; ev[k] = (LA[lane * 16 + (cid >> 4)] & 0x7fu) * 128u + (LB[lane * 16 + (cid & 15u)] & 0x7fu); }
        const float inv = 1.f / sum;
        const float* US = p.US + l * 16384; const float* VS = p.VS + l * 16384;
#pragma unroll
        for (int k = 0; k < 16; ++k) {
            const float su = US[ev[k]], sv = VS[ev[k]];
            Ee[ti * 128 + head * 16 + k] = ev[k]; Eg[ti * 128 + head * 16 + k] = ex[k] * inv * sv; Es[ti * 128 + head * 16 + k] = su;
        }
    }
    const unsigned char* U8 = p.U8; const unsigned char* V8 = p.V8;
    const int jl = 8 * (lane >> 5) + 4 * ((lane >> 4) & 1) + 2 * ((lane >> 3) & 1) + ((lane >> 2) & 1);
    const bool b5 = lane & 32, b4 = lane & 16, b3 = lane & 8, b2 = lane & 4;
#pragma unroll 1
    for (int ti = 0; ti < 8; ++ti) {
        const int tok = tokb + ti;
        const u32x4 h0 = *(const u32x4*)(p.H + (size_t)tok * D + lane * 16), h1 = *(const u32x4*)(p.H + (size_t)tok * D + lane * 16 + 8);
        const unsigned hw[8] = {h0.x, h0.y, h0.z, h0.w, h1.x, h1.y, h1.z, h1.w};
        f32x2v hf[8], y2[8];
#pragma unroll
        for (int i = 0; i < 8; ++i) { hf[i] = (f32x2v){bflo(hw[i]), bfhi(hw[i])}; y2[i] = (f32x2v){0.f, 0.f}; }
#pragma unroll 1
        for (int bt = 0; bt < 8; ++bt) {
            u32x4 uu[16], vv[16];
#pragma unroll
            for (int j = 0; j < 16; ++j) {
                const unsigned e = __builtin_amdgcn_readfirstlane(Ee[ti * 128 + bt * 16 + j]);
                uu[j] = *(const u32x4*)(U8 + (size_t)e * D + lane * 16);
                vv[j] = *(const u32x4*)(V8 + (size_t)e * D + lane * 16);
            }
            float a[16];
#pragma unroll
            for (int j = 0; j < 16; ++j) {
                const unsigned w[4] = {uu[j].x, uu[j].y, uu[j].z, uu[j].w};
                f32x2v acc = {0.f, 0.f};
#pragma unroll
                for (int q = 0; q < 4; ++q) { acc = __builtin_amdgcn_cvt_pk_f32_fp8(w[q], false) * hf[2 * q] + acc; acc = __builtin_amdgcn_cvt_pk_f32_fp8(w[q], true) * hf[2 * q + 1] + acc; }
                a[j] = acc.x + acc.y;
            }
            float k1[8], k2[4], k3[2], k4;
#pragma unroll
            for (int i = 0; i < 8; ++i) { const float snd = b5 ? a[i] : a[8 + i]; const float rcv = __shfl_xor(snd, 32); k1[i] = (b5 ? a[8 + i] : a[i]) + rcv; }
#pragma unroll
            for (int i = 0; i < 4; ++i) { const float snd = b4 ? k1[i] : k1[4 + i]; const float rcv = __shfl_xor(snd, 16); k2[i] = (b4 ? k1[4 + i] : k1[i]) + rcv; }
#pragma unroll
            for (int i = 0; i < 2; ++i) { const float snd = b3 ? k2[i] : k2[2 + i]; const float rcv = __shfl_xor(snd, 8); k3[i] = (b3 ? k2[2 + i] : k2[i]) + rcv; }
            { const float snd = b2 ? k3[0] : k3[1]; const float rcv = __shfl_xor(snd, 4); k4 = (b2 ? k3[1] : k3[0]) + rcv; }
            k4 += __shfl_xor(k4, 2); k4 += __shfl_xor(k4, 1);
            const int ei = ti * 128 + bt * 16 + jl;
            const float w = Eg[ei] * gelu_erf(k4 * Es[ei]);
#pragma unroll
            for (int j = 0; j < 16; ++j) {
                const int src = 32 * (j >> 3) + 16 * ((j >> 2) & 1) + 8 * ((j >> 1) & 1) + 4 * (j & 1);
                const float wj = __uint_as_float(__builtin_amdgcn_readlane(__float_as_uint(w), src));
                const f32x2v wj2 = {wj, wj};
                const unsigned wd[4] = {vv[j].x, vv[j].y, vv[j].z, vv[j].w};
#pragma unroll
                for (int q = 0; q < 4; ++q) { y2[2 * q] = __builtin_amdgcn_cvt_pk_f32_fp8(wd[q], false) * wj2 + y2[2 * q]; y2[2 * q + 1] = __builtin_amdgcn_cvt_pk_f32_fp8(wd[q], true) * wj2 + y2[2 * q + 1]; }
            }
        }
        const int b = (p.tok0 + tok) / SEQ;
        const float* mod = p.MOD + ((size_t)l * BATCH + b) * 6 * D;
        float v[16], gt[16];
        load16c(v, X1 + (size_t)tok * D, lane); load16c(gt, mod + 5 * D, lane);
        {
            const float mean1 = p.STATS[2 * (size_t)tok], rstd1 = p.STATS[2 * (size_t)tok + 1];
            float g1[16], b1[16]; load16c(g1, p.in[17] + l * D, lane); load16c(b1, p.in[18] + l * D, lane);
#pragma unroll
            for (int i = 0; i < 16; ++i) v[i] = (v[i] - mean1) * rstd1 * g1[i] + b1[i];
        }
#pragma unroll
        for (int i = 0; i < 8; ++i) { v[2 * i] = DN_ALPHA * v[2 * i] + (1.f + gt[2 * i]) * y2[i].x; v[2 * i + 1] = DN_ALPHA * v[2 * i + 1] + (1.f + gt[2 * i + 1]) * y2[i].y; }
        ln16c(v, p.in[23] + l * D, p.in[24] + l * D, lane);
        store16c(xout + (size_t)tok * D, v, lane);
        if (l + 1 < DEPTH) { const float* modn = p.MOD + ((size_t)(l + 1) * BATCH + b) * 6 * D; store_mod16c(p.H + (size_t)tok * D, v, modn, modn + D, lane); }
    }
}
#ifndef P6_NR
#define P6_NR 8
#endif
constexpr int NR = P6_NR, RSH = (NR == 16) ? 10 : (NR == 8) ? 11 : (NR == 4) ? 12 : (NR == 2) ? 13 : 14;

DI void p6x_combine(const Params& p, int l, int tokb, unsigned* LA, unsigned* LB, unsigned* Ee, float* Eg, float* Es, int lane) {
    const int ti = lane >> 3, head = lane & 7;
    const unsigned* src = p.TOPK + ((size_t)(tokb + ti) * 16 + head * 2) * 16;
    unsigned A[16], B[16];
#pragma unroll
    for (int q = 0; q < 4; ++q) { const u32x4 a = *(const u32x4*)(src + 4 * q), b = *(const u32x4*)(src + 16 + 4 * q);
        A[4 * q] = a.x; A[4 * q + 1] = a.y; A[4 * q + 2] = a.z; A[4 * q + 3] = a.w; B[4 * q] = b.x; B[4 * q + 1] = b.y; B[4 * q + 2] = b.z; B[4 * q + 3] = b.w;
        *(u32x4*)(LA + lane * 16 + 4 * q) = a; *(u32x4*)(LB + lane * 16 + 4 * q) = b; }
    float sA[16], sB[16];
#pragma unroll
    for (int k = 0; k < 16; ++k) { sA[k] = funord(A[k] & ~0x7fu); sB[k] = funord(B[k] & ~0x7fu); }
    unsigned T[16];
#pragma unroll
    for (int k = 0; k < 16; ++k) T[k] = 0u;
#pragma unroll
    for (int a = 0; a < 16; ++a)
#pragma unroll
        for (int b = 0; b < 16; ++b)
            if ((a + 1) * (b + 1) <= 16) {
                unsigned v = (ford(sA[a] + sB[b]) & ~0xffu) | (unsigned)(a * 16 + b);
#pragma unroll
                for (int k = 0; k < 16; ++k) { const unsigned t = max(T[k], v); v = min(T[k], v); T[k] = t; }
            }
    float ex[16]; float sum = 0.f; const float mx = funord(T[0] & ~0xffu);
    unsigned ev[16];
#pragma unroll
    for (int k = 0; k < 16; ++k) { ex[k] = __expf(funord(T[k] & ~0xffu) - mx); sum += ex[k];
        const unsigned cid = T[k] & 0xffu; ev[k] = (LA[lane * 16 + (cid >> 4)] & 0x7fu) * 128u + (LB[lane * 16 + (cid & 15u)] & 0x7fu); }
    const float inv = 1.f / sum;
    const float* US = p.US + l * 16384; const float* VS = p.VS + l * 16384;
    float su[16], gv[16];
#pragma unroll
    for (int k = 0; k < 16; ++k) { su[k] = US[ev[k]]; gv[k] = ex[k] * inv * VS[ev[k]]; }
    unsigned* cnt = LB; unsigned* off = LB + 8 * NR; unsigned* cur = LB + 16 * NR;
    for (int i = lane; i < 24 * NR; i += 64) LB[i] = 0u;
#pragma unroll
    for (int k = 0; k < 16; ++k) atomicAdd(&cnt[ti * NR + (ev[k] >> RSH)], 1u);
    {
#pragma unroll
        for (int rb = 0; rb < NR; rb += 8) {
            unsigned s = 0u;
#pragma unroll
            for (int r = 0; r < NR; ++r) { const unsigned c = cnt[ti * NR + r]; if (r < head + rb) s += c; }
            if (head + rb < NR) off[ti * NR + head + rb] = s;
        }
    }
#pragma unroll
    for (int k = 0; k < 16; ++k) {
        const int r = ev[k] >> RSH;
        const unsigned pos = off[ti * NR + r] + atomicAdd(&cur[ti * NR + r], 1u);
        Ee[ti * 128 + pos] = ev[k]; Eg[ti * 128 + pos] = gv[k]; Es[ti * 128 + pos] = su[k];
    }
}

DI float gelu_fast(float v) {
    const float av = fabsf(v), t = __builtin_amdgcn_rcpf(av * 0.2316418882f + 1.0f);
    float q = t * 0.5307027145f + (-0.7265760135f); q = q * t + 0.7107068705f; q = q * t + (-0.142248368f); q = q * t + 0.127414796f; q = q * t;
    const float e = __builtin_amdgcn_exp2f((v * v) * (-0.72134752044f));
    const float m = v * (q * e);
    return v < 0.f ? m : v - m;
}
template <bool DRY> DI void p6x_ids(unsigned (&en)[8], const unsigned* Ee, unsigned desc) {
    const int ebase = desc & 0x3ff, n = (desc >> 10) & 0xf;
#pragma unroll
    for (int j = 0; j < 8; ++j) en[j] = (__builtin_amdgcn_readfirstlane(Ee[ebase + (j < n ? j : 0)]) & (DRY ? 1023u : 0xffffu)) * (unsigned)D;
}
typedef __amdgpu_buffer_rsrc_t rsrc_t;
DI u32x4 rowload(rsrc_t r, int voff, unsigned soff) { return __builtin_amdgcn_raw_buffer_load_b128(r, voff, (int)soff, 0); }
DI void p6x_issue(u32x4 (&buf)[8], rsrc_t T8, const unsigned (&en)[8], int voff) {
#pragma unroll
    for (int j = 0; j < 8; ++j) buf[j] = rowload(T8, voff, en[j]);
}
template <int CTRL> DI float dppf(float v) { return __uint_as_float(__builtin_amdgcn_mov_dpp(__float_as_uint(v), CTRL, 0xf, 0xf, true)); }
DI float pair32(float x, float y) { auto r = __builtin_amdgcn_permlane32_swap(__float_as_uint(x), __float_as_uint(y), false, false); return __uint_as_float(r[0]) + __uint_as_float(r[1]); }
DI float pair16(float x, float y) { auto r = __builtin_amdgcn_permlane16_swap(__float_as_uint(x), __float_as_uint(y), false, false); return __uint_as_float(r[0]) + __uint_as_float(r[1]); }
DI float p6x_dots(u32x4 (&uu)[8], rsrc_t U8, const unsigned (&en)[8], bool refill, u32x4 (&hw)[2], const bf16* hnext, const float* Eg, const float* Es, unsigned desc,
                  int lane, int jl, bool b5, bool b4, bool b3) {
    const int ebase = desc & 0x3ff, n = (desc >> 10) & 0xf;
    float a[8];
    {
        f32x2v hf[8];
#pragma unroll
        for (int i = 0; i < 8; ++i) { const unsigned hwi = (i < 4) ? hw[0][i & 3] : hw[1][i & 3]; hf[i] = (f32x2v){bflo(hwi), bfhi(hwi)}; }
#pragma unroll
        for (int j = 0; j < 8; ++j) {
            f32x2v acc0 = __builtin_amdgcn_cvt_pk_f32_fp8(uu[j].x, false) * hf[0];
            f32x2v acc1 = __builtin_amdgcn_cvt_pk_f32_fp8(uu[j].x, true) * hf[1];
            acc0 = __builtin_amdgcn_cvt_pk_f32_fp8(uu[j].y, false) * hf[2] + acc0;
            acc1 = __builtin_amdgcn_cvt_pk_f32_fp8(uu[j].y, true) * hf[3] + acc1;
            acc0 = __builtin_amdgcn_cvt_pk_f32_fp8(uu[j].z, false) * hf[4] + acc0;
            acc1 = __builtin_amdgcn_cvt_pk_f32_fp8(uu[j].z, true) * hf[5] + acc1;
            acc0 = __builtin_amdgcn_cvt_pk_f32_fp8(uu[j].w, false) * hf[6] + acc0;
            acc1 = __builtin_amdgcn_cvt_pk_f32_fp8(uu[j].w, true) * hf[7] + acc1;
            acc0 += acc1;
            a[j] = acc0.x + acc0.y;
        }
    }
    __builtin_amdgcn_sched_barrier(0);
    hw[0] = *(const u32x4*)hnext; hw[1] = *(const u32x4*)(hnext + 8);
#pragma unroll
    for (int j = 0; j < 8; ++j) uu[j] = rowload(U8, lane * 16, en[j]);
    __builtin_amdgcn_sched_barrier(0);
    float k1[4], k2[2], k3;
#pragma unroll
    for (int i = 0; i < 4; ++i) k1[i] = pair32(a[i], a[4 + i]);
#pragma unroll
    for (int i = 0; i < 2; ++i) k2[i] = pair16(k1[i], k1[2 + i]);
    { const float snd = b3 ? k2[0] : k2[1]; k3 = (b3 ? k2[1] : k2[0]) + dppf<0x128>(snd); }
    k3 += dppf<0x141>(k3);
    k3 += dppf<0xB1>(k3);
    k3 += dppf<0x4E>(k3);
    const int ei = ebase + (jl < n ? jl : 0);
    return (jl < n) ? Eg[ei] * gelu_fast(k3 * Es[ei]) : 0.f;
}
DI void p6x_axpy(u32x4 (&vv)[8], rsrc_t V8, const unsigned (&en)[8], bool refill, float w, f32x2v (&y2)[8], int lane) {
#pragma unroll
    for (int j = 0; j < 8; ++j) {
        const int src = 32 * (j >> 2) + 16 * ((j >> 1) & 1) + 8 * (j & 1);
        const float wj = __uint_as_float(__builtin_amdgcn_readlane(__float_as_uint(w), src));
        const f32x2v wj2 = {wj, wj};
        const unsigned wd[4] = {vv[j].x, vv[j].y, vv[j].z, vv[j].w};
#pragma unroll
        for (int q = 0; q < 4; ++q) { y2[2 * q] = __builtin_amdgcn_cvt_pk_f32_fp8(wd[q], false) * wj2 + y2[2 * q]; y2[2 * q + 1] = __builtin_amdgcn_cvt_pk_f32_fp8(wd[q], true) * wj2 + y2[2 * q + 1]; }
    }
    __builtin_amdgcn_sched_barrier(0);
#pragma unroll
    for (int j = 0; j < 8; ++j) vv[j] = rowload(V8, lane * 16, en[j]);
    __builtin_amdgcn_sched_barrier(0);
}
#define P6X_AXPY(T) p6x_axpy(V, V8, en, more, w_, y2[T], lane)

template <bool DRY> DI void p6x_block(const Params& p, int l, int tok_first, int ntok, const float* X1, float* xout, char* lds) {
    int tid_ = threadIdx.x; asm volatile("" : "+v"(tid_)); const int tid = tid_, lane = tid & 63;
    const int wv = __builtin_amdgcn_readfirstlane(tid >> 6);
    unsigned* LA = (unsigned*)(lds + wv * 16384); unsigned* LB = LA + 1024; unsigned* Ee = LA + 2048; float* Eg = (float*)(LA + 3072); float* Es = (float*)LA;
    const unsigned* cnt = LB; const unsigned* off = LB + 8 * NR; unsigned* dl = LB + 24 * NR;
    const rsrc_t U8 = __builtin_amdgcn_make_buffer_rsrc((void*)p.U8, 0, 16384 * D, 0x00020000), V8 = __builtin_amdgcn_make_buffer_rsrc((void*)p.V8, 0, 16384 * D, 0x00020000);
    const int jl = 4 * (lane >> 5) + 2 * ((lane >> 4) & 1) + ((lane >> 3) & 1);
    const bool b5 = lane & 32, b4 = lane & 16, b3 = lane & 8;
    const int per_wave = ntok >> 2;
    __syncthreads();
#pragma unroll 1
    for (int g8 = 0; g8 < per_wave; g8 += 8) {
        const int tokb = tok_first + wv * per_wave + g8;
        { int lc = lane; asm volatile("" : "+v"(lc)); p6x_combine(p, l, tokb, LA, LB, Ee, Eg, Es, lc); }
#pragma unroll 1
        for (int sw = 0; sw < 2; ++sw) {
            int nd;
            {
                int lane_d = lane; asm volatile("" : "+v"(lane_d));
                const bool rev = ((g8 >> 3) * 2 + sw) & 1;
                const int rr = (lane_d >> 2) & (NR - 1), t = lane_d & 3, r = rev ? (NR - 1 - rr) : rr, ti = sw * 4 + t;
                const int n = (lane_d < 4 * NR) ? (int)cnt[ti * NR + r] : 0, base = (int)off[ti * NR + r];
                const int nbat = (n + 7) >> 3;
                int incl = nbat;
#pragma unroll
                for (int o = 1; o < 64; o <<= 1) { const int up = __shfl_up(incl, o); if (lane_d >= o) incl += up; }
                const int start = incl - nbat;
                for (int k = 0; k < nbat; ++k) { const int rem = n - 8 * k; dl[start + k] = ((unsigned)t << 14) | ((unsigned)(rem < 8 ? rem : 8) << 10) | (unsigned)(ti * 128 + base + 8 * k); }
                nd = __builtin_amdgcn_readlane(incl, 63);
            }
            f32x2v y2[4][8];
#pragma unroll
            for (int t = 0; t < 4; ++t)
#pragma unroll
                for (int i = 0; i < 8; ++i) y2[t][i] = (f32x2v){0.f, 0.f};
            const bf16* hbase = p.H + (size_t)(tokb + sw * 4) * D + lane * 16;
            u32x4 U[8], V[8]; unsigned en[8];
            unsigned dA = __builtin_amdgcn_readfirstlane(dl[0]);
            u32x4 hw[2];
            if (nd > 0) { p6x_ids<DRY>(en, Ee, dA); p6x_issue(U, U8, en, lane * 16); p6x_issue(V, V8, en, lane * 16); const bf16* hr = hbase + (size_t)(dA >> 14) * D; hw[0] = *(const u32x4*)hr; hw[1] = *(const u32x4*)(hr + 8); }
#pragma unroll 1
            for (int i = 0; i < nd; ++i) {
                const bool more = i + 1 < nd;
                const unsigned dB = __builtin_amdgcn_readfirstlane(dl[more ? i + 1 : i]);
                p6x_ids<DRY>(en, Ee, dB);
                const int t_ = (int)(dA >> 14);
                const float w_ = p6x_dots(U, U8, en, more, hw, hbase + (size_t)(dB >> 14) * D, Eg, Es, dA, lane, jl, b5, b4, b3);
                switch (t_) { case 0: P6X_AXPY(0); break; case 1: P6X_AXPY(1); break; case 2: P6X_AXPY(2); break; default: P6X_AXPY(3); break; }
                dA = dB;
            }
#pragma unroll
            for (int t = 0; t < 4; ++t) {
                int lane_e = lane; asm volatile("" : "+v"(lane_e));
                const int tok = tokb + sw * 4 + t;
                const int b = (p.tok0 + tok) / SEQ;
                const float* mod = p.MOD + ((size_t)l * BATCH + b) * 6 * D;
                float v[16], gt[16];
                load16c(v, X1 + (size_t)tok * D, lane_e); load16c(gt, mod + 5 * D, lane_e);
#pragma unroll
                for (int i = 0; i < 8; ++i) { v[2 * i] = DN_ALPHA * v[2 * i] + (1.f + gt[2 * i]) * y2[t][i].x; v[2 * i + 1] = DN_ALPHA * v[2 * i + 1] + (1.f + gt[2 * i + 1]) * y2[t][i].y; }
                ln16c(v, p.in[23] + l * D, p.in[24] + l * D, lane_e);
                if (DRY) {
#pragma unroll
                    for (int i = 0; i < 16; ++i) asm volatile("" :: "v"(v[i]));
                    continue; }
                store16c(xout + (size_t)tok * D, v, lane_e);
                if (l + 1 < DEPTH) { const float* modn = p.MOD + ((size_t)(l + 1) * BATCH + b) * 6 * D; store_mod16c(p.H + (size_t)tok * D, v, modn, modn + D, lane_e); }
                __builtin_amdgcn_sched_barrier(0);
            }
        }
    }
}
#ifdef P6_NOPTAIL
#define P6_TAILNOP "\n\ts_nop 7\n\ts_nop 7\n\ts_nop 7\n\ts_nop 7\n\ts_nop 7\n\ts_nop 7\n\ts_nop 7\n\ts_nop 7"
#else
#define P6_TAILNOP
#endif
#ifdef P6C_SAFE
#define P6C_W10 "s_waitcnt vmcnt(0)"
#else
#define P6C_W10 "s_waitcnt vmcnt(10)"
#endif

DI u32x4 p6a_rsrc(const unsigned char* base) {
    const unsigned long long a = (unsigned long long)base;
    u32x4 r; r.x = __builtin_amdgcn_readfirstlane((unsigned)a); r.y = __builtin_amdgcn_readfirstlane((unsigned)(a >> 32) & 0xffffu); r.z = 16384u * (unsigned)D; r.w = 0x00020000u;
    return r;
}
#ifndef P6_DRYMODE
#define P6_DRYMODE 0
#endif
#ifndef P6_FULLBATCH
#define P6_FULLBATCH 0
#endif
#ifndef P6_LDMOD
#define P6_LDMOD ""
#endif
#ifndef P6_SWEEPSYNC
#define P6_SWEEPSYNC 0
#endif
#ifndef P6_DRYMASK
#define P6_DRYMASK 0
#endif
template <bool DRY> DI void p6a_ids(unsigned (&en)[8], const unsigned* Ee, unsigned desc, int lane) {
    const int ebase = desc & 0x3ff, n = (desc >> 10) & 0xf, j = lane & 7;
    const unsigned ev = (Ee[ebase + (j < n ? j : 0)] & ((DRY && (P6_DRYMODE == 1 || P6_DRYMASK)) ? 1023u : 0xffffu)) * (unsigned)D;
#pragma unroll
    for (int k = 0; k < 8; ++k) en[k] = __builtin_amdgcn_readlane(ev, k);
}
DI void p6a_load8(u32x4 (&b)[8], u32x4 rsrc, int voff, const unsigned (&so)[8]) {
    asm volatile("s_nop 4\n\t"
        "buffer_load_dwordx4 %0, %8, %9, %10 offen" P6_LDMOD "\n\t" "buffer_load_dwordx4 %1, %8, %9, %11 offen" P6_LDMOD "\n\t" "buffer_load_dwordx4 %2, %8, %9, %12 offen" P6_LDMOD "\n\t" "buffer_load_dwordx4 %3, %8, %9, %13 offen" P6_LDMOD "\n\t"
        "buffer_load_dwordx4 %4, %8, %9, %14 offen" P6_LDMOD "\n\t" "buffer_load_dwordx4 %5, %8, %9, %15 offen" P6_LDMOD "\n\t" "buffer_load_dwordx4 %6, %8, %9, %16 offen" P6_LDMOD "\n\t" "buffer_load_dwordx4 %7, %8, %9, %17 offen" P6_LDMOD P6_TAILNOP
        : "=&v"(b[0]), "=&v"(b[1]), "=&v"(b[2]), "=&v"(b[3]), "=&v"(b[4]), "=&v"(b[5]), "=&v"(b[6]), "=&v"(b[7])
        : "v"(voff), "s"(rsrc), "s"(so[0]), "s"(so[1]), "s"(so[2]), "s"(so[3]), "s"(so[4]), "s"(so[5]), "s"(so[6]), "s"(so[7])
        : "memory");
}
DI void p6a_loadh(u32x4 (&h)[2], const bf16* src) {
    asm volatile("global_load_dwordx4 %0, %2, off\n\tglobal_load_dwordx4 %1, %2, off offset:16" : "=&v"(h[0]), "=&v"(h[1]) : "v"(src) : "memory");
}
DI void p6a_wait_hu(u32x4 (&h)[2], u32x4 (&b)[8]) {
    asm volatile("s_waitcnt vmcnt(8)" : "+v"(h[0]), "+v"(h[1]), "+v"(b[0]), "+v"(b[1]), "+v"(b[2]), "+v"(b[3]), "+v"(b[4]), "+v"(b[5]), "+v"(b[6]), "+v"(b[7]) :: "memory");
}
DI void p6a_wait_v(u32x4 (&b)[8]) {
    asm volatile(P6C_W10  : "+v"(b[0]), "+v"(b[1]), "+v"(b[2]), "+v"(b[3]), "+v"(b[4]), "+v"(b[5]), "+v"(b[6]), "+v"(b[7]) :: "memory");
}
DI void p6a_drain(u32x4 (&h)[2], u32x4 (&u)[8], u32x4 (&v)[8]) {
    asm volatile("s_waitcnt vmcnt(0)" : "+v"(h[0]), "+v"(h[1]), "+v"(u[0]), "+v"(u[1]), "+v"(u[2]), "+v"(u[3]), "+v"(u[4]), "+v"(u[5]), "+v"(u[6]), "+v"(u[7]),
                                        "+v"(v[0]), "+v"(v[1]), "+v"(v[2]), "+v"(v[3]), "+v"(v[4]), "+v"(v[5]), "+v"(v[6]), "+v"(v[7]) :: "memory");
}
DI void p6a_dot8(float (&a)[8], const u32x4 (&uu)[8], const u32x4 (&hw)[2]) {
    f32x2v hf[8];
#pragma unroll
    for (int i = 0; i < 8; ++i) { const unsigned hwi = (i < 4) ? hw[0][i & 3] : hw[1][i & 3]; hf[i] = (f32x2v){bflo(hwi), bfhi(hwi)}; }
#pragma unroll
    for (int j = 0; j < 8; ++j) {
        f32x2v acc0 = __builtin_amdgcn_cvt_pk_f32_fp8(uu[j].x, false) * hf[0];
        f32x2v acc1 = __builtin_amdgcn_cvt_pk_f32_fp8(uu[j].x, true) * hf[1];
        acc0 = __builtin_amdgcn_cvt_pk_f32_fp8(uu[j].y, false) * hf[2] + acc0;
        acc1 = __builtin_amdgcn_cvt_pk_f32_fp8(uu[j].y, true) * hf[3] + acc1;
        acc0 = __builtin_amdgcn_cvt_pk_f32_fp8(uu[j].z, false) * hf[4] + acc0;
        acc1 = __builtin_amdgcn_cvt_pk_f32_fp8(uu[j].z, true) * hf[5] + acc1;
        acc0 = __builtin_amdgcn_cvt_pk_f32_fp8(uu[j].w, false) * hf[6] + acc0;
        acc1 = __builtin_amdgcn_cvt_pk_f32_fp8(uu[j].w, true) * hf[7] + acc1;
        acc0 += acc1;
        a[j] = acc0.x + acc0.y;
    }
}
DI float p6a_reduce_gate(const float (&a)[8], const float* Eg, const float* Es, unsigned desc, int jl, bool b3) {
    const int ebase = desc & 0x3ff, n = (desc >> 10) & 0xf;
    float k1[4], k2[2], k3;
#pragma unroll
    for (int i = 0; i < 4; ++i) k1[i] = pair32(a[i], a[4 + i]);
#pragma unroll
    for (int i = 0; i < 2; ++i) k2[i] = pair16(k1[i], k1[2 + i]);
    { const float snd = b3 ? k2[0] : k2[1]; k3 = (b3 ? k2[1] : k2[0]) + dppf<0x128>(snd); }
    k3 += dppf<0x141>(k3); k3 += dppf<0xB1>(k3); k3 += dppf<0x4E>(k3);
    const int ei = ebase + (jl < n ? jl : 0);
    return (jl < n) ? Eg[ei] * gelu_fast(k3 * Es[ei]) : 0.f;
}
DI void p6a_axpy8(const u32x4 (&vv)[8], float w, f32x2v (&y2)[8]) {
#pragma unroll
    for (int j = 0; j < 8; ++j) {
        const int src = 32 * (j >> 2) + 16 * ((j >> 1) & 1) + 8 * (j & 1);
        const float wj = __uint_as_float(__builtin_amdgcn_readlane(__float_as_uint(w), src));
        const f32x2v wj2 = {wj, wj};
        const unsigned wd[4] = {vv[j].x, vv[j].y, vv[j].z, vv[j].w};
#pragma unroll
        for (int q = 0; q < 4; ++q) { y2[2 * q] = __builtin_amdgcn_cvt_pk_f32_fp8(wd[q], false) * wj2 + y2[2 * q]; y2[2 * q + 1] = __builtin_amdgcn_cvt_pk_f32_fp8(wd[q], true) * wj2 + y2[2 * q + 1]; }
    }
}
template <bool DRY> DI void p6a_block(const Params& p, int l, int tok_first, int ntok, const float* X1, float* xout, char* lds) {
    int tid_ = threadIdx.x; asm volatile("" : "+v"(tid_)); const int tid = tid_, lane = tid & 63;
    const int wv = __builtin_amdgcn_readfirstlane(tid >> 6);
    unsigned* LA = (unsigned*)(lds + wv * 16384); unsigned* LB = LA + 1024; unsigned* Ee = LA + 2048; float* Eg = (float*)(LA + 3072); float* Es = (float*)LA;
    const unsigned* cnt = LB; const unsigned* off = LB + 8 * NR; unsigned* dl = LB + 24 * NR;
    const u32x4 rU = p6a_rsrc(p.U8), rV = p6a_rsrc(p.V8);
    const int jl = 4 * (lane >> 5) + 2 * ((lane >> 4) & 1) + ((lane >> 3) & 1);
    const bool b5 = lane & 32, b4 = lane & 16, b3 = lane & 8;
    const int per_wave = ntok >> 2;
    __syncthreads();
#pragma unroll 1
    for (int g8 = 0; g8 < per_wave; g8 += 8) {
        const int tokb = tok_first + wv * per_wave + g8;
        { int lc = lane; asm volatile("" : "+v"(lc)); p6x_combine(p, l, tokb, LA, LB, Ee, Eg, Es, lc); }
#pragma unroll 1
        for (int sw = 0; sw < 2; ++sw) {
            int nd;
#if P6_FULLBATCH
            {
                int lane_d = lane; asm volatile("" : "+v"(lane_d));
                const bool rev = ((g8 >> 3) * 2 + sw) & 1;
                const int kk = lane_d >> 2, t = lane_d & 3, k = rev ? (15 - kk) : kk, ti = sw * 4 + t;
                dl[lane_d] = ((unsigned)t << 14) | (8u << 10) | (unsigned)(ti * 128 + 8 * k);
                nd = 64; asm volatile("" : "+s"(nd));
            }
#else
            {
                int lane_d = lane; asm volatile("" : "+v"(lane_d));
                const bool rev = ((g8 >> 3) * 2 + sw) & 1;
                const int rr = (lane_d >> 2) & (NR - 1), t = lane_d & 3, r = rev ? (NR - 1 - rr) : rr, ti = sw * 4 + t;
                const int n = (lane_d < 4 * NR) ? (int)cnt[ti * NR + r] : 0, base = (int)off[ti * NR + r];
                const int nbat = (n + 7) >> 3;
                int incl = nbat;
#pragma unroll
                for (int o = 1; o < 64; o <<= 1) { const int up = __shfl_up(incl, o); if (lane_d >= o) incl += up; }
                const int start = incl - nbat;
                for (int k = 0; k < nbat; ++k) { const int rem = n - 8 * k; dl[start + k] = ((unsigned)t << 14) | ((unsigned)(rem < 8 ? rem : 8) << 10) | (unsigned)(ti * 128 + base + 8 * k); }
                nd = __builtin_amdgcn_readlane(incl, 63);
            }
#endif
#if P6_SWEEPSYNC
            { XcdBarrier xb_; xb_.bar = p.ctr + 4096; xb_.x = xb_xcc_id(); xb_.st = (volatile LAS unsigned*)(lds + LDS_TOTAL - 32); xcd_barrier(xb_); }
#endif
            f32x2v y2[4][8];
#pragma unroll
            for (int t = 0; t < 4; ++t)
#pragma unroll
                for (int i = 0; i < 8; ++i) y2[t][i] = (f32x2v){0.f, 0.f};
            const bf16* hbase = p.H + (size_t)(tokb + sw * 4) * D + lane * 16;
            u32x4 U[8], V[8], hw[2]; unsigned en[8];
            asm volatile("s_waitcnt vmcnt(0)" ::: "memory");
            unsigned dA = __builtin_amdgcn_readfirstlane(dl[0]);
            { p6a_ids<DRY>(en, Ee, dA, lane); p6a_loadh(hw, hbase + (size_t)(dA >> 14) * D); p6a_load8(U, rU, lane * 16, en); p6a_load8(V, rV, lane * 16, en); }
#pragma unroll 1
            for (int i = 0; i < nd; ++i) {
                const unsigned dB = __builtin_amdgcn_readfirstlane(dl[i + 1 < nd ? i + 1 : i]);
                p6a_ids<DRY>(en, Ee, dB, lane);
                const int t_ = (int)(dA >> 14);
                if (DRY && P6_DRYMODE == 4) p6a_drain(hw, U, V); else if (!(DRY && P6_DRYMODE == 2)) p6a_wait_hu(hw, U);
                float a[8];
                if (DRY && (P6_DRYMODE == 3 || P6_DRYMODE == 4)) {
#pragma unroll
                    for (int j = 0; j < 8; ++j) a[j] = __uint_as_float(U[j].x); }
                else p6a_dot8(a, U, hw);
                __builtin_amdgcn_sched_barrier(0);
                if (!(DRY && P6_DRYMODE == 2)) { p6a_loadh(hw, hbase + (size_t)(dB >> 14) * D); p6a_load8(U, rU, lane * 16, en); }
                __builtin_amdgcn_sched_barrier(0);
                const float w_ = p6a_reduce_gate(a, Eg, Es, dA, jl, b3);
                if (!(DRY && (P6_DRYMODE == 2 || P6_DRYMODE == 4))) p6a_wait_v(V);
                if (DRY && (P6_DRYMODE == 3 || P6_DRYMODE == 4)) { y2[0][0].x += w_ * __uint_as_float(V[0].x ^ V[1].x ^ V[2].x ^ V[3].x ^ V[4].x ^ V[5].x ^ V[6].x ^ V[7].x); } else
                switch (t_) { case 0: p6a_axpy8(V, w_, y2[0]); break; case 1: p6a_axpy8(V, w_, y2[1]); break; case 2: p6a_axpy8(V, w_, y2[2]); break; default: p6a_axpy8(V, w_, y2[3]); break; }
                __builtin_amdgcn_sched_barrier(0);
                if (!(DRY && (P6_DRYMODE == 2 || P6_DRYMODE == 4))) p6a_load8(V, rV, lane * 16, en);
                __builtin_amdgcn_sched_barrier(0);
                dA = dB;
            }
            p6a_drain(hw, U, V);
#pragma unroll
            for (int t = 0; t < 4; ++t) {
                int lane_e = lane; asm volatile("" : "+v"(lane_e));
                const int tok = tokb + sw * 4 + t;
                const int b = (p.tok0 + tok) / SEQ;
                const float* mod = p.MOD + ((size_t)l * BATCH + b) * 6 * D;
                float v[16], gt[16];
                load16c(v, X1 + (size_t)tok * D, lane_e); load16c(gt, mod + 5 * D, lane_e);
                {
                    const float mean1 = p.STATS[2 * (size_t)tok], rstd1 = p.STATS[2 * (size_t)tok + 1];
                    float g1[16], b1[16]; load16c(g1, p.in[17] + l * D, lane_e); load16c(b1, p.in[18] + l * D, lane_e);
#pragma unroll
                    for (int i = 0; i < 16; ++i) v[i] = (v[i] - mean1) * rstd1 * g1[i] + b1[i];
                }
#pragma unroll
                for (int i = 0; i < 8; ++i) { v[2 * i] = DN_ALPHA * v[2 * i] + (1.f + gt[2 * i]) * y2[t][i].x; v[2 * i + 1] = DN_ALPHA * v[2 * i + 1] + (1.f + gt[2 * i + 1]) * y2[t][i].y; }
                ln16c(v, p.in[23] + l * D, p.in[24] + l * D, lane_e);
                if (DRY) {
#pragma unroll
                    for (int i = 0; i < 16; ++i) asm volatile("" :: "v"(v[i]));
                    continue; }
                store16c(xout + (size_t)tok * D, v, lane_e);
                if (l + 1 < DEPTH) { const float* modn = p.MOD + ((size_t)(l + 1) * BATCH + b) * 6 * D; store_mod16c(p.H + (size_t)tok * D, v, modn, modn + D, lane_e); }
                __builtin_amdgcn_sched_barrier(0);
            }
        }
    }
}
#define XB_TMO      128
#define XB_XCNT(j)  (256  + 64 * (j))
#define XB_XSUB(j)  (1280 + 64 * (j))
#define XB_XGEN(j)  (2304 + 64 * (j))
#define XB_TOP      3328
#define XB_TOPGEN   3392
#define XCD_BAR_WORDS 3456
#define XB_SPIN_CAP (1u << 22)
#define LAS __attribute__((address_space(3)))
DI unsigned xb_ld(unsigned* p)              { return __hip_atomic_load(p, __ATOMIC_RELAXED, __HIP_MEMORY_SCOPE_AGENT); }
DI unsigned xb_add(unsigned* p, unsigned v) { return __hip_atomic_fetch_add(p, v, __ATOMIC_RELAXED, __HIP_MEMORY_SCOPE_AGENT); }
DI unsigned xb_xcc_id() { return (unsigned)__builtin_amdgcn_s_getreg((3 << 11) | 20) & 0xFu; }
#define XB_SPIN(cond, bar) do { unsigned _sp = 0; while (cond) { __builtin_amdgcn_s_sleep(1); \
    if ((++_sp & 255u) == 0u) { if (xb_ld(&(bar)[XB_TMO])) break; if (_sp > XB_SPIN_CAP) { atomicAdd(&(bar)[XB_TMO], 1u); break; } } } } while (0)
struct XcdBarrier { unsigned* bar; unsigned x; volatile LAS unsigned* st; };
DI XcdBarrier xcd_barrier_post(unsigned* bar, volatile LAS unsigned* st) {
    XcdBarrier b; b.bar = bar; b.x = xb_xcc_id(); b.st = st;
    if (threadIdx.x == 0) st[2] = xb_add(&bar[XB_XCNT(b.x)], 1u);
    return b;
}
DI void xcd_barrier_complete(unsigned* bar, unsigned x, unsigned& nloc, unsigned& nx) {
    const unsigned G = gridDim.x * gridDim.y * gridDim.z;
    unsigned sum, cnt, mine, sp = 0u;
    for (;;) {
        sum = 0u; cnt = 0u; mine = 0u;
#pragma unroll
        for (unsigned j = 0; j < 16; ++j) { const unsigned c = xb_ld(&bar[XB_XCNT(j)]); sum += c; cnt += (c > 0u) ? 1u : 0u; mine = (j == x) ? c : mine; }
        if (sum == G) break;
        __builtin_amdgcn_s_sleep(1);
        if ((++sp & 255u) == 0u) { if (xb_ld(&bar[XB_TMO])) break; if (sp > XB_SPIN_CAP) { atomicAdd(&bar[XB_TMO], 1u); break; } }
    }
    nloc = mine > 0u ? mine : 1u; nx = cnt > 0u ? cnt : 1u;
}
DI void xcd_barrier(const XcdBarrier& b) {
    asm volatile("s_waitcnt vmcnt(0)" ::: "memory");
    __syncthreads();
    if (threadIdx.x == 0) {
        unsigned* bar = b.bar;
        __builtin_amdgcn_s_waitcnt(0);
        unsigned nloc = b.st[0], nx = b.st[1];
        if (nloc == 0u) { xcd_barrier_complete(bar, b.x, nloc, nx); b.st[0] = nloc; b.st[1] = nx; }
        const unsigned old = xb_add(&bar[XB_XSUB(b.x)], 1u);
        const unsigned gen = old / nloc;
        if (old + 1u == (gen + 1u) * nloc) {
            __builtin_amdgcn_fence(__ATOMIC_RELEASE, "agent");
            asm volatile("s_waitcnt vmcnt(0)" ::: "memory");
            const unsigned og = xb_add(&bar[XB_TOP], 1u);
            const unsigned tg = og / nx;
            if (og + 1u == (tg + 1u) * nx) xb_add(&bar[XB_TOPGEN], 1u);
            else XB_SPIN(xb_ld(&bar[XB_TOPGEN]) == tg, bar);
            __builtin_amdgcn_fence(__ATOMIC_ACQUIRE, "agent");
            xb_add(&bar[XB_XGEN(b.x)], 1u);
            asm volatile("s_waitcnt vmcnt(0)" ::: "memory");
        } else {
            XB_SPIN(xb_ld(&bar[XB_XGEN(b.x)]) == gen, bar);
            __builtin_amdgcn_fence(__ATOMIC_ACQUIRE, "agent");
            asm volatile("s_waitcnt vmcnt(0)" ::: "memory");
        }
    }
    __syncthreads();
}
DI void ada_item(const Params& p, int item, char* lds) {
    int tid_ = threadIdx.x; asm volatile("" : "+v"(tid_)); const int tid = tid_, lane = tid & 63, wv = tid >> 6;
    float* cs = (float*)lds;
    float* part = cs + 4 * D;
    __syncthreads();
    for (int i = tid; i < BATCH * D; i += 256) { const float cv = p.in[1][i]; cs[i] = cv / (1.f + __expf(-cv)); }
    __syncthreads();
    const int col = item * 64 + lane, l = col / (6 * D), j = col % (6 * D);
    const float* w = p.in[2] + (size_t)l * D * 6 * D + j;
    float a0 = 0.f, a1 = 0.f, a2 = 0.f, a3 = 0.f;
#pragma unroll 16
    for (int k = wv * 256; k < wv * 256 + 256; ++k) { const float wk = w[(size_t)k * 6 * D]; a0 += cs[k] * wk; a1 += cs[D + k] * wk; a2 += cs[2 * D + k] * wk; a3 += cs[3 * D + k] * wk; }
    part[(wv * 4 + 0) * 64 + lane] = a0; part[(wv * 4 + 1) * 64 + lane] = a1; part[(wv * 4 + 2) * 64 + lane] = a2; part[(wv * 4 + 3) * 64 + lane] = a3;
    __syncthreads();
    {
        const float s = part[(0 * 4 + wv) * 64 + lane] + part[(1 * 4 + wv) * 64 + lane] + part[(2 * 4 + wv) * 64 + lane] + part[(3 * 4 + wv) * 64 + lane];
        p.MOD[((size_t)l * BATCH + wv) * 6 * D + j] = s + p.in[3][l * 6 * D + j];
    }
}

DI void rope_table_item(const Params& p, int idx) {
    const int pos = idx >> 4, i = idx & 15;
    const float inv = 1.0f / powf(10000.0f, (float)(2 * i) / 32.0f);
    const float ang = (float)pos * inv;
    double fr = (double)ang * 0.15915494309189535;
    fr -= rint(fr);
    const float f = (float)fr;
    p.COS[idx] = __builtin_amdgcn_cosf(f); p.SIN[idx] = __builtin_amdgcn_sinf(f);
}

DI void convert_tables(const Params& p, int l, int bid, int nb) {
    const float* us = p.in[21] + (size_t)l * 16384 * D; const float* vs = p.in[22] + (size_t)l * 16384 * D;
    const size_t n8 = (size_t)16384 * D / 8;
    for (size_t i = (size_t)bid * 256 + threadIdx.x; i < n8; i += (size_t)nb * 256) { cvt8(us, p.Ut, i); cvt8(vs, p.Vt, i); }
}

DI void prologue(const Params& p, char* lds) {
    int tid_ = threadIdx.x; asm volatile("" : "+v"(tid_)); const int tid = tid_, lane = tid & 63, wv = tid >> 6, bid = blockIdx.x, nb = gridDim.x;
    for (int it = bid; it < DEPTH * 6 * D / 64; it += nb) ada_item(p, it, lds);
    __syncthreads();
    float* scr = (float*)(lds + wv * 16384);
    const int n_win = (D / 64) * (WIN_N / 32), n_uq = 4 * 24, n_ukv = 2 * 32, n_wo = 16 * 32, n_pq = 16 * 64, per_l = n_win + n_uq + n_ukv + n_wo + n_pq;
    for (int it = bid * 4 + wv; it < DEPTH * per_l; it += nb * 4) {
        const int l = it / per_l; int r = it % per_l;
        if (r < n_win) { transpose_item(TK_WIN, p.in[4] + (size_t)l * D * D_IN, D_IN, D, WIN_N, p.WinT + (size_t)l * WIN_N * D, nullptr, scr, r, lane); continue; } r -= n_win;
        if (r < n_uq) { transpose_item(TK_WUQ, p.in[6] + (size_t)l * 256 * 768, 768, 256, 768, p.WuqT + (size_t)l * 768 * 256, p.in[5] + l * 256, scr, r, lane); continue; } r -= n_uq;
        if (r < n_ukv) { transpose_item(TK_WUKV, p.in[8] + (size_t)l * 128 * 1024, 1024, 128, 1024, p.WukvT + (size_t)l * 1024 * 128, p.in[7] + l * 128, scr, r, lane); continue; } r -= n_ukv;
        if (r < n_wo) { transpose_item(TK_WO, p.in[16] + (size_t)l * D * D, D, D, D, p.WoT + (size_t)l * D * D, nullptr, scr, r, lane); continue; } r -= n_wo;
        transpose_item(TK_WPQ, p.in[19] + (size_t)l * D * 2048, 2048, D, 2048, p.WpqT + (size_t)l * 2048 * D, nullptr, scr, r, lane);
    }
    for (int it = bid; it < DEPTH * 1028; it += nb) fold_pw_item(p, it / 1028, it % 1028);
    for (size_t i = (size_t)bid * 256 + tid; i < (size_t)DEPTH * 16 * 128 * 128; i += (size_t)nb * 256)
        p.SKp[i] = f2bf(p.in[20][(i & ~(size_t)127) + perm16((int)(i & 127))]);
    for (int i = bid * 256 + tid; i < SEQ * 16; i += nb * 256) rope_table_item(p, i);
    convert_tables_fp8(p, 0, bid, nb);
}

DI void modh_items(const Params& p, int bid, int nb) {
    const size_t n8 = (size_t)p.rows * D / 8;
    for (size_t i = (size_t)bid * 256 + threadIdx.x; i < n8; i += (size_t)nb * 256) {
        const size_t e = i * 8; const int row = (int)(e >> 10), col = (int)(e & 1023), b = row / SEQ;
        const float* mod = p.MOD + (size_t)b * 6 * D;
        const float4 x0 = *(const float4*)(p.in[0] + e), x1 = *(const float4*)(p.in[0] + e + 4);
        const float4 h0 = *(const float4*)(mod + col), h1 = *(const float4*)(mod + col + 4), s0 = *(const float4*)(mod + D + col), s1 = *(const float4*)(mod + D + col + 4);
        u32x4 o;
        o.x = pk2(x0.x * (1.f + s0.x) + h0.x, x0.y * (1.f + s0.y) + h0.y); o.y = pk2(x0.z * (1.f + s0.z) + h0.z, x0.w * (1.f + s0.w) + h0.w);
        o.z = pk2(x1.x * (1.f + s1.x) + h1.x, x1.y * (1.f + s1.y) + h1.y); o.w = pk2(x1.z * (1.f + s1.z) + h1.z, x1.w * (1.f + s1.w) + h1.w);
        *(u32x4*)(p.H + e) = o;
    }
}

#ifndef SWA_UNIT
#define SWA_UNIT swa_unit2
#endif
#ifndef MLA_UNIT
#define MLA_UNIT mla_unit2
#endif
#ifndef P6_BLOCK
#define P6_BLOCK p6a_block
#endif
#ifndef REP_P1
#define REP_P1 1
#endif
#ifndef REP_P2
#define REP_P2 1
#endif
#ifndef REP_P3
#define REP_P3 1
#endif
#ifndef REP_P4
#define REP_P4 1
#endif
#ifndef REP_P5
#define REP_P5 1
#endif
#ifndef REP_SYNC
#define REP_SYNC 1
#endif
typedef const __attribute__((address_space(4))) Params* kparams_t;
#define LOADP(q) const Params& q = p
#define GSYNC() do { for (int rs_ = 0; rs_ < REP_SYNC; ++rs_) { XcdBarrier xb_; xb_.bar = p.ctr + 4096; xb_.x = xb_xcc_id(); xb_.st = (volatile LAS unsigned*)(lds + LDS_TOTAL - 32); xcd_barrier(xb_); } } while (0)
__global__ void __launch_bounds__(256, 2) mega(Params p) {
    extern __shared__ __attribute__((aligned(16))) char lds[];
    cg::grid_group grid = cg::this_grid();
#define bid ((int)blockIdx.x)
#define nb ((int)gridDim.x)
#define rows NTOK
#define mtiles (NTOK / 128)
    {
        if (threadIdx.x < 4) ((volatile LAS unsigned*)(lds + LDS_TOTAL - 32))[threadIdx.x] = 0u;
        __syncthreads();
    }
    (void)xcd_barrier_post(p.ctr + 4096, (volatile LAS unsigned*)(lds + LDS_TOTAL - 32));
#ifndef REP_PRO
#define REP_PRO 1
#endif
    for (int rep = 0; rep < REP_PRO; ++rep) prologue(p, lds);
    grid.sync();
    {
        volatile LAS unsigned* cw = (volatile LAS unsigned*)(lds + LDS_TOTAL - 32);
        if (threadIdx.x == 0) {
            unsigned pre = 0u, even = 1u; const unsigned myx = xb_xcc_id(); unsigned* bar_ = p.ctr + 4096;
            for (unsigned j = 0; j < 16; ++j) { const unsigned c = xb_ld(&bar_[XB_XCNT(j)]); if (j < myx) pre += c; if (j < 8 ? c * 8u != (unsigned)nb : c != 0u) even = 0u; }
            cw[3] = pre + cw[2]; cw[5] = even;
        }
        __syncthreads();
    }
#define SLOT ((int)((volatile LAS unsigned*)(lds + LDS_TOTAL - 32))[3])
#define XEVEN ((int)((volatile LAS unsigned*)(lds + LDS_TOTAL - 32))[5])
#define FOR_TILES(NT, T) for (int u_ = XEVEN ? (SLOT % (nb / 8)) : bid, T = 0; u_ < (XEVEN ? (mtiles / 8) * (NT) : mtiles * (NT)) && ((T = XEVEN ? ((SLOT / (nb / 8)) * (mtiles / 8) + u_ / (NT)) * (NT) + u_ % (NT) : u_), true); u_ += XEVEN ? nb / 8 : nb)
#ifndef REP_MODH
#define REP_MODH 1
#endif
    for (int rep = 0; rep < REP_MODH; ++rep) modh_items(p, bid, nb);
    GSYNC();
    for (int l = 0; l < DEPTH; ++l) {
        { LOADP(q);
#ifdef G3_PROBE
        for (int rep = 0; rep < REP_P1; ++rep) { __syncthreads(); if (threadIdx.x == 0) *(volatile int*)(lds + LDS_TOTAL - 64) = (rep + 1 < REP_P1) ? G3_PROBE : 0; __syncthreads(); FOR_TILES(12, t) p1_tile(q, l, t, lds); }
#else
        for (int rep = 0; rep < REP_P1; ++rep) FOR_TILES(12, t) p1_tile(q, l, t, lds);
#endif
#ifndef REP_CVT
#define REP_CVT 1
#endif
        if (l > 0) for (int rep = 0; rep < REP_CVT; ++rep) convert_tables_fp8(q, l, bid, nb);
        }
        GSYNC();
        { LOADP(q);
        for (int rep = 0; rep < REP_P2; ++rep) { FOR_TILES(6, t) p2q_tile(q, l, t, lds); FOR_TILES(8, t2) p2kv_tile(q, l, t2, lds); }
        }
        GSYNC();
        { LOADP(q);
        {
            const int nbt = rows / SEQ, nmla = nbt * 8 * 64, nswa = nbt * 4 * 64, nconv = rows / 32, ntot = nmla + nswa + nconv;
            int* su = (int*)(lds + LDS_TOTAL - 16);
            for (int rep = 0; rep < REP_P3; ++rep) { unsigned* ctr = q.ctr + l * 64 + rep * 16;
            for (;;) {
                __syncthreads();
                if (threadIdx.x == 0) *su = (int)atomicAdd(ctr, 1u);
                __syncthreads();
                const int u = *su;
                if (u >= ntot) break;
#ifdef P3_ABL
                if (u < nmla) { if (rep + 1 < REP_P3) MLA_UNIT<P3_ABL>(q, u, lds); else MLA_UNIT<0>(q, u, lds); }
#else
                if (u < nmla) MLA_UNIT<0>(q, u, lds);
#endif
                else if (u < nmla + nswa) SWA_UNIT(q, l, u - nmla, lds);
                else conv_unit(q, l, u - nmla - nswa, lds);
            } }
        }
        }
        GSYNC();
        { LOADP(q);
        for (int rep = 0; rep < REP_P4; ++rep) FOR_TILES(8, t) p4_tile(q, l, t, (l == 0) ? q.in[0] : q.XB, q.out, lds);
        }
        GSYNC();
        { LOADP(q);
        { int t_ = threadIdx.x; asm volatile("" : "+v"(t_)); const int wv = t_ >> 6, lane = t_ & 63; for (int r = bid * 4 + wv; r < rows; r += nb * 4) p4b_row(q, l, r, q.out, lane); }
        }
        GSYNC();
        { LOADP(q);
#ifdef G3_PROBE
        for (int rep = 0; rep < REP_P5; ++rep) { __syncthreads(); if (threadIdx.x == 0) *(volatile int*)(lds + LDS_TOTAL - 64) = (rep + 1 < REP_P5) ? G3_PROBE : 0; __syncthreads(); FOR_TILES(16, t) p5_tile(q, l, t, lds); }
#else
        for (int rep = 0; rep < REP_P5; ++rep) FOR_TILES(16, t) p5_tile(q, l, t, lds);
#endif
        }
        GSYNC();
        { LOADP(q);
        {
            const int slot = SLOT, per = rows / nb;
            if (per * nb == rows && (per & 31) == 0) {
#ifdef REP_P6
                for (int rep = 1; rep < REP_P6; ++rep) P6_BLOCK<true>(q, l, slot * per, per, q.out, (l + 1 < DEPTH) ? q.XB : q.out, lds);
#endif
                P6_BLOCK<false>(q, l, slot * per, per, q.out, (l + 1 < DEPTH) ? q.XB : q.out, lds); }
            else for (int u = bid; u < rows / 32; u += nb) p6f_unit(q, l, u, q.out, (l + 1 < DEPTH) ? q.XB : q.out, lds);
        }
        }
        if (l + 1 < DEPTH) GSYNC();
    }
}

#undef bid
#undef nb
#undef rows
#undef mtiles
extern "C" void kernel_launch(void* const* d_in, const int* in_sizes, int n_in, void* d_out, int out_size, void* d_ws, size_t ws_size, hipStream_t stream) {
    const size_t MiB = 1u << 20;
    char* ws = (char*)d_ws;
    Params P{};
    for (int i = 0; i < 25; ++i) P.in[i] = (const float*)d_in[i];
    P.out = (float*)d_out; P.rows = NTOK; P.tok0 = 0;
    size_t o = 0;
    auto take = [&](size_t mib) { char* r = ws + o; o += mib * MiB; return r; };
    char* ctl = take(1);
    P.ctr = (unsigned*)ctl; P.biasO = (float*)(ctl + 64 * 1024); P.MOD = (float*)(ctl + 128 * 1024);
    P.COS = (float*)take(1); P.SIN = P.COS + SEQ * 16;
    P.WinT = (bf16*)take(6); P.WuqT = (bf16*)take(1); P.WukvT = (bf16*)take(1); P.WoT = (bf16*)take(4); P.WpqT = (bf16*)take(8); P.SKp = (bf16*)take(1);
    P.U8 = (unsigned char*)take(16); P.V8 = (unsigned char*)take(16); P.US = (float*)take(1); P.VS = P.US + DEPTH * 16384;
    P.H = (bf16*)take(64); P.MIXIN = P.H;
    P.PROJ = (bf16*)take(80); P.Q = (bf16*)take(48); P.TOPK = (unsigned*)P.Q;
    P.KN = (bf16*)take(32); P.KR = (bf16*)take(2); P.VT = (bf16*)take(32); P.VsT = (bf16*)take(8);
    P.XB = (float*)take(128); P.STATS = (float*)take(1);
    if (o > ws_size) { fprintf(stderr, "kernel_launch: workspace too small: need %zu, have %zu\n", o, ws_size); return; }
    static int grid_blocks = 0;
    if (!grid_blocks) {
        int dev = 0, cus = 0, per_cu = 0;
        (void)hipGetDevice(&dev);
        (void)hipDeviceGetAttribute(&cus, hipDeviceAttributeMultiprocessorCount, dev);
        (void)hipFuncSetAttribute((const void*)mega, hipFuncAttributeMaxDynamicSharedMemorySize, LDS_TOTAL);
        (void)hipOccupancyMaxActiveBlocksPerMultiprocessor(&per_cu, mega, 256, LDS_TOTAL);
        if (per_cu > 2) per_cu = 2;
        if (per_cu < 1) per_cu = 1;
        grid_blocks = cus * per_cu;
    }
    (void)hipMemsetAsync(ctl, 0, 32768, stream);
    void* args[] = {(void*)&P};
    hipError_t e = hipLaunchCooperativeKernel((void*)mega, dim3(grid_blocks), dim3(256), args, LDS_TOTAL, stream);
    if (e != hipSuccess) fprintf(stderr, "cooperative launch failed: %s (grid %d)\n", hipGetErrorString(e), grid_blocks);
}
```

```cpp
#include <hip/hip_runtime.h>
#include <hip/hip_cooperative_groups.h>
#include <cstdio>
#include <cstdint>
namespace cg = cooperative_groups;

constexpr int D = 1024, BATCH = 4, SEQ = 8192, DEPTH = 2, NTOK = BATCH * SEQ;
constexpr int D_IN = 1440;
constexpr int OFF_CQ = 0, OFF_CKV = 256, OFF_KR = 384, OFF_CONV = 416, OFF_QS = 928, OFF_KS = 1184, OFF_VS = 1312;
constexpr float EPS = 1e-6f;
constexpr float DN_ALPHA = 1.41421356237309515f;

typedef __attribute__((ext_vector_type(8))) short bf16x8;
typedef __attribute__((ext_vector_type(16))) float f32x16;
typedef __attribute__((ext_vector_type(4))) unsigned u32x4;
typedef __attribute__((ext_vector_type(2))) unsigned u32x2;
typedef float f32x2_t __attribute__((ext_vector_type(2)));
typedef __bf16 bf16x2_t __attribute__((ext_vector_type(2)));
typedef unsigned short bf16;
#define DI __device__ __forceinline__
#define MFMA32(a, b, c) __builtin_amdgcn_mfma_f32_32x32x16_bf16((a), (b), (c), 0, 0, 0)

DI unsigned pk2(float lo, float hi) { f32x2_t v = {lo, hi}; bf16x2_t b = __builtin_convertvector(v, bf16x2_t); return __builtin_bit_cast(unsigned, b); }
DI bf16 f2bf(float f) { return (bf16)(pk2(f, 0.f) & 0xffffu); }
DI float bf2f(bf16 b) { return __uint_as_float((unsigned)b << 16); }
typedef float f32x2v __attribute__((ext_vector_type(2)));
DI float bflo(unsigned u) { return __uint_as_float(u << 16); }
DI float bfhi(unsigned u) { return __uint_as_float(u & 0xffff0000u); }
DI int crow(int reg, int hh) { return (reg & 3) + 8 * (reg >> 2) + 4 * hh; }
DI int cperm_lin(int rho) { return 16 * ((rho >> 2) & 1) + (rho & 3) + 4 * (rho >> 3); }
DI int cperm_rope(int rho) { int hh = (rho >> 2) & 1, reg = (rho & 3) + 4 * (rho >> 3); return (reg < 8) ? 8 * hh + reg : 16 + 8 * hh + (reg - 8); }
DI int perm16(int p) { int g = (p >> 2) & 3; g = (g == 1) ? 2 : (g == 2) ? 1 : g; return (p & ~15) | (g << 2) | (p & 3); }

constexpr float LOG2E = 1.4426950408889634f;
constexpr int PROJ_LD = 1280;
constexpr int WIN_N = 1536;
constexpr int TS = 144;
constexpr int TILE_B = 128 * TS;
constexpr int STAGE_B = 2 * TILE_B;
constexpr int LDS_BYTES = 2 * STAGE_B;

struct Params {
    const float* in[25];
    float* out;
    bf16 *WinT, *WuqT, *WukvT, *WoT, *WpqT, *SKp, *Ut, *Vt;
    float* biasO;
    float* MOD;
    float* COS; float* SIN;
    bf16 *H, *PROJ, *Q, *KN, *KR, *VT, *VsT, *MIXIN;
    float* XB;
    unsigned* TOPK;
    float* STATS;
    unsigned char *U8, *V8; float *US, *VS;
    unsigned* ctr;
    int rows;
    int tok0;
};

enum { TK_WIN = 0, TK_WUQ = 1, TK_WUKV = 2, TK_WO = 3, TK_WPQ = 4 };
DI void transpose_item(int kind, const float* W, int ldin, int K, int Nout, bf16* WT, const float* rowscale, float* scr, int item, int lane) {
    const int nblk = Nout / 32, kb = item / nblk, nb = item % nblk, k0 = 64 * kb, n0 = 32 * nb;
    int src0 = n0; float cs = 1.f;
    if (kind == TK_WIN) {
        if (n0 < 384) src0 = n0;
        else if (n0 < 896) src0 = 416 + (n0 - 384);
        else if (n0 < 1152) { src0 = 928 + (n0 - 896); cs = 0.125f * LOG2E; }
        else if (n0 < 1280) src0 = 1184 + (n0 - 1152);
        else if (n0 < 1408) src0 = 1312 + (n0 - 1280);
        else if (n0 < 1440) src0 = 384 + (n0 - 1408);
        else src0 = -1;
    } else if (kind == TK_WUQ) cs = 0.10206207261596577f * LOG2E;
#pragma unroll
    for (int i = 0; i < 32; ++i) {
        const int kk = 2 * i + (lane >> 5);
        float v = (src0 >= 0) ? W[(size_t)(k0 + kk) * ldin + src0 + (lane & 31)] : 0.f;
        if (rowscale) v *= rowscale[k0 + kk];
        scr[kk * 33 + (lane & 31)] = v * cs;
    }
    __builtin_amdgcn_s_waitcnt(0xc07f); asm volatile("" ::: "memory");
    const int c = lane & 7;
#pragma unroll
    for (int j = 0; j < 4; ++j) {
        const int n = (lane >> 3) + 8 * j; const float* s = scr + (8 * c) * 33 + n;
        u32x4 o; o.x = pk2(s[0], s[33]); o.y = pk2(s[66], s[99]); o.z = pk2(s[132], s[165]); o.w = pk2(s[198], s[231]);
        if (!(kind == TK_WO && k0 + 8 * c >= 512 && k0 + 8 * c < 768))
            *(u32x4*)(WT + (size_t)(n0 + n) * K + k0 + 8 * c) = o;
    }
    __builtin_amdgcn_s_waitcnt(0xc07f); asm volatile("" ::: "memory");
}

DI void cvt8(const float* src, bf16* dst, size_t i8) {
    const float4 a = ((const float4*)src)[2 * i8], b = ((const float4*)src)[2 * i8 + 1];
    u32x4 o; o.x = pk2(a.x, a.y); o.y = pk2(a.z, a.w); o.z = pk2(b.x, b.y); o.w = pk2(b.z, b.w);
    ((u32x4*)dst)[i8] = o;
}

struct TileRegs { u32x4 v[4]; };
DI void gload_tile(TileRegs& t, const bf16* base, int ld, int k0, int tid) {
#pragma unroll
    for (int i = 0; i < 4; ++i) { const int q = tid + 256 * i, row = q >> 3, kc = q & 7; t.v[i] = *(const u32x4*)(base + (size_t)row * ld + k0 + kc * 8); }
}
DI void sstore_tile(const TileRegs& t, char* lds, int tid) {
#pragma unroll
    for (int i = 0; i < 4; ++i) { const int q = tid + 256 * i, row = q >> 3, kc = q & 7; *(u32x4*)(lds + row * TS + kc * 16) = t.v[i]; }
}
template <int NF, int NG>
DI void gemm_core2(const bf16* A, int lda, const bf16* W, int ldw, int K, char* lds, f32x16 (&acc)[NF][NG], int fo, const int (&frow)[NF], int go, const int (&grow)[NG]) {
    int tid_ = threadIdx.x; asm volatile("" : "+v"(tid_)); const int tid = tid_, hh = (tid & 63) >> 5;
    const int nk = K / 64;
    TileRegs ta0, tw0, ta1, tw1;
    gload_tile(ta0, A, lda, 0, tid); gload_tile(tw0, W, ldw, 0, tid);
    gload_tile(ta1, A, lda, 64, tid); gload_tile(tw1, W, ldw, 64, tid);
    __syncthreads();
    sstore_tile(ta0, lds, tid); sstore_tile(tw0, lds + TILE_B, tid);
    if (2 < nk) { gload_tile(ta0, A, lda, 128, tid); gload_tile(tw0, W, ldw, 128, tid); }
    __syncthreads();
#define GEMM_STEP(KS, TA, TW, TAN, TWN) do { \
        char* cur = lds + ((KS) & 1) * STAGE_B; \
        _Pragma("unroll") for (int kk = 0; kk < 4; ++kk) { \
            bf16x8 f[NF], g[NG]; \
            _Pragma("unroll") for (int x = 0; x < NF; ++x) f[x] = *(const bf16x8*)(cur + fo + frow[x] * TS + kk * 32 + hh * 16); \
            _Pragma("unroll") for (int y = 0; y < NG; ++y) g[y] = *(const bf16x8*)(cur + go + grow[y] * TS + kk * 32 + hh * 16); \
            _Pragma("unroll") for (int x = 0; x < NF; ++x) _Pragma("unroll") for (int y = 0; y < NG; ++y) acc[x][y] = MFMA32(f[x], g[y], acc[x][y]); } \
        if ((KS) + 1 < nk) { char* nxt = lds + (((KS) + 1) & 1) * STAGE_B; sstore_tile(TAN, nxt, tid); sstore_tile(TWN, nxt + TILE_B, tid); \
            if ((KS) + 3 < nk) { gload_tile(TAN, A, lda, ((KS) + 3) * 64, tid); gload_tile(TWN, W, ldw, ((KS) + 3) * 64, tid); } } \
        __syncthreads(); } while (0)
    for (int ks = 0; ks < nk; ks += 2) { GEMM_STEP(ks, ta0, tw0, ta1, tw1); GEMM_STEP(ks + 1, ta1, tw1, ta0, tw0); }
#undef GEMM_STEP
}

template <int NF, int NG>
DI void gemm_core(const bf16* A, int lda, const bf16* W, int ldw, int K, char* lds, f32x16 (&acc)[NF][NG], int fo, const int (&frow)[NF], int go, const int (&grow)[NG]) {
    int tid_ = threadIdx.x; asm volatile("" : "+v"(tid_)); const int tid = tid_, hh = (tid & 63) >> 5;
    TileRegs ta, tw;
    gload_tile(ta, A, lda, 0, tid); gload_tile(tw, W, ldw, 0, tid);
    __syncthreads();
    sstore_tile(ta, lds, tid); sstore_tile(tw, lds + TILE_B, tid);
    __syncthreads();
    const int nk = K / 64;
    for (int ks = 0; ks < nk; ++ks) {
        char* cur = lds + (ks & 1) * STAGE_B;
        if (ks + 1 < nk) { gload_tile(ta, A, lda, (ks + 1) * 64, tid); gload_tile(tw, W, ldw, (ks + 1) * 64, tid); }
#pragma unroll
        for (int kk = 0; kk < 4; ++kk) {
            bf16x8 f[NF], g[NG];
#pragma unroll
            for (int x = 0; x < NF; ++x) f[x] = *(const bf16x8*)(cur + fo + frow[x] * TS + kk * 32 + hh * 16);
#pragma unroll
            for (int y = 0; y < NG; ++y) g[y] = *(const bf16x8*)(cur + go + grow[y] * TS + kk * 32 + hh * 16);
#pragma unroll
            for (int x = 0; x < NF; ++x)
#pragma unroll
                for (int y = 0; y < NG; ++y) acc[x][y] = MFMA32(f[x], g[y], acc[x][y]);
        }
        if (ks + 1 < nk) { char* nxt = lds + ((ks + 1) & 1) * STAGE_B; sstore_tile(ta, nxt, tid); sstore_tile(tw, nxt + TILE_B, tid); }
        __syncthreads();
    }
}

#define LAS3 __attribute__((address_space(3)))
constexpr int GT = 128 * 128;
DI void glds_tile(const bf16* base, int ld, int k0, char* tile, int wv, int lane) {
#pragma unroll
    for (int i = 0; i < 4; ++i) {
        const int row0 = 32 * wv + 8 * i, rr = lane >> 3;
        const bf16* src = base + (size_t)(row0 + rr) * ld + k0 + (((lane & 7) ^ (((row0 + rr) >> 1) & 7)) << 3);
        __builtin_amdgcn_global_load_lds((const void*)src, (LAS3 void*)(tile + row0 * 128), 16, 0, 0);
    }
}
template <int NF, int NG>
DI void gemm_core3(const bf16* A, int lda, const bf16* W, int ldw, int K, char* lds, f32x16 (&acc)[NF][NG], int fo, const int (&frow)[NF], int go, const int (&grow)[NG]) {
    int tid_ = threadIdx.x; asm volatile("" : "+v"(tid_)); const int tid = tid_, lane = tid & 63, hh = lane >> 5;
    const int wv = __builtin_amdgcn_readfirstlane(tid >> 6);
    const int nk = K / 64;
    const int fof = fo ? GT : 0, gof = go ? GT : 0;
    int foff[NF], goff[NG], fsw[NF], gsw[NG];
#pragma unroll
    for (int x = 0; x < NF; ++x) { foff[x] = fof + frow[x] * 128; fsw[x] = (frow[x] >> 1) & 7; }
#pragma unroll
    for (int y = 0; y < NG; ++y) { goff[y] = gof + grow[y] * 128; gsw[y] = (grow[y] >> 1) & 7; }
    __syncthreads();
#ifdef G3_PROBE
    const int dry = __builtin_amdgcn_readfirstlane(*(volatile int*)(lds + LDS_BYTES + 1024 - 64));
#else
    const int dry = 0;
#endif
    glds_tile(A, lda, 0, lds, wv, lane); glds_tile(W, ldw, 0, lds + GT, wv, lane);
    __syncthreads();
    for (int ks = 0; ks < nk; ++ks) {
        char* cur = lds + (ks & 1) * (2 * GT);
        if (ks + 1 < nk && !(dry & 1)) { char* nxt = lds + ((ks + 1) & 1) * (2 * GT); glds_tile(A, lda, (ks + 1) * 64, nxt, wv, lane); glds_tile(W, ldw, (ks + 1) * 64, nxt + GT, wv, lane); }
#pragma unroll
        for (int kk = 0; kk < 4; ++kk) {
            bf16x8 f[NF], g[NG];
#pragma unroll
            for (int x = 0; x < NF; ++x) f[x] = *(const bf16x8*)(cur + foff[x] + ((((kk << 1) | hh) ^ fsw[x]) << 4));
#pragma unroll
            for (int y = 0; y < NG; ++y) g[y] = *(const bf16x8*)(cur + goff[y] + ((((kk << 1) | hh) ^ gsw[y]) << 4));
            if (dry & 2) {
#pragma unroll
                for (int x = 0; x < NF; ++x) asm volatile("" :: "v"(f[x]));
#pragma unroll
                for (int y = 0; y < NG; ++y) asm volatile("" :: "v"(g[y]));
            } else {
#pragma unroll
            for (int x = 0; x < NF; ++x)
#pragma unroll
                for (int y = 0; y < NG; ++y) acc[x][y] = MFMA32(f[x], g[y], acc[x][y]);
            }
        }
        __syncthreads();
    }
}


template <int NF, int NG>
DI void gemm_core5(const bf16* A, int lda, const bf16* W, int ldw, int K, char* lds, f32x16 (&acc)[NF][NG], int fo, const int (&frow)[NF], int go, const int (&grow)[NG]) {
    int tid_ = threadIdx.x; asm volatile("" : "+v"(tid_)); const int tid = tid_, lane = tid & 63, hh = lane >> 5;
    const int wv = __builtin_amdgcn_readfirstlane(tid >> 6);
    const int nk = K / 64;
    const int fof = fo ? GT : 0, gof = go ? GT : 0;
    int foff[NF], goff[NG], fsw[NF], gsw[NG];
#pragma unroll
    for (int x = 0; x < NF; ++x) { foff[x] = fof + frow[x] * 128; fsw[x] = (frow[x] >> 1) & 7; }
#pragma unroll
    for (int y = 0; y < NG; ++y) { goff[y] = gof + grow[y] * 128; gsw[y] = (grow[y] >> 1) & 7; }
    __syncthreads();
#ifdef G3_PROBE
    const int dry = __builtin_amdgcn_readfirstlane(*(volatile int*)(lds + LDS_BYTES + 1024 - 64));
#else
    const int dry = 0;
#endif
    glds_tile(A, lda, 0, lds, wv, lane); glds_tile(W, ldw, 0, lds + GT, wv, lane);
    __syncthreads();
    for (int ks = 0; ks < nk; ++ks) {
        char* cur = lds + (ks & 1) * (2 * GT);
        if (ks + 1 < nk && !(dry & 1)) { char* nxt = lds + ((ks + 1) & 1) * (2 * GT); glds_tile(A, lda, (ks + 1) * 64, nxt, wv, lane); glds_tile(W, ldw, (ks + 1) * 64, nxt + GT, wv, lane); }
        bf16x8 f[4][NF], g[4][NG];
#pragma unroll
        for (int kk = 0; kk < 4; ++kk) {
#pragma unroll
            for (int x = 0; x < NF; ++x) f[kk][x] = *(const bf16x8*)(cur + foff[x] + ((((kk << 1) | hh) ^ fsw[x]) << 4));
#pragma unroll
            for (int y = 0; y < NG; ++y) g[kk][y] = *(const bf16x8*)(cur + goff[y] + ((((kk << 1) | hh) ^ gsw[y]) << 4));
        }
        __builtin_amdgcn_sched_barrier(0);
#pragma unroll
        for (int kk = 0; kk < 4; ++kk)
#pragma unroll
            for (int x = 0; x < NF; ++x)
#pragma unroll
                for (int y = 0; y < NG; ++y) acc[x][y] = MFMA32(f[kk][x], g[kk][y], acc[x][y]);
        __builtin_amdgcn_sched_barrier(0);
        __syncthreads();
    }
}


DI u32x4 g4_rsrc(const void* base, unsigned bytes) {
    const unsigned long long a = (unsigned long long)base;
    u32x4 r; r.x = __builtin_amdgcn_readfirstlane((unsigned)a); r.y = __builtin_amdgcn_readfirstlane((unsigned)(a >> 32) & 0xffffu); r.z = bytes; r.w = 0x00020000u;
    return r;
}
DI void g4_dma(unsigned m0v, int voff, u32x4 rsrc, unsigned soff) {
    asm volatile("s_nop 4\n\ts_mov_b32 m0, %0\n\ts_nop 0\n\tbuffer_load_dwordx4 %1, %2, %3 offen lds" :: "s"(m0v), "v"(voff), "s"(rsrc), "s"(soff) : "m0", "memory");
}
template <int NF, int NG>
DI void gemm_core4(const bf16* A, int lda, const bf16* W, int ldw, int K, char* lds, f32x16 (&acc)[NF][NG], int fo, const int (&frow)[NF], int go, const int (&grow)[NG]) {
    int tid_ = threadIdx.x; asm volatile("" : "+v"(tid_)); const int tid = tid_, lane = tid & 63, hh = lane >> 5;
    const int wv = __builtin_amdgcn_readfirstlane(tid >> 6);
    const int nk = K / 32;
    const int fof = fo ? 8192 : 0, gof = go ? 8192 : 0;
    int foff[NF], goff[NG], fsw[NF], gsw[NG];
#pragma unroll
    for (int x = 0; x < NF; ++x) { foff[x] = fof + frow[x] * 64; fsw[x] = (frow[x] >> 2) & 3; }
#pragma unroll
    for (int y = 0; y < NG; ++y) { goff[y] = gof + grow[y] * 64; gsw[y] = (grow[y] >> 2) & 3; }
    const u32x4 rA = g4_rsrc(A, 128u * (unsigned)lda * 2u), rW = g4_rsrc(W, 128u * (unsigned)ldw * 2u);
    const int lsw = ((lane & 3) ^ ((lane >> 4) & 3)) << 4;
    const int voA = (lane >> 2) * lda * 2 + lsw, voW = (lane >> 2) * ldw * 2 + lsw;
    const unsigned ldsb = (unsigned)(size_t)(LAS3 char*)lds;
    const unsigned mb = __builtin_amdgcn_readfirstlane(ldsb + 2048u * wv);
    const unsigned sA0 = (unsigned)(32 * wv * lda) * 2u, sA1 = sA0 + (unsigned)(16 * lda) * 2u, sW0 = (unsigned)(32 * wv * ldw) * 2u, sW1 = sW0 + (unsigned)(16 * ldw) * 2u;
    auto issue = [&](int ks) {
        const unsigned so = (unsigned)(ks & 3) * 16384u, kb = (unsigned)ks * 64u;
        g4_dma(mb + so, voA, rA, sA0 + kb); g4_dma(mb + so + 1024u, voA, rA, sA1 + kb);
        g4_dma(mb + so + 8192u, voW, rW, sW0 + kb); g4_dma(mb + so + 9216u, voW, rW, sW1 + kb);
    };
    __syncthreads();
    issue(0); if (nk > 1) issue(1); if (nk > 2) issue(2);
    for (int ks = 0; ks < nk; ++ks) {
        if (ks + 2 < nk) asm volatile("s_waitcnt vmcnt(8)" ::: "memory"); else if (ks + 1 < nk) asm volatile("s_waitcnt vmcnt(4)" ::: "memory"); else asm volatile("s_waitcnt vmcnt(0)" ::: "memory");
        __syncthreads();
        if (ks + 3 < nk) issue(ks + 3);
        const char* cur = lds + (ks & 3) * 16384;
#pragma unroll
        for (int kk = 0; kk < 2; ++kk) {
            bf16x8 f[NF], g[NG];
#pragma unroll
            for (int x = 0; x < NF; ++x) f[x] = *(const bf16x8*)(cur + foff[x] + ((((kk << 1) | hh) ^ fsw[x]) << 4));
#pragma unroll
            for (int y = 0; y < NG; ++y) g[y] = *(const bf16x8*)(cur + goff[y] + ((((kk << 1) | hh) ^ gsw[y]) << 4));
#pragma unroll
            for (int x = 0; x < NF; ++x)
#pragma unroll
                for (int y = 0; y < NG; ++y) acc[x][y] = MFMA32(f[x], g[y], acc[x][y]);
        }
    }
    __syncthreads();
}

#ifndef GEMM_CORE
#define GEMM_CORE gemm_core3
#endif
template <int NF, int NG> DI void zero_acc(f32x16 (&acc)[NF][NG]) {
#pragma unroll
    for (int x = 0; x < NF; ++x)
#pragma unroll
        for (int y = 0; y < NG; ++y)
#pragma unroll
            for (int r = 0; r < 16; ++r) acc[x][y][r] = 0.f;
}

DI void store16(bf16* dst, const float* v) {
    u32x4 a, b;
    a.x = pk2(v[0], v[1]); a.y = pk2(v[2], v[3]); a.z = pk2(v[4], v[5]); a.w = pk2(v[6], v[7]);
    b.x = pk2(v[8], v[9]); b.y = pk2(v[10], v[11]); b.z = pk2(v[12], v[13]); b.w = pk2(v[14], v[15]);
    *(u32x4*)dst = a; *(u32x4*)(dst + 8) = b;
}
DI void store8(bf16* dst, const float* v) {
    u32x4 a; a.x = pk2(v[0], v[1]); a.y = pk2(v[2], v[3]); a.z = pk2(v[4], v[5]); a.w = pk2(v[6], v[7]);
    *(u32x4*)dst = a;
}
DI void store_vt(bf16* dst, const f32x16& a, int hh) {
    float v0[8], v1[8];
#pragma unroll
    for (int i = 0; i < 8; ++i) { v0[i] = a[i]; v1[i] = a[8 + i]; }
    store8(dst + 8 * hh, v0); store8(dst + 16 + 8 * hh, v1);
}

DI void p1_tile(const Params& p, int l, int tile, char* lds) {
    int tid_ = threadIdx.x; asm volatile("" : "+v"(tid_)); const int tid = tid_, lane = tid & 63, r = lane & 31, hh = lane >> 5;
    const int wv = __builtin_amdgcn_readfirstlane(tid >> 6), wm = wv >> 1, wn = wv & 1;
    const int mt = tile / 12, nt = tile % 12, m0 = mt * 128, n0 = nt * 128;
    const bf16* A = p.H + (size_t)m0 * D;
    const bf16* W = p.WinT + ((size_t)l * WIN_N + n0) * D;
    f32x16 acc[2][2]; zero_acc(acc);
    int frow[2], grow[2];
    const bool kr = (nt == 11);
    int fo, go;
    if (nt == 10) { fo = 0; go = TILE_B; frow[0] = 64 * wm + r; frow[1] = frow[0] + 32; grow[0] = 64 * wn + r; grow[1] = grow[0] + 32; }
    else { fo = TILE_B; go = 0; frow[0] = 64 * wn + (kr ? cperm_rope(r) : cperm_lin(r)); frow[1] = 64 * wn + 32 + cperm_lin(r); grow[0] = 64 * wm + r; grow[1] = grow[0] + 32; }
    GEMM_CORE<2, 2>(A, D, W, D, D, lds, acc, fo, frow, go, grow);
    if (nt == 10) {
#pragma unroll
        for (int x = 0; x < 2; ++x)
#pragma unroll
            for (int y = 0; y < 2; ++y) {
                const int tok = m0 + 64 * wm + 32 * x, b = tok / SEQ, s0 = tok % SEQ, d = 32 * y + r;
                store_vt(p.VsT + ((size_t)(b * 2 + wn) * 64 + d) * SEQ + s0, acc[x][y], hh);
            }
    } else {
        if (!kr) {
#pragma unroll
            for (int x = 0; x < 2; ++x)
#pragma unroll
                for (int y = 0; y < 2; ++y) {
                    const int tok = m0 + 64 * wm + 32 * y + r, col = n0 + 64 * wn + 32 * x + 16 * hh;
                    float v[16];
#pragma unroll
                    for (int i = 0; i < 16; ++i) v[i] = acc[x][y][i];
                    store16(p.PROJ + (size_t)tok * PROJ_LD + col, v);
                }
        } else if (wn == 0) {
#pragma unroll
            for (int y = 0; y < 2; ++y) {
                const int tok = m0 + 64 * wm + 32 * y + r, pos = tok % SEQ;
                const float4 c0 = *(const float4*)(p.COS + pos * 16 + 8 * hh), c1 = *(const float4*)(p.COS + pos * 16 + 8 * hh + 4);
                const float4 s0 = *(const float4*)(p.SIN + pos * 16 + 8 * hh), s1 = *(const float4*)(p.SIN + pos * 16 + 8 * hh + 4);
                const float cs[8] = {c0.x, c0.y, c0.z, c0.w, c1.x, c1.y, c1.z, c1.w}, sn[8] = {s0.x, s0.y, s0.z, s0.w, s1.x, s1.y, s1.z, s1.w};
                float o1[8], o2[8];
#pragma unroll
                for (int i = 0; i < 8; ++i) { const float t1 = acc[0][y][i], t2 = acc[0][y][8 + i]; o1[i] = t1 * cs[i] - t2 * sn[i]; o2[i] = t1 * sn[i] + t2 * cs[i]; }
                store8(p.KR + (size_t)tok * 32 + 8 * hh, o1); store8(p.KR + (size_t)tok * 32 + 16 + 8 * hh, o2);
            }
        }
    }
}
constexpr int LDS_RS_OFF = LDS_BYTES;
constexpr int LDS_TOTAL = LDS_BYTES + 1024;

template <int W> DI void row_rms(const bf16* A, int lda, float* rs, int tid) {
    const int row = tid >> 1, half = tid & 1;
    const u32x4* p = (const u32x4*)(A + (size_t)row * lda + half * (W / 2));
    float ss = 0.f;
#pragma unroll
    for (int i = 0; i < W / 16; ++i) { const u32x4 v = p[i];
        ss += bflo(v.x) * bflo(v.x) + bfhi(v.x) * bfhi(v.x) + bflo(v.y) * bflo(v.y) + bfhi(v.y) * bfhi(v.y)
            + bflo(v.z) * bflo(v.z) + bfhi(v.z) * bfhi(v.z) + bflo(v.w) * bflo(v.w) + bfhi(v.w) * bfhi(v.w); }
    ss += __shfl_xor(ss, 1);
    if (half == 0) rs[row] = rsqrtf(ss * (1.f / W) + EPS);
}

DI void p2q_tile(const Params& p, int l, int tile, char* lds) {
    int tid_ = threadIdx.x; asm volatile("" : "+v"(tid_)); const int tid = tid_, lane = tid & 63, r = lane & 31, hh = lane >> 5;
    const int wv = __builtin_amdgcn_readfirstlane(tid >> 6), wm = wv >> 1, wn = wv & 1;
    const int mt = tile / 6, nt = tile % 6, m0 = mt * 128, n0 = nt * 128;
    const bf16* A = p.PROJ + (size_t)m0 * PROJ_LD;
    const bf16* W = p.WuqT + ((size_t)l * 768 + n0) * 256;
    float* rs = (float*)(lds + LDS_RS_OFF);
    __syncthreads();
    row_rms<256>(A, PROJ_LD, rs, tid);
    f32x16 acc[2][2]; zero_acc(acc);
    int frow[2], grow[2]; bool rope[2];
#pragma unroll
    for (int x = 0; x < 2; ++x) { rope[x] = (((n0 + 64 * wn + 32 * x) >> 5) % 3) == 2; frow[x] = 64 * wn + 32 * x + (rope[x] ? cperm_rope(r) : cperm_lin(r)); }
    grow[0] = 64 * wm + r; grow[1] = grow[0] + 32;
    GEMM_CORE<2, 2>(A, PROJ_LD, W, 256, 256, lds, acc, TILE_B, frow, 0, grow);
#pragma unroll
    for (int y = 0; y < 2; ++y) {
        const int tl = 64 * wm + 32 * y + r, tok = m0 + tl, pos = tok % SEQ;
        const float sc = rs[tl];
#pragma unroll
        for (int x = 0; x < 2; ++x) {
            bf16* dst = p.Q + (size_t)tok * 768 + n0 + 64 * wn + 32 * x;
            if (rope[x]) {
                const float4 c0 = *(const float4*)(p.COS + pos * 16 + 8 * hh), c1 = *(const float4*)(p.COS + pos * 16 + 8 * hh + 4);
                const float4 s0 = *(const float4*)(p.SIN + pos * 16 + 8 * hh), s1 = *(const float4*)(p.SIN + pos * 16 + 8 * hh + 4);
                const float cs[8] = {c0.x, c0.y, c0.z, c0.w, c1.x, c1.y, c1.z, c1.w}, sn[8] = {s0.x, s0.y, s0.z, s0.w, s1.x, s1.y, s1.z, s1.w};
                float o1[8], o2[8];
#pragma unroll
                for (int i = 0; i < 8; ++i) { const float t1 = acc[x][y][i] * sc, t2 = acc[x][y][8 + i] * sc; o1[i] = t1 * cs[i] - t2 * sn[i]; o2[i] = t1 * sn[i] + t2 * cs[i]; }
                store8(dst + 8 * hh, o1); store8(dst + 16 + 8 * hh, o2);
            } else {
                float v[16];
#pragma unroll
                for (int i = 0; i < 16; ++i) v[i] = acc[x][y][i] * sc;
                store16(dst + 16 * hh, v);
            }
        }
    }
}

DI void p2kv_tile(const Params& p, int l, int tile, char* lds) {
    int tid_ = threadIdx.x; asm volatile("" : "+v"(tid_)); const int tid = tid_, lane = tid & 63, r = lane & 31, hh = lane >> 5;
    const int wv = __builtin_amdgcn_readfirstlane(tid >> 6), wm = wv >> 1, wn = wv & 1;
    const int mt = tile >> 3, h = tile & 7, m0 = mt * 128, n0 = h * 128;
    const bf16* A = p.PROJ + (size_t)m0 * PROJ_LD + 256;
    const bf16* W = p.WukvT + ((size_t)l * 1024 + n0) * 128;
    float* rs = (float*)(lds + LDS_RS_OFF);
    __syncthreads();
    row_rms<128>(A, PROJ_LD, rs, tid);
    f32x16 acc[2][2]; zero_acc(acc);
    int frow[2], grow[2];
    int fo, go;
    if (wn == 0) { fo = TILE_B; go = 0; frow[0] = cperm_lin(r); frow[1] = 32 + cperm_lin(r); grow[0] = 64 * wm + r; grow[1] = grow[0] + 32; }
    else         { fo = 0; go = TILE_B; frow[0] = 64 * wm + r; frow[1] = frow[0] + 32; grow[0] = 64 + r; grow[1] = 96 + r; }
    GEMM_CORE<2, 2>(A, PROJ_LD, W, 128, 128, lds, acc, fo, frow, go, grow);
    if (wn == 0) {
#pragma unroll
        for (int y = 0; y < 2; ++y) {
            const int tl = 64 * wm + 32 * y + r, tok = m0 + tl; const float sc = rs[tl];
#pragma unroll
            for (int x = 0; x < 2; ++x) {
                float v[16];
#pragma unroll
                for (int i = 0; i < 16; ++i) v[i] = acc[x][y][i] * sc;
                store16(p.KN + (size_t)tok * 512 + h * 64 + 32 * x + 16 * hh, v);
            }
        }
    } else {
#pragma unroll
        for (int x = 0; x < 2; ++x) {
            const int tl0 = 64 * wm + 32 * x, tok0 = m0 + tl0, b = tok0 / SEQ, s0 = tok0 % SEQ;
#pragma unroll
            for (int y = 0; y < 2; ++y) {
                f32x16 a = acc[x][y];
#pragma unroll
                for (int i = 0; i < 16; ++i) a[i] *= rs[tl0 + crow(i, hh)];
                store_vt(p.VT + ((size_t)(b * 8 + h) * 64 + 32 * y + r) * SEQ + s0, a, hh);
            }
        }
    }
}
constexpr int VSTR = 144;
template <int KD> struct AttnCfg { static constexpr int KSTR = KD * 2 + 16; static constexpr int BUF = 64 * KSTR + 64 * VSTR; };

template <int KD, int MODE, int ABL = 0>
DI void attn_unit(const bf16* Qp, int qld, const bf16* K1, int k1ld, const bf16* K2, const bf16* VTp, bf16* Op, int b, int qb, float sink_l2, char* lds) {
    constexpr int KSTR = AttnCfg<KD>::KSTR, BUF = AttnCfg<KD>::BUF, NKS = KD / 16;
    int tid_ = threadIdx.x; asm volatile("" : "+v"(tid_)); const int tid = tid_, lane = tid & 63, r = lane & 31, hh = lane >> 5;
    const int wv = __builtin_amdgcn_readfirstlane(tid >> 6);
    const int q0 = qb * 128, qpos = q0 + 32 * wv + r;
    const size_t rowb = (size_t)b * SEQ;
    bf16x8 qf[NKS];
#pragma unroll
    for (int ks = 0; ks < NKS; ++ks) qf[ks] = *(const bf16x8*)(Qp + (rowb + qpos) * qld + ks * 16 + hh * 8);
#pragma unroll
    for (int ks = 0; ks < NKS; ++ks) asm volatile("" : "+v"(qf[ks]));
    const int kstart = (MODE == 0) ? 0 : (q0 >= 128 ? q0 - 128 : 0);
    const int nt = (q0 + 128 - kstart) / 64;
    f32x16 ot[2];
#pragma unroll
    for (int i = 0; i < 16; ++i) { ot[0][i] = 0.f; ot[1][i] = 0.f; }
    float m = (MODE == 0) ? -INFINITY : sink_l2, l = (MODE == 1 && hh == 0) ? 1.f : 0.f;
    u32x4 sk[3], sv[2];
    auto gload = [&](int t) {
        const int key0 = kstart + 64 * t;
#pragma unroll
        for (int i = 0; i < 2; ++i) { const int q = tid + 256 * i, row = q >> 3, c = q & 7;
            sk[i] = *(const u32x4*)(K1 + (rowb + key0 + row) * k1ld + c * 8);
            sv[i] = *(const u32x4*)(VTp + (size_t)row * SEQ + key0 + c * 8); }
        if (KD == 96) { const int row = tid >> 2, c = tid & 3; sk[2] = *(const u32x4*)(K2 + (rowb + key0 + row) * 32 + c * 8); }
    };
    auto sstore = [&](char* buf) {
#pragma unroll
        for (int i = 0; i < 2; ++i) { const int q = tid + 256 * i, row = q >> 3, c = q & 7;
            *(u32x4*)(buf + row * KSTR + c * 16) = sk[i];
            *(u32x4*)(buf + 64 * KSTR + row * VSTR + c * 16) = sv[i]; }
        if (KD == 96) { const int row = tid >> 2, c = tid & 3; *(u32x4*)(buf + row * KSTR + 128 + c * 16) = sk[2]; }
    };
    gload(0);
    __syncthreads();
    sstore(lds);
    __syncthreads();
    for (int t = 0; t < nt; ++t) {
        const char* cur = lds + (t & 1) * BUF;
        if (!(ABL & 8)) if (t + 1 < nt) gload(t + 1);
        const int key0 = kstart + 64 * t;
        f32x16 st[2];
        bf16x8 kf[2][NKS];
#pragma unroll
        for (int mt = 0; mt < 2; ++mt)
#pragma unroll
            for (int ks = 0; ks < NKS; ++ks) kf[mt][ks] = *(const bf16x8*)(cur + (mt * 32 + r) * KSTR + ks * 32 + hh * 16);
        __builtin_amdgcn_sched_barrier(0);
#pragma unroll
        for (int mt = 0; mt < 2; ++mt) {
#pragma unroll
            for (int i = 0; i < 16; ++i) st[mt][i] = 0.f;
#pragma unroll
            for (int ks = 0; ks < NKS; ++ks) { if (ABL & 2) { asm volatile("" :: "v"(kf[mt][ks])); st[mt][ks] += 1.f; } else st[mt] = MFMA32(kf[mt][ks], qf[ks], st[mt]); }
        }
        const char* vt = cur + 64 * KSTR;
        bf16x8 vf[2][4];
#pragma unroll
        for (int mt = 0; mt < 2; ++mt)
#pragma unroll
            for (int s = 0; s < 4; ++s) vf[mt][s] = *(const bf16x8*)(vt + (mt * 32 + r) * VSTR + s * 32 + hh * 16);
        __builtin_amdgcn_sched_barrier(0);
        const bool need_mask = (MODE == 1) || (key0 + 63 > q0 + 32 * wv);
        if (need_mask) {
#pragma unroll
            for (int mt = 0; mt < 2; ++mt)
#pragma unroll
                for (int i = 0; i < 16; ++i) {
                    const int key = key0 + mt * 32 + crow(i, hh);
                    const bool ok = (MODE == 0) ? (key <= qpos) : (key <= qpos && key > qpos - 128);
                    if (!ok) st[mt][i] = -INFINITY;
                }
        }
        float mx = st[0][0];
#pragma unroll
        for (int i = 1; i < 16; ++i) mx = fmaxf(mx, st[0][i]);
#pragma unroll
        for (int i = 0; i < 16; ++i) mx = fmaxf(mx, st[1][i]);
        { auto rr = __builtin_amdgcn_permlane32_swap(__float_as_uint(mx), __float_as_uint(mx), false, false); mx = fmaxf(__uint_as_float(rr[0]), __uint_as_float(rr[1])); }
        const float mn = fmaxf(m, mx);
        const float alpha = __builtin_amdgcn_exp2f(m - mn);
        m = mn;
        float ps = 0.f;
#pragma unroll
        for (int mt = 0; mt < 2; ++mt)
#pragma unroll
            for (int i = 0; i < 16; ++i) { const float pv = (ABL & 1) ? (st[mt][i] - mn) : __builtin_amdgcn_exp2f(st[mt][i] - mn); st[mt][i] = pv; ps += pv; }
        l = l * alpha + ps;
#pragma unroll
        for (int i = 0; i < 16; ++i) { ot[0][i] *= alpha; ot[1][i] *= alpha; }
        bf16x8 pb[4];
#pragma unroll
        for (int s = 0; s < 4; ++s) {
            const int mt = s >> 1, o = 8 * (s & 1);
            u32x4 w; w.x = pk2(st[mt][o], st[mt][o + 1]); w.y = pk2(st[mt][o + 2], st[mt][o + 3]); w.z = pk2(st[mt][o + 4], st[mt][o + 5]); w.w = pk2(st[mt][o + 6], st[mt][o + 7]);
            pb[s] = __builtin_bit_cast(bf16x8, w);
        }
        __builtin_amdgcn_sched_barrier(0);
#pragma unroll
        for (int mt = 0; mt < 2; ++mt)
#pragma unroll
            for (int s = 0; s < 4; ++s) { if (ABL & 4) { asm volatile("" :: "v"(vf[mt][s]), "v"(pb[s])); ot[mt][s] += 1.f; } else ot[mt] = MFMA32(vf[mt][s], pb[s], ot[mt]); }
        if (!(ABL & 8)) if (t + 1 < nt) sstore(lds + ((t + 1) & 1) * BUF);
        __syncthreads();
    }
    { auto rr = __builtin_amdgcn_permlane32_swap(__float_as_uint(l), __float_as_uint(l), false, false); l = __uint_as_float(rr[0]) + __uint_as_float(rr[1]); }
    const float inv = 1.f / l;
    bf16* orow = Op + (rowb + qpos) * 1024;
#pragma unroll
    for (int mt = 0; mt < 2; ++mt)
#pragma unroll
        for (int g = 0; g < 4; ++g) {
            u32x2 w; w.x = pk2(ot[mt][4 * g] * inv, ot[mt][4 * g + 1] * inv); w.y = pk2(ot[mt][4 * g + 2] * inv, ot[mt][4 * g + 3] * inv);
            *(u32x2*)(orow + mt * 32 + 8 * g + 4 * hh) = w;
        }
}

template <int ABL = 0> DI void mla_unit(const Params& p, int u, char* lds) {
    const int nbh = (p.rows / SEQ) * 8, qb = 63 - u / nbh, bh = u % nbh, b = bh >> 3, h = bh & 7;
    attn_unit<96, 0, ABL>(p.Q + h * 96, 768, p.KN + h * 64, 512, p.KR, p.VT + (size_t)bh * 64 * SEQ, p.MIXIN + h * 64, b, qb, 0.f, lds);
}
DI void swa_unit(const Params& p, int l, int u, char* lds) {
    const int qb = u & 63, bh = u >> 6, b = bh >> 2, hq = bh & 3, kvh = hq >> 1;
    attn_unit<64, 1>(p.PROJ + 896 + hq * 64, PROJ_LD, p.PROJ + 1152 + kvh * 64, PROJ_LD, nullptr, p.VsT + (size_t)(b * 2 + kvh) * 64 * SEQ, p.MIXIN + 768 + hq * 64, b, qb,
                     p.in[15][l * 4 + hq] * LOG2E, lds);
}

DI void conv_unit(const Params& p, int l, int u, char* lds) {
    int tid_ = threadIdx.x; asm volatile("" : "+v"(tid_)); const int tid = tid_, lane = tid & 63, wv = tid >> 6;
    const int tok0 = u * 32, pos0 = tok0 % SEQ;
    bf16* glu = (bf16*)lds;
    float* hc = (float*)(lds + 62 * 512);
    __syncthreads();
    for (int it = tid; it < 62 * 32; it += 256) {
        const int row = it >> 5, c8 = (it & 31) * 8, pos = pos0 - 30 + row;
        u32x4 o = {0u, 0u, 0u, 0u};
        if (pos >= 0) {
            const bf16* src = p.PROJ + (size_t)(tok0 - 30 + row) * PROJ_LD + 384 + c8;
            const u32x4 a = *(const u32x4*)src, g = *(const u32x4*)(src + 256);
            const unsigned av[4] = {a.x, a.y, a.z, a.w}, gv[4] = {g.x, g.y, g.z, g.w}; unsigned ov[4];
#pragma unroll
            for (int i = 0; i < 4; ++i) {
                const float g0 = bflo(gv[i]), g1 = bfhi(gv[i]);
                ov[i] = pk2(bflo(av[i]) / (1.f + __expf(-g0)), bfhi(av[i]) / (1.f + __expf(-g1)));
            }
            o.x = ov[0]; o.y = ov[1]; o.z = ov[2]; o.w = ov[3];
        }
        *(u32x4*)(glu + row * 256 + c8) = o;
    }
    __syncthreads();
    {
        const int c = tid;
        float w[31];
        const float* wd = p.in[9] + (size_t)l * 31 * 256 + c;
#pragma unroll
        for (int k = 0; k < 31; ++k) w[k] = wd[k * 256];
        const float bd = p.in[10][l * 256 + c];
#pragma unroll 1
        for (int ch = 0; ch < 4; ++ch) {
            float g[38], acc[8];
#pragma unroll
            for (int i = 0; i < 38; ++i) g[i] = bf2f(glu[(ch * 8 + i) * 256 + c]);
#pragma unroll
            for (int tt = 0; tt < 8; ++tt) { acc[tt] = bd;
#pragma unroll
                for (int k = 0; k < 31; ++k) acc[tt] += w[k] * g[tt + k]; }
#pragma unroll
            for (int tt = 0; tt < 8; ++tt) hc[(ch * 8 + tt) * 256 + c] = acc[tt];
        }
    }
    __syncthreads();
    {
        const float4 gg = *(const float4*)(p.in[11] + l * 256 + lane * 4), bb = *(const float4*)(p.in[12] + l * 256 + lane * 4);
#pragma unroll 1
        for (int i = 0; i < 8; ++i) {
            const int t = wv * 8 + i;
            const float4 v = *(const float4*)(hc + t * 256 + lane * 4);
            float s = v.x + v.y + v.z + v.w;
#pragma unroll
            for (int o = 1; o < 64; o <<= 1) s += __shfl_xor(s, o);
            const float mean = s * (1.f / 256.f);
            const float d0 = v.x - mean, d1 = v.y - mean, d2 = v.z - mean, d3 = v.w - mean;
            float q = d0 * d0 + d1 * d1 + d2 * d2 + d3 * d3;
#pragma unroll
            for (int o = 1; o < 64; o <<= 1) q += __shfl_xor(q, o);
            const float rstd = rsqrtf(q * (1.f / 256.f) + EPS);
            float y0 = d0 * rstd * gg.x + bb.x, y1 = d1 * rstd * gg.y + bb.y, y2 = d2 * rstd * gg.z + bb.z, y3 = d3 * rstd * gg.w + bb.w;
            y0 = y0 / (1.f + __expf(-y0)); y1 = y1 / (1.f + __expf(-y1)); y2 = y2 / (1.f + __expf(-y2)); y3 = y3 / (1.f + __expf(-y3));
            u32x2 w; w.x = pk2(y0, y1); w.y = pk2(y2, y3);
            *(u32x2*)(p.MIXIN + (size_t)(tok0 + t) * 1024 + 512 + lane * 4) = w;
        }
    }
}

constexpr int MSLOT = 20480, MKR = 8192, MVT = 12288;
DI u32x4 mla_rsrc(const void* base, unsigned bytes) {
    const unsigned long long a = (unsigned long long)base;
    u32x4 r; r.x = __builtin_amdgcn_readfirstlane((unsigned)a); r.y = __builtin_amdgcn_readfirstlane((unsigned)(a >> 32) & 0xffffu); r.z = bytes; r.w = 0x00020000u;
    return r;
}
DI void mla_dma(unsigned m0v, int voff, u32x4 rsrc, unsigned soff) {
    asm volatile("s_nop 4\n\ts_mov_b32 m0, %0\n\ts_nop 0\n\tbuffer_load_dwordx4 %1, %2, %3 offen lds" :: "s"(m0v), "v"(voff), "s"(rsrc), "s"(soff) : "m0", "memory");
}
template <int ABL = 0>
DI void mla_attn_dma(const bf16* Qp, const bf16* Kn, const bf16* Kr, const bf16* VTp, bf16* Op, int b, int qb, char* lds) {
    int tid_ = threadIdx.x; asm volatile("" : "+v"(tid_)); const int tid = tid_, lane = tid & 63, r = lane & 31, hh = lane >> 5;
    const int wv = __builtin_amdgcn_readfirstlane(tid >> 6);
    const int q0 = qb * 128, qpos = q0 + 32 * wv + r;
    const size_t rowb = (size_t)b * SEQ;
    const int nt = (q0 + 128) / 64;
    const u32x4 rKn = mla_rsrc(Kn + rowb * 512, (unsigned)SEQ * 1024u), rKr = mla_rsrc(Kr + rowb * 32, (unsigned)SEQ * 64u), rVt = mla_rsrc(VTp, 64u * (unsigned)SEQ * 2u);
    const int l8 = lane >> 3, l4 = lane >> 2;
    const int f0 = l8 >> 1, f1 = f0 ^ 4;
    const int vkn = l8 * 1024 + (((lane & 7) ^ f0) << 4), vkn1 = l8 * 1024 + (((lane & 7) ^ f1) << 4), vkr = l4 * 64 + (((lane & 3) ^ ((l4 >> 2) & 3)) << 4), vvt = l8 * (SEQ * 2) + (((lane & 7) ^ f0) << 4), vvt1 = l8 * (SEQ * 2) + (((lane & 7) ^ f1) << 4);
    const unsigned ldsb = (unsigned)(size_t)(LAS3 char*)lds;
    const unsigned mkn = __builtin_amdgcn_readfirstlane(ldsb + 2048u * wv), mkr = __builtin_amdgcn_readfirstlane(ldsb + MKR + 1024u * wv), mvt = __builtin_amdgcn_readfirstlane(ldsb + MVT + 2048u * wv);
    auto dma = [&](int t, unsigned slot) {
        const unsigned key0 = 64u * t, so = slot * MSLOT;
        const unsigned skn = (key0 + 16u * wv) * 1024u, skr = (key0 + 16u * wv) * 64u, svt = (16u * wv * SEQ + key0) * 2u;
        mla_dma(mkn + so, vkn, rKn, skn); mla_dma(mkn + so + 1024u, vkn1, rKn, skn + 8u * 1024u);
        mla_dma(mkr + so, vkr, rKr, skr);
        mla_dma(mvt + so, vvt, rVt, svt); mla_dma(mvt + so + 1024u, vvt1, rVt, svt + 8u * SEQ * 2u);
    };
    dma(0, 0); if (nt > 1) dma(1, 1);
    bf16x8 qf[6];
#pragma unroll
    for (int ks = 0; ks < 6; ++ks) qf[ks] = *(const bf16x8*)(Qp + (rowb + qpos) * 768 + ks * 16 + hh * 8);
#pragma unroll
    for (int ks = 0; ks < 6; ++ks) asm volatile("" : "+v"(qf[ks]));
    asm volatile("s_waitcnt vmcnt(0)" ::: "memory");
    __syncthreads();
    f32x16 ot[2];
#pragma unroll
    for (int i = 0; i < 16; ++i) { ot[0][i] = 0.f; ot[1][i] = 0.f; }
    float m = -INFINITY, l = 0.f;
    const int sw7 = (r >> 1) & 7, sw3 = (r >> 2) & 3;
    unsigned slot = 0;
    for (int t = 0; t < nt; ++t) {
        const char* cur = lds + slot * MSLOT;
        const unsigned slot2 = (slot >= 1) ? slot - 1 : 2;
        if (!(ABL & 8)) if (t + 2 < nt) dma(t + 2, slot2);
        const int key0 = 64 * t;
        f32x16 st[2];
        bf16x8 kf[2][6];
#pragma unroll
        for (int mt = 0; mt < 2; ++mt) {
#pragma unroll
            for (int ks = 0; ks < 4; ++ks) kf[mt][ks] = *(const bf16x8*)(cur + (mt * 32 + r) * 128 + ((((ks << 1) | hh) ^ sw7) << 4));
#pragma unroll
            for (int ks = 4; ks < 6; ++ks) kf[mt][ks] = *(const bf16x8*)(cur + MKR + (mt * 32 + r) * 64 + ((((((ks - 4) << 1) | hh)) ^ sw3) << 4));
        }
        __builtin_amdgcn_sched_barrier(0);
#pragma unroll
        for (int mt = 0; mt < 2; ++mt) {
#pragma unroll
            for (int i = 0; i < 16; ++i) st[mt][i] = 0.f;
#pragma unroll
            for (int ks = 0; ks < 6; ++ks) { if (ABL & 2) { asm volatile("" :: "v"(kf[mt][ks])); st[mt][ks] += 1.f; } else st[mt] = MFMA32(kf[mt][ks], qf[ks], st[mt]); }
        }
        const char* vt = cur + MVT;
        bf16x8 vf[2][4];
#pragma unroll
        for (int mt = 0; mt < 2; ++mt)
#pragma unroll
            for (int s = 0; s < 4; ++s) vf[mt][s] = *(const bf16x8*)(vt + (mt * 32 + r) * 128 + ((((s << 1) | hh) ^ sw7) << 4));
        __builtin_amdgcn_sched_barrier(0);
        if (key0 + 63 > q0 + 32 * wv) {
#pragma unroll
            for (int mt = 0; mt < 2; ++mt)
#pragma unroll
                for (int i = 0; i < 16; ++i) { const int key = key0 + mt * 32 + crow(i, hh); if (key > qpos) st[mt][i] = -INFINITY; }
        }
        float mx = st[0][0];
#pragma unroll
        for (int i = 1; i < 16; ++i) mx = fmaxf(mx, st[0][i]);
#pragma unroll
        for (int i = 0; i < 16; ++i) mx = fmaxf(mx, st[1][i]);
        { auto rr = __builtin_amdgcn_permlane32_swap(__float_as_uint(mx), __float_as_uint(mx), false, false); mx = fmaxf(__uint_as_float(rr[0]), __uint_as_float(rr[1])); }
        const float mn = fmaxf(m, mx);
        const float alpha = __builtin_amdgcn_exp2f(m - mn);
        m = mn;
        float ps = 0.f;
#pragma unroll
        for (int mt = 0; mt < 2; ++mt)
#pragma unroll
            for (int i = 0; i < 16; ++i) { const float pv = (ABL & 1) ? (st[mt][i] - mn) : __builtin_amdgcn_exp2f(st[mt][i] - mn); st[mt][i] = pv; ps += pv; }
        l = l * alpha + ps;
#pragma unroll
        for (int i = 0; i < 16; ++i) { ot[0][i] *= alpha; ot[1][i] *= alpha; }
        bf16x8 pb[4];
#pragma unroll
        for (int s = 0; s < 4; ++s) {
            const int mt = s >> 1, o = 8 * (s & 1);
            u32x4 w; w.x = pk2(st[mt][o], st[mt][o + 1]); w.y = pk2(st[mt][o + 2], st[mt][o + 3]); w.z = pk2(st[mt][o + 4], st[mt][o + 5]); w.w = pk2(st[mt][o + 6], st[mt][o + 7]);
            pb[s] = __builtin_bit_cast(bf16x8, w);
        }
        __builtin_amdgcn_sched_barrier(0);
#pragma unroll
        for (int mt = 0; mt < 2; ++mt)
#pragma unroll
            for (int s = 0; s < 4; ++s) { if (ABL & 4) { asm volatile("" :: "v"(vf[mt][s]), "v"(pb[s])); ot[mt][s] += 1.f; } else ot[mt] = MFMA32(vf[mt][s], pb[s], ot[mt]); }
        if (t + 2 < nt && !(ABL & 8)) asm volatile("s_waitcnt vmcnt(5)" ::: "memory"); else asm volatile("s_waitcnt vmcnt(0)" ::: "memory");
        __syncthreads();
        slot = (slot == 2) ? 0 : slot + 1;
    }
    { auto rr = __builtin_amdgcn_permlane32_swap(__float_as_uint(l), __float_as_uint(l), false, false); l = __uint_as_float(rr[0]) + __uint_as_float(rr[1]); }
    const float inv = 1.f / l;
    bf16* orow = Op + (rowb + qpos) * 1024;
#pragma unroll
    for (int mt = 0; mt < 2; ++mt)
#pragma unroll
        for (int g = 0; g < 4; ++g) {
            u32x2 w; w.x = pk2(ot[mt][4 * g] * inv, ot[mt][4 * g + 1] * inv); w.y = pk2(ot[mt][4 * g + 2] * inv, ot[mt][4 * g + 3] * inv);
            *(u32x2*)(orow + mt * 32 + 8 * g + 4 * hh) = w;
        }
}
template <int ABL = 0> DI void mla_unit2(const Params& p, int u, char* lds) {
    const int nbh = (p.rows / SEQ) * 8, qb = 63 - u / nbh, bh = u % nbh, b = bh >> 3, h = bh & 7;
    mla_attn_dma<ABL>(p.Q + h * 96, p.KN + h * 64, p.KR, p.VT + (size_t)bh * 64 * SEQ, p.MIXIN + h * 64, b, qb, lds);
}

DI void swa_attn_dma(const bf16* Qp, const bf16* Kp, const bf16* VTp, bf16* Op, int b, int qb, float sink_l2, char* lds) {
    int tid_ = threadIdx.x; asm volatile("" : "+v"(tid_)); const int tid = tid_, lane = tid & 63, r = lane & 31, hh = lane >> 5;
    const int wv = __builtin_amdgcn_readfirstlane(tid >> 6);
    const int q0 = qb * 128, qpos = q0 + 32 * wv + r;
    const size_t rowb = (size_t)b * SEQ;
    const int kstart = q0 >= 128 ? q0 - 128 : 0, nt = (q0 + 128 - kstart) / 64;
    const u32x4 rK = mla_rsrc(Kp + rowb * PROJ_LD, (unsigned)SEQ * (unsigned)(PROJ_LD * 2)), rVt = mla_rsrc(VTp, 64u * (unsigned)SEQ * 2u);
    const int l8 = lane >> 3, f0 = l8 >> 1, f1 = f0 ^ 4;
    const int vk0 = l8 * (PROJ_LD * 2) + (((lane & 7) ^ f0) << 4), vk1 = l8 * (PROJ_LD * 2) + (((lane & 7) ^ f1) << 4);
    const int vv0 = l8 * (SEQ * 2) + (((lane & 7) ^ f0) << 4), vv1 = l8 * (SEQ * 2) + (((lane & 7) ^ f1) << 4);
    const unsigned ldsb = (unsigned)(size_t)(LAS3 char*)lds;
    const unsigned mk = __builtin_amdgcn_readfirstlane(ldsb + 2048u * wv), mv = __builtin_amdgcn_readfirstlane(ldsb + 8192u + 2048u * wv);
    for (int t = 0; t < nt; ++t) {
        const unsigned key0 = (unsigned)(kstart + 64 * t), so = (unsigned)t * 16384u;
        const unsigned sk = (key0 + 16u * wv) * (unsigned)(PROJ_LD * 2), sv = (16u * wv * SEQ + key0) * 2u;
        mla_dma(mk + so, vk0, rK, sk); mla_dma(mk + so + 1024u, vk1, rK, sk + 8u * (unsigned)(PROJ_LD * 2));
        mla_dma(mv + so, vv0, rVt, sv); mla_dma(mv + so + 1024u, vv1, rVt, sv + 8u * SEQ * 2u);
    }
    bf16x8 qf[4];
#pragma unroll
    for (int ks = 0; ks < 4; ++ks) qf[ks] = *(const bf16x8*)(Qp + (rowb + qpos) * PROJ_LD + ks * 16 + hh * 8);
#pragma unroll
    for (int ks = 0; ks < 4; ++ks) asm volatile("" : "+v"(qf[ks]));
    asm volatile("s_waitcnt vmcnt(0)" ::: "memory");
    __syncthreads();
    f32x16 ot[2];
#pragma unroll
    for (int i = 0; i < 16; ++i) { ot[0][i] = 0.f; ot[1][i] = 0.f; }
    float m = sink_l2, l = (hh == 0) ? 1.f : 0.f;
    const int sw7 = (r >> 1) & 7;
    for (int t = 0; t < nt; ++t) {
        const char* cur = lds + t * 16384;
        const int key0 = kstart + 64 * t;
        f32x16 st[2];
        bf16x8 kf[2][4];
#pragma unroll
        for (int mt = 0; mt < 2; ++mt)
#pragma unroll
            for (int ks = 0; ks < 4; ++ks) kf[mt][ks] = *(const bf16x8*)(cur + (mt * 32 + r) * 128 + ((((ks << 1) | hh) ^ sw7) << 4));
        __builtin_amdgcn_sched_barrier(0);
#pragma unroll
        for (int mt = 0; mt < 2; ++mt) {
#pragma unroll
            for (int i = 0; i < 16; ++i) st[mt][i] = 0.f;
#pragma unroll
            for (int ks = 0; ks < 4; ++ks) st[mt] = MFMA32(kf[mt][ks], qf[ks], st[mt]);
        }
        const char* vt = cur + 8192;
        bf16x8 vf[2][4];
#pragma unroll
        for (int mt = 0; mt < 2; ++mt)
#pragma unroll
            for (int s = 0; s < 4; ++s) vf[mt][s] = *(const bf16x8*)(vt + (mt * 32 + r) * 128 + ((((s << 1) | hh) ^ sw7) << 4));
        __builtin_amdgcn_sched_barrier(0);
#pragma unroll
        for (int mt = 0; mt < 2; ++mt)
#pragma unroll
            for (int i = 0; i < 16; ++i) { const int key = key0 + mt * 32 + crow(i, hh); if (!(key <= qpos && key > qpos - 128)) st[mt][i] = -INFINITY; }
        float mx = st[0][0];
#pragma unroll
        for (int i = 1; i < 16; ++i) mx = fmaxf(mx, st[0][i]);
#pragma unroll
        for (int i = 0; i < 16; ++i) mx = fmaxf(mx, st[1][i]);
        { auto rr = __builtin_amdgcn_permlane32_swap(__float_as_uint(mx), __float_as_uint(mx), false, false); mx = fmaxf(__uint_as_float(rr[0]), __uint_as_float(rr[1])); }
        const float mn = fmaxf(m, mx);
        const float alpha = __builtin_amdgcn_exp2f(m - mn);
        m = mn;
        float ps = 0.f;
#pragma unroll
        for (int mt = 0; mt < 2; ++mt)
#pragma unroll
            for (int i = 0; i < 16; ++i) { const float pv = __builtin_amdgcn_exp2f(st[mt][i] - mn); st[mt][i] = pv; ps += pv; }
        l = l * alpha + ps;
#pragma unroll
        for (int i = 0; i < 16; ++i) { ot[0][i] *= alpha; ot[1][i] *= alpha; }
        bf16x8 pb[4];
#pragma unroll
        for (int s = 0; s < 4; ++s) {
            const int mt = s >> 1, o = 8 * (s & 1);
            u32x4 w; w.x = pk2(st[mt][o], st[mt][o + 1]); w.y = pk2(st[mt][o + 2], st[mt][o + 3]); w.z = pk2(st[mt][o + 4], st[mt][o + 5]); w.w = pk2(st[mt][o + 6], st[mt][o + 7]);
            pb[s] = __builtin_bit_cast(bf16x8, w);
        }
        __builtin_amdgcn_sched_barrier(0);
#pragma unroll
        for (int mt = 0; mt < 2; ++mt)
#pragma unroll
            for (int s = 0; s < 4; ++s) ot[mt] = MFMA32(vf[mt][s], pb[s], ot[mt]);
    }
    { auto rr = __builtin_amdgcn_permlane32_swap(__float_as_uint(l), __float_as_uint(l), false, false); l = __uint_as_float(rr[0]) + __uint_as_float(rr[1]); }
    const float inv = 1.f / l;
    bf16* orow = Op + (rowb + qpos) * 1024;
#pragma unroll
    for (int mt = 0; mt < 2; ++mt)
#pragma unroll
        for (int g = 0; g < 4; ++g) {
            u32x2 w; w.x = pk2(ot[mt][4 * g] * inv, ot[mt][4 * g + 1] * inv); w.y = pk2(ot[mt][4 * g + 2] * inv, ot[mt][4 * g + 3] * inv);
            *(u32x2*)(orow + mt * 32 + 8 * g + 4 * hh) = w;
        }
}
DI void swa_unit2(const Params& p, int l, int u, char* lds) {
    const int qb = u & 63, bh = u >> 6, b = bh >> 2, hq = bh & 3, kvh = hq >> 1;
    swa_attn_dma(p.PROJ + 896 + hq * 64, p.PROJ + 1152 + kvh * 64, p.VsT + (size_t)(b * 2 + kvh) * 64 * SEQ, p.MIXIN + 768 + hq * 64, b, qb, p.in[15][l * 4 + hq] * LOG2E, lds);
}
DI void fold_pw_item(const Params& p, int l, int item) {
    const int tid = threadIdx.x;
    const float* wo = p.in[16] + (size_t)l * D * D + (size_t)512 * D;
    if (item < 1024) {
        const int kp = item >> 2, n = (item & 3) * 256 + tid;
        const float* wp = p.in[13] + (size_t)l * 256 * 256 + (size_t)kp * 256;
        float acc = 0.f;
        for (int j = 0; j < 256; ++j) acc += wp[j] * wo[(size_t)j * D + n];
        p.WoT[((size_t)l * D + n) * D + 512 + kp] = f2bf(acc);
    } else {
        const int n = (item - 1024) * 256 + tid;
        const float* bp = p.in[14] + l * 256;
        float acc = 0.f;
        for (int j = 0; j < 256; ++j) acc += bp[j] * wo[(size_t)j * D + n];
        p.biasO[l * D + n] = acc;
    }
}

DI void p4_tile(const Params& p, int l, int tile, const float* xin, float* X1, char* lds) {
    int tid_ = threadIdx.x; asm volatile("" : "+v"(tid_)); const int tid = tid_, lane = tid & 63, r = lane & 31, hh = lane >> 5;
    const int wv = __builtin_amdgcn_readfirstlane(tid >> 6), wm = wv >> 1, wn = wv & 1;
    const int mt = tile >> 3, nt = tile & 7, m0 = mt * 128, n0 = nt * 128;
    const bf16* A = p.MIXIN + (size_t)m0 * D;
    const bf16* W = p.WoT + ((size_t)l * D + n0) * D;
    f32x16 acc[2][2]; zero_acc(acc);
    int frow[2], grow[2];
    frow[0] = 64 * wm + r; frow[1] = frow[0] + 32; grow[0] = 64 * wn + r; grow[1] = grow[0] + 32;
    GEMM_CORE<2, 2>(A, D, W, D, D, lds, acc, 0, frow, TILE_B, grow);
    const int b = (p.tok0 + m0) / SEQ;
    const float* gt = p.MOD + ((size_t)l * BATCH + b) * 6 * D + 2 * D;
#pragma unroll
    for (int y = 0; y < 2; ++y) {
        const int col = n0 + 64 * wn + 32 * y + r;
        const float g1 = 1.f + gt[col], bo = p.biasO[l * D + col];
#pragma unroll
        for (int x = 0; x < 2; ++x) {
            const size_t base = (size_t)(m0 + 64 * wm + 32 * x + 4 * hh) * D + col;
            float xv[16];
#pragma unroll
            for (int i = 0; i < 16; ++i) xv[i] = xin[base + (size_t)((i & 3) + 8 * (i >> 2)) * D];
#pragma unroll
            for (int i = 0; i < 16; ++i) X1[base + (size_t)((i & 3) + 8 * (i >> 2)) * D] = DN_ALPHA * xv[i] + g1 * (acc[x][y][i] + bo);
        }
    }
}

DI void ln16(float (&v)[16], const float* g, const float* bta, int lane) {
    float s = 0.f;
#pragma unroll
    for (int i = 0; i < 16; ++i) s += v[i];
#pragma unroll
    for (int o = 1; o < 64; o <<= 1) s += __shfl_xor(s, o);
    const float mean = s * (1.f / D); float q = 0.f;
#pragma unroll
    for (int i = 0; i < 16; ++i) { v[i] -= mean; q += v[i] * v[i]; }
#pragma unroll
    for (int o = 1; o < 64; o <<= 1) q += __shfl_xor(q, o);
    const float rstd = rsqrtf(q * (1.f / D) + EPS);
#pragma unroll
    for (int hf = 0; hf < 2; ++hf)
#pragma unroll
        for (int q4 = 0; q4 < 2; ++q4) {
            const int c = hf * 512 + lane * 8 + q4 * 4;
            const float4 gg = *(const float4*)(g + c), bb = *(const float4*)(bta + c);
            const int i = hf * 8 + q4 * 4;
            v[i] = v[i] * rstd * gg.x + bb.x; v[i + 1] = v[i + 1] * rstd * gg.y + bb.y; v[i + 2] = v[i + 2] * rstd * gg.z + bb.z; v[i + 3] = v[i + 3] * rstd * gg.w + bb.w;
        }
}
DI void load16(float (&v)[16], const float* row, int lane) {
#pragma unroll
    for (int hf = 0; hf < 2; ++hf)
#pragma unroll
        for (int q4 = 0; q4 < 2; ++q4) { const float4 t = *(const float4*)(row + hf * 512 + lane * 8 + q4 * 4); const int i = hf * 8 + q4 * 4; v[i] = t.x; v[i + 1] = t.y; v[i + 2] = t.z; v[i + 3] = t.w; }
}
DI void store16f(float* row, const float (&v)[16], int lane) {
#pragma unroll
    for (int hf = 0; hf < 2; ++hf)
#pragma unroll
        for (int q4 = 0; q4 < 2; ++q4) { const int i = hf * 8 + q4 * 4; *(float4*)(row + hf * 512 + lane * 8 + q4 * 4) = make_float4(v[i], v[i + 1], v[i + 2], v[i + 3]); }
}
DI void store_mod16(bf16* hrow, const float (&v)[16], const float* sh, const float* sc, int lane) {
#pragma unroll
    for (int hf = 0; hf < 2; ++hf) {
        float o[8];
#pragma unroll
        for (int q4 = 0; q4 < 2; ++q4) {
            const int c = hf * 512 + lane * 8 + q4 * 4, i = hf * 8 + q4 * 4;
            const float4 s4 = *(const float4*)(sc + c), h4 = *(const float4*)(sh + c);
            o[q4 * 4] = v[i] * (1.f + s4.x) + h4.x; o[q4 * 4 + 1] = v[i + 1] * (1.f + s4.y) + h4.y; o[q4 * 4 + 2] = v[i + 2] * (1.f + s4.z) + h4.z; o[q4 * 4 + 3] = v[i + 3] * (1.f + s4.w) + h4.w;
        }
        store8(hrow + hf * 512 + lane * 8, o);
    }
}
DI void p4b_row(const Params& p, int l, int row, float* X1, int lane) {
    float v[16];
    load16(v, X1 + (size_t)row * D, lane);
    float s = 0.f;
#pragma unroll
    for (int i = 0; i < 16; ++i) s += v[i];
#pragma unroll
    for (int o = 1; o < 64; o <<= 1) s += __shfl_xor(s, o);
    const float mean = s * (1.f / D); float q = 0.f;
#pragma unroll
    for (int i = 0; i < 16; ++i) { v[i] -= mean; q += v[i] * v[i]; }
#pragma unroll
    for (int o = 1; o < 64; o <<= 1) q += __shfl_xor(q, o);
    const float rstd = rsqrtf(q * (1.f / D) + EPS);
    if (lane == 0) { p.STATS[2 * (size_t)row] = mean; p.STATS[2 * (size_t)row + 1] = rstd; }
    const float* g = p.in[17] + l * D; const float* bta = p.in[18] + l * D;
#pragma unroll
    for (int hf = 0; hf < 2; ++hf)
#pragma unroll
        for (int q4 = 0; q4 < 2; ++q4) {
            const int c = hf * 512 + lane * 8 + q4 * 4;
            const float4 gg = *(const float4*)(g + c), bb = *(const float4*)(bta + c);
            const int i = hf * 8 + q4 * 4;
            v[i] = v[i] * rstd * gg.x + bb.x; v[i + 1] = v[i + 1] * rstd * gg.y + bb.y; v[i + 2] = v[i + 2] * rstd * gg.z + bb.z; v[i + 3] = v[i + 3] * rstd * gg.w + bb.w;
        }
    const int b = (p.tok0 + row) / SEQ;
    const float* mod = p.MOD + ((size_t)l * BATCH + b) * 6 * D;
    store_mod16(p.H + (size_t)row * D, v, mod + 3 * D, mod + 4 * D, lane);
}

DI unsigned ford(float f) { const unsigned u = __float_as_uint(f); return u ^ ((u >> 31) ? 0xffffffffu : 0x80000000u); }
DI float funord(unsigned o) { const unsigned u = o ^ ((o >> 31) ? 0x80000000u : 0xffffffffu); return __uint_as_float(u); }
constexpr int SKSTR = 272;

DI void p5_tile(const Params& p, int l, int tile, char* lds) {
    int tid_ = threadIdx.x; asm volatile("" : "+v"(tid_)); const int tid = tid_, lane = tid & 63, r = lane & 31, hh = lane >> 5;
    const int wv = __builtin_amdgcn_readfirstlane(tid >> 6);
    const int mt = tile >> 4, hp = tile & 15, m0 = mt * 128;
    const bf16* A = p.H + (size_t)m0 * D;
    const bf16* W = p.WpqT + ((size_t)l * 2048 + hp * 128) * D;
    f32x16 acc[4][1]; zero_acc(acc);
    int frow[4], grow[1];
#pragma unroll
    for (int x = 0; x < 4; ++x) frow[x] = 32 * x + r;
    grow[0] = 32 * wv + r;
    GEMM_CORE<4, 1>(A, D, W, D, D, lds, acc, TILE_B, frow, 0, grow);
#ifdef G3_PROBE
    const int dry5 = __builtin_amdgcn_readfirstlane(*(volatile int*)(lds + LDS_BYTES + 1024 - 64));
    if (dry5 & 4) return;
#endif
    bf16x8 xb[8];
#pragma unroll
    for (int s = 0; s < 8; ++s) {
        const int x = s >> 1, o = 8 * (s & 1);
        u32x4 w; w.x = pk2(acc[x][0][o], acc[x][0][o + 1]); w.y = pk2(acc[x][0][o + 2], acc[x][0][o + 3]); w.z = pk2(acc[x][0][o + 4], acc[x][0][o + 5]); w.w = pk2(acc[x][0][o + 6], acc[x][0][o + 7]);
        xb[s] = __builtin_bit_cast(bf16x8, w);
    }
    const bf16* sk = p.SKp + ((size_t)l * 16 + hp) * 128 * 128;
#pragma unroll
    for (int i = 0; i < 8; ++i) { const int q = tid + 256 * i, row = q >> 4, c = q & 15; *(u32x4*)(lds + row * SKSTR + c * 16) = *(const u32x4*)(sk + row * 128 + c * 8); }
    __syncthreads();
    unsigned L[16];
#pragma unroll
    for (int m2 = 0; m2 < 4; ++m2) {
        f32x16 st;
#pragma unroll
        for (int i = 0; i < 16; ++i) st[i] = 0.f;
#pragma unroll
        for (int s = 0; s < 8; ++s) {
            const bf16x8 a = *(const bf16x8*)(lds + (32 * m2 + r) * SKSTR + s * 32 + hh * 16);
            st = MFMA32(a, xb[s], st);
        }
        unsigned V[16];
#pragma unroll
        for (int i = 0; i < 16; ++i) V[i] = (ford(st[i]) & ~0x7fu) | (unsigned)(32 * m2 + crow(i, hh));
#pragma unroll
        for (int k = 2; k <= 16; k <<= 1)
#pragma unroll
            for (int j = k >> 1; j >= 1; j >>= 1)
#pragma unroll
                for (int i = 0; i < 16; ++i) { const int o = i ^ j; if (o > i) { const unsigned a = max(V[i], V[o]), b = min(V[i], V[o]); if ((i & k) == 0) { V[i] = a; V[o] = b; } else { V[i] = b; V[o] = a; } } }
        if (m2 == 0) {
#pragma unroll
            for (int k = 0; k < 16; ++k) L[k] = V[k];
        } else {
#pragma unroll
            for (int k = 0; k < 16; ++k) L[k] = max(L[k], V[15 - k]);
#pragma unroll
            for (int d = 8; d >= 1; d >>= 1)
#pragma unroll
                for (int i = 0; i < 16; ++i) if ((i & d) == 0) { const unsigned a = max(L[i], L[i + d]), b = min(L[i], L[i + d]); L[i] = a; L[i + d] = b; }
        }
    }
    unsigned C[16];
#pragma unroll
    for (int k = 0; k < 16; ++k) C[k] = max(L[k], (unsigned)__shfl_xor((int)L[15 - k], 32));
#pragma unroll
    for (int d = 8; d >= 1; d >>= 1)
#pragma unroll
        for (int i = 0; i < 16; ++i) if ((i & d) == 0) { const unsigned a = max(C[i], C[i + d]), b = min(C[i], C[i + d]); C[i] = a; C[i + d] = b; }
    unsigned* dst = p.TOPK + ((size_t)(m0 + 32 * wv + r) * 16 + hp) * 16 + 8 * hh;
    u32x4 o0, o1;
    if (hh == 0) { o0 = (u32x4){C[0], C[1], C[2], C[3]}; o1 = (u32x4){C[4], C[5], C[6], C[7]}; }
    else { o0 = (u32x4){C[8], C[9], C[10], C[11]}; o1 = (u32x4){C[12], C[13], C[14], C[15]}; }
    *(u32x4*)dst = o0; *(u32x4*)(dst + 4) = o1;
}
typedef __bf16 bf16x2v __attribute__((ext_vector_type(2)));
DI float dot2(unsigned a, unsigned b, float c) { return __builtin_amdgcn_fdot2_f32_bf16(__builtin_bit_cast(bf16x2v, a), __builtin_bit_cast(bf16x2v, b), c, false); }
DI float gelu_erf(float a) { return 0.5f * a * (1.f + erff(a * 0.70710678118654752f)); }

DI void p6_unit(const Params& p, int l, int u, const float* X1, float* xout, char* lds) {
    int tid_ = threadIdx.x; asm volatile("" : "+v"(tid_)); const int tid = tid_, lane = tid & 63;
    const int wv = __builtin_amdgcn_readfirstlane(tid >> 6);
    unsigned* LA = (unsigned*)(lds + wv * 16384); unsigned* LB = LA + 1024; unsigned* Ee = LA + 2048; float* Eg = (float*)(LA + 3072);
    const int tokb = u * 32 + wv * 8;
    __syncthreads();
    {
        const int ti = lane >> 3, head = lane & 7;
        const unsigned* src = p.TOPK + ((size_t)(tokb + ti) * 16 + head * 2) * 16;
        unsigned A[16], B[16];
#pragma unroll
        for (int q = 0; q < 4; ++q) { const u32x4 a = *(const u32x4*)(src + 4 * q), b = *(const u32x4*)(src + 16 + 4 * q);
            A[4 * q] = a.x; A[4 * q + 1] = a.y; A[4 * q + 2] = a.z; A[4 * q + 3] = a.w; B[4 * q] = b.x; B[4 * q + 1] = b.y; B[4 * q + 2] = b.z; B[4 * q + 3] = b.w;
            *(u32x4*)(LA + lane * 16 + 4 * q) = a; *(u32x4*)(LB + lane * 16 + 4 * q) = b; }
        float sA[16], sB[16];
#pragma unroll
        for (int k = 0; k < 16; ++k) { sA[k] = funord(A[k] & ~0x7fu); sB[k] = funord(B[k] & ~0x7fu); }
        unsigned T[16];
#pragma unroll
        for (int k = 0; k < 16; ++k) T[k] = 0u;
#pragma unroll
        for (int a = 0; a < 16; ++a)
#pragma unroll
            for (int b = 0; b < 16; ++b)
                if ((a + 1) * (b + 1) <= 16) {
                    unsigned v = (ford(sA[a] + sB[b]) & ~0xffu) | (unsigned)(a * 16 + b);
#pragma unroll
                    for (int k = 0; k < 16; ++k) { const unsigned t = max(T[k], v); v = min(T[k], v); T[k] = t; }
                }
        float ex[16]; float sum = 0.f; const float mx = funord(T[0] & ~0xffu);
#pragma unroll
        for (int k = 0; k < 16; ++k) { ex[k] = __expf(funord(T[k] & ~0xffu) - mx); sum += ex[k]; }
        const float inv = 1.f / sum;
#pragma unroll
        for (int k = 0; k < 16; ++k) {
            const unsigned cid = T[k] & 0xffu, ia = LA[lane * 16 + (cid >> 4)] & 0x7fu, ib = LB[lane * 16 + (cid & 15u)] & 0x7fu;
            Ee[ti * 128 + head * 16 + k] = ia * 128u + ib; Eg[ti * 128 + head * 16 + k] = ex[k] * inv;
        }
    }
    const bf16* Ut = p.Ut; const bf16* Vt = p.Vt;
    const int jl = 4 * (lane >> 5) + 2 * ((lane >> 4) & 1) + ((lane >> 3) & 1);
    const bool b5 = lane & 32, b4 = lane & 16, b3 = lane & 8;
#pragma unroll 1
    for (int ti = 0; ti < 8; ++ti) {
        const int tok = tokb + ti;
        const u32x4 h0 = *(const u32x4*)(p.H + (size_t)tok * D + lane * 8), h1 = *(const u32x4*)(p.H + (size_t)tok * D + 512 + lane * 8);
        float y[16];
#pragma unroll
        for (int i = 0; i < 16; ++i) y[i] = 0.f;
#pragma unroll 1
        for (int bt = 0; bt < 16; ++bt) {
            u32x4 uu[8][2], vv[8][2];
#pragma unroll
            for (int j = 0; j < 8; ++j) {
                const unsigned e = __builtin_amdgcn_readfirstlane(Ee[ti * 128 + bt * 8 + j]);
                const bf16* ur = Ut + (size_t)e * D + lane * 8; const bf16* vr = Vt + (size_t)e * D + lane * 8;
                uu[j][0] = *(const u32x4*)ur; uu[j][1] = *(const u32x4*)(ur + 512);
                vv[j][0] = *(const u32x4*)vr; vv[j][1] = *(const u32x4*)(vr + 512);
            }
            float a[8];
#pragma unroll
            for (int j = 0; j < 8; ++j) {
                float s = dot2(h0.x, uu[j][0].x, 0.f); s = dot2(h0.y, uu[j][0].y, s); s = dot2(h0.z, uu[j][0].z, s); s = dot2(h0.w, uu[j][0].w, s);
                s = dot2(h1.x, uu[j][1].x, s); s = dot2(h1.y, uu[j][1].y, s); s = dot2(h1.z, uu[j][1].z, s); s = dot2(h1.w, uu[j][1].w, s);
                a[j] = s;
            }
            float k1[4], k2[2], k3;
#pragma unroll
            for (int i = 0; i < 4; ++i) { const float snd = b5 ? a[i] : a[4 + i]; const float rcv = __shfl_xor(snd, 32); k1[i] = (b5 ? a[4 + i] : a[i]) + rcv; }
#pragma unroll
            for (int i = 0; i < 2; ++i) { const float snd = b4 ? k1[i] : k1[2 + i]; const float rcv = __shfl_xor(snd, 16); k2[i] = (b4 ? k1[2 + i] : k1[i]) + rcv; }
            { const float snd = b3 ? k2[0] : k2[1]; const float rcv = __shfl_xor(snd, 8); k3 = (b3 ? k2[1] : k2[0]) + rcv; }
            k3 += __shfl_xor(k3, 4); k3 += __shfl_xor(k3, 2); k3 += __shfl_xor(k3, 1);
            const float w = Eg[ti * 128 + bt * 8 + jl] * gelu_erf(k3);
#pragma unroll
            for (int j = 0; j < 8; ++j) {
                const int src = 32 * (j >> 2) + 16 * ((j >> 1) & 1) + 8 * (j & 1);
                const float wj = __uint_as_float(__builtin_amdgcn_readlane(__float_as_uint(w), src));
                const unsigned w0[4] = {vv[j][0].x, vv[j][0].y, vv[j][0].z, vv[j][0].w}, w1[4] = {vv[j][1].x, vv[j][1].y, vv[j][1].z, vv[j][1].w};
#pragma unroll
                for (int i = 0; i < 4; ++i) { y[2 * i] += wj * bflo(w0[i]); y[2 * i + 1] += wj * bfhi(w0[i]); y[8 + 2 * i] += wj * bflo(w1[i]); y[8 + 2 * i + 1] += wj * bfhi(w1[i]); }
            }
        }
        const int b = (p.tok0 + tok) / SEQ;
        const float* mod = p.MOD + ((size_t)l * BATCH + b) * 6 * D;
        float v[16], gt[16];
        load16(v, X1 + (size_t)tok * D, lane); load16(gt, mod + 5 * D, lane);
#pragma unroll
        for (int i = 0; i < 16; ++i) v[i] = DN_ALPHA * v[i] + (1.f + gt[i]) * y[i];
        ln16(v, p.in[23] + l * D, p.in[24] + l * D, lane);
        store16f(xout + (size_t)tok * D, v, lane);
        if (l + 1 < DEPTH) { const float* modn = p.MOD + ((size_t)(l + 1) * BATCH + b) * 6 * D; store_mod16(p.H + (size_t)tok * D, v, modn, modn + D, lane); }
    }
}
DI void table_row_fp8(const float* src, unsigned char* dst, float* inv_scale, int lane) {
    float v[16];
#pragma unroll
    for (int q = 0; q < 4; ++q) { const float4 t = *(const float4*)(src + lane * 16 + q * 4); v[4 * q] = t.x; v[4 * q + 1] = t.y; v[4 * q + 2] = t.z; v[4 * q + 3] = t.w; }
    float mx = 0.f;
#pragma unroll
    for (int i = 0; i < 16; ++i) mx = fmaxf(mx, fabsf(v[i]));
#pragma unroll
    for (int o = 1; o < 64; o <<= 1) mx = fmaxf(mx, __shfl_xor(mx, o));
    const float sc = (mx > 0.f) ? 448.f / mx : 1.f;
    u32x4 o;
    unsigned w[4];
#pragma unroll
    for (int q = 0; q < 4; ++q) { unsigned t = 0u; t = __builtin_amdgcn_cvt_pk_fp8_f32(v[4 * q] * sc, v[4 * q + 1] * sc, t, false); t = __builtin_amdgcn_cvt_pk_fp8_f32(v[4 * q + 2] * sc, v[4 * q + 3] * sc, t, true); w[q] = t; }
    o.x = w[0]; o.y = w[1]; o.z = w[2]; o.w = w[3];
    *(u32x4*)(dst + lane * 16) = o;
    if (lane == 0) *inv_scale = (mx > 0.f) ? mx * (1.f / 448.f) : 1.f;
}
DI void convert_tables_fp8(const Params& p, int l, int bid, int nb) {
    int t_ = threadIdx.x; asm volatile("" : "+v"(t_)); const int wv = t_ >> 6, lane = t_ & 63;
    const float* us = p.in[21] + (size_t)l * 16384 * D; const float* vs = p.in[22] + (size_t)l * 16384 * D;
    for (int row = bid * 4 + wv; row < 2 * 16384; row += nb * 4) {
        if (row < 16384) table_row_fp8(us + (size_t)row * D, p.U8 + (size_t)row * D, p.US + l * 16384 + row, lane);
        else { const int r2 = row - 16384; table_row_fp8(vs + (size_t)r2 * D, p.V8 + (size_t)r2 * D, p.VS + l * 16384 + r2, lane); }
    }
}
DI void load16c(float (&v)[16], const float* row, int lane) {
#pragma unroll
    for (int q = 0; q < 4; ++q) { const float4 t = *(const float4*)(row + lane * 16 + q * 4); v[4 * q] = t.x; v[4 * q + 1] = t.y; v[4 * q + 2] = t.z; v[4 * q + 3] = t.w; }
}
DI void ln16c(float (&v)[16], const float* g, const float* bta, int lane) {
    float s = 0.f;
#pragma unroll
    for (int i = 0; i < 16; ++i) s += v[i];
#pragma unroll
    for (int o = 1; o < 64; o <<= 1) s += __shfl_xor(s, o);
    const float mean = s * (1.f / D); float q = 0.f;
#pragma unroll
    for (int i = 0; i < 16; ++i) { v[i] -= mean; q += v[i] * v[i]; }
#pragma unroll
    for (int o = 1; o < 64; o <<= 1) q += __shfl_xor(q, o);
    const float rstd = rsqrtf(q * (1.f / D) + EPS);
    float gg[16], bb[16]; load16c(gg, g, lane); load16c(bb, bta, lane);
#pragma unroll
    for (int i = 0; i < 16; ++i) v[i] = v[i] * rstd * gg[i] + bb[i];
}
DI void store16c(float* row, const float (&v)[16], int lane) {
#pragma unroll
    for (int q = 0; q < 4; ++q) *(float4*)(row + lane * 16 + q * 4) = make_float4(v[4 * q], v[4 * q + 1], v[4 * q + 2], v[4 * q + 3]);
}
DI void store_mod16c(bf16* hrow, const float (&v)[16], const float* sh, const float* sc, int lane) {
    float s[16], h[16], o[16]; load16c(s, sc, lane); load16c(h, sh, lane);
#pragma unroll
    for (int i = 0; i < 16; ++i) o[i] = v[i] * (1.f + s[i]) + h[i];
    store16(hrow + lane * 16, o);
}

DI void p6f_unit(const Params& p, int l, int u, const float* X1, float* xout, char* lds) {
    int tid_ = threadIdx.x; asm volatile("" : "+v"(tid_)); const int tid = tid_, lane = tid & 63;
    const int wv = __builtin_amdgcn_readfirstlane(tid >> 6);
    unsigned* LA = (unsigned*)(lds + wv * 16384); unsigned* LB = LA + 1024; unsigned* Ee = LA + 2048; float* Eg = (float*)(LA + 3072); float* Es = (float*)LA;
    const int tokb = u * 32 + wv * 8;
    __syncthreads();
    {
        const int ti = lane >> 3, head = lane & 7;
        const unsigned* src = p.TOPK + ((size_t)(tokb + ti) * 16 + head * 2) * 16;
        unsigned A[16], B[16];
#pragma unroll
        for (int q = 0; q < 4; ++q) { const u32x4 a = *(const u32x4*)(src + 4 * q), b = *(const u32x4*)(src + 16 + 4 * q);
            A[4 * q] = a.x; A[4 * q + 1] = a.y; A[4 * q + 2] = a.z; A[4 * q + 3] = a.w; B[4 * q] = b.x; B[4 * q + 1] = b.y; B[4 * q + 2] = b.z; B[4 * q + 3] = b.w;
            *(u32x4*)(LA + lane * 16 + 4 * q) = a; *(u32x4*)(LB + lane * 16 + 4 * q) = b; }
        float sA[16], sB[16];
#pragma unroll
        for (int k = 0; k < 16; ++k) { sA[k] = funord(A[k] & ~0x7fu); sB[k] = funord(B[k] & ~0x7fu); }
        unsigned T[16];
#pragma unroll
        for (int k = 0; k < 16; ++k) T[k] = 0u;
#pragma unroll
        for (int a = 0; a < 16; ++a)
#pragma unroll
            for (int b = 0; b < 16; ++b)
                if ((a + 1) * (b + 1) <= 16) {
                    unsigned v = (ford(sA[a] + sB[b]) & ~0xffu) | (unsigned)(a * 16 + b);
#pragma unroll
                    for (int k = 0; k < 16; ++k) { const unsigned t = max(T[k], v); v = min(T[k], v); T[k] = t; }
                }
        float ex[16]; float sum = 0.f; const float mx = funord(T[0] & ~0xffu);
        unsigned ev[16];
#pragma unroll
        for (int k = 0; k < 16; ++k) { ex[k] = __expf(funord(T[k] & ~0xffu) - mx); sum += ex[k];
            const unsigned cid = T[k] & 0xffu; ev[k] = (LA[lane * 16 + (cid >> 4)] & 0x7fu) * 128u + (LB[lane * 16 + (cid & 15u)] & 0x7fu); }
        const float inv = 1.f / sum;
        const float* US = p.US + l * 16384; const float* VS = p.VS + l * 16384;
#pragma unroll
        for (int k = 0; k < 16; ++k) {
            const float su = US[ev[k]], sv = VS[ev[k]];
            Ee[ti * 128 + head * 16 + k] = ev[k]; Eg[ti * 128 + head * 16 + k] = ex[k] * inv * sv; Es[ti * 128 + head * 16 + k] = su;
        }
    }
    const unsigned char* U8 = p.U8; const unsigned char* V8 = p.V8;
    const int jl = 8 * (lane >> 5) + 4 * ((lane >> 4) & 1) + 2 * ((lane >> 3) & 1) + ((lane >> 2) & 1);
    const bool b5 = lane & 32, b4 = lane & 16, b3 = lane & 8, b2 = lane & 4;
#pragma unroll 1
    for (int ti = 0; ti < 8; ++ti) {
        const int tok = tokb + ti;
        const u32x4 h0 = *(const u32x4*)(p.H + (size_t)tok * D + lane * 16), h1 = *(const u32x4*)(p.H + (size_t)tok * D + lane * 16 + 8);
        const unsigned hw[8] = {h0.x, h0.y, h0.z, h0.w, h1.x, h1.y, h1.z, h1.w};
        f32x2v hf[8], y2[8];
#pragma unroll
        for (int i = 0; i < 8; ++i) { hf[i] = (f32x2v){bflo(hw[i]), bfhi(hw[i])}; y2[i] = (f32x2v){0.f, 0.f}; }
#pragma unroll 1
        for (int bt = 0; bt < 8; ++bt) {
            u32x4 uu[16], vv[16];
#pragma unroll
            for (int j = 0; j < 16; ++j) {
                const unsigned e = __builtin_amdgcn_readfirstlane(Ee[ti * 128 + bt * 16 + j]);
                uu[j] = *(const u32x4*)(U8 + (size_t)e * D + lane * 16);
                vv[j] = *(const u32x4*)(V8 + (size_t)e * D + lane * 16);
            }
            float a[16];
#pragma unroll
            for (int j = 0; j < 16; ++j) {
                const unsigned w[4] = {uu[j].x, uu[j].y, uu[j].z, uu[j].w};
                f32x2v acc = {0.f, 0.f};
#pragma unroll
                for (int q = 0; q < 4; ++q) { acc = __builtin_amdgcn_cvt_pk_f32_fp8(w[q], false) * hf[2 * q] + acc; acc = __builtin_amdgcn_cvt_pk_f32_fp8(w[q], true) * hf[2 * q + 1] + acc; }
                a[j] = acc.x + acc.y;
            }
            float k1[8], k2[4], k3[2], k4;
#pragma unroll
            for (int i = 0; i < 8; ++i) { const float snd = b5 ? a[i] : a[8 + i]; const float rcv = __shfl_xor(snd, 32); k1[i] = (b5 ? a[8 + i] : a[i]) + rcv; }
#pragma unroll
            for (int i = 0; i < 4; ++i) { const float snd = b4 ? k1[i] : k1[4 + i]; const float rcv = __shfl_xor(snd, 16); k2[i] = (b4 ? k1[4 + i] : k1[i]) + rcv; }
#pragma unroll
            for (int i = 0; i < 2; ++i) { const float snd = b3 ? k2[i] : k2[2 + i]; const float rcv = __shfl_xor(snd, 8); k3[i] = (b3 ? k2[2 + i] : k2[i]) + rcv; }
            { const float snd = b2 ? k3[0] : k3[1]; const float rcv = __shfl_xor(snd, 4); k4 = (b2 ? k3[1] : k3[0]) + rcv; }
            k4 += __shfl_xor(k4, 2); k4 += __shfl_xor(k4, 1);
            const int ei = ti * 128 + bt * 16 + jl;
            const float w = Eg[ei] * gelu_erf(k4 * Es[ei]);
#pragma unroll
            for (int j = 0; j < 16; ++j) {
                const int src = 32 * (j >> 3) + 16 * ((j >> 2) & 1) + 8 * ((j >> 1) & 1) + 4 * (j & 1);
                const float wj = __uint_as_float(__builtin_amdgcn_readlane(__float_as_uint(w), src));
                const f32x2v wj2 = {wj, wj};
                const unsigned wd[4] = {vv[j].x, vv[j].y, vv[j].z, vv[j].w};
#pragma unroll
                for (int q = 0; q < 4; ++q) { y2[2 * q] = __builtin_amdgcn_cvt_pk_f32_fp8(wd[q], false) * wj2 + y2[2 * q]; y2[2 * q + 1] = __builtin_amdgcn_cvt_pk_f32_fp8(wd[q], true) * wj2 + y2[2 * q + 1]; }
            }
        }
        const int b = (p.tok0 + tok) / SEQ;
        const float* mod = p.MOD + ((size_t)l * BATCH + b) * 6 * D;
        float v[16], gt[16];
        load16c(v, X1 + (size_t)tok * D, lane); load16c(gt, mod + 5 * D, lane);
        {
            const float mean1 = p.STATS[2 * (size_t)tok], rstd1 = p.STATS[2 * (size_t)tok + 1];
            float g1[16], b1[16]; load16c(g1, p.in[17] + l * D, lane); load16c(b1, p.in[18] + l * D, lane);
#pragma unroll
            for (int i = 0; i < 16; ++i) v[i] = (v[i] - mean1) * rstd1 * g1[i] + b1[i];
        }
#pragma unroll
        for (int i = 0; i < 8; ++i) { v[2 * i] = DN_ALPHA * v[2 * i] + (1.f + gt[2 * i]) * y2[i].x; v[2 * i + 1] = DN_ALPHA * v[2 * i + 1] + (1.f + gt[2 * i + 1]) * y2[i].y; }
        ln16c(v, p.in[23] + l * D, p.in[24] + l * D, lane);
        store16c(xout + (size_t)tok * D, v, lane);
        if (l + 1 < DEPTH) { const float* modn = p.MOD + ((size_t)(l + 1) * BATCH + b) * 6 * D; store_mod16c(p.H + (size_t)tok * D, v, modn, modn + D, lane); }
    }
}
#ifndef P6_NR
#define P6_NR 8
#endif
constexpr int NR = P6_NR, RSH = (NR == 16) ? 10 : (NR == 8) ? 11 : (NR == 4) ? 12 : (NR == 2) ? 13 : 14;

DI void p6x_combine(const Params& p, int l, int tokb, unsigned* LA, unsigned* LB, unsigned* Ee, float* Eg, float* Es, int lane) {
    const int ti = lane >> 3, head = lane & 7;
    const unsigned* src = p.TOPK + ((size_t)(tokb + ti) * 16 + head * 2) * 16;
    unsigned A[16], B[16];
#pragma unroll
    for (int q = 0; q < 4; ++q) { const u32x4 a = *(const u32x4*)(src + 4 * q), b = *(const u32x4*)(src + 16 + 4 * q);
        A[4 * q] = a.x; A[4 * q + 1] = a.y; A[4 * q + 2] = a.z; A[4 * q + 3] = a.w; B[4 * q] = b.x; B[4 * q + 1] = b.y; B[4 * q + 2] = b.z; B[4 * q + 3] = b.w;
        *(u32x4*)(LA + lane * 16 + 4 * q) = a; *(u32x4*)(LB + lane * 16 + 4 * q) = b; }
    float sA[16], sB[16];
#pragma unroll
    for (int k = 0; k < 16; ++k) { sA[k] = funord(A[k] & ~0x7fu); sB[k] = funord(B[k] & ~0x7fu); }
    unsigned T[16];
#pragma unroll
    for (int k = 0; k < 16; ++k) T[k] = 0u;
#pragma unroll
    for (int a = 0; a < 16; ++a)
#pragma unroll
        for (int b = 0; b < 16; ++b)
            if ((a + 1) * (b + 1) <= 16) {
                unsigned v = (ford(sA[a] + sB[b]) & ~0xffu) | (unsigned)(a * 16 + b);
#pragma unroll
                for (int k = 0; k < 16; ++k) { const unsigned t = max(T[k], v); v = min(T[k], v); T[k] = t; }
            }
    float ex[16]; float sum = 0.f; const float mx = funord(T[0] & ~0xffu);
    unsigned ev[16];
#pragma unroll
    for (int k = 0; k < 16; ++k) { ex[k] = __expf(funord(T[k] & ~0xffu) - mx); sum += ex[k];
        const unsigned cid = T[k] & 0xffu; ev[k] = (LA[lane * 16 + (cid >> 4)] & 0x7fu) * 128u + (LB[lane * 16 + (cid & 15u)] & 0x7fu); }
    const float inv = 1.f / sum;
    const float* US = p.US + l * 16384; const float* VS = p.VS + l * 16384;
    float su[16], gv[16];
#pragma unroll
    for (int k = 0; k < 16; ++k) { su[k] = US[ev[k]]; gv[k] = ex[k] * inv * VS[ev[k]]; }
    unsigned* cnt = LB; unsigned* off = LB + 8 * NR; unsigned* cur = LB + 16 * NR;
    for (int i = lane; i < 24 * NR; i += 64) LB[i] = 0u;
#pragma unroll
    for (int k = 0; k < 16; ++k) atomicAdd(&cnt[ti * NR + (ev[k] >> RSH)], 1u);
    {
#pragma unroll
        for (int rb = 0; rb < NR; rb += 8) {
            unsigned s = 0u;
#pragma unroll
            for (int r = 0; r < NR; ++r) { const unsigned c = cnt[ti * NR + r]; if (r < head + rb) s += c; }
            if (head + rb < NR) off[ti * NR + head + rb] = s;
        }
    }
#pragma unroll
    for (int k = 0; k < 16; ++k) {
        const int r = ev[k] >> RSH;
        const unsigned pos = off[ti * NR + r] + atomicAdd(&cur[ti * NR + r], 1u);
        Ee[ti * 128 + pos] = ev[k]; Eg[ti * 128 + pos] = gv[k]; Es[ti * 128 + pos] = su[k];
    }
}

DI float gelu_fast(float v) {
    const float av = fabsf(v), t = __builtin_amdgcn_rcpf(av * 0.2316418882f + 1.0f);
    float q = t * 0.5307027145f + (-0.7265760135f); q = q * t + 0.7107068705f; q = q * t + (-0.142248368f); q = q * t + 0.127414796f; q = q * t;
    const float e = __builtin_amdgcn_exp2f((v * v) * (-0.72134752044f));
    const float m = v * (q * e);
    return v < 0.f ? m : v - m;
}
template <bool DRY> DI void p6x_ids(unsigned (&en)[8], const unsigned* Ee, unsigned desc) {
    const int ebase = desc & 0x3ff, n = (desc >> 10) & 0xf;
#pragma unroll
    for (int j = 0; j < 8; ++j) en[j] = (__builtin_amdgcn_readfirstlane(Ee[ebase + (j < n ? j : 0)]) & (DRY ? 1023u : 0xffffu)) * (unsigned)D;
}
typedef __amdgpu_buffer_rsrc_t rsrc_t;
DI u32x4 rowload(rsrc_t r, int voff, unsigned soff) { return __builtin_amdgcn_raw_buffer_load_b128(r, voff, (int)soff, 0); }
DI void p6x_issue(u32x4 (&buf)[8], rsrc_t T8, const unsigned (&en)[8], int voff) {
#pragma unroll
    for (int j = 0; j < 8; ++j) buf[j] = rowload(T8, voff, en[j]);
}
template <int CTRL> DI float dppf(float v) { return __uint_as_float(__builtin_amdgcn_mov_dpp(__float_as_uint(v), CTRL, 0xf, 0xf, true)); }
DI float pair32(float x, float y) { auto r = __builtin_amdgcn_permlane32_swap(__float_as_uint(x), __float_as_uint(y), false, false); return __uint_as_float(r[0]) + __uint_as_float(r[1]); }
DI float pair16(float x, float y) { auto r = __builtin_amdgcn_permlane16_swap(__float_as_uint(x), __float_as_uint(y), false, false); return __uint_as_float(r[0]) + __uint_as_float(r[1]); }
DI float p6x_dots(u32x4 (&uu)[8], rsrc_t U8, const unsigned (&en)[8], bool refill, u32x4 (&hw)[2], const bf16* hnext, const float* Eg, const float* Es, unsigned desc,
                  int lane, int jl, bool b5, bool b4, bool b3) {
    const int ebase = desc & 0x3ff, n = (desc >> 10) & 0xf;
    float a[8];
    {
        f32x2v hf[8];
#pragma unroll
        for (int i = 0; i < 8; ++i) { const unsigned hwi = (i < 4) ? hw[0][i & 3] : hw[1][i & 3]; hf[i] = (f32x2v){bflo(hwi), bfhi(hwi)}; }
#pragma unroll
        for (int j = 0; j < 8; ++j) {
            f32x2v acc0 = __builtin_amdgcn_cvt_pk_f32_fp8(uu[j].x, false) * hf[0];
            f32x2v acc1 = __builtin_amdgcn_cvt_pk_f32_fp8(uu[j].x, true) * hf[1];
            acc0 = __builtin_amdgcn_cvt_pk_f32_fp8(uu[j].y, false) * hf[2] + acc0;
            acc1 = __builtin_amdgcn_cvt_pk_f32_fp8(uu[j].y, true) * hf[3] + acc1;
            acc0 = __builtin_amdgcn_cvt_pk_f32_fp8(uu[j].z, false) * hf[4] + acc0;
            acc1 = __builtin_amdgcn_cvt_pk_f32_fp8(uu[j].z, true) * hf[5] + acc1;
            acc0 = __builtin_amdgcn_cvt_pk_f32_fp8(uu[j].w, false) * hf[6] + acc0;
            acc1 = __builtin_amdgcn_cvt_pk_f32_fp8(uu[j].w, true) * hf[7] + acc1;
            acc0 += acc1;
            a[j] = acc0.x + acc0.y;
        }
    }
    __builtin_amdgcn_sched_barrier(0);
    hw[0] = *(const u32x4*)hnext; hw[1] = *(const u32x4*)(hnext + 8);
#pragma unroll
    for (int j = 0; j < 8; ++j) uu[j] = rowload(U8, lane * 16, en[j]);
    __builtin_amdgcn_sched_barrier(0);
    float k1[4], k2[2], k3;
#pragma unroll
    for (int i = 0; i < 4; ++i) k1[i] = pair32(a[i], a[4 + i]);
#pragma unroll
    for (int i = 0; i < 2; ++i) k2[i] = pair16(k1[i], k1[2 + i]);
    { const float snd = b3 ? k2[0] : k2[1]; k3 = (b3 ? k2[1] : k2[0]) + dppf<0x128>(snd); }
    k3 += dppf<0x141>(k3);
    k3 += dppf<0xB1>(k3);
    k3 += dppf<0x4E>(k3);
    const int ei = ebase + (jl < n ? jl : 0);
    return (jl < n) ? Eg[ei] * gelu_fast(k3 * Es[ei]) : 0.f;
}
DI void p6x_axpy(u32x4 (&vv)[8], rsrc_t V8, const unsigned (&en)[8], bool refill, float w, f32x2v (&y2)[8], int lane) {
#pragma unroll
    for (int j = 0; j < 8; ++j) {
        const int src = 32 * (j >> 2) + 16 * ((j >> 1) & 1) + 8 * (j & 1);
        const float wj = __uint_as_float(__builtin_amdgcn_readlane(__float_as_uint(w), src));
        const f32x2v wj2 = {wj, wj};
        const unsigned wd[4] = {vv[j].x, vv[j].y, vv[j].z, vv[j].w};
#pragma unroll
        for (int q = 0; q < 4; ++q) { y2[2 * q] = __builtin_amdgcn_cvt_pk_f32_fp8(wd[q], false) * wj2 + y2[2 * q]; y2[2 * q + 1] = __builtin_amdgcn_cvt_pk_f32_fp8(wd[q], true) * wj2 + y2[2 * q + 1]; }
    }
    __builtin_amdgcn_sched_barrier(0);
#pragma unroll
    for (int j = 0; j < 8; ++j) vv[j] = rowload(V8, lane * 16, en[j]);
    __builtin_amdgcn_sched_barrier(0);
}
#define P6X_AXPY(T) p6x_axpy(V, V8, en, more, w_, y2[T], lane)

template <bool DRY> DI void p6x_block(const Params& p, int l, int tok_first, int ntok, const float* X1, float* xout, char* lds) {
    int tid_ = threadIdx.x; asm volatile("" : "+v"(tid_)); const int tid = tid_, lane = tid & 63;
    const int wv = __builtin_amdgcn_readfirstlane(tid >> 6);
    unsigned* LA = (unsigned*)(lds + wv * 16384); unsigned* LB = LA + 1024; unsigned* Ee = LA + 2048; float* Eg = (float*)(LA + 3072); float* Es = (float*)LA;
    const unsigned* cnt = LB; const unsigned* off = LB + 8 * NR; unsigned* dl = LB + 24 * NR;
    const rsrc_t U8 = __builtin_amdgcn_make_buffer_rsrc((void*)p.U8, 0, 16384 * D, 0x00020000), V8 = __builtin_amdgcn_make_buffer_rsrc((void*)p.V8, 0, 16384 * D, 0x00020000);
    const int jl = 4 * (lane >> 5) + 2 * ((lane >> 4) & 1) + ((lane >> 3) & 1);
    const bool b5 = lane & 32, b4 = lane & 16, b3 = lane & 8;
    const int per_wave = ntok >> 2;
    __syncthreads();
#pragma unroll 1
    for (int g8 = 0; g8 < per_wave; g8 += 8) {
        const int tokb = tok_first + wv * per_wave + g8;
        { int lc = lane; asm volatile("" : "+v"(lc)); p6x_combine(p, l, tokb, LA, LB, Ee, Eg, Es, lc); }
#pragma unroll 1
        for (int sw = 0; sw < 2; ++sw) {
            int nd;
            {
                int lane_d = lane; asm volatile("" : "+v"(lane_d));
                const bool rev = ((g8 >> 3) * 2 + sw) & 1;
                const int rr = (lane_d >> 2) & (NR - 1), t = lane_d & 3, r = rev ? (NR - 1 - rr) : rr, ti = sw * 4 + t;
                const int n = (lane_d < 4 * NR) ? (int)cnt[ti * NR + r] : 0, base = (int)off[ti * NR + r];
                const int nbat = (n + 7) >> 3;
                int incl = nbat;
#pragma unroll
                for (int o = 1; o < 64; o <<= 1) { const int up = __shfl_up(incl, o); if (lane_d >= o) incl += up; }
                const int start = incl - nbat;
                for (int k = 0; k < nbat; ++k) { const int rem = n - 8 * k; dl[start + k] = ((unsigned)t << 14) | ((unsigned)(rem < 8 ? rem : 8) << 10) | (unsigned)(ti * 128 + base + 8 * k); }
                nd = __builtin_amdgcn_readlane(incl, 63);
            }
            f32x2v y2[4][8];
#pragma unroll
            for (int t = 0; t < 4; ++t)
#pragma unroll
                for (int i = 0; i < 8; ++i) y2[t][i] = (f32x2v){0.f, 0.f};
            const bf16* hbase = p.H + (size_t)(tokb + sw * 4) * D + lane * 16;
            u32x4 U[8], V[8]; unsigned en[8];
            unsigned dA = __builtin_amdgcn_readfirstlane(dl[0]);
            u32x4 hw[2];
            if (nd > 0) { p6x_ids<DRY>(en, Ee, dA); p6x_issue(U, U8, en, lane * 16); p6x_issue(V, V8, en, lane * 16); const bf16* hr = hbase + (size_t)(dA >> 14) * D; hw[0] = *(const u32x4*)hr; hw[1] = *(const u32x4*)(hr + 8); }
#pragma unroll 1
            for (int i = 0; i < nd; ++i) {
                const bool more = i + 1 < nd;
                const unsigned dB = __builtin_amdgcn_readfirstlane(dl[more ? i + 1 : i]);
                p6x_ids<DRY>(en, Ee, dB);
                const int t_ = (int)(dA >> 14);
                const float w_ = p6x_dots(U, U8, en, more, hw, hbase + (size_t)(dB >> 14) * D, Eg, Es, dA, lane, jl, b5, b4, b3);
                switch (t_) { case 0: P6X_AXPY(0); break; case 1: P6X_AXPY(1); break; case 2: P6X_AXPY(2); break; default: P6X_AXPY(3); break; }
                dA = dB;
            }
#pragma unroll
            for (int t = 0; t < 4; ++t) {
                int lane_e = lane; asm volatile("" : "+v"(lane_e));
                const int tok = tokb + sw * 4 + t;
                const int b = (p.tok0 + tok) / SEQ;
                const float* mod = p.MOD + ((size_t)l * BATCH + b) * 6 * D;
                float v[16], gt[16];
                load16c(v, X1 + (size_t)tok * D, lane_e); load16c(gt, mod + 5 * D, lane_e);
#pragma unroll
                for (int i = 0; i < 8; ++i) { v[2 * i] = DN_ALPHA * v[2 * i] + (1.f + gt[2 * i]) * y2[t][i].x; v[2 * i + 1] = DN_ALPHA * v[2 * i + 1] + (1.f + gt[2 * i + 1]) * y2[t][i].y; }
                ln16c(v, p.in[23] + l * D, p.in[24] + l * D, lane_e);
                if (DRY) {
#pragma unroll
                    for (int i = 0; i < 16; ++i) asm volatile("" :: "v"(v[i]));
                    continue; }
                store16c(xout + (size_t)tok * D, v, lane_e);
                if (l + 1 < DEPTH) { const float* modn = p.MOD + ((size_t)(l + 1) * BATCH + b) * 6 * D; store_mod16c(p.H + (size_t)tok * D, v, modn, modn + D, lane_e); }
                __builtin_amdgcn_sched_barrier(0);
            }
        }
    }
}
#ifdef P6_NOPTAIL
#define P6_TAILNOP "\n\ts_nop 7\n\ts_nop 7\n\ts_nop 7\n\ts_nop 7\n\ts_nop 7\n\ts_nop 7\n\ts_nop 7\n\ts_nop 7"
#else
#define P6_TAILNOP
#endif
#ifdef P6C_SAFE
#define P6C_W10 "s_waitcnt vmcnt(0)"
#else
#define P6C_W10 "s_waitcnt vmcnt(10)"
#endif

DI u32x4 p6a_rsrc(const unsigned char* base) {
    const unsigned long long a = (unsigned long long)base;
    u32x4 r; r.x = __builtin_amdgcn_readfirstlane((unsigned)a); r.y = __builtin_amdgcn_readfirstlane((unsigned)(a >> 32) & 0xffffu); r.z = 16384u * (unsigned)D; r.w = 0x00020000u;
    return r;
}
#ifndef P6_DRYMODE
#define P6_DRYMODE 0
#endif
#ifndef P6_FULLBATCH
#define P6_FULLBATCH 0
#endif
#ifndef P6_LDMOD
#define P6_LDMOD ""
#endif
#ifndef P6_SWEEPSYNC
#define P6_SWEEPSYNC 0
#endif
#ifndef P6_DRYMASK
#define P6_DRYMASK 0
#endif
template <bool DRY> DI void p6a_ids(unsigned (&en)[8], const unsigned* Ee, unsigned desc, int lane) {
    const int ebase = desc & 0x3ff, n = (desc >> 10) & 0xf, j = lane & 7;
    const unsigned ev = (Ee[ebase + (j < n ? j : 0)] & ((DRY && (P6_DRYMODE == 1 || P6_DRYMASK)) ? 1023u : 0xffffu)) * (unsigned)D;
#pragma unroll
    for (int k = 0; k < 8; ++k) en[k] = __builtin_amdgcn_readlane(ev, k);
}
DI void p6a_load8(u32x4 (&b)[8], u32x4 rsrc, int voff, const unsigned (&so)[8]) {
    asm volatile("s_nop 4\n\t"
        "buffer_load_dwordx4 %0, %8, %9, %10 offen" P6_LDMOD "\n\t" "buffer_load_dwordx4 %1, %8, %9, %11 offen" P6_LDMOD "\n\t" "buffer_load_dwordx4 %2, %8, %9, %12 offen" P6_LDMOD "\n\t" "buffer_load_dwordx4 %3, %8, %9, %13 offen" P6_LDMOD "\n\t"
        "buffer_load_dwordx4 %4, %8, %9, %14 offen" P6_LDMOD "\n\t" "buffer_load_dwordx4 %5, %8, %9, %15 offen" P6_LDMOD "\n\t" "buffer_load_dwordx4 %6, %8, %9, %16 offen" P6_LDMOD "\n\t" "buffer_load_dwordx4 %7, %8, %9, %17 offen" P6_LDMOD P6_TAILNOP
        : "=&v"(b[0]), "=&v"(b[1]), "=&v"(b[2]), "=&v"(b[3]), "=&v"(b[4]), "=&v"(b[5]), "=&v"(b[6]), "=&v"(b[7])
        : "v"(voff), "s"(rsrc), "s"(so[0]), "s"(so[1]), "s"(so[2]), "s"(so[3]), "s"(so[4]), "s"(so[5]), "s"(so[6]), "s"(so[7])
        : "memory");
}
DI void p6a_loadh(u32x4 (&h)[2], const bf16* src) {
    asm volatile("global_load_dwordx4 %0, %2, off\n\tglobal_load_dwordx4 %1, %2, off offset:16" : "=&v"(h[0]), "=&v"(h[1]) : "v"(src) : "memory");
}
DI void p6a_wait_hu(u32x4 (&h)[2], u32x4 (&b)[8]) {
    asm volatile("s_waitcnt vmcnt(8)" : "+v"(h[0]), "+v"(h[1]), "+v"(b[0]), "+v"(b[1]), "+v"(b[2]), "+v"(b[3]), "+v"(b[4]), "+v"(b[5]), "+v"(b[6]), "+v"(b[7]) :: "memory");
}
DI void p6a_wait_v(u32x4 (&b)[8]) {
    asm volatile(P6C_W10  : "+v"(b[0]), "+v"(b[1]), "+v"(b[2]), "+v"(b[3]), "+v"(b[4]), "+v"(b[5]), "+v"(b[6]), "+v"(b[7]) :: "memory");
}
DI void p6a_drain(u32x4 (&h)[2], u32x4 (&u)[8], u32x4 (&v)[8]) {
    asm volatile("s_waitcnt vmcnt(0)" : "+v"(h[0]), "+v"(h[1]), "+v"(u[0]), "+v"(u[1]), "+v"(u[2]), "+v"(u[3]), "+v"(u[4]), "+v"(u[5]), "+v"(u[6]), "+v"(u[7]),
                                        "+v"(v[0]), "+v"(v[1]), "+v"(v[2]), "+v"(v[3]), "+v"(v[4]), "+v"(v[5]), "+v"(v[6]), "+v"(v[7]) :: "memory");
}
DI void p6a_dot8(float (&a)[8], const u32x4 (&uu)[8], const u32x4 (&hw)[2]) {
    f32x2v hf[8];
#pragma unroll
    for (int i = 0; i < 8; ++i) { const unsigned hwi = (i < 4) ? hw[0][i & 3] : hw[1][i & 3]; hf[i] = (f32x2v){bflo(hwi), bfhi(hwi)}; }
#pragma unroll
    for (int j = 0; j < 8; ++j) {
        f32x2v acc0 = __builtin_amdgcn_cvt_pk_f32_fp8(uu[j].x, false) * hf[0];
        f32x2v acc1 = __builtin_amdgcn_cvt_pk_f32_fp8(uu[j].x, true) * hf[1];
        acc0 = __builtin_amdgcn_cvt_pk_f32_fp8(uu[j].y, false) * hf[2] + acc0;
        acc1 = __builtin_amdgcn_cvt_pk_f32_fp8(uu[j].y, true) * hf[3] + acc1;
        acc0 = __builtin_amdgcn_cvt_pk_f32_fp8(uu[j].z, false) * hf[4] + acc0;
        acc1 = __builtin_amdgcn_cvt_pk_f32_fp8(uu[j].z, true) * hf[5] + acc1;
        acc0 = __builtin_amdgcn_cvt_pk_f32_fp8(uu[j].w, false) * hf[6] + acc0;
        acc1 = __builtin_amdgcn_cvt_pk_f32_fp8(uu[j].w, true) * hf[7] + acc1;
        acc0 += acc1;
        a[j] = acc0.x + acc0.y;
    }
}
DI float p6a_reduce_gate(const float (&a)[8], const float* Eg, const float* Es, unsigned desc, int jl, bool b3) {
    const int ebase = desc & 0x3ff, n = (desc >> 10) & 0xf;
    float k1[4], k2[2], k3;
#pragma unroll
    for (int i = 0; i < 4; ++i) k1[i] = pair32(a[i], a[4 + i]);
#pragma unroll
    for (int i = 0; i < 2; ++i) k2[i] = pair16(k1[i], k1[2 + i]);
    { const float snd = b3 ? k2[0] : k2[1]; k3 = (b3 ? k2[1] : k2[0]) + dppf<0x128>(snd); }
    k3 += dppf<0x141>(k3); k3 += dppf<0xB1>(k3); k3 += dppf<0x4E>(k3);
    const int ei = ebase + (jl < n ? jl : 0);
    return (jl < n) ? Eg[ei] * gelu_fast(k3 * Es[ei]) : 0.f;
}
DI void p6a_axpy8(const u32x4 (&vv)[8], float w, f32x2v (&y2)[8]) {
#pragma unroll
    for (int j = 0; j < 8; ++j) {
        const int src = 32 * (j >> 2) + 16 * ((j >> 1) & 1) + 8 * (j & 1);
        const float wj = __uint_as_float(__builtin_amdgcn_readlane(__float_as_uint(w), src));
        const f32x2v wj2 = {wj, wj};
        const unsigned wd[4] = {vv[j].x, vv[j].y, vv[j].z, vv[j].w};
#pragma unroll
        for (int q = 0; q < 4; ++q) { y2[2 * q] = __builtin_amdgcn_cvt_pk_f32_fp8(wd[q], false) * wj2 + y2[2 * q]; y2[2 * q + 1] = __builtin_amdgcn_cvt_pk_f32_fp8(wd[q], true) * wj2 + y2[2 * q + 1]; }
    }
}
template <bool DRY> DI void p6a_block(const Params& p, int l, int tok_first, int ntok, const float* X1, float* xout, char* lds) {
    int tid_ = threadIdx.x; asm volatile("" : "+v"(tid_)); const int tid = tid_, lane = tid & 63;
    const int wv = __builtin_amdgcn_readfirstlane(tid >> 6);
    unsigned* LA = (unsigned*)(lds + wv * 16384); unsigned* LB = LA + 1024; unsigned* Ee = LA + 2048; float* Eg = (float*)(LA + 3072); float* Es = (float*)LA;
    const unsigned* cnt = LB; const unsigned* off = LB + 8 * NR; unsigned* dl = LB + 24 * NR;
    const u32x4 rU = p6a_rsrc(p.U8), rV = p6a_rsrc(p.V8);
    const int jl = 4 * (lane >> 5) + 2 * ((lane >> 4) & 1) + ((lane >> 3) & 1);
    const bool b5 = lane & 32, b4 = lane & 16, b3 = lane & 8;
    const int per_wave = ntok >> 2;
    __syncthreads();
#pragma unroll 1
    for (int g8 = 0; g8 < per_wave; g8 += 8) {
        const int tokb = tok_first + wv * per_wave + g8;
        { int lc = lane; asm volatile("" : "+v"(lc)); p6x_combine(p, l, tokb, LA, LB, Ee, Eg, Es, lc); }
#pragma unroll 1
        for (int sw = 0; sw < 2; ++sw) {
            int nd;
#if P6_FULLBATCH
            {
                int lane_d = lane; asm volatile("" : "+v"(lane_d));
                const bool rev = ((g8 >> 3) * 2 + sw) & 1;
                const int kk = lane_d >> 2, t = lane_d & 3, k = rev ? (15 - kk) : kk, ti = sw * 4 + t;
                dl[lane_d] = ((unsigned)t << 14) | (8u << 10) | (unsigned)(ti * 128 + 8 * k);
                nd = 64; asm volatile("" : "+s"(nd));
            }
#else
            {
                int lane_d = lane; asm volatile("" : "+v"(lane_d));
                const bool rev = ((g8 >> 3) * 2 + sw) & 1;
                const int rr = (lane_d >> 2) & (NR - 1), t = lane_d & 3, r = rev ? (NR - 1 - rr) : rr, ti = sw * 4 + t;
                const int n = (lane_d < 4 * NR) ? (int)cnt[ti * NR + r] : 0, base = (int)off[ti * NR + r];
                const int nbat = (n + 7) >> 3;
                int incl = nbat;
#pragma unroll
                for (int o = 1; o < 64; o <<= 1) { const int up = __shfl_up(incl, o); if (lane_d >= o) incl += up; }
                const int start = incl - nbat;
                for (int k = 0; k < nbat; ++k) { const int rem = n - 8 * k; dl[start + k] = ((unsigned)t << 14) | ((unsigned)(rem < 8 ? rem : 8) << 10) | (unsigned)(ti * 128 + base + 8 * k); }
                nd = __builtin_amdgcn_readlane(incl, 63);
            }
#endif
#if P6_SWEEPSYNC
            { XcdBarrier xb_; xb_.bar = p.ctr + 4096; xb_.x = xb_xcc_id(); xb_.st = (volatile LAS unsigned*)(lds + LDS_TOTAL - 32); xcd_barrier(xb_); }
#endif
            f32x2v y2[4][8];
#pragma unroll
            for (int t = 0; t < 4; ++t)
#pragma unroll
                for (int i = 0; i < 8; ++i) y2[t][i] = (f32x2v){0.f, 0.f};
            const bf16* hbase = p.H + (size_t)(tokb + sw * 4) * D + lane * 16;
            u32x4 U[8], V[8], hw[2]; unsigned en[8];
            asm volatile("s_waitcnt vmcnt(0)" ::: "memory");
            unsigned dA = __builtin_amdgcn_readfirstlane(dl[0]);
            { p6a_ids<DRY>(en, Ee, dA, lane); p6a_loadh(hw, hbase + (size_t)(dA >> 14) * D); p6a_load8(U, rU, lane * 16, en); p6a_load8(V, rV, lane * 16, en); }
#pragma unroll 1
            for (int i = 0; i < nd; ++i) {
                const unsigned dB = __builtin_amdgcn_readfirstlane(dl[i + 1 < nd ? i + 1 : i]);
                p6a_ids<DRY>(en, Ee, dB, lane);
                const int t_ = (int)(dA >> 14);
                if (DRY && P6_DRYMODE == 4) p6a_drain(hw, U, V); else if (!(DRY && P6_DRYMODE == 2)) p6a_wait_hu(hw, U);
                float a[8];
                if (DRY && (P6_DRYMODE == 3 || P6_DRYMODE == 4)) {
#pragma unroll
                    for (int j = 0; j < 8; ++j) a[j] = __uint_as_float(U[j].x); }
                else p6a_dot8(a, U, hw);
                __builtin_amdgcn_sched_barrier(0);
                if (!(DRY && P6_DRYMODE == 2)) { p6a_loadh(hw, hbase + (size_t)(dB >> 14) * D); p6a_load8(U, rU, lane * 16, en); }
                __builtin_amdgcn_sched_barrier(0);
                const float w_ = p6a_reduce_gate(a, Eg, Es, dA, jl, b3);
                if (!(DRY && (P6_DRYMODE == 2 || P6_DRYMODE == 4))) p6a_wait_v(V);
                if (DRY && (P6_DRYMODE == 3 || P6_DRYMODE == 4)) { y2[0][0].x += w_ * __uint_as_float(V[0].x ^ V[1].x ^ V[2].x ^ V[3].x ^ V[4].x ^ V[5].x ^ V[6].x ^ V[7].x); } else
                switch (t_) { case 0: p6a_axpy8(V, w_, y2[0]); break; case 1: p6a_axpy8(V, w_, y2[1]); break; case 2: p6a_axpy8(V, w_, y2[2]); break; default: p6a_axpy8(V, w_, y2[3]); break; }
                __builtin_amdgcn_sched_barrier(0);
                if (!(DRY && (P6_DRYMODE == 2 || P6_DRYMODE == 4))) p6a_load8(V, rV, lane * 16, en);
                __builtin_amdgcn_sched_barrier(0);
                dA = dB;
            }
            p6a_drain(hw, U, V);
#pragma unroll
            for (int t = 0; t < 4; ++t) {
                int lane_e = lane; asm volatile("" : "+v"(lane_e));
                const int tok = tokb + sw * 4 + t;
                const int b = (p.tok0 + tok) / SEQ;
                const float* mod = p.MOD + ((size_t)l * BATCH + b) * 6 * D;
                float v[16], gt[16];
                load16c(v, X1 + (size_t)tok * D, lane_e); load16c(gt, mod + 5 * D, lane_e);
                {
                    const float mean1 = p.STATS[2 * (size_t)tok], rstd1 = p.STATS[2 * (size_t)tok + 1];
                    float g1[16], b1[16]; load16c(g1, p.in[17] + l * D, lane_e); load16c(b1, p.in[18] + l * D, lane_e);
#pragma unroll
                    for (int i = 0; i < 16; ++i) v[i] = (v[i] - mean1) * rstd1 * g1[i] + b1[i];
                }
#pragma unroll
                for (int i = 0; i < 8; ++i) { v[2 * i] = DN_ALPHA * v[2 * i] + (1.f + gt[2 * i]) * y2[t][i].x; v[2 * i + 1] = DN_ALPHA * v[2 * i + 1] + (1.f + gt[2 * i + 1]) * y2[t][i].y; }
                ln16c(v, p.in[23] + l * D, p.in[24] + l * D, lane_e);
                if (DRY) {
#pragma unroll
                    for (int i = 0; i < 16; ++i) asm volatile("" :: "v"(v[i]));
                    continue; }
                store16c(xout + (size_t)tok * D, v, lane_e);
                if (l + 1 < DEPTH) { const float* modn = p.MOD + ((size_t)(l + 1) * BATCH + b) * 6 * D; store_mod16c(p.H + (size_t)tok * D, v, modn, modn + D, lane_e); }
                __builtin_amdgcn_sched_barrier(0);
            }
        }
    }
}
#define XB_TMO      128
#define XB_XCNT(j)  (256  + 64 * (j))
#define XB_XSUB(j)  (1280 + 64 * (j))
#define XB_XGEN(j)  (2304 + 64 * (j))
#define XB_TOP      3328
#define XB_TOPGEN   3392
#define XCD_BAR_WORDS 3456
#define XB_SPIN_CAP (1u << 22)
#define LAS __attribute__((address_space(3)))
DI unsigned xb_ld(unsigned* p)              { return __hip_atomic_load(p, __ATOMIC_RELAXED, __HIP_MEMORY_SCOPE_AGENT); }
DI unsigned xb_add(unsigned* p, unsigned v) { return __hip_atomic_fetch_add(p, v, __ATOMIC_RELAXED, __HIP_MEMORY_SCOPE_AGENT); }
DI unsigned xb_xcc_id() { return (unsigned)__builtin_amdgcn_s_getreg((3 << 11) | 20) & 0xFu; }
#define XB_SPIN(cond, bar) do { unsigned _sp = 0; while (cond) { __builtin_amdgcn_s_sleep(1); \
    if ((++_sp & 255u) == 0u) { if (xb_ld(&(bar)[XB_TMO])) break; if (_sp > XB_SPIN_CAP) { atomicAdd(&(bar)[XB_TMO], 1u); break; } } } } while (0)
struct XcdBarrier { unsigned* bar; unsigned x; volatile LAS unsigned* st; };
DI XcdBarrier xcd_barrier_post(unsigned* bar, volatile LAS unsigned* st) {
    XcdBarrier b; b.bar = bar; b.x = xb_xcc_id(); b.st = st;
    if (threadIdx.x == 0) st[2] = xb_add(&bar[XB_XCNT(b.x)], 1u);
    return b;
}
DI void xcd_barrier_complete(unsigned* bar, unsigned x, unsigned& nloc, unsigned& nx) {
    const unsigned G = gridDim.x * gridDim.y * gridDim.z;
    unsigned sum, cnt, mine, sp = 0u;
    for (;;) {
        sum = 0u; cnt = 0u; mine = 0u;
#pragma unroll
        for (unsigned j = 0; j < 16; ++j) { const unsigned c = xb_ld(&bar[XB_XCNT(j)]); sum += c; cnt += (c > 0u) ? 1u : 0u; mine = (j == x) ? c : mine; }
        if (sum == G) break;
        __builtin_amdgcn_s_sleep(1);
        if ((++sp & 255u) == 0u) { if (xb_ld(&bar[XB_TMO])) break; if (sp > XB_SPIN_CAP) { atomicAdd(&bar[XB_TMO], 1u); break; } }
    }
    nloc = mine > 0u ? mine : 1u; nx = cnt > 0u ? cnt : 1u;
}
DI void xcd_barrier(const XcdBarrier& b) {
    asm volatile("s_waitcnt vmcnt(0)" ::: "memory");
    __syncthreads();
    if (threadIdx.x == 0) {
        unsigned* bar = b.bar;
        __builtin_amdgcn_s_waitcnt(0);
        unsigned nloc = b.st[0], nx = b.st[1];
        if (nloc == 0u) { xcd_barrier_complete(bar, b.x, nloc, nx); b.st[0] = nloc; b.st[1] = nx; }
        const unsigned old = xb_add(&bar[XB_XSUB(b.x)], 1u);
        const unsigned gen = old / nloc;
        if (old + 1u == (gen + 1u) * nloc) {
            __builtin_amdgcn_fence(__ATOMIC_RELEASE, "agent");
            asm volatile("s_waitcnt vmcnt(0)" ::: "memory");
            const unsigned og = xb_add(&bar[XB_TOP], 1u);
            const unsigned tg = og / nx;
            if (og + 1u == (tg + 1u) * nx) xb_add(&bar[XB_TOPGEN], 1u);
            else XB_SPIN(xb_ld(&bar[XB_TOPGEN]) == tg, bar);
            __builtin_amdgcn_fence(__ATOMIC_ACQUIRE, "agent");
            xb_add(&bar[XB_XGEN(b.x)], 1u);
            asm volatile("s_waitcnt vmcnt(0)" ::: "memory");
        } else {
            XB_SPIN(xb_ld(&bar[XB_XGEN(b.x)]) == gen, bar);
            __builtin_amdgcn_fence(__ATOMIC_ACQUIRE, "agent");
            asm volatile("s_waitcnt vmcnt(0)" ::: "memory");
        }
    }
    __syncthreads();
}
DI void ada_item(const Params& p, int item, char* lds) {
    int tid_ = threadIdx.x; asm volatile("" : "+v"(tid_)); const int tid = tid_, lane = tid & 63, wv = tid >> 6;
    float* cs = (float*)lds;
    float* part = cs + 4 * D;
    __syncthreads();
    for (int i = tid; i < BATCH * D; i += 256) { const float cv = p.in[1][i]; cs[i] = cv / (1.f + __expf(-cv)); }
    __syncthreads();
    const int col = item * 64 + lane, l = col / (6 * D), j = col % (6 * D);
    const float* w = p.in[2] + (size_t)l * D * 6 * D + j;
    float a0 = 0.f, a1 = 0.f, a2 = 0.f, a3 = 0.f;
#pragma unroll 16
    for (int k = wv * 256; k < wv * 256 + 256; ++k) { const float wk = w[(size_t)k * 6 * D]; a0 += cs[k] * wk; a1 += cs[D + k] * wk; a2 += cs[2 * D + k] * wk; a3 += cs[3 * D + k] * wk; }
    part[(wv * 4 + 0) * 64 + lane] = a0; part[(wv * 4 + 1) * 64 + lane] = a1; part[(wv * 4 + 2) * 64 + lane] = a2; part[(wv * 4 + 3) * 64 + lane] = a3;
    __syncthreads();
    {
        const float s = part[(0 * 4 + wv) * 64 + lane] + part[(1 * 4 + wv) * 64 + lane] + part[(2 * 4 + wv) * 64 + lane] + part[(3 * 4 + wv) * 64 + lane];
        p.MOD[((size_t)l * BATCH + wv) * 6 * D + j] = s + p.in[3][l * 6 * D + j];
    }
}

DI void rope_table_item(const Params& p, int idx) {
    const int pos = idx >> 4, i = idx & 15;
    const float inv = 1.0f / powf(10000.0f, (float)(2 * i) / 32.0f);
    const float ang = (float)pos * inv;
    double fr = (double)ang * 0.15915494309189535;
    fr -= rint(fr);
    const float f = (float)fr;
    p.COS[idx] = __builtin_amdgcn_cosf(f); p.SIN[idx] = __builtin_amdgcn_sinf(f);
}

DI void convert_tables(const Params& p, int l, int bid, int nb) {
    const float* us = p.in[21] + (size_t)l * 16384 * D; const float* vs = p.in[22] + (size_t)l * 16384 * D;
    const size_t n8 = (size_t)16384 * D / 8;
    for (size_t i = (size_t)bid * 256 + threadIdx.x; i < n8; i += (size_t)nb * 256) { cvt8(us, p.Ut, i); cvt8(vs, p.Vt, i); }
}

DI void prologue(const Params& p, char* lds) {
    int tid_ = threadIdx.x; asm volatile("" : "+v"(tid_)); const int tid = tid_, lane = tid & 63, wv = tid >> 6, bid = blockIdx.x, nb = gridDim.x;
    for (int it = bid; it < DEPTH * 6 * D / 64; it += nb) ada_item(p, it, lds);
    __syncthreads();
    float* scr = (float*)(lds + wv * 16384);
    const int n_win = (D / 64) * (WIN_N / 32), n_uq = 4 * 24, n_ukv = 2 * 32, n_wo = 16 * 32, n_pq = 16 * 64, per_l = n_win + n_uq + n_ukv + n_wo + n_pq;
    for (int it = bid * 4 + wv; it < DEPTH * per_l; it += nb * 4) {
        const int l = it / per_l; int r = it % per_l;
        if (r < n_win) { transpose_item(TK_WIN, p.in[4] + (size_t)l * D * D_IN, D_IN, D, WIN_N, p.WinT + (size_t)l * WIN_N * D, nullptr, scr, r, lane); continue; } r -= n_win;
        if (r < n_uq) { transpose_item(TK_WUQ, p.in[6] + (size_t)l * 256 * 768, 768, 256, 768, p.WuqT + (size_t)l * 768 * 256, p.in[5] + l * 256, scr, r, lane); continue; } r -= n_uq;
        if (r < n_ukv) { transpose_item(TK_WUKV, p.in[8] + (size_t)l * 128 * 1024, 1024, 128, 1024, p.WukvT + (size_t)l * 1024 * 128, p.in[7] + l * 128, scr, r, lane); continue; } r -= n_ukv;
        if (r < n_wo) { transpose_item(TK_WO, p.in[16] + (size_t)l * D * D, D, D, D, p.WoT + (size_t)l * D * D, nullptr, scr, r, lane); continue; } r -= n_wo;
        transpose_item(TK_WPQ, p.in[19] + (size_t)l * D * 2048, 2048, D, 2048, p.WpqT + (size_t)l * 2048 * D, nullptr, scr, r, lane);
    }
    for (int it = bid; it < DEPTH * 1028; it += nb) fold_pw_item(p, it / 1028, it % 1028);
    for (size_t i = (size_t)bid * 256 + tid; i < (size_t)DEPTH * 16 * 128 * 128; i += (size_t)nb * 256)
        p.SKp[i] = f2bf(p.in[20][(i & ~(size_t)127) + perm16((int)(i & 127))]);
    for (int i = bid * 256 + tid; i < SEQ * 16; i += nb * 256) rope_table_item(p, i);
    convert_tables_fp8(p, 0, bid, nb);
}

DI void modh_items(const Params& p, int bid, int nb) {
    const size_t n8 = (size_t)p.rows * D / 8;
    for (size_t i = (size_t)bid * 256 + threadIdx.x; i < n8; i += (size_t)nb * 256) {
        const size_t e = i * 8; const int row = (int)(e >> 10), col = (int)(e & 1023), b = row / SEQ;
        const float* mod = p.MOD + (size_t)b * 6 * D;
        const float4 x0 = *(const float4*)(p.in[0] + e), x1 = *(const float4*)(p.in[0] + e + 4);
        const float4 h0 = *(const float4*)(mod + col), h1 = *(const float4*)(mod + col + 4), s0 = *(const float4*)(mod + D + col), s1 = *(const float4*)(mod + D + col + 4);
        u32x4 o;
        o.x = pk2(x0.x * (1.f + s0.x) + h0.x, x0.y * (1.f + s0.y) + h0.y); o.y = pk2(x0.z * (1.f + s0.z) + h0.z, x0.w * (1.f + s0.w) + h0.w);
        o.z = pk2(x1.x * (1.f + s1.x) + h1.x, x1.y * (1.f + s1.y) + h1.y); o.w = pk2(x1.z * (1.f + s1.z) + h1.z, x1.w * (1.f + s1.w) + h1.w);
        *(u32x4*)(p.H + e) = o;
    }
}

#ifndef SWA_UNIT
#define SWA_UNIT swa_unit2
#endif
#ifndef MLA_UNIT
#define MLA_UNIT mla_unit2
#endif
#ifndef P6_BLOCK
#define P6_BLOCK p6a_block
#endif
#ifndef REP_P1
#define REP_P1 1
#endif
#ifndef REP_P2
#define REP_P2 1
#endif
#ifndef REP_P3
#define REP_P3 1
#endif
#ifndef REP_P4
#define REP_P4 1
#endif
#ifndef REP_P5
#define REP_P5 1
#endif
#ifndef REP_SYNC
#define REP_SYNC 1
#endif
typedef const __attribute__((address_space(4))) Params* kparams_t;
#define LOADP(q) const Params& q = p
#define GSYNC() do { for (int rs_ = 0; rs_ < REP_SYNC; ++rs_) { XcdBarrier xb_; xb_.bar = p.ctr + 4096; xb_.x = xb_xcc_id(); xb_.st = (volatile LAS unsigned*)(lds + LDS_TOTAL - 32); xcd_barrier(xb_); } } while (0)
__global__ void __launch_bounds__(256, 2) mega(Params p) {
    extern __shared__ __attribute__((aligned(16))) char lds[];
#define bid ((int)blockIdx.x)
#define nb ((int)gridDim.x)
#define rows NTOK
#define mtiles (NTOK / 128)
    {
        if (threadIdx.x < 4) ((volatile LAS unsigned*)(lds + LDS_TOTAL - 32))[threadIdx.x] = 0u;
        __syncthreads();
    }
    (void)xcd_barrier_post(p.ctr + 4096, (volatile LAS unsigned*)(lds + LDS_TOTAL - 32));
#ifndef REP_PRO
#define REP_PRO 1
#endif
    for (int rep = 0; rep < REP_PRO; ++rep) prologue(p, lds);
    GSYNC();
    {
        volatile LAS unsigned* cw = (volatile LAS unsigned*)(lds + LDS_TOTAL - 32);
        if (threadIdx.x == 0) {
            unsigned pre = 0u, even = 1u; const unsigned myx = xb_xcc_id(); unsigned* bar_ = p.ctr + 4096;
            for (unsigned j = 0; j < 16; ++j) { const unsigned c = xb_ld(&bar_[XB_XCNT(j)]); if (j < myx) pre += c; if (j < 8 ? c * 8u != (unsigned)nb : c != 0u) even = 0u; }
            cw[3] = pre + cw[2]; cw[5] = even;
        }
        __syncthreads();
    }
#define SLOT ((int)((volatile LAS unsigned*)(lds + LDS_TOTAL - 32))[3])
#define XEVEN ((int)((volatile LAS unsigned*)(lds + LDS_TOTAL - 32))[5])
#define FOR_TILES(NT, T) for (int u_ = XEVEN ? (SLOT % (nb / 8)) : bid, T = 0; u_ < (XEVEN ? (mtiles / 8) * (NT) : mtiles * (NT)) && ((T = XEVEN ? ((SLOT / (nb / 8)) * (mtiles / 8) + u_ / (NT)) * (NT) + u_ % (NT) : u_), true); u_ += XEVEN ? nb / 8 : nb)
#ifndef REP_MODH
#define REP_MODH 1
#endif
    for (int rep = 0; rep < REP_MODH; ++rep) modh_items(p, bid, nb);
    GSYNC();
    for (int l = 0; l < DEPTH; ++l) {
        { LOADP(q);
#ifdef G3_PROBE
        for (int rep = 0; rep < REP_P1; ++rep) { __syncthreads(); if (threadIdx.x == 0) *(volatile int*)(lds + LDS_TOTAL - 64) = (rep + 1 < REP_P1) ? G3_PROBE : 0; __syncthreads(); FOR_TILES(12, t) p1_tile(q, l, t, lds); }
#else
        for (int rep = 0; rep < REP_P1; ++rep) FOR_TILES(12, t) p1_tile(q, l, t, lds);
#endif
#ifndef REP_CVT
#define REP_CVT 1
#endif
        if (l > 0) for (int rep = 0; rep < REP_CVT; ++rep) convert_tables_fp8(q, l, bid, nb);
        }
        GSYNC();
        { LOADP(q);
        for (int rep = 0; rep < REP_P2; ++rep) { FOR_TILES(6, t) p2q_tile(q, l, t, lds); FOR_TILES(8, t2) p2kv_tile(q, l, t2, lds); }
        }
        GSYNC();
        { LOADP(q);
        {
            const int nbt = rows / SEQ, nmla = nbt * 8 * 64, nswa = nbt * 4 * 64, nconv = rows / 32, ntot = nmla + nswa + nconv;
            int* su = (int*)(lds + LDS_TOTAL - 16);
            for (int rep = 0; rep < REP_P3; ++rep) { unsigned* ctr = q.ctr + l * 64 + rep * 16;
            for (;;) {
                __syncthreads();
                if (threadIdx.x == 0) *su = (int)atomicAdd(ctr, 1u);
                __syncthreads();
                const int u = *su;
                if (u >= ntot) break;
#ifdef P3_ABL
                if (u < nmla) { if (rep + 1 < REP_P3) MLA_UNIT<P3_ABL>(q, u, lds); else MLA_UNIT<0>(q, u, lds); }
#else
                if (u < nmla) MLA_UNIT<0>(q, u, lds);
#endif
                else if (u < nmla + nswa) SWA_UNIT(q, l, u - nmla, lds);
                else conv_unit(q, l, u - nmla - nswa, lds);
            } }
        }
        }
        GSYNC();
        { LOADP(q);
        for (int rep = 0; rep < REP_P4; ++rep) FOR_TILES(8, t) p4_tile(q, l, t, (l == 0) ? q.in[0] : q.XB, q.out, lds);
        }
        GSYNC();
        { LOADP(q);
        { int t_ = threadIdx.x; asm volatile("" : "+v"(t_)); const int wv = t_ >> 6, lane = t_ & 63; for (int r = bid * 4 + wv; r < rows; r += nb * 4) p4b_row(q, l, r, q.out, lane); }
        }
        GSYNC();
        { LOADP(q);
#ifdef G3_PROBE
        for (int rep = 0; rep < REP_P5; ++rep) { __syncthreads(); if (threadIdx.x == 0) *(volatile int*)(lds + LDS_TOTAL - 64) = (rep + 1 < REP_P5) ? G3_PROBE : 0; __syncthreads(); FOR_TILES(16, t) p5_tile(q, l, t, lds); }
#else
        for (int rep = 0; rep < REP_P5; ++rep) FOR_TILES(16, t) p5_tile(q, l, t, lds);
#endif
        }
        GSYNC();
        { LOADP(q);
        {
            const int slot = SLOT, per = rows / nb;
            if (per * nb == rows && (per & 31) == 0) {
#ifdef REP_P6
                for (int rep = 1; rep < REP_P6; ++rep) P6_BLOCK<true>(q, l, slot * per, per, q.out, (l + 1 < DEPTH) ? q.XB : q.out, lds);
#endif
                P6_BLOCK<false>(q, l, slot * per, per, q.out, (l + 1 < DEPTH) ? q.XB : q.out, lds); }
            else for (int u = bid; u < rows / 32; u += nb) p6f_unit(q, l, u, q.out, (l + 1 < DEPTH) ? q.XB : q.out, lds);
        }
        }
        if (l + 1 < DEPTH) GSYNC();
    }
}

#undef bid
#undef nb
#undef rows
#undef mtiles
extern "C" void kernel_launch(void* const* d_in, const int* in_sizes, int n_in, void* d_out, int out_size, void* d_ws, size_t ws_size, hipStream_t stream) {
    const size_t MiB = 1u << 20;
    char* ws = (char*)d_ws;
    Params P{};
    for (int i = 0; i < 25; ++i) P.in[i] = (const float*)d_in[i];
    P.out = (float*)d_out; P.rows = NTOK; P.tok0 = 0;
    size_t o = 0;
    auto take = [&](size_t mib) { char* r = ws + o; o += mib * MiB; return r; };
    char* ctl = take(1);
    P.ctr = (unsigned*)ctl; P.biasO = (float*)(ctl + 64 * 1024); P.MOD = (float*)(ctl + 128 * 1024);
    P.COS = (float*)take(1); P.SIN = P.COS + SEQ * 16;
    P.WinT = (bf16*)take(6); P.WuqT = (bf16*)take(1); P.WukvT = (bf16*)take(1); P.WoT = (bf16*)take(4); P.WpqT = (bf16*)take(8); P.SKp = (bf16*)take(1);
    P.U8 = (unsigned char*)take(16); P.V8 = (unsigned char*)take(16); P.US = (float*)take(1); P.VS = P.US + DEPTH * 16384;
    P.H = (bf16*)take(64); P.MIXIN = P.H;
    P.PROJ = (bf16*)take(80); P.Q = (bf16*)take(48); P.TOPK = (unsigned*)P.Q;
    P.KN = (bf16*)take(32); P.KR = (bf16*)take(2); P.VT = (bf16*)take(32); P.VsT = (bf16*)take(8);
    P.XB = (float*)take(128); P.STATS = (float*)take(1);
    if (o > ws_size) { fprintf(stderr, "kernel_launch: workspace too small: need %zu, have %zu\n", o, ws_size); return; }
    static int grid_blocks = 0;
    if (!grid_blocks) {
        int dev = 0, cus = 0, per_cu = 0;
        (void)hipGetDevice(&dev);
        (void)hipDeviceGetAttribute(&cus, hipDeviceAttributeMultiprocessorCount, dev);
        (void)hipFuncSetAttribute((const void*)mega, hipFuncAttributeMaxDynamicSharedMemorySize, LDS_TOTAL);
        (void)hipOccupancyMaxActiveBlocksPerMultiprocessor(&per_cu, mega, 256, LDS_TOTAL);
        if (per_cu > 2) per_cu = 2;
        if (per_cu < 1) per_cu = 1;
        grid_blocks = cus * per_cu;
    }
    (void)hipMemsetAsync(ctl, 0, 32768, stream);
    void* args[] = {(void*)&P};
    hipError_t e = hipLaunchCooperativeKernel((void*)mega, dim3(grid_blocks), dim3(256), args, LDS_TOTAL, stream);
    if (e != hipSuccess) fprintf(stderr, "cooperative launch failed: %s (grid %d)\n", hipGetErrorString(e), grid_blocks);
}
```
